# Optimizing an MI355X kernel written in HIP

```python
import jax, jax.numpy as jnp
from jax import lax
import numpy as np

D_MODEL = 1024
BATCH = 4
SEQ = 8192
DEPTH = 1

N_META = 16
BLOCK = 128
WINDOW = 128
N_PAD = BLOCK - N_META
ROPE_THETA = 10000.0
SWA_HEADS = 8
SWA_KV_HEADS = 2
SWA_HEAD_DIM = 64
MLA_HEADS = 4
MLA_Q_RANK = 256
MLA_KV_RANK = 256
MLA_NOPE_DIM = 128
MLA_ROPE_DIM = 64
MLA_V_DIM = 128
SWA_Q_COLS = SWA_HEADS * SWA_HEAD_DIM
SWA_KV_COLS = SWA_KV_HEADS * SWA_HEAD_DIM
MLA_OUT_COLS = MLA_HEADS * MLA_V_DIM
D_MIX = SWA_Q_COLS + MLA_OUT_COLS
IN_SPLITS = (SWA_Q_COLS, SWA_Q_COLS + SWA_KV_COLS, SWA_Q_COLS + 2 * SWA_KV_COLS,
             SWA_Q_COLS + 2 * SWA_KV_COLS + MLA_Q_RANK,
             SWA_Q_COLS + 2 * SWA_KV_COLS + MLA_Q_RANK + MLA_KV_RANK)
IN_COLS = SWA_Q_COLS + 2 * SWA_KV_COLS + MLA_Q_RANK + MLA_KV_RANK + MLA_ROPE_DIM
N_GROUPS = 4
EXPERTS_PER_GROUP = 8
N_EXPERTS = N_GROUPS * EXPERTS_PER_GROUP
TOP_K = 2
D_EXPERT = 256
LN_EPS = 1e-5
RMS_EPS = 1e-6
ALPHA = (2.0 * DEPTH) ** 0.25
BETA = (8.0 * DEPTH) ** -0.25
NEG = -1e30

kernel_name = "hymba_swa_sink_mla_hier_moe_deepnorm"


def layer_norm(x, g, b):
    xf = x.astype(jnp.float32)
    mu = jnp.mean(xf, axis=-1, keepdims=True)
    var = jnp.mean(jnp.square(xf - mu), axis=-1, keepdims=True)
    return ((xf - mu) * lax.rsqrt(var + LN_EPS) * g + b).astype(x.dtype)


def rms_norm(x, g):
    xf = x.astype(jnp.float32)
    ms = jnp.mean(jnp.square(xf), axis=-1, keepdims=True)
    return (xf * lax.rsqrt(ms + RMS_EPS) * g).astype(x.dtype)


def rope(x, pos):
    d = x.shape[-1]
    inv_freq = ROPE_THETA ** (-jnp.arange(0, d, 2, dtype=jnp.float32) / d)
    ang = pos[:, None] * inv_freq[None, :]
    cos = jnp.concatenate([jnp.cos(ang), jnp.cos(ang)], axis=-1)[:, None, :]
    sin = jnp.concatenate([jnp.sin(ang), jnp.sin(ang)], axis=-1)[:, None, :]
    xf = x.astype(jnp.float32)
    rot = jnp.concatenate([-xf[..., d // 2:], xf[..., :d // 2]], axis=-1)
    return (xf * cos + rot * sin).astype(x.dtype)


def swa_sink_attention(q, k, v, sinks, pos):
    B, Lp = q.shape[0], q.shape[1]
    nb = Lp // BLOCK
    G = SWA_HEADS // SWA_KV_HEADS
    q = rope(q, pos)
    k = rope(k, pos)
    qb = q.reshape(B, nb, BLOCK, SWA_KV_HEADS, G, SWA_HEAD_DIM)
    kb = k.reshape(B, nb, BLOCK, SWA_KV_HEADS, SWA_HEAD_DIM)
    vb = v.reshape(B, nb, BLOCK, SWA_KV_HEADS, SWA_HEAD_DIM)

    def with_prev(t):
        prev = jnp.pad(t[:, :-1], ((0, 0), (1, 0), (0, 0), (0, 0), (0, 0)))
        return jnp.concatenate([prev, t], axis=2)

    kw, vw = with_prev(kb), with_prev(vb)
    q_idx = jnp.arange(Lp).reshape(nb, BLOCK)
    k_idx = q_idx[:, :1] - BLOCK + jnp.arange(2 * BLOCK)[None, :]
    diff = q_idx[:, :, None] - k_idx[:, None, :]
    mask = (diff >= 0) & (diff < WINDOW) & (k_idx[:, None, :] >= N_PAD)
    s = jnp.einsum('bnqhgd,bnkhd->bnhgqk', qb, kw).astype(jnp.float32) * (SWA_HEAD_DIM ** -0.5)
    s = jnp.where(mask[None, :, None, None], s, NEG)
    sink = sinks.astype(jnp.float32).reshape(SWA_KV_HEADS, G)[None, None, :, :, None, None]
    m = jnp.maximum(jnp.max(s, axis=-1, keepdims=True), sink)
    e = jnp.exp(s - m)
    p = e / (jnp.sum(e, axis=-1, keepdims=True) + jnp.exp(sink - m))
    o = jnp.einsum('bnhgqk,bnkhd->bnqhgd', p.astype(v.dtype), vw)
    return o.reshape(B, Lp, SWA_Q_COLS)


def mla_attention(c_q, c_kv, k_rope, q_norm_g, w_uq, kv_norm_g, w_ukv, pos):
    B, Lp = c_q.shape[0], c_q.shape[1]
    H = MLA_HEADS
    q = (rms_norm(c_q, q_norm_g) @ w_uq).reshape(B, Lp, H, MLA_NOPE_DIM + MLA_ROPE_DIM)
    q = jnp.concatenate([q[..., :MLA_NOPE_DIM], rope(q[..., MLA_NOPE_DIM:], pos)], axis=-1)
    kv = (rms_norm(c_kv, kv_norm_g) @ w_ukv).reshape(B, Lp, H, MLA_NOPE_DIM + MLA_V_DIM)
    k_nope, v = kv[..., :MLA_NOPE_DIM], kv[..., MLA_NOPE_DIM:]
    k_r = jnp.broadcast_to(rope(k_rope[:, :, None, :], pos), (B, Lp, H, MLA_ROPE_DIM))
    k = jnp.concatenate([k_nope, k_r], axis=-1)
    scale = (MLA_NOPE_DIM + MLA_ROPE_DIM) ** -0.5
    nb = Lp // BLOCK
    qb = jnp.moveaxis(q.reshape(B, nb, BLOCK, H, MLA_NOPE_DIM + MLA_ROPE_DIM), 1, 0)
    k_idx = jnp.arange(Lp)

    def block_attn(args):
        q_blk, n = args
        q_idx = n * BLOCK + jnp.arange(BLOCK)
        mask = (k_idx[None, :] <= q_idx[:, None]) & (k_idx[None, :] >= N_PAD)
        s = jnp.einsum('bqhd,bkhd->bhqk', q_blk, k).astype(jnp.float32) * scale
        p = jax.nn.softmax(jnp.where(mask[None, None], s, NEG), axis=-1)
        return jnp.einsum('bhqk,bkhd->bqhd', p.astype(v.dtype), v)

    o = lax.map(block_attn, (qb, jnp.arange(nb)))
    return jnp.moveaxis(o, 0, 1).reshape(B, Lp, MLA_OUT_COLS)


def hierarchical_moe(h, w_group, b_group, w_router, b_router, w_gate, w_up, w_down):
    B, Lp, D = h.shape
    t = h.reshape(B * Lp, D)
    T = t.shape[0]
    group_probs = jax.nn.softmax((t @ w_group).astype(jnp.float32) + b_group, axis=-1)
    g_top, g_idx = lax.top_k(group_probs, 1)
    e_logits = ((t @ w_router).astype(jnp.float32) + b_router).reshape(T, N_GROUPS, EXPERTS_PER_GROUP)
    sel = jnp.broadcast_to(g_idx[:, :, None], (T, 1, EXPERTS_PER_GROUP))
    in_group = jnp.take_along_axis(e_logits, sel, axis=1)[:, 0]
    e_top, e_idx = lax.top_k(in_group, TOP_K)
    weights = g_top * jax.nn.softmax(e_top, axis=-1)
    expert_ids = g_idx * EXPERTS_PER_GROUP + e_idx
    combine = jnp.einsum('tk,tke->te', weights, jax.nn.one_hot(expert_ids, N_EXPERTS, dtype=jnp.float32))
    nblk = T // BLOCK

    def expert_block(args):
        xb, cb = args
        hid = jax.nn.silu(jnp.einsum('td,edf->tef', xb, w_gate)) * jnp.einsum('td,edf->tef', xb, w_up)
        hid = hid * cb.astype(hid.dtype)[:, :, None]
        return jnp.einsum('tef,efd->td', hid, w_down)

    out = lax.map(expert_block, (t.reshape(nblk, BLOCK, D), combine.reshape(nblk, BLOCK, N_EXPERTS)))
    return out.reshape(B, Lp, D)


def setup_inputs(seed: int = 0) -> dict:
    key = jax.random.key(seed)
    ks = jax.random.split(key, 24)
    f32 = jnp.float32

    def nrm(k, shape, scale):
        return jax.random.normal(k, shape, f32) * scale

    L = DEPTH
    return {
        "x": nrm(ks[0], (BATCH, SEQ, D_MODEL), 1.0),
        "meta_tokens": nrm(ks[1], (N_META, D_MODEL), 1.0),
        "ln_in_g": 1.0 + nrm(ks[2], (D_MODEL,), 0.02),
        "ln_in_b": nrm(ks[3], (D_MODEL,), 0.02),
        "w_in": nrm(ks[4], (L, D_MODEL, IN_COLS), D_MODEL ** -0.5),
        "swa_sinks": nrm(ks[5], (L, SWA_HEADS), 0.5),
        "mla_q_norm_g": 1.0 + nrm(ks[6], (L, MLA_Q_RANK), 0.02),
        "mla_w_uq": nrm(ks[7], (L, MLA_Q_RANK, MLA_HEADS * (MLA_NOPE_DIM + MLA_ROPE_DIM)), MLA_Q_RANK ** -0.5),
        "mla_kv_norm_g": 1.0 + nrm(ks[8], (L, MLA_KV_RANK), 0.02),
        "mla_w_ukv": nrm(ks[9], (L, MLA_KV_RANK, MLA_HEADS * (MLA_NOPE_DIM + MLA_V_DIM)), MLA_KV_RANK ** -0.5),
        "swa_out_norm_g": 1.0 + nrm(ks[10], (L, SWA_Q_COLS), 0.02),
        "mla_out_norm_g": 1.0 + nrm(ks[11], (L, MLA_OUT_COLS), 0.02),
        "w_o": nrm(ks[12], (L, D_MIX, D_MODEL), (D_MIX ** -0.5) * BETA),
        "ln1_g": 1.0 + nrm(ks[13], (L, D_MODEL), 0.02),
        "ln1_b": nrm(ks[14], (L, D_MODEL), 0.02),
        "moe_w_group": nrm(ks[15], (L, D_MODEL, N_GROUPS), D_MODEL ** -0.5),
        "moe_b_group": nrm(ks[16], (L, N_GROUPS), 0.01),
        "moe_w_router": nrm(ks[17], (L, D_MODEL, N_EXPERTS), D_MODEL ** -0.5),
        "moe_b_router": nrm(ks[18], (L, N_EXPERTS), 0.01),
        "moe_w_gate": nrm(ks[19], (L, N_EXPERTS, D_MODEL, D_EXPERT), D_MODEL ** -0.5),
        "moe_w_up": nrm(ks[20], (L, N_EXPERTS, D_MODEL, D_EXPERT), D_MODEL ** -0.5),
        "moe_w_down": nrm(ks[21], (L, N_EXPERTS, D_EXPERT, D_MODEL), (D_EXPERT ** -0.5) * BETA),
        "ln2_g": 1.0 + nrm(ks[22], (L, D_MODEL), 0.02),
        "ln2_b": nrm(ks[23], (L, D_MODEL), 0.02),
    }


def reference(x, meta_tokens, ln_in_g, ln_in_b, w_in, swa_sinks, mla_q_norm_g, mla_w_uq,
              mla_kv_norm_g, mla_w_ukv, swa_out_norm_g, mla_out_norm_g, w_o, ln1_g, ln1_b,
              moe_w_group, moe_b_group, moe_w_router, moe_b_router, moe_w_gate, moe_w_up,
              moe_w_down, ln2_g, ln2_b):
    B = x.shape[0]
    pads = jnp.zeros((B, N_PAD, D_MODEL), x.dtype)
    meta = jnp.broadcast_to(meta_tokens.astype(x.dtype)[None], (B, N_META, D_MODEL))
    h = jnp.concatenate([pads, meta, x], axis=1)
    Lp = h.shape[1]
    pos = jnp.maximum(jnp.arange(Lp) - N_PAD, 0).astype(jnp.float32)
    h = layer_norm(h, ln_in_g, ln_in_b)
    for l in range(DEPTH):
        u = h @ w_in[l]
        q_a, k_a, v_a, c_q, c_kv, k_rope = jnp.split(u, IN_SPLITS, axis=-1)
        a_out = swa_sink_attention(
            q_a.reshape(B, Lp, SWA_HEADS, SWA_HEAD_DIM),
            k_a.reshape(B, Lp, SWA_KV_HEADS, SWA_HEAD_DIM),
            v_a.reshape(B, Lp, SWA_KV_HEADS, SWA_HEAD_DIM),
            swa_sinks[l], pos)
        b_out = mla_attention(c_q, c_kv, k_rope, mla_q_norm_g[l], mla_w_uq[l],
                              mla_kv_norm_g[l], mla_w_ukv[l], pos)
        mix = jnp.concatenate([rms_norm(a_out, swa_out_norm_g[l]),
                               rms_norm(b_out, mla_out_norm_g[l])], axis=-1) @ w_o[l]
        h = layer_norm(ALPHA * h + mix, ln1_g[l], ln1_b[l])
        ffn = hierarchical_moe(h, moe_w_group[l], moe_b_group[l], moe_w_router[l], moe_b_router[l],
                               moe_w_gate[l], moe_w_up[l], moe_w_down[l])
        h = layer_norm(ALPHA * h + ffn, ln2_g[l], ln2_b[l])
    return h[:, BLOCK:]
```

```cpp
#include <hip/hip_runtime.h>
#include <cstdio>
#include <cstdint>

typedef unsigned short bf16_t;
typedef float f32x4 __attribute__((ext_vector_type(4)));
typedef unsigned u32x4 __attribute__((ext_vector_type(4)));
typedef unsigned u32x2 __attribute__((ext_vector_type(2)));

constexpr int NB = 4, SEQ = 8192, DM = 1024, T = NB * SEQ, LP = SEQ + 128, NPAD = 112, NMETA = 16;
constexpr int INC = 1344;
constexpr float LN_EPS = 1e-5f, RMS_EPS = 1e-6f;
constexpr float ALPHA = 1.189207115002721f;
constexpr size_t MiB = 1u << 20;

constexpr size_t WS_CTL = 0;
constexpr size_t WS_HM = 1 * MiB;
constexpr size_t WS_CKVM = 1 * MiB + 128 * 1024;
constexpr size_t WS_UM = 1 * MiB + 256 * 1024;
constexpr size_t WS_KVTM = 1 * MiB + 640 * 1024;
constexpr size_t WS_SSQ = 2 * MiB;
constexpr size_t WS_EW = 4 * MiB;
constexpr size_t WS_LIST = 5 * MiB;
constexpr size_t WS_W = 16 * MiB;
constexpr size_t WS_H0 = 72 * MiB;
constexpr size_t WS_QA = 136 * MiB;
constexpr size_t WS_KA = 168 * MiB;
constexpr size_t WS_VA = 177 * MiB;
constexpr size_t WS_CQ = 186 * MiB;
constexpr size_t WS_CKV = 202 * MiB;
constexpr size_t WS_KM = 218 * MiB;
constexpr size_t WS_VM = 267 * MiB;
constexpr size_t WS_QM = 300 * MiB;
constexpr size_t WS_AO = 348 * MiB;
constexpr size_t WS_HID = 412 * MiB;
constexpr size_t WS_PRE1 = 136 * MiB;
constexpr size_t WS_H1 = 264 * MiB;
constexpr size_t WS_Y = 72 * MiB;
constexpr size_t WS_TMP = 348 * MiB;
constexpr size_t WS_AN = 412 * MiB;
constexpr size_t WS_END = 512 * MiB;
constexpr int CW_CNT = 1024;

__constant__ float c_inv_freq[32] = {1.000000000e+00f, 7.498942614e-01f, 5.623413324e-01f, 4.216965139e-01f, 3.162277639e-01f, 2.371373773e-01f, 1.778279394e-01f, 1.333521307e-01f, 1.000000015e-01f, 7.498941571e-02f, 5.623413250e-02f, 4.216965288e-02f, 3.162277490e-02f, 2.371373773e-02f, 1.778279431e-02f, 1.333521493e-02f, 9.999999776e-03f, 7.498941850e-03f, 5.623413250e-03f, 4.216964822e-03f, 3.162277630e-03f, 2.371373586e-03f, 1.778279431e-03f, 1.333521446e-03f, 1.000000047e-03f, 7.498942432e-04f, 5.623413017e-04f, 4.216965172e-04f, 3.162277571e-04f, 2.371373703e-04f, 1.778279402e-04f, 1.333521504e-04f};

__device__ __forceinline__ float bf2f(bf16_t v) { return __uint_as_float((unsigned)v << 16); }
__device__ __forceinline__ unsigned f2bf(float f) { unsigned u = __float_as_uint(f); return (u + 0x7fffu + ((u >> 16) & 1u)) >> 16; }
__device__ __forceinline__ unsigned pk2(float lo, float hi) { return f2bf(lo) | (f2bf(hi) << 16); }
__device__ __forceinline__ float wave_sum(float v) {
#pragma unroll
    for (int o = 1; o < 64; o <<= 1) v += __shfl_xor(v, o);
    return v;
}
__device__ __forceinline__ float wave_max(float v) {
#pragma unroll
    for (int o = 1; o < 64; o <<= 1) v = fmaxf(v, __shfl_xor(v, o));
    return v;
}
__device__ __forceinline__ void rope_cs(int pos, int i, float& c, float& s) {
    const double ang = (double)pos * (double)c_inv_freq[i];
    const double rev = ang * 0.15915494309189535;
    const float fr = (float)(rev - __builtin_rint(rev));
    s = __builtin_amdgcn_sinf(fr); c = __builtin_amdgcn_cosf(fr);
}

namespace naive {

__global__ __launch_bounds__(256) void k_ln_in(const float* __restrict__ x, const float* __restrict__ meta, const float* __restrict__ g, const float* __restrict__ b, bf16_t* H0, bf16_t* HM) {
    const int wave = threadIdx.x >> 6, lane = threadIdx.x & 63;
    const int row = blockIdx.x * 4 + wave;
    if (row >= T + NMETA) return;
    const float* src = row < T ? x + (size_t)row * DM : meta + (size_t)(row - T) * DM;
    bf16_t* dst = row < T ? H0 + (size_t)row * DM : HM + (size_t)(row - T) * DM;
    f32x4 v[4]; float s = 0.f;
#pragma unroll
    for (int j = 0; j < 4; ++j) { v[j] = *(const f32x4*)(src + j * 256 + lane * 4); s += (v[j].x + v[j].y) + (v[j].z + v[j].w); }
    const float mean = wave_sum(s) * (1.f / DM); float s2 = 0.f;
#pragma unroll
    for (int j = 0; j < 4; ++j) { v[j] = v[j] - mean; s2 += (v[j].x * v[j].x + v[j].y * v[j].y) + (v[j].z * v[j].z + v[j].w * v[j].w); }
    const float rstd = 1.f / sqrtf(wave_sum(s2) * (1.f / DM) + LN_EPS);
#pragma unroll
    for (int j = 0; j < 4; ++j) { const int c = j * 256 + lane * 4; const f32x4 gg = *(const f32x4*)(g + c), bb = *(const f32x4*)(b + c);
        const f32x4 o = v[j] * rstd * gg + bb; u32x2 w; w.x = pk2(o.x, o.y); w.y = pk2(o.z, o.w); *(u32x2*)(dst + c) = w; }
}

template <class AT> __device__ __forceinline__ float tofl(AT v);
template <> __device__ __forceinline__ float tofl<float>(float v) { return v; }
template <> __device__ __forceinline__ float tofl<bf16_t>(bf16_t v) { return bf2f(v); }

template <class AT>
__device__ __forceinline__ void naive_mm(const AT* __restrict__ A, const long long* aoff, const float* __restrict__ Bp, int ldb, int K, float (&acc)[4][4], float* As, float* Bs) {
    const int tid = threadIdx.x, tx = tid & 15, ty = tid >> 4;
    for (int k0 = 0; k0 < K; k0 += 16) {
        { const int r = tid >> 2, kk = (tid & 3) * 4; const AT* p = A + aoff[r] + k0 + kk;
#pragma unroll
          for (int i = 0; i < 4; ++i) As[(kk + i) * 65 + r] = tofl<AT>(p[i]); }
        { const int kk = tid >> 4, n = (tid & 15) * 4; const f32x4 t = *(const f32x4*)(Bp + (size_t)(k0 + kk) * ldb + n);
          *(f32x4*)(Bs + kk * 64 + n) = t; }
        __syncthreads();
#pragma unroll
        for (int kk = 0; kk < 16; ++kk) { float a[4], b[4];
#pragma unroll
            for (int i = 0; i < 4; ++i) a[i] = As[kk * 65 + ty * 4 + i];
#pragma unroll
            for (int j = 0; j < 4; ++j) b[j] = Bs[kk * 64 + tx * 4 + j];
#pragma unroll
            for (int i = 0; i < 4; ++i)
#pragma unroll
                for (int j = 0; j < 4; ++j) acc[i][j] += a[i] * b[j]; }
        __syncthreads();
    }
}

template <class AT>
__global__ __launch_bounds__(256) void k_gemm(const AT* __restrict__ A, int lda, const float* __restrict__ Bm, int ldb, float* __restrict__ C, int ldc, int K) {
    __shared__ float As[16 * 65]; __shared__ __attribute__((aligned(16))) float Bs[16 * 64]; __shared__ long long aoff[64];
    const int tid = threadIdx.x, tx = tid & 15, ty = tid >> 4; const int n0 = blockIdx.x * 64, m0 = blockIdx.y * 64;
    if (tid < 64) aoff[tid] = (long long)(m0 + tid) * lda;
    __syncthreads();
    float acc[4][4];
#pragma unroll
    for (int i = 0; i < 4; ++i)
#pragma unroll
        for (int j = 0; j < 4; ++j) acc[i][j] = 0.f;
    naive_mm<AT>(A, aoff, Bm + n0, ldb, K, acc, As, Bs);
#pragma unroll
    for (int i = 0; i < 4; ++i) { f32x4 o = {acc[i][0], acc[i][1], acc[i][2], acc[i][3]}; *(f32x4*)(C + (size_t)(m0 + ty * 4 + i) * ldc + n0 + tx * 4) = o; }
}

__global__ __launch_bounds__(256) void k_inproj_epi(const float* __restrict__ U, int m_base, int nrows, int meta, const float* __restrict__ gq, const float* __restrict__ gkv,
                                                    bf16_t* QA, bf16_t* KA, bf16_t* VA, bf16_t* CQ, bf16_t* CKV, bf16_t* CKVM, bf16_t* KM) {
    const int wave = threadIdx.x >> 6, l = threadIdx.x & 63;
    const int r = blockIdx.x * 4 + wave; if (r >= nrows) return;
    const float* u = U + (size_t)r * INC;
    float v[21];
#pragma unroll
    for (int j = 0; j < 21; ++j) v[j] = u[64 * j + l];
    const int m = m_base + r;
    const int bb = m / SEQ, t = m % SEQ;
    const int pos = meta ? r : t + NMETA;
    float c, s; rope_cs(pos, l & 31, c, s);
#pragma unroll
    for (int j = 0; j < 21; ++j) if (j < 10 || j == 20) { const float p = __shfl_xor(v[j], 32); v[j] = (l < 32) ? v[j] * c - p * s : v[j] * c + p * s; }
    float sq = 0.f, skv = 0.f;
#pragma unroll
    for (int j = 12; j < 16; ++j) sq += v[j] * v[j];
#pragma unroll
    for (int j = 16; j < 20; ++j) skv += v[j] * v[j];
    const float rq = 1.f / sqrtf(wave_sum(sq) * (1.f / 256.f) + RMS_EPS), rkv = 1.f / sqrtf(wave_sum(skv) * (1.f / 256.f) + RMS_EPS);
    if (!meta) {
#pragma unroll
        for (int j = 0; j < 8; ++j) QA[(size_t)m * 512 + 64 * j + l] = (bf16_t)f2bf(v[j]);
#pragma unroll
        for (int j = 0; j < 4; ++j) CQ[(size_t)m * 256 + 64 * j + l] = (bf16_t)f2bf(v[12 + j] * rq * gq[64 * j + l]);
#pragma unroll
        for (int j = 0; j < 4; ++j) CKV[(size_t)m * 256 + 64 * j + l] = (bf16_t)f2bf(v[16 + j] * rkv * gkv[64 * j + l]);
    } else {
#pragma unroll
        for (int j = 0; j < 4; ++j) CKVM[(size_t)r * 256 + 64 * j + l] = (bf16_t)f2bf(v[16 + j] * rkv * gkv[64 * j + l]);
    }
    for (int b2 = 0; b2 < (meta ? NB : 1); ++b2) {
        const size_t prow = meta ? (size_t)b2 * LP + NPAD + r : (size_t)bb * LP + 128 + t;
#pragma unroll
        for (int j = 0; j < 2; ++j) { KA[prow * 128 + 64 * j + l] = (bf16_t)f2bf(v[8 + j]); VA[prow * 128 + 64 * j + l] = (bf16_t)f2bf(v[10 + j]); }
#pragma unroll
        for (int h = 0; h < 4; ++h) KM[prow * 768 + h * 192 + 128 + l] = (bf16_t)f2bf(v[20]);
    }
}

__global__ __launch_bounds__(256) void k_qup_epi(const float* __restrict__ TQ, bf16_t* QM) {
    const int wave = threadIdx.x >> 6, l = threadIdx.x & 63;
    const int m = blockIdx.x * 4 + wave; if (m >= T) return;
    const int t = m % SEQ, pos = t + NMETA;
    float c, s; rope_cs(pos, l & 31, c, s);
    const float* q = TQ + (size_t)m * 768;
#pragma unroll
    for (int h = 0; h < 4; ++h) {
        QM[(size_t)m * 768 + h * 192 + l] = (bf16_t)f2bf(q[h * 192 + l]);
        QM[(size_t)m * 768 + h * 192 + 64 + l] = (bf16_t)f2bf(q[h * 192 + 64 + l]);
        const float v = q[h * 192 + 128 + l], p = __shfl_xor(v, 32);
        QM[(size_t)m * 768 + h * 192 + 128 + l] = (bf16_t)f2bf((l < 32) ? v * c - p * s : v * c + p * s);
    }
}
__global__ __launch_bounds__(256) void k_kvup_epi(const float* __restrict__ TKV, int nrows, int meta, bf16_t* KM, bf16_t* VM) {
    const int wave = threadIdx.x >> 6, l = threadIdx.x & 63;
    const int r = blockIdx.x * 4 + wave; if (r >= nrows) return;
    const float* kv = TKV + (size_t)r * 1024;
    const int bb = r / SEQ, t = r % SEQ;
    for (int b2 = 0; b2 < (meta ? NB : 1); ++b2) {
        const size_t prow = meta ? (size_t)b2 * LP + NPAD + r : (size_t)bb * LP + 128 + t;
#pragma unroll
        for (int h = 0; h < 4; ++h)
#pragma unroll
            for (int j = 0; j < 2; ++j) {
                KM[prow * 768 + h * 192 + 64 * j + l] = (bf16_t)f2bf(kv[h * 256 + 64 * j + l]);
                VM[prow * 512 + h * 128 + 64 * j + l] = (bf16_t)f2bf(kv[h * 256 + 128 + 64 * j + l]);
            }
    }
}

template <int DQK, int DV, bool SWA>
__global__ __launch_bounds__(256) void k_attn(const bf16_t* __restrict__ Q, int ldq, const bf16_t* __restrict__ K, int ldk, const bf16_t* __restrict__ V, int ldv,
                                              bf16_t* AO, int ocol0, float* SSQ, int slot0, const float* __restrict__ sinks, int nheads, float scale) {
    __shared__ __attribute__((aligned(16))) float qs[4][8][DQK];
    __shared__ __attribute__((aligned(16))) float ps[4][64][8];
    const int wave = threadIdx.x >> 6, lane = threadIdx.x & 63;
    const int item = blockIdx.x * 4 + wave;
    const int ngrp = SEQ / 8;
    const int g = item % ngrp, h = (item / ngrp) % nheads, b = item / (ngrp * nheads);
    const int t0 = g * 8, P0 = 128 + t0;
    const int kvh = SWA ? h / 4 : h;
    const size_t qrow0 = (size_t)b * SEQ + t0;
    for (int i = lane; i < 8 * DQK; i += 64) { const int r = i / DQK, d = i % DQK; qs[wave][r][d] = bf2f(Q[(qrow0 + r) * ldq + h * DQK + d]); }
    __syncthreads();
    float m_[8], l_[8], o[8][2];
    const float sink = SWA ? sinks[h] : 0.f;
#pragma unroll
    for (int r = 0; r < 8; ++r) { m_[r] = SWA ? sink : -1e30f; l_[r] = SWA ? 1.f : 0.f; o[r][0] = 0.f; o[r][1] = 0.f; }
    int klo = SWA ? P0 - 127 : NPAD; if (klo < NPAD) klo = NPAD;
    const int khi = P0 + 7;
    const bf16_t* Kb = K + (size_t)b * LP * ldk + kvh * DQK;
    const bf16_t* Vb = V + (size_t)b * LP * ldv + kvh * DV;
    for (int kb = klo; kb <= khi; kb += 64) {
        const int key = kb + lane; const bool inr = key <= khi;
        float s[8];
#pragma unroll
        for (int r = 0; r < 8; ++r) s[r] = 0.f;
        const bf16_t* kp = Kb + (size_t)(inr ? key : khi) * ldk;
        for (int d = 0; d < DQK; d += 8) {
            const u32x4 kw = *(const u32x4*)(kp + d);
            float kf[8];
#pragma unroll
            for (int e = 0; e < 4; ++e) { kf[2 * e] = __uint_as_float(kw[e] << 16); kf[2 * e + 1] = __uint_as_float(kw[e] & 0xffff0000u); }
#pragma unroll
            for (int r = 0; r < 8; ++r) { const f32x4 q0 = *(const f32x4*)&qs[wave][r][d], q1 = *(const f32x4*)&qs[wave][r][d + 4];
                s[r] += (q0.x * kf[0] + q0.y * kf[1]) + (q0.z * kf[2] + q0.w * kf[3]) + (q1.x * kf[4] + q1.y * kf[5]) + (q1.z * kf[6] + q1.w * kf[7]); }
        }
        float alpha[8];
#pragma unroll
        for (int r = 0; r < 8; ++r) {
            const int qp = P0 + r; int lo = SWA ? qp - 127 : NPAD; if (lo < NPAD) lo = NPAD;
            const bool valid = inr && key >= lo && key <= qp;
            const float sv = valid ? s[r] * scale : -INFINITY;
            const float mn = fmaxf(m_[r], wave_max(sv));
            const float p = valid ? __expf(sv - mn) : 0.f;
            alpha[r] = __expf(m_[r] - mn); m_[r] = mn;
            l_[r] = l_[r] * alpha[r] + wave_sum(p);
            o[r][0] *= alpha[r]; o[r][1] *= alpha[r];
            ps[wave][lane][r] = p;
        }
        __builtin_amdgcn_s_waitcnt(0);
        const int nk = (khi - kb + 1) < 64 ? (khi - kb + 1) : 64;
        for (int j = 0; j < nk; ++j) {
            const f32x4 p0 = *(const f32x4*)&ps[wave][j][0], p1 = *(const f32x4*)&ps[wave][j][4];
            const bf16_t* vp = Vb + (size_t)(kb + j) * ldv;
            float v0, v1;
            if (DV == 128) { const unsigned w = *(const unsigned*)(vp + 2 * lane); v0 = __uint_as_float(w << 16); v1 = __uint_as_float(w & 0xffff0000u); }
            else { v0 = bf2f(vp[lane]); v1 = 0.f; }
            o[0][0] += p0.x * v0; o[0][1] += p0.x * v1; o[1][0] += p0.y * v0; o[1][1] += p0.y * v1;
            o[2][0] += p0.z * v0; o[2][1] += p0.z * v1; o[3][0] += p0.w * v0; o[3][1] += p0.w * v1;
            o[4][0] += p1.x * v0; o[4][1] += p1.x * v1; o[5][0] += p1.y * v0; o[5][1] += p1.y * v1;
            o[6][0] += p1.z * v0; o[6][1] += p1.z * v1; o[7][0] += p1.w * v0; o[7][1] += p1.w * v1;
        }
    }
#pragma unroll
    for (int r = 0; r < 8; ++r) {
        const float il = 1.f / l_[r];
        const size_t m = qrow0 + r;
        float ss;
        if (DV == 128) { const unsigned w = pk2(o[r][0] * il, o[r][1] * il); *(unsigned*)(AO + m * 1024 + ocol0 + h * DV + 2 * lane) = w;
            const float a = __uint_as_float(w << 16), c = __uint_as_float(w & 0xffff0000u); ss = a * a + c * c; }
        else { const unsigned w = f2bf(o[r][0] * il); AO[m * 1024 + ocol0 + h * DV + lane] = (bf16_t)w; const float a = __uint_as_float(w << 16); ss = a * a; }
        ss = wave_sum(ss);
        if (lane == 0) SSQ[m * 12 + slot0 + h] = ss;
    }
}

__global__ __launch_bounds__(256) void k_onorm(const bf16_t* __restrict__ AO, const float* __restrict__ ga, const float* __restrict__ gb, bf16_t* AN) {
    const int wave = threadIdx.x >> 6, lane = threadIdx.x & 63;
    const int m = blockIdx.x * 4 + wave; if (m >= T) return;
#pragma unroll
    for (int part = 0; part < 2; ++part) {
        const bf16_t* p = AO + (size_t)m * 1024 + part * 512 + lane * 8; const float* gg = (part ? gb : ga) + lane * 8;
        float v[8]; float ss = 0.f;
#pragma unroll
        for (int e = 0; e < 8; ++e) { v[e] = bf2f(p[e]); ss += v[e] * v[e]; }
        const float rstd = 1.f / sqrtf(wave_sum(ss) * (1.f / 512.f) + RMS_EPS);
#pragma unroll
        for (int e = 0; e < 8; ++e) AN[(size_t)m * 1024 + part * 512 + lane * 8 + e] = (bf16_t)f2bf(v[e] * rstd * gg[e]);
    }
}
__global__ __launch_bounds__(256) void k_res1(const bf16_t* __restrict__ H0, float* PRE1) {
    const size_t i = ((size_t)blockIdx.x * 256 + threadIdx.x) * 4; if (i >= (size_t)T * DM) return;
    f32x4 p = *(f32x4*)(PRE1 + i); const u32x2 h = *(const u32x2*)(H0 + i);
    p.x += ALPHA * __uint_as_float(h.x << 16); p.y += ALPHA * __uint_as_float(h.x & 0xffff0000u);
    p.z += ALPHA * __uint_as_float(h.y << 16); p.w += ALPHA * __uint_as_float(h.y & 0xffff0000u);
    *(f32x4*)(PRE1 + i) = p;
}

__global__ __launch_bounds__(256) void k_ln1_router(const float* __restrict__ PRE1, const float* __restrict__ g, const float* __restrict__ b,
                                                    const float* __restrict__ wg, const float* __restrict__ bg, const float* __restrict__ wr, const float* __restrict__ br,
                                                    bf16_t* H1, unsigned* ctl, int* list, float* ew) {
    const int wave = threadIdx.x >> 6, lane = threadIdx.x & 63;
    const int m = blockIdx.x * 4 + wave; if (m >= T) return;
    const float* src = PRE1 + (size_t)m * DM;
    f32x4 v[4]; float s = 0.f;
#pragma unroll
    for (int j = 0; j < 4; ++j) { v[j] = *(const f32x4*)(src + j * 256 + lane * 4); s += (v[j].x + v[j].y) + (v[j].z + v[j].w); }
    const float mean = wave_sum(s) * (1.f / DM); float s2 = 0.f;
#pragma unroll
    for (int j = 0; j < 4; ++j) { v[j] = v[j] - mean; s2 += (v[j].x * v[j].x + v[j].y * v[j].y) + (v[j].z * v[j].z + v[j].w * v[j].w); }
    const float rstd = 1.f / sqrtf(wave_sum(s2) * (1.f / DM) + LN_EPS);
    f32x4 accg = {0.f, 0.f, 0.f, 0.f}; f32x4 accr[8];
#pragma unroll
    for (int q = 0; q < 8; ++q) accr[q] = (f32x4){0.f, 0.f, 0.f, 0.f};
#pragma unroll
    for (int j = 0; j < 4; ++j) { const int c = j * 256 + lane * 4; const f32x4 gg = *(const f32x4*)(g + c), bb = *(const f32x4*)(b + c);
        const f32x4 o = v[j] * rstd * gg + bb; u32x2 w; w.x = pk2(o.x, o.y); w.y = pk2(o.z, o.w); *(u32x2*)(H1 + (size_t)m * DM + c) = w;
#define RT_K(E, HK) { const float hk = (HK); const int k = c + (E); accg += hk * *(const f32x4*)(wg + (size_t)k * 4); \
            _Pragma("unroll") for (int q = 0; q < 8; ++q) accr[q] += hk * *(const f32x4*)(wr + (size_t)k * 32 + q * 4); }
        RT_K(0, o.x) RT_K(1, o.y) RT_K(2, o.z) RT_K(3, o.w)
#undef RT_K
    }
    accg.x = wave_sum(accg.x); accg.y = wave_sum(accg.y); accg.z = wave_sum(accg.z); accg.w = wave_sum(accg.w);
#pragma unroll
    for (int q = 0; q < 8; ++q) { accr[q].x = wave_sum(accr[q].x); accr[q].y = wave_sum(accr[q].y); accr[q].z = wave_sum(accr[q].z); accr[q].w = wave_sum(accr[q].w); }
    const f32x4 lgv = accg + *(const f32x4*)bg;
    const float mx = fmaxf(fmaxf(lgv.x, lgv.y), fmaxf(lgv.z, lgv.w));
    const float ex0 = expf(lgv.x - mx), ex1 = expf(lgv.y - mx), ex2 = expf(lgv.z - mx), ex3 = expf(lgv.w - mx);
    const float se = ((ex0 + ex1) + ex2) + ex3;
    int gi = 0; float gt = ex0 / se;
    { const float p = ex1 / se; if (p > gt) { gt = p; gi = 1; } }
    { const float p = ex2 / se; if (p > gt) { gt = p; gi = 2; } }
    { const float p = ex3 / se; if (p > gt) { gt = p; gi = 3; } }
    f32x4 lo = accr[0], hi = accr[1];
    lo = gi == 1 ? accr[2] : lo; hi = gi == 1 ? accr[3] : hi;
    lo = gi == 2 ? accr[4] : lo; hi = gi == 2 ? accr[5] : hi;
    lo = gi == 3 ? accr[6] : lo; hi = gi == 3 ? accr[7] : hi;
    lo += *(const f32x4*)(br + gi * 8); hi += *(const f32x4*)(br + gi * 8 + 4);
    float ig[8] = {lo.x, lo.y, lo.z, lo.w, hi.x, hi.y, hi.z, hi.w};
    int e1 = 0; float t1 = ig[0];
#pragma unroll
    for (int i = 1; i < 8; ++i) if (ig[i] > t1) { t1 = ig[i]; e1 = i; }
    int e2 = -1; float t2 = -INFINITY;
#pragma unroll
    for (int i = 0; i < 8; ++i) if (i != e1 && ig[i] > t2) { t2 = ig[i]; e2 = i; }
    const float z = expf(t2 - t1), w1 = gt / (1.f + z), w2 = gt * z / (1.f + z);
    if (lane == 0) {
        const int ea = gi * 8 + e1, eb = gi * 8 + e2;
        const unsigned pa = atomicAdd(&ctl[CW_CNT + 64 * ea], 1u); list[(size_t)ea * T + pa] = m * 2; ew[m * 2] = w1;
        const unsigned pb = atomicAdd(&ctl[CW_CNT + 64 * eb], 1u); list[(size_t)eb * T + pb] = m * 2 + 1; ew[m * 2 + 1] = w2;
    }
}

__device__ __forceinline__ bool moe_tile(const unsigned* ctl, int tile, int TM, int& e, int& r0, int& n) {
    int acc = 0;
    for (int i = 0; i < 32; ++i) { const int c = (int)ctl[CW_CNT + 64 * i]; const int nt = (c + TM - 1) / TM; if (tile < acc + nt) { e = i; r0 = (tile - acc) * TM; n = c; return true; } acc += nt; }
    return false;
}
__global__ __launch_bounds__(256) void k_moe_gu(const bf16_t* __restrict__ H1, const float* __restrict__ wgate, const float* __restrict__ wup, const unsigned* ctl, const int* __restrict__ list, const float* __restrict__ ew, bf16_t* HID) {
    __shared__ float As[16 * 65]; __shared__ __attribute__((aligned(16))) float Bs[16 * 64]; __shared__ long long aoff[64]; __shared__ int sidx[64];
    int e, r0, n; if (!moe_tile(ctl, blockIdx.x, 64, e, r0, n)) return;
    const int tid = threadIdx.x, tx = tid & 15, ty = tid >> 4, n0 = blockIdx.y * 64;
    if (tid < 64) { const int idx = (r0 + tid < n) ? list[(size_t)e * T + r0 + tid] : -1; sidx[tid] = idx; aoff[tid] = idx >= 0 ? (long long)(idx >> 1) * DM : 0; }
    __syncthreads();
    float ag[4][4], au[4][4];
#pragma unroll
    for (int i = 0; i < 4; ++i)
#pragma unroll
        for (int j = 0; j < 4; ++j) { ag[i][j] = 0.f; au[i][j] = 0.f; }
    naive_mm<bf16_t>(H1, aoff, wgate + (size_t)e * DM * 256 + n0, 256, DM, ag, As, Bs);
    naive_mm<bf16_t>(H1, aoff, wup + (size_t)e * DM * 256 + n0, 256, DM, au, As, Bs);
#pragma unroll
    for (int i = 0; i < 4; ++i) { const int r = ty * 4 + i; const int idx = sidx[r]; const float w = idx >= 0 ? ew[idx] : 0.f;
#pragma unroll
        for (int j = 0; j < 4; ++j) { const float gv = ag[i][j]; const float hv = gv / (1.f + __expf(-gv)) * au[i][j] * w;
            HID[((size_t)blockIdx.x * 64 + r) * 256 + n0 + tx * 4 + j] = (bf16_t)f2bf(hv); } }
}
__global__ __launch_bounds__(256) void k_moe_dn(const bf16_t* __restrict__ HID, const float* __restrict__ wdown, const unsigned* ctl, const int* __restrict__ list, bf16_t* Y) {
    __shared__ float As[16 * 65]; __shared__ __attribute__((aligned(16))) float Bs[16 * 64]; __shared__ long long aoff[64]; __shared__ int sidx[64];
    int e, r0, n; if (!moe_tile(ctl, blockIdx.x, 64, e, r0, n)) return;
    const int tid = threadIdx.x, tx = tid & 15, ty = tid >> 4, n0 = blockIdx.y * 64;
    if (tid < 64) { const int idx = (r0 + tid < n) ? list[(size_t)e * T + r0 + tid] : -1; sidx[tid] = idx; aoff[tid] = ((long long)blockIdx.x * 64 + tid) * 256; }
    __syncthreads();
    float acc[4][4];
#pragma unroll
    for (int i = 0; i < 4; ++i)
#pragma unroll
        for (int j = 0; j < 4; ++j) acc[i][j] = 0.f;
    naive_mm<bf16_t>(HID, aoff, wdown + (size_t)e * 256 * DM + n0, DM, 256, acc, As, Bs);
#pragma unroll
    for (int i = 0; i < 4; ++i) { const int idx = sidx[ty * 4 + i]; if (idx >= 0) {
#pragma unroll
        for (int j = 0; j < 4; ++j) Y[(size_t)idx * DM + n0 + tx * 4 + j] = (bf16_t)f2bf(acc[i][j]); } }
}
__global__ __launch_bounds__(256) void k_ln2(const bf16_t* __restrict__ H1, const bf16_t* __restrict__ Y, const float* __restrict__ g, const float* __restrict__ b, float* out) {
    const int wave = threadIdx.x >> 6, lane = threadIdx.x & 63;
    const int m = blockIdx.x * 4 + wave; if (m >= T) return;
    f32x4 v[4]; float s = 0.f;
#pragma unroll
    for (int j = 0; j < 4; ++j) { const int c = j * 256 + lane * 4;
        const u32x2 h = *(const u32x2*)(H1 + (size_t)m * DM + c), y0 = *(const u32x2*)(Y + (size_t)(2 * m) * DM + c), y1 = *(const u32x2*)(Y + (size_t)(2 * m + 1) * DM + c);
        v[j].x = ALPHA * __uint_as_float(h.x << 16) + __uint_as_float(y0.x << 16) + __uint_as_float(y1.x << 16);
        v[j].y = ALPHA * __uint_as_float(h.x & 0xffff0000u) + __uint_as_float(y0.x & 0xffff0000u) + __uint_as_float(y1.x & 0xffff0000u);
        v[j].z = ALPHA * __uint_as_float(h.y << 16) + __uint_as_float(y0.y << 16) + __uint_as_float(y1.y << 16);
        v[j].w = ALPHA * __uint_as_float(h.y & 0xffff0000u) + __uint_as_float(y0.y & 0xffff0000u) + __uint_as_float(y1.y & 0xffff0000u);
        s += (v[j].x + v[j].y) + (v[j].z + v[j].w); }
    const float mean = wave_sum(s) * (1.f / DM); float s2 = 0.f;
#pragma unroll
    for (int j = 0; j < 4; ++j) { v[j] = v[j] - mean; s2 += (v[j].x * v[j].x + v[j].y * v[j].y) + (v[j].z * v[j].z + v[j].w * v[j].w); }
    const float rstd = 1.f / sqrtf(wave_sum(s2) * (1.f / DM) + LN_EPS);
#pragma unroll
    for (int j = 0; j < 4; ++j) { const int c = j * 256 + lane * 4; const f32x4 gg = *(const f32x4*)(g + c), bb = *(const f32x4*)(b + c);
        *(f32x4*)(out + (size_t)m * DM + c) = v[j] * rstd * gg + bb; }
}

}

extern "C" void kernel_launch(void* const* d_in, const int* in_sizes, int n_in, void* d_out, int out_size, void* d_ws, size_t ws_size, hipStream_t stream) {
    if (n_in != 24 || ws_size < WS_END || out_size != T * DM) { fprintf(stderr, "kernel_launch: unexpected shapes n_in=%d ws=%zu out=%d\n", n_in, ws_size, out_size); return; }
    const float* x = (const float*)d_in[0]; const float* meta = (const float*)d_in[1]; const float* ln_in_g = (const float*)d_in[2]; const float* ln_in_b = (const float*)d_in[3];
    const float* w_in = (const float*)d_in[4]; const float* sinks = (const float*)d_in[5]; const float* gq = (const float*)d_in[6]; const float* w_uq = (const float*)d_in[7];
    const float* gkv = (const float*)d_in[8]; const float* w_ukv = (const float*)d_in[9]; const float* ga = (const float*)d_in[10]; const float* gb = (const float*)d_in[11];
    const float* w_o = (const float*)d_in[12]; const float* ln1_g = (const float*)d_in[13]; const float* ln1_b = (const float*)d_in[14];
    const float* wg = (const float*)d_in[15]; const float* bg = (const float*)d_in[16]; const float* wr = (const float*)d_in[17]; const float* br = (const float*)d_in[18];
    const float* wgate = (const float*)d_in[19]; const float* wup = (const float*)d_in[20]; const float* wdown = (const float*)d_in[21];
    const float* ln2_g = (const float*)d_in[22]; const float* ln2_b = (const float*)d_in[23];
    unsigned char* ws = (unsigned char*)d_ws; float* out = (float*)d_out;
    unsigned* ctl = (unsigned*)(ws + WS_CTL);
    bf16_t* HM = (bf16_t*)(ws + WS_HM); bf16_t* CKVM = (bf16_t*)(ws + WS_CKVM); float* UM = (float*)(ws + WS_UM); float* KVTM = (float*)(ws + WS_KVTM);
    float* SSQ = (float*)(ws + WS_SSQ); float* ew = (float*)(ws + WS_EW); int* list = (int*)(ws + WS_LIST);
    bf16_t* H0 = (bf16_t*)(ws + WS_H0); bf16_t* QA = (bf16_t*)(ws + WS_QA); bf16_t* KA = (bf16_t*)(ws + WS_KA); bf16_t* VA = (bf16_t*)(ws + WS_VA);
    bf16_t* CQ = (bf16_t*)(ws + WS_CQ); bf16_t* CKV = (bf16_t*)(ws + WS_CKV); bf16_t* KM = (bf16_t*)(ws + WS_KM); bf16_t* VM = (bf16_t*)(ws + WS_VM);
    bf16_t* QM = (bf16_t*)(ws + WS_QM); bf16_t* AO = (bf16_t*)(ws + WS_AO); bf16_t* HID = (bf16_t*)(ws + WS_HID); float* PRE1 = (float*)(ws + WS_PRE1);
    bf16_t* H1 = (bf16_t*)(ws + WS_H1); bf16_t* Y = (bf16_t*)(ws + WS_Y); float* TMP = (float*)(ws + WS_TMP); bf16_t* AN = (bf16_t*)(ws + WS_AN);

    hipMemsetAsync(ws + WS_CTL, 0, 2 * MiB, stream);
    hipMemsetAsync(ws + WS_KA, 0, (size_t)NB * LP * 128 * 2, stream);
    hipMemsetAsync(ws + WS_VA, 0, (size_t)NB * LP * 128 * 2, stream);
    hipMemsetAsync(ws + WS_KM, 0, (size_t)NB * LP * 768 * 2, stream);
    hipMemsetAsync(ws + WS_VM, 0, (size_t)NB * LP * 512 * 2, stream);

    naive::k_ln_in<<<(T + NMETA + 3) / 4, 256, 0, stream>>>(x, meta, ln_in_g, ln_in_b, H0, HM);
    for (int half = 0; half < 2; ++half) {
        const int m0 = half * (T / 2);
        naive::k_gemm<bf16_t><<<dim3(INC / 64, (T / 2) / 64), 256, 0, stream>>>(H0 + (size_t)m0 * DM, DM, w_in, INC, TMP, INC, DM);
        naive::k_inproj_epi<<<(T / 2) / 4, 256, 0, stream>>>(TMP, m0, T / 2, 0, gq, gkv, QA, KA, VA, CQ, CKV, CKVM, KM);
    }
    naive::k_gemm<bf16_t><<<dim3(INC / 64, 1), 256, 0, stream>>>(HM, DM, w_in, INC, UM, INC, DM);
    naive::k_inproj_epi<<<NMETA / 4, 256, 0, stream>>>(UM, 0, NMETA, 1, gq, gkv, QA, KA, VA, CQ, CKV, CKVM, KM);
    naive::k_gemm<bf16_t><<<dim3(768 / 64, T / 64), 256, 0, stream>>>(CQ, 256, w_uq, 768, TMP, 768, 256);
    naive::k_qup_epi<<<T / 4, 256, 0, stream>>>(TMP, QM);
    naive::k_gemm<bf16_t><<<dim3(1024 / 64, T / 64), 256, 0, stream>>>(CKV, 256, w_ukv, 1024, TMP, 1024, 256);
    naive::k_kvup_epi<<<T / 4, 256, 0, stream>>>(TMP, T, 0, KM, VM);
    naive::k_gemm<bf16_t><<<dim3(1024 / 64, 1), 256, 0, stream>>>(CKVM, 256, w_ukv, 1024, KVTM, 1024, 256);
    naive::k_kvup_epi<<<NMETA / 4, 256, 0, stream>>>(KVTM, NMETA, 1, KM, VM);
    naive::k_attn<64, 64, true><<<NB * 8 * (SEQ / 8) / 4, 256, 0, stream>>>(QA, 512, KA, 128, VA, 128, AO, 0, SSQ, 0, sinks, 8, 0.125f);
    naive::k_attn<192, 128, false><<<NB * 4 * (SEQ / 8) / 4, 256, 0, stream>>>(QM, 768, KM, 768, VM, 512, AO, 512, SSQ, 8, sinks, 4, 0.07216878364870322f);
    naive::k_onorm<<<T / 4, 256, 0, stream>>>(AO, ga, gb, AN);
    naive::k_gemm<bf16_t><<<dim3(DM / 64, T / 64), 256, 0, stream>>>(AN, DM, w_o, DM, PRE1, DM, DM);
    naive::k_res1<<<(T * (DM / 4)) / 256, 256, 0, stream>>>(H0, PRE1);
    naive::k_ln1_router<<<T / 4, 256, 0, stream>>>(PRE1, ln1_g, ln1_b, wg, bg, wr, br, H1, ctl, list, ew);
    naive::k_moe_gu<<<dim3(1056, 4), 256, 0, stream>>>(H1, wgate, wup, ctl, list, ew, HID);
    naive::k_moe_dn<<<dim3(1056, 16), 256, 0, stream>>>(HID, wdown, ctl, list, Y);
    naive::k_ln2<<<T / 4, 256, 0, stream>>>(H1, Y, ln2_g, ln2_b, out);
}
```

```cpp
#include <hip/hip_runtime.h>
#include <cstdio>
#include <cstdint>

typedef unsigned short bf16_t;
typedef float f32x4 __attribute__((ext_vector_type(4)));
typedef unsigned u32x4 __attribute__((ext_vector_type(4)));
typedef unsigned u32x2 __attribute__((ext_vector_type(2)));

constexpr int NB = 4, SEQ = 8192, DM = 1024, T = NB * SEQ, LP = SEQ + 128, NPAD = 112, NMETA = 16;
constexpr int INC = 1344;
constexpr float LN_EPS = 1e-5f, RMS_EPS = 1e-6f;
constexpr float ALPHA = 1.189207115002721f;
constexpr size_t MiB = 1u << 20;

constexpr size_t WS_CTL = 0;
constexpr size_t WS_HM = 1 * MiB;
constexpr size_t WS_CKVM = 1 * MiB + 128 * 1024;
constexpr size_t WS_UM = 1 * MiB + 256 * 1024;
constexpr size_t WS_KVTM = 1 * MiB + 640 * 1024;
constexpr size_t WS_SSQ = 2 * MiB;
constexpr size_t WS_EW = 4 * MiB;
constexpr size_t WS_LIST = 5 * MiB;
constexpr size_t WS_W = 16 * MiB;
constexpr size_t WS_H0 = 72 * MiB;
constexpr size_t WS_QA = 136 * MiB;
constexpr size_t WS_KA = 168 * MiB;
constexpr size_t WS_VA = 177 * MiB;
constexpr size_t WS_CQ = 186 * MiB;
constexpr size_t WS_CKV = 202 * MiB;
constexpr size_t WS_KM = 218 * MiB;
constexpr size_t WS_VM = 267 * MiB;
constexpr size_t WS_QM = 300 * MiB;
constexpr size_t WS_AO = 348 * MiB;
constexpr size_t WS_HID = 412 * MiB;
constexpr size_t WS_PRE1 = 136 * MiB;
constexpr size_t WS_H1 = 264 * MiB;
constexpr size_t WS_Y = 72 * MiB;
constexpr size_t WS_TMP = 348 * MiB;
constexpr size_t WS_AN = 412 * MiB;
constexpr size_t WS_END = 512 * MiB;
constexpr int CW_CNT = 1024;

__constant__ float c_inv_freq[32] = {1.000000000e+00f, 7.498942614e-01f, 5.623413324e-01f, 4.216965139e-01f, 3.162277639e-01f, 2.371373773e-01f, 1.778279394e-01f, 1.333521307e-01f, 1.000000015e-01f, 7.498941571e-02f, 5.623413250e-02f, 4.216965288e-02f, 3.162277490e-02f, 2.371373773e-02f, 1.778279431e-02f, 1.333521493e-02f, 9.999999776e-03f, 7.498941850e-03f, 5.623413250e-03f, 4.216964822e-03f, 3.162277630e-03f, 2.371373586e-03f, 1.778279431e-03f, 1.333521446e-03f, 1.000000047e-03f, 7.498942432e-04f, 5.623413017e-04f, 4.216965172e-04f, 3.162277571e-04f, 2.371373703e-04f, 1.778279402e-04f, 1.333521504e-04f};

__device__ __forceinline__ float bf2f(bf16_t v) { return __uint_as_float((unsigned)v << 16); }
__device__ __forceinline__ unsigned f2bf(float f) { unsigned u = __float_as_uint(f); return (u + 0x7fffu + ((u >> 16) & 1u)) >> 16; }
__device__ __forceinline__ unsigned pk2(float lo, float hi) { return f2bf(lo) | (f2bf(hi) << 16); }
__device__ __forceinline__ int lane_id() { return (int)__builtin_amdgcn_mbcnt_hi(~0u, __builtin_amdgcn_mbcnt_lo(~0u, 0u)); }
__device__ __forceinline__ float wave_sum(float v) {
#pragma unroll
    for (int o = 1; o < 64; o <<= 1) v += __shfl_xor(v, o);
    return v;
}
__device__ __forceinline__ float wave_max(float v) {
#pragma unroll
    for (int o = 1; o < 64; o <<= 1) v = fmaxf(v, __shfl_xor(v, o));
    return v;
}
__device__ __forceinline__ void rope_cs(int pos, int i, float& c, float& s) {
    const double ang = (double)pos * (double)c_inv_freq[i];
    const double rev = ang * 0.15915494309189535;
    const float fr = (float)(rev - __builtin_rint(rev));
    s = __builtin_amdgcn_sinf(fr); c = __builtin_amdgcn_cosf(fr);
}


#define LAS __attribute__((address_space(3)))
#define GAS __attribute__((address_space(1)))
typedef short bf16x8 __attribute__((ext_vector_type(8)));
typedef float f32x2 __attribute__((ext_vector_type(2)));

constexpr size_t WS_CQS = 9 * MiB;
constexpr size_t WS_CKVS = 10 * MiB;
constexpr size_t WS_COS = 11 * MiB;
constexpr size_t WS_SIN = 13 * MiB;
constexpr size_t WS_WIN = 16 * MiB;
constexpr size_t WS_WUQ = 19 * MiB;
constexpr size_t WS_WUKV = 19 * MiB + 512 * 1024;
constexpr size_t WS_WO = 20 * MiB;
constexpr size_t WS_WGU = 22 * MiB;
constexpr size_t WS_WDN = 54 * MiB;
constexpr int NPOS = SEQ + NMETA;

namespace pg8 {
constexpr int BM = 256, BK = 64, HALF = 128, HTB = HALF * BK * 2, STAGE_BYTES = 8 * HTB, NXCD = 8, WGM = 8;
__host__ __device__ __forceinline__ int lds_byte(int r, int c) { const int st = (r >> 4) * 2 + (c >> 5), rr = r & 15, cc = c & 31, ob = rr * 64 + cc * 2; return st * 1024 + (ob ^ (((ob >> 9) & 1) << 5)); }
__host__ __device__ __forceinline__ void stage_rc(int b, int& R, int& C) { const int st = b / 1024, sb = b % 1024, swz = sb ^ (((sb >> 9) & 1) << 5); R = (st >> 1) * 16 + swz / 64; C = (st & 1) * 32 + (swz % 64) / 2; }
__host__ __device__ __forceinline__ int perm32(int rho) { const int n = rho >> 4, i = rho & 15; return 8 * (i >> 2) + 4 * n + (i & 3); }
struct Unit { int pm, pn, e, r0, n; };
__device__ __forceinline__ unsigned cvt_pk_bf16(float lo, float hi) { unsigned r; asm volatile("v_cvt_pk_bf16_f32 %0, %1, %2" : "=v"(r) : "v"(lo), "v"(hi)); return r; }
__device__ __forceinline__ u32x4 pack8(const f32x4 a, const f32x4 b) { u32x4 w; w.x = cvt_pk_bf16(a[0], a[1]); w.y = cvt_pk_bf16(a[2], a[3]); w.z = cvt_pk_bf16(b[0], b[1]); w.w = cvt_pk_bf16(b[2], b[3]); return w; }

template <class Epi, class Sched, bool ALIGN_EPI>
__device__ __forceinline__ void gemm_phase(LAS unsigned char* lds, const int K, const Sched& S, const Epi& E) {
    const int tid = threadIdx.x, wid = __builtin_amdgcn_readfirstlane(tid >> 6), lane = tid & 63, wr = wid >> 2, wc = wid & 3, fr = lane & 15, fq = lane >> 4;
    const int nt = K / BK;
    int Rr[2]; unsigned cof[2], voffB[2];
#pragma unroll
    for (int i = 0; i < 2; ++i) { int R, C; stage_rc(tid * 16 + i * 8192, R, C); Rr[i] = R; cof[i] = (unsigned)C * 2u; const int Rb = Epi::PERM ? ((R & ~31) + perm32(R & 31)) : R; voffB[i] = (unsigned)(Rb * K + C) * 2u; }
    const size_t kstep = (size_t)(BK * 2);
    const size_t hstepB = (size_t)HALF * K * 2;
    const unsigned ldsw = (unsigned)wid * 1024u;
    const int aoff = lds_byte(wr * 64 + fr, fq * 8), boff = lds_byte(wc * 32 + fr, fq * 8);
#define PG8_SA(b, h) (((b) * 2 + (h)) * HTB)
#define PG8_SB(b, h) ((4 + (b) * 2 + (h)) * HTB)
#define PG8_STAGE(bufoff, gbase, voff) do { _Pragma("unroll") for (int _i = 0; _i < 2; ++_i) \
        __builtin_amdgcn_global_load_lds((const unsigned*)((const char*)(gbase) + (voff)[_i]), (LAS unsigned*)(lds + (bufoff) + ldsw + _i * 8192), 16, 0, 0); } while (0)
#define PG8_LDA(dst, b, h) do { _Pragma("unroll") for (int m = 0; m < 4; ++m) _Pragma("unroll") for (int k = 0; k < 2; ++k) dst[m][k] = *(const LAS bf16x8*)(lds + PG8_SA(b, h) + aoff + m * 2048 + k * 1024); } while (0)
#define PG8_LDB(dst, b, h) do { _Pragma("unroll") for (int n = 0; n < 2; ++n) _Pragma("unroll") for (int k = 0; k < 2; ++k) dst[n][k] = *(const LAS bf16x8*)(lds + PG8_SB(b, h) + boff + n * 2048 + k * 1024); } while (0)
#define PG8_MMA(ai, bj, At, Bt) do { __builtin_amdgcn_s_setprio(1); _Pragma("unroll") for (int m = 0; m < 4; ++m) _Pragma("unroll") for (int n = 0; n < 2; ++n) _Pragma("unroll") for (int k = 0; k < 2; ++k) \
        acc[ai][bj][m][n] = __builtin_amdgcn_mfma_f32_16x16x32_bf16(Bt[n][k], At[m][k], acc[ai][bj][m][n], 0, 0, 0); __builtin_amdgcn_s_setprio(0); } while (0)
#define PG8_WAIT_V(n) asm volatile("s_waitcnt vmcnt(" #n ")" ::: "memory")
#define PG8_WAIT_L(n) asm volatile("s_waitcnt lgkmcnt(" #n ")" ::: "memory")
#define PG8_BAR __builtin_amdgcn_s_barrier()
#define PG8_SCHED __builtin_amdgcn_sched_barrier(0)
    Unit cur, nxt; int ui = 0;
    if (!S.next(0, cur)) return;
    f32x4 acc[2][2][4][2];
#pragma unroll
    for (int a = 0; a < 2; ++a)
#pragma unroll
        for (int b = 0; b < 2; ++b)
#pragma unroll
            for (int m = 0; m < 4; ++m)
#pragma unroll
                for (int n = 0; n < 2; ++n) acc[a][b][m][n] = (f32x4){0.f, 0.f, 0.f, 0.f};
    bf16x8 At[4][2], B0[2][2], B1[2][2];
    unsigned vA0[2], vA1[2], vN0[2], vN1[2];
#pragma unroll
    for (int i = 0; i < 2; ++i) { vA0[i] = S.arow_off(cur, Rr[i]) + cof[i]; vA1[i] = S.arow_off(cur, Rr[i] + HALF) + cof[i]; }
    const char* cA = S.abase(cur); const char* cB = S.bbase(cur);
    PG8_STAGE(PG8_SB(0, 0), cB, voffB); PG8_STAGE(PG8_SB(0, 1), cB + hstepB, voffB); PG8_STAGE(PG8_SA(0, 0), cA, vA0); PG8_STAGE(PG8_SA(0, 1), cA, vA1);
    if (wr == 1) PG8_BAR;
    PG8_WAIT_V(2); PG8_BAR;
    PG8_STAGE(PG8_SB(1, 0), cB + kstep, voffB); PG8_STAGE(PG8_SA(1, 0), cA + kstep, vA0); PG8_STAGE(PG8_SB(1, 1), cB + hstepB + kstep, voffB);
    PG8_WAIT_V(6); PG8_BAR;
    for (;;) {
        const bool has_next = S.next(ui + 1, nxt);
        const char* nA = has_next ? S.abase(nxt) : cA; const char* nB = has_next ? S.bbase(nxt) : cB;
#pragma unroll
        for (int i = 0; i < 2; ++i) { vN0[i] = has_next ? S.arow_off(nxt, Rr[i]) + cof[i] : vA0[i]; vN1[i] = has_next ? S.arow_off(nxt, Rr[i] + HALF) + cof[i] : vA1[i]; }
#pragma unroll 1
        for (int t = 0; t < nt; t += 2) {
            const bool last = (t == nt - 2);
            const char* a1 = cA + (size_t)(t + 1) * kstep;
            const char* a2 = last ? nA : cA + (size_t)(t + 2) * kstep; const char* b2 = last ? nB : cB + (size_t)(t + 2) * kstep;
            const char* a3 = a2 + kstep; const char* b3 = b2 + kstep;
            unsigned w0[2], w1[2];
#pragma unroll
            for (int i = 0; i < 2; ++i) { w0[i] = last ? vN0[i] : vA0[i]; w1[i] = last ? vN1[i] : vA1[i]; }
            PG8_LDB(B0, 0, 0); PG8_LDB(B1, 0, 1); PG8_SCHED; PG8_LDA(At, 0, 0); PG8_STAGE(PG8_SA(1, 1), a1, vA1);
            PG8_WAIT_V(8); PG8_WAIT_L(0); PG8_BAR; PG8_MMA(0, 0, At, B0); PG8_MMA(0, 1, At, B1); PG8_BAR; PG8_SCHED;
            PG8_LDA(At, 0, 1); PG8_STAGE(PG8_SB(0, 0), b2, voffB); PG8_STAGE(PG8_SB(0, 1), b2 + hstepB, voffB); PG8_STAGE(PG8_SA(0, 0), a2, w0);
            PG8_WAIT_V(8); PG8_WAIT_L(0); PG8_BAR; PG8_MMA(1, 0, At, B0); PG8_MMA(1, 1, At, B1); PG8_BAR; PG8_SCHED;
            PG8_LDB(B0, 1, 0); PG8_LDB(B1, 1, 1); PG8_SCHED; PG8_LDA(At, 1, 0); PG8_STAGE(PG8_SA(0, 1), a2, w1);
            PG8_WAIT_V(8); PG8_WAIT_L(0); PG8_BAR; PG8_MMA(0, 0, At, B0); PG8_MMA(0, 1, At, B1); PG8_BAR; PG8_SCHED;
            PG8_LDA(At, 1, 1); PG8_STAGE(PG8_SB(1, 0), b3, voffB); PG8_STAGE(PG8_SB(1, 1), b3 + hstepB, voffB); PG8_STAGE(PG8_SA(1, 0), a3, w0);
            PG8_WAIT_V(8); PG8_WAIT_L(0); PG8_BAR; PG8_MMA(1, 0, At, B0); PG8_MMA(1, 1, At, B1); PG8_BAR; PG8_SCHED;
            if constexpr (Epi::MIDK) { if (t + 2 == nt / 2) E.midk(acc, cur, wr, wc, fr, fq); }
        }
        if constexpr (ALIGN_EPI) { if (wr == 0) PG8_BAR; }
        E(acc, cur, wr, wc, fr, fq);
        if (!has_next) break;
#pragma unroll
        for (int a = 0; a < 2; ++a)
#pragma unroll
            for (int b = 0; b < 2; ++b)
#pragma unroll
                for (int m = 0; m < 4; ++m)
#pragma unroll
                    for (int n = 0; n < 2; ++n) acc[a][b][m][n] = (f32x4){0.f, 0.f, 0.f, 0.f};
        cur = nxt; cA = nA; cB = nB; ++ui;
#pragma unroll
        for (int i = 0; i < 2; ++i) { vA0[i] = vN0[i]; vA1[i] = vN1[i]; }
        if constexpr (ALIGN_EPI) { if (wr == 1) PG8_BAR; }
    }
    PG8_WAIT_V(0);
    if constexpr (!ALIGN_EPI) { if (wr == 0) PG8_BAR; }
    PG8_BAR;
#undef PG8_SA
#undef PG8_SB
#undef PG8_STAGE
#undef PG8_LDA
#undef PG8_LDB
#undef PG8_MMA
#undef PG8_WAIT_V
#undef PG8_WAIT_L
#undef PG8_BAR
#undef PG8_SCHED
}

struct StaticOrder {
    const char* A; const char* Bt; int K;
    int nM, nN, nwg, G, c;
    __device__ void init(const void* A_, const void* Bt_, int M, int N, int K_, int G_, int c_) { A = (const char*)A_; Bt = (const char*)Bt_; K = K_; nM = M / BM; nN = N / BM; nwg = nM * nN; G = G_; c = c_; }
    __device__ bool next(int i, Unit& u) const {
        const long L = (long)i * G + c; if (L >= nwg) return false;
        int wgid = (int)L; { const int q = nwg / NXCD, r = nwg % NXCD, xcd = wgid % NXCD, off = wgid / NXCD; wgid = (xcd < r ? xcd * (q + 1) : r * (q + 1) + (xcd - r) * q) + off; }
        const int nig = WGM * nN, gid = wgid / nig, fm = gid * WGM, gsz = (nM - fm) < WGM ? (nM - fm) : WGM;
        u.pm = fm + ((wgid % nig) % gsz); u.pn = (wgid % nig) / gsz; return true;
    }
    __device__ __forceinline__ const char* abase(const Unit& u) const { return A + (size_t)u.pm * BM * K * 2; }
    __device__ __forceinline__ const char* bbase(const Unit& u) const { return Bt + (size_t)u.pn * BM * K * 2; }
    __device__ __forceinline__ unsigned arow_off(const Unit&, int R) const { return (unsigned)(R * K) * 2u; }
};
}

#define XB_TMO      128
#define XB_XCNT(j)  (256  + 64 * (j))
#define XB_XSUB(j)  (1280 + 64 * (j))
#define XB_XGEN(j)  (2304 + 64 * (j))
#define XB_TOP      3328
#define XB_TOPGEN   3392
#define XCD_BAR_WORDS 3456
#define XB_SPIN_CAP (1u << 18)
__device__ __forceinline__ unsigned xb_ld(unsigned* p)              { return __hip_atomic_load(p, __ATOMIC_RELAXED, __HIP_MEMORY_SCOPE_AGENT); }
__device__ __forceinline__ unsigned xb_add(unsigned* p, unsigned v) { return __hip_atomic_fetch_add(p, v, __ATOMIC_RELAXED, __HIP_MEMORY_SCOPE_AGENT); }
__device__ __forceinline__ unsigned xb_xcc_id() { return (unsigned)__builtin_amdgcn_s_getreg((3 << 11) | 20) & 0xFu; }
#define XB_SPIN(cond, bar) do { unsigned _sp = 0; while (cond) { __builtin_amdgcn_s_sleep(1); \
    if ((++_sp & 255u) == 0u) { if (xb_ld(&(bar)[XB_TMO])) break; if (_sp > XB_SPIN_CAP) { atomicAdd(&(bar)[XB_TMO], 1u); break; } } } } while (0)
struct XcdBarrier { unsigned* bar; unsigned x; volatile LAS unsigned* st; };
__device__ __forceinline__ XcdBarrier xcd_barrier_post(unsigned* bar, volatile LAS unsigned* st) {
    XcdBarrier b; b.bar = bar; b.x = xb_xcc_id(); b.st = st;
    if (threadIdx.x == 0) (void)xb_add(&bar[XB_XCNT(b.x)], 1u);
    return b;
}
__device__ __forceinline__ void xcd_barrier_complete(unsigned* bar, unsigned x, unsigned& nloc, unsigned& nx) {
    const unsigned G = gridDim.x * gridDim.y * gridDim.z;
    unsigned sum, cnt, mine, sp = 0u;
    for (;;) {
        sum = 0u; cnt = 0u; mine = 0u;
#pragma unroll
        for (unsigned j = 0; j < 16; ++j) { const unsigned c = xb_ld(&bar[XB_XCNT(j)]); sum += c; cnt += (c > 0u) ? 1u : 0u; mine = (j == x) ? c : mine; }
        if (sum == G) break;
        __builtin_amdgcn_s_sleep(1);
        if ((++sp & 255u) == 0u) { if (xb_ld(&bar[XB_TMO])) break; if (sp > XB_SPIN_CAP) { atomicAdd(&bar[XB_TMO], 1u); break; } }
    }
    nloc = mine > 0u ? mine : 1u; nx = cnt > 0u ? cnt : 1u;
}
__device__ __forceinline__ void xcd_barrier(const XcdBarrier& b) {
    asm volatile("s_waitcnt vmcnt(0)" ::: "memory");
    __syncthreads();
    if (threadIdx.x == 0) {
        unsigned* bar = b.bar;
        __builtin_amdgcn_s_waitcnt(0);
        unsigned nloc = b.st[0], nx = b.st[1];
        if (nloc == 0u) { xcd_barrier_complete(bar, b.x, nloc, nx); b.st[0] = nloc; b.st[1] = nx; }
        const unsigned old = xb_add(&bar[XB_XSUB(b.x)], 1u);
        const unsigned gen = old / nloc;
        if (old + 1u == (gen + 1u) * nloc) {
            __builtin_amdgcn_fence(__ATOMIC_RELEASE, "agent");
            asm volatile("s_waitcnt vmcnt(0)" ::: "memory");
            const unsigned og = xb_add(&bar[XB_TOP], 1u);
            const unsigned tg = og / nx;
            if (og + 1u == (tg + 1u) * nx) xb_add(&bar[XB_TOPGEN], 1u);
            else XB_SPIN(xb_ld(&bar[XB_TOPGEN]) == tg, bar);
            __builtin_amdgcn_fence(__ATOMIC_ACQUIRE, "agent");
            xb_add(&bar[XB_XGEN(b.x)], 1u);
            asm volatile("s_waitcnt vmcnt(0)" ::: "memory");
        } else {
            XB_SPIN(xb_ld(&bar[XB_XGEN(b.x)]) == gen, bar);
            __builtin_amdgcn_fence(__ATOMIC_ACQUIRE, "agent");
            asm volatile("s_waitcnt vmcnt(0)" ::: "memory");
        }
    }
    __syncthreads();
}

constexpr int NWAVES = 8;
constexpr int RING_BYTES = 135168, LDSCTL_OFF = RING_BYTES, MISC_OFF = LDSCTL_OFF + 320, LDS_BYTES = 147456;
constexpr int CW_BAR = 4096;
#define LDS_WAIT() asm volatile("s_waitcnt lgkmcnt(0)" ::: "memory")
#define VM_WAIT() asm volatile("s_waitcnt vmcnt(0)" ::: "memory")

struct Args {
    const float* in[24]; float* out; unsigned char* ws; int ph_lo, ph_hi;
};
struct Frame {
    LAS unsigned char* lds; unsigned char* ws; unsigned* ctl;
    int tid, lane, wave, G, bx;
};

__device__ __forceinline__ void p0_tr_item(const float* __restrict__ W, int ldn, int c0, int k0, bf16_t* dst, int K, const float* __restrict__ sc0, const float* __restrict__ sc1, LAS float* scr, int lane) {
    if (c0 >= 0) {
#pragma unroll 8
        for (int i = 0; i < 32; ++i) { const int kk = 2 * i + (lane >> 5); const int k = k0 + kk; float v = W[(size_t)k * ldn + c0 + (lane & 31)];
            if (sc0) v *= (k < 512 || !sc1) ? sc0[k] : sc1[k - 512];
            scr[kk * 33 + (lane & 31)] = v; }
    } else {
#pragma unroll 8
        for (int i = 0; i < 32; ++i) { const int kk = 2 * i + (lane >> 5); scr[kk * 33 + (lane & 31)] = 0.f; }
    }
    LDS_WAIT(); asm volatile("" ::: "memory");
    const int c = lane & 7;
#pragma unroll
    for (int j = 0; j < 4; ++j) { const int n = (lane >> 3) + 8 * j; const LAS float* s = scr + (8 * c) * 33 + n;
        u32x4 o; o.x = pk2(s[0 * 33], s[1 * 33]); o.y = pk2(s[2 * 33], s[3 * 33]); o.z = pk2(s[4 * 33], s[5 * 33]); o.w = pk2(s[6 * 33], s[7 * 33]);
        *(u32x4*)(dst + (size_t)n * K + k0 + 8 * c) = o; }
    LDS_WAIT(); asm volatile("" ::: "memory");
}
__device__ __forceinline__ int win_src_col(int tile, int q) {
    if (tile <= 1) return 256 * tile + 64 * (q & 3) + ((q >> 2) ? 32 : 0);
    if (tile == 2) { const int tb[8] = {512, 576, 640, 672, 544, 608, 704, 736}; int r = tb[0];
#pragma unroll
        for (int i = 1; i < 8; ++i) r = (q == i) ? tb[i] : r; return r; }
    if (tile == 3) return 768 + 32 * q;
    if (tile == 4) return 1024 + 32 * q;
    return q == 0 ? 1280 : (q == 4 ? 1312 : -1);
}
__device__ __forceinline__ int wuq_src_col(int tile, int q) {
    if (tile <= 1) return (2 * tile + (q >> 2)) * 192 + 32 * (q & 3);
    return (q & 3) * 192 + 128 + ((q >> 2) ? 32 : 0);
}

__device__ __forceinline__ void ln_row_bf16(const float* __restrict__ src, const float* __restrict__ g, const float* __restrict__ b, bf16_t* dst, int lane) {
    f32x4 v[4]; float s = 0.f;
#pragma unroll
    for (int j = 0; j < 4; ++j) { v[j] = *(const f32x4*)(src + j * 256 + lane * 4); s += (v[j].x + v[j].y) + (v[j].z + v[j].w); }
    const float mean = wave_sum(s) * (1.f / DM); float s2 = 0.f;
#pragma unroll
    for (int j = 0; j < 4; ++j) { v[j] = v[j] - mean; s2 += (v[j].x * v[j].x + v[j].y * v[j].y) + (v[j].z * v[j].z + v[j].w * v[j].w); }
    const float rstd = 1.f / sqrtf(wave_sum(s2) * (1.f / DM) + LN_EPS);
#pragma unroll
    for (int j = 0; j < 4; ++j) { const int c = j * 256 + lane * 4; const f32x4 gg = *(const f32x4*)(g + c), bb = *(const f32x4*)(b + c);
        const f32x4 o = v[j] * rstd * gg + bb; u32x2 w; w.x = pk2(o.x, o.y); w.y = pk2(o.z, o.w); *(u32x2*)(dst + c) = w; }
}

__device__ __forceinline__ void p0_meta(const Frame& F, const Args& a) {
    LAS float* hm = (LAS float*)(F.lds);
    LAS float* ck = (LAS float*)(F.lds + 65536);
    LAS float* ckn = (LAS float*)(F.lds + 65536 + 16384);
    LAS float* sB = (LAS float*)(F.lds + 65536 + 32768);
    const int lane = F.lane, w = F.wave;
    const float* meta = a.in[1]; const float* g = a.in[2]; const float* b = a.in[3]; const float* w_in = a.in[4]; const float* gkv = a.in[8]; const float* w_ukv = a.in[9];
    bf16_t* KA = (bf16_t*)(F.ws + WS_KA); bf16_t* VA = (bf16_t*)(F.ws + WS_VA); bf16_t* KM = (bf16_t*)(F.ws + WS_KM); bf16_t* VM = (bf16_t*)(F.ws + WS_VM);
#pragma unroll 1
    for (int rr = 0; rr < 2; ++rr) { const int row = 2 * w + rr; const float* src = meta + (size_t)row * DM;
        f32x4 v[4]; float s = 0.f;
#pragma unroll
        for (int j = 0; j < 4; ++j) { v[j] = *(const f32x4*)(src + j * 256 + lane * 4); s += (v[j].x + v[j].y) + (v[j].z + v[j].w); }
        const float mean = wave_sum(s) * (1.f / DM); float s2 = 0.f;
#pragma unroll
        for (int j = 0; j < 4; ++j) { v[j] = v[j] - mean; s2 += (v[j].x * v[j].x + v[j].y * v[j].y) + (v[j].z * v[j].z + v[j].w * v[j].w); }
        const float rstd = 1.f / sqrtf(wave_sum(s2) * (1.f / DM) + LN_EPS);
#pragma unroll
        for (int j = 0; j < 4; ++j) { const int c = j * 256 + lane * 4; const f32x4 gg = *(const f32x4*)(g + c), bb = *(const f32x4*)(b + c); const f32x4 o = v[j] * rstd * gg + bb;
            hm[(c + 0) * 16 + row] = o.x; hm[(c + 1) * 16 + row] = o.y; hm[(c + 2) * 16 + row] = o.z; hm[(c + 3) * 16 + row] = o.w; } }
    __syncthreads();
#pragma unroll 1
    for (int cg = w; cg < 9; cg += 8) {
        const int col = (cg < 2 ? 512 + 64 * cg : cg < 4 ? 640 + 64 * (cg - 2) : cg < 8 ? 1024 + 64 * (cg - 4) : 1280) + lane;
        float acc[16];
#pragma unroll
        for (int r = 0; r < 16; ++r) acc[r] = 0.f;
#pragma unroll 2
        for (int k = 0; k < DM; ++k) { const float wv = w_in[(size_t)k * INC + col];
            const f32x4 h0 = *(const LAS f32x4*)(hm + k * 16), h1 = *(const LAS f32x4*)(hm + k * 16 + 4), h2 = *(const LAS f32x4*)(hm + k * 16 + 8), h3 = *(const LAS f32x4*)(hm + k * 16 + 12);
            acc[0] += wv * h0.x; acc[1] += wv * h0.y; acc[2] += wv * h0.z; acc[3] += wv * h0.w; acc[4] += wv * h1.x; acc[5] += wv * h1.y; acc[6] += wv * h1.z; acc[7] += wv * h1.w;
            acc[8] += wv * h2.x; acc[9] += wv * h2.y; acc[10] += wv * h2.z; acc[11] += wv * h2.w; acc[12] += wv * h3.x; acc[13] += wv * h3.y; acc[14] += wv * h3.z; acc[15] += wv * h3.w; }
        const bool roped = (cg < 2) || (cg == 8);
        LAS float* dst = (cg >= 4 && cg < 8) ? ck + 64 * (cg - 4) + lane : sB + (cg < 4 ? 64 * cg : 256) + lane;
        const int dstride = (cg >= 4 && cg < 8) ? 256 : 320;
#pragma unroll
        for (int r = 0; r < 16; ++r) {
            float v = acc[r];
            if (roped) { float c, s; rope_cs(r, lane & 31, c, s); const float p = __shfl_xor(v, 32); v = (lane < 32) ? v * c - p * s : v * c + p * s; }
            dst[r * dstride] = v;
        }
    }
    __syncthreads();
#pragma unroll 1
    for (int idx = F.tid; idx < NB * 16 * 320; idx += NWAVES * 64) { const int b2 = idx / (16 * 320), rem = idx % (16 * 320), r = rem / 320, c = rem % 320;
        const size_t prow = (size_t)b2 * LP + NPAD + r; const bf16_t hv = (bf16_t)f2bf(sB[r * 320 + c]);
        if (c < 128) KA[prow * 128 + c] = hv; else if (c < 256) VA[prow * 128 + (c - 128)] = hv;
        else { const int cc = c - 256; KM[prow * 768 + 128 + cc] = hv; KM[prow * 768 + 192 + 128 + cc] = hv; KM[prow * 768 + 384 + 128 + cc] = hv; KM[prow * 768 + 576 + 128 + cc] = hv; } }
#pragma unroll 1
    for (int rr = 0; rr < 2; ++rr) { const int row = 2 * w + rr; float v[4]; float ss = 0.f;
#pragma unroll
        for (int j = 0; j < 4; ++j) { v[j] = ck[row * 256 + 64 * j + lane]; ss += v[j] * v[j]; }
        const float rstd = 1.f / sqrtf(wave_sum(ss) * (1.f / 256.f) + RMS_EPS);
#pragma unroll
        for (int j = 0; j < 4; ++j) ckn[(64 * j + lane) * 16 + row] = v[j] * rstd * gkv[64 * j + lane]; }
    __syncthreads();
#pragma unroll 1
    for (int cg = w; cg < 16; cg += 8) {
        const int col = 64 * cg + lane;
        float acc[16];
#pragma unroll
        for (int r = 0; r < 16; ++r) acc[r] = 0.f;
#pragma unroll 2
        for (int k = 0; k < 256; ++k) { const float wv = w_ukv[(size_t)k * 1024 + col];
            const f32x4 h0 = *(const LAS f32x4*)(ckn + k * 16), h1 = *(const LAS f32x4*)(ckn + k * 16 + 4), h2 = *(const LAS f32x4*)(ckn + k * 16 + 8), h3 = *(const LAS f32x4*)(ckn + k * 16 + 12);
            acc[0] += wv * h0.x; acc[1] += wv * h0.y; acc[2] += wv * h0.z; acc[3] += wv * h0.w; acc[4] += wv * h1.x; acc[5] += wv * h1.y; acc[6] += wv * h1.z; acc[7] += wv * h1.w;
            acc[8] += wv * h2.x; acc[9] += wv * h2.y; acc[10] += wv * h2.z; acc[11] += wv * h2.w; acc[12] += wv * h3.x; acc[13] += wv * h3.y; acc[14] += wv * h3.z; acc[15] += wv * h3.w; }
#pragma unroll
        for (int r = 0; r < 16; ++r) hm[r * 1024 + col] = acc[r];
    }
    __syncthreads();
#pragma unroll 1
    for (int idx = F.tid; idx < NB * 16 * 1024; idx += NWAVES * 64) { const int b2 = idx >> 14, r = (idx >> 10) & 15, col = idx & 1023, h = col >> 8, cc = col & 255;
        const size_t prow = (size_t)b2 * LP + NPAD + r; const bf16_t hv = (bf16_t)f2bf(hm[r * 1024 + col]);
        if (cc < 128) KM[prow * 768 + h * 192 + cc] = hv; else VM[prow * 512 + h * 128 + (cc - 128)] = hv; }
    __syncthreads();
}

__device__ __forceinline__ void p0_prologue(const Frame& F, const Args& a) {
    if (F.bx == F.G - 1) { p0_meta(F, a); return; }
    LAS float* scr = (LAS float*)(F.lds + F.wave * 16384);
    const int gw = F.bx * NWAVES + F.wave, NGW = (F.G - 1) * NWAVES, lane = F.lane;
    unsigned char* ws = F.ws;
    constexpr int I_IN = 16 * 48, I_UQ = 4 * 24, I_UKV = 4 * 32, I_O = 16 * 32, I_GU = 32 * 16 * 16, I_DN = 32 * 4 * 32;
    constexpr int NITEMS = I_IN + I_UQ + I_UKV + I_O + I_GU + I_DN;
    for (int it = gw; it < NITEMS; it += NGW) {
        int r = it;
        if (r < I_IN) { const int kb = r / 48, nb = r % 48; p0_tr_item(a.in[4], INC, win_src_col(nb >> 3, nb & 7), 64 * kb, (bf16_t*)(ws + WS_WIN) + (size_t)(32 * nb) * DM, DM, nullptr, nullptr, scr, lane); continue; } r -= I_IN;
        if (r < I_UQ) { const int kb = r / 24, nb = r % 24; p0_tr_item(a.in[7], 768, wuq_src_col(nb >> 3, nb & 7), 64 * kb, (bf16_t*)(ws + WS_WUQ) + (size_t)(32 * nb) * 256, 256, a.in[6], nullptr, scr, lane); continue; } r -= I_UQ;
        if (r < I_UKV) { const int kb = r / 32, nb = r % 32; p0_tr_item(a.in[9], 1024, 32 * nb, 64 * kb, (bf16_t*)(ws + WS_WUKV) + (size_t)(32 * nb) * 256, 256, a.in[8], nullptr, scr, lane); continue; } r -= I_UKV;
        if (r < I_O) { const int kb = r / 32, nb = r % 32; p0_tr_item(a.in[12], DM, 32 * nb, 64 * kb, (bf16_t*)(ws + WS_WO) + (size_t)(32 * nb) * DM, DM, a.in[10], a.in[11], scr, lane); continue; } r -= I_O;
        if (r < I_GU) { const int e = r / 256, r2 = r % 256, kb = r2 / 16, nb = r2 % 16; const int tile = nb >> 3, q = nb & 7;
            const float* src = (q < 4 ? a.in[19] : a.in[20]) + (size_t)e * DM * 256;
            p0_tr_item(src, 256, 128 * tile + 32 * (q & 3), 64 * kb, (bf16_t*)(ws + WS_WGU) + ((size_t)e * 512 + 32 * nb) * DM, DM, nullptr, nullptr, scr, lane); continue; } r -= I_GU;
        { const int e = r / 128, r2 = r % 128, kb = r2 / 32, nb = r2 % 32;
            p0_tr_item(a.in[21] + (size_t)e * 256 * DM, DM, 32 * nb, 64 * kb, (bf16_t*)(ws + WS_WDN) + ((size_t)e * 1024 + 32 * nb) * 256, 256, nullptr, nullptr, scr, lane); }
    }
    { float* COS = (float*)(ws + WS_COS); float* SIN = (float*)(ws + WS_SIN);
      for (int it = gw; it < NPOS * 32 / 64; it += NGW) { const int idx = it * 64 + lane; float c, s; rope_cs(idx >> 5, idx & 31, c, s); COS[idx] = c; SIN[idx] = s; } }
    for (int it = gw; it < NB * NPAD; it += NGW) { const size_t prow = (size_t)(it / NPAD) * LP + (it % NPAD);
        const u32x4 z = {0u, 0u, 0u, 0u};
        for (int o = lane * 16; o < 3072; o += 1024) {
            unsigned char* p;
            if (o < 256) p = ws + WS_KA + prow * 256 + o; else if (o < 512) p = ws + WS_VA + prow * 256 + (o - 512 + 256);
            else if (o < 2048) p = ws + WS_KM + prow * 1536 + (o - 512); else p = ws + WS_VM + prow * 1024 + (o - 2048);
            *(u32x4*)p = z; } }
    for (int m = gw; m < T; m += NGW) ln_row_bf16(a.in[0] + (size_t)m * DM, a.in[2], a.in[3], (bf16_t*)(ws + WS_H0) + (size_t)m * DM, lane);
}

__device__ __forceinline__ void rope8(const f32x4 lo0, const f32x4 lo1, const f32x4 hi0, const f32x4 hi1, const float* __restrict__ cosr, const float* __restrict__ sinr, u32x4& olo, u32x4& ohi, float scale) {
    const f32x4 c0 = *(const f32x4*)cosr, c1 = *(const f32x4*)(cosr + 4), s0 = *(const f32x4*)sinr, s1 = *(const f32x4*)(sinr + 4);
    olo = pg8::pack8((lo0 * c0 - hi0 * s0) * scale, (lo1 * c1 - hi1 * s1) * scale);
    ohi = pg8::pack8((hi0 * c0 + lo0 * s0) * scale, (hi1 * c1 + lo1 * s1) * scale);
}
struct EpiInProj {
    static constexpr bool PERM = true, MIDK = false;
    unsigned char* ws;
    __device__ __forceinline__ void operator()(const f32x4 (&acc)[2][2][4][2], const pg8::Unit& u, int wr, int wc, int fr, int fq) const {
        const int pn = u.pn, bb = u.pm >> 5, t0 = (u.pm & 31) * 256 + wr * 64 + fr;
        const float* COS = (const float*)(ws + WS_COS); const float* SIN = (const float*)(ws + WS_SIN);
        const int j0 = 8 * fq;
#pragma unroll
        for (int ai = 0; ai < 2; ++ai)
#pragma unroll
            for (int m = 0; m < 4; ++m) {
                const int t = t0 + ai * 128 + m * 16; const size_t mrow = (size_t)bb * SEQ + t; const size_t prow = (size_t)bb * LP + 128 + t; const int pos = t + NMETA;
                const f32x4 a00 = acc[ai][0][m][0], a01 = acc[ai][0][m][1], a10 = acc[ai][1][m][0], a11 = acc[ai][1][m][1];
                if (pn <= 1) { u32x4 lo, hi; rope8(a00, a01, a10, a11, COS + pos * 32 + j0, SIN + pos * 32 + j0, lo, hi, 1.f);
                    bf16_t* q = (bf16_t*)(ws + WS_QA) + mrow * 512 + (4 * pn + wc) * 64 + j0; *(u32x4*)q = lo; *(u32x4*)(q + 32) = hi; }
                else if (pn == 2) {
                    if (wc < 2) { u32x4 lo, hi; rope8(a00, a01, a10, a11, COS + pos * 32 + j0, SIN + pos * 32 + j0, lo, hi, 1.f);
                        bf16_t* k = (bf16_t*)(ws + WS_KA) + prow * 128 + wc * 64 + j0; *(u32x4*)k = lo; *(u32x4*)(k + 32) = hi; }
                    else { bf16_t* v = (bf16_t*)(ws + WS_VA) + prow * 128 + 32 * (wc - 2) + j0; *(u32x4*)v = pg8::pack8(a00, a01); *(u32x4*)(v + 64) = pg8::pack8(a10, a11); } }
                else if (pn <= 4) {
                    bf16_t* c = (bf16_t*)(ws + (pn == 3 ? WS_CQ : WS_CKV)) + mrow * 256 + 32 * wc + j0; *(u32x4*)c = pg8::pack8(a00, a01); *(u32x4*)(c + 128) = pg8::pack8(a10, a11);
                    const f32x4 q = a00 * a00 + a01 * a01 + a10 * a10 + a11 * a11; float s = (q[0] + q[1]) + (q[2] + q[3]);
                    s += __shfl_xor(s, 16); s += __shfl_xor(s, 32);
                    if (fq == 0) ((float*)(ws + (pn == 3 ? WS_CQS : WS_CKVS)))[mrow * 4 + wc] = s; }
                else { if (wc == 0) { u32x4 lo, hi; rope8(a00, a01, a10, a11, COS + pos * 32 + j0, SIN + pos * 32 + j0, lo, hi, 1.f);
                        bf16_t* k = (bf16_t*)(ws + WS_KM) + prow * 768 + 128 + j0;
#pragma unroll
                        for (int h = 0; h < 4; ++h) { *(u32x4*)(k + h * 192) = lo; *(u32x4*)(k + h * 192 + 32) = hi; } } }
            }
    }
};

struct UpOrder {
    const char* CQ; const char* CKV; const char* Wq; const char* Wkv; int G, c;
    __device__ bool next(int i, pg8::Unit& u) const {
        int L = i * G + c; if (L >= 896) return false;
        if (L < 384) { u.pm = L / 3; u.pn = L % 3; } else { L -= 384; u.pm = L >> 2; u.pn = 3 + (L & 3); }
        return true;
    }
    __device__ __forceinline__ const char* abase(const pg8::Unit& u) const { return (u.pn < 3 ? CQ : CKV) + (size_t)u.pm * 256 * 256 * 2; }
    __device__ __forceinline__ const char* bbase(const pg8::Unit& u) const { return u.pn < 3 ? Wq + (size_t)u.pn * 256 * 256 * 2 : Wkv + (size_t)(u.pn - 3) * 256 * 256 * 2; }
    __device__ __forceinline__ unsigned arow_off(const pg8::Unit&, int R) const { return (unsigned)(R * 256) * 2u; }
};
struct EpiUp {
    static constexpr bool PERM = true, MIDK = false;
    unsigned char* ws;
    __device__ __forceinline__ void operator()(const f32x4 (&acc)[2][2][4][2], const pg8::Unit& u, int wr, int wc, int fr, int fq) const {
        const int pn = u.pn, bb = u.pm >> 5, tb = (u.pm & 31) * 256;
        const size_t m0 = (size_t)bb * SEQ + tb, p0 = (size_t)bb * LP + 128 + tb;
        const char* COSb = (const char*)(ws + WS_COS) + (size_t)(tb + NMETA) * 128; const char* SINb = (const char*)(ws + WS_SIN) + (size_t)(tb + NMETA) * 128;
        const char* SSb = (const char*)(ws + (pn < 3 ? WS_CQS : WS_CKVS)) + m0 * 16;
        char* QMb = (char*)(ws + WS_QM) + m0 * 1536; char* KMb = (char*)(ws + WS_KM) + p0 * 1536; char* VMb = (char*)(ws + WS_VM) + p0 * 1024;
        int rl = wr * 64 + fr; asm volatile("" : "+v"(rl));
        const int j0 = 8 * fq;
#pragma unroll
        for (int ai = 0; ai < 2; ++ai)
#pragma unroll
            for (int m = 0; m < 4; ++m) {
                const unsigned r = (unsigned)(rl + ai * 128 + m * 16);
                const f32x4 sv = *(const f32x4*)(SSb + (size_t)(r * 16u));
                const float rstd = 1.f / sqrtf(((sv[0] + sv[1]) + (sv[2] + sv[3])) * (1.f / 256.f) + RMS_EPS);
                const f32x4 a00 = acc[ai][0][m][0] * rstd, a01 = acc[ai][0][m][1] * rstd, a10 = acc[ai][1][m][0] * rstd, a11 = acc[ai][1][m][1] * rstd;
                if (pn < 2) { char* q = QMb + (size_t)(r * 1536u + (unsigned)(((2 * pn) * 192 + 32 * wc + j0) * 2)); *(u32x4*)q = pg8::pack8(a00, a01); *(u32x4*)(q + 384) = pg8::pack8(a10, a11); }
                else if (pn == 2) { u32x4 lo, hi; const unsigned co = r * 128u + (unsigned)(j0 * 4); rope8(a00, a01, a10, a11, (const float*)(COSb + (size_t)co), (const float*)(SINb + (size_t)co), lo, hi, 1.f);
                    char* q = QMb + (size_t)(r * 1536u + (unsigned)((wc * 192 + 128 + j0) * 2)); *(u32x4*)q = lo; *(u32x4*)(q + 64) = hi; }
                else { const int h = pn - 3;
                    *(u32x4*)(KMb + (size_t)(r * 1536u + (unsigned)((h * 192 + 32 * wc + j0) * 2))) = pg8::pack8(a00, a01);
                    *(u32x4*)(VMb + (size_t)(r * 1024u + (unsigned)((h * 128 + 32 * wc + j0) * 2))) = pg8::pack8(a10, a11); }
                asm volatile("" ::: "memory");
            }
    }
};

namespace att {
typedef short s16x4 __attribute__((ext_vector_type(4)));
typedef float f32x16 __attribute__((ext_vector_type(16)));
constexpr int NW = 8, QBLK = 32, KVBLK = 64, QB = NW * QBLK;
#define SBAR() __builtin_amdgcn_sched_barrier(0)
__device__ __forceinline__ int crow(int r, int hi) { return (r & 3) + 8 * (r >> 2) + 4 * hi; }
__device__ __forceinline__ unsigned cvtpk(float lo, float hi) { unsigned r; asm volatile("v_cvt_pk_bf16_f32 %0, %1, %2" : "=v"(r) : "v"(lo), "v"(hi)); return r; }
__device__ __forceinline__ int v_rd_base(int lane) { return ((lane & 3) << 3) | (((lane >> 2) & 3) << 6) | (((lane >> 4) & 1) << 5) | (((lane >> 5) & 1) << 8); }

template <int DQK_, int DV_, int LDQ_, int LDK_, int LDV_, int W_, bool SK_, int NPARK_>
struct Cfg {
    static constexpr int DQK = DQK_, DV = DV_, LDQ = LDQ_, LDK = LDK_, LDV = LDV_, W = W_; static constexpr bool SK = SK_;
    static constexpr int ROWB = DQK * 2, SHM_K = KVBLK * ROWB, SHM_V = KVBLK * DV * 2;
    static constexpr int KCPR = DQK / 8, VCPR = DV / 8, NKC = KVBLK * KCPR / 512, NVC = KVBLK * VCPR / 512, KG = (DV / 32) * 512, NQF = DQK / 16, NOF = DV / 32;
    static constexpr int NPARK = NPARK_, NQR = DQK_ / 16 - NPARK_;
    static constexpr int WS_OFF = 2 * SHM_V + 2 * SHM_K, PARK_OFF = WS_OFF + NW * 64 * 4, LDS_BYTES = PARK_OFF + NW * NPARK_ * 1024;
};
template <class C> struct BlockRef { const bf16_t* Q; const bf16_t* K; const bf16_t* V; bf16_t* O; float* SSQ; int P0; float m0, l0, c2; };
template <class C> struct Seam { bf16x8 qr[C::NQR]; bf16x8 st_k[C::NKC]; bf16x8 st_v[C::NVC]; };

__device__ __forceinline__ void mask_tile(f32x16& p0, f32x16& p1, int dq, unsigned W, int klim) {
    const float NEG = -__builtin_inff();
#pragma unroll
    for (int r = 0; r < 16; ++r) {
        const int c = (r & 3) + 8 * (r >> 2);
        if ((unsigned)(dq - c) >= W || c < klim) p0[r] = NEG;
        if ((unsigned)(dq - c - 32) >= W || c + 32 < klim) p1[r] = NEG;
    }
}
__device__ __forceinline__ void partialSM(f32x16& p0, f32x16& p1, float& m_reg, float& mn, float& alpha, float c2, float thr) {
    float pmax = p0[0];
#pragma unroll
    for (int r = 1; r < 16; ++r) pmax = fmaxf(pmax, p0[r]);
#pragma unroll
    for (int r = 0; r < 16; ++r) pmax = fmaxf(pmax, p1[r]);
    { auto rr = __builtin_amdgcn_permlane32_swap(__float_as_uint(pmax), __float_as_uint(pmax), false, false);
      pmax = fmaxf(__uint_as_float(rr[0]), __uint_as_float(rr[1])); }
    if (__builtin_expect(__all((pmax - m_reg) <= thr), 1)) { mn = m_reg; alpha = 1.f; }
    else { mn = fmaxf(m_reg, pmax); alpha = __builtin_amdgcn_exp2f((m_reg - mn) * c2); m_reg = mn; }
    const float mnL = -mn * c2;
#pragma unroll
    for (int r = 0; r < 16; ++r) p0[r] = fmaf(p0[r], c2, mnL);
#pragma unroll
    for (int r = 0; r < 16; ++r) p1[r] = fmaf(p1[r], c2, mnL);
#pragma unroll
    for (int r = 0; r < 16; ++r) p0[r] = __builtin_amdgcn_exp2f(p0[r]);
}
__device__ __forceinline__ void finishSM(f32x16& p0, f32x16& p1, float alpha, float& l_reg, bf16x8& pa0, bf16x8& pa1, bf16x8& pa2, bf16x8& pa3) {
#pragma unroll
    for (int r = 0; r < 16; ++r) p1[r] = __builtin_amdgcn_exp2f(p1[r]);
    float ps = 0;
#pragma unroll
    for (int r = 0; r < 16; ++r) ps += p0[r];
#pragma unroll
    for (int r = 0; r < 16; ++r) ps += p1[r];
    { auto rr = __builtin_amdgcn_permlane32_swap(__float_as_uint(ps), __float_as_uint(ps), false, false);
      ps = __uint_as_float(rr[0]) + __uint_as_float(rr[1]); }
    l_reg = l_reg * alpha + ps;
#define PK4(P, B_, OUT) do { unsigned a0 = cvtpk(P[B_+0], P[B_+1]), a1 = cvtpk(P[B_+2], P[B_+3]);                          \
        unsigned b0 = cvtpk(P[B_+4], P[B_+5]), b1 = cvtpk(P[B_+6], P[B_+7]);                                             \
        auto r0 = __builtin_amdgcn_permlane32_swap(a0, b0, false, false); auto r1 = __builtin_amdgcn_permlane32_swap(a1, b1, false, false); \
        u32x4 w = {r0[0], r1[0], r0[1], r1[1]}; OUT = *reinterpret_cast<bf16x8*>(&w); } while (0)
    PK4(p0, 0, pa0); PK4(p0, 8, pa1); PK4(p1, 0, pa2); PK4(p1, 8, pa3);
#undef PK4
}
template <class C, int KB>
__device__ __forceinline__ void qkt(f32x16& p0, f32x16& p1, const char* K_lds, int r32, int hi, const bf16x8* qr, const char* qpark, bool act) {
    if (C::SK && !act) { const float NEG = -__builtin_inff();
#pragma unroll
        for (int r = 0; r < 16; ++r) { p0[r] = NEG; p1[r] = NEG; } return; }
    p0 = f32x16{}; p1 = f32x16{};
    const char* kb[4];
#pragma unroll
    for (int dd = 0; dd < 4; ++dd) kb[dd] = K_lds + KB * C::SHM_K + r32 * C::ROWB + (((dd * 16 + hi * 8) * 2) ^ ((r32 & 7) << 4));
#pragma unroll
    for (int d0 = 0; d0 < C::NQF; ++d0) { const char* a = kb[d0 & 3] + (d0 >> 2) * 128;
        bf16x8 b0 = *reinterpret_cast<const bf16x8*>(a);
        bf16x8 b1 = *reinterpret_cast<const bf16x8*>(a + 32 * C::ROWB);
        bf16x8 qf; if (d0 < C::NQR) qf = qr[d0 < C::NQR ? d0 : 0]; else qf = *reinterpret_cast<const bf16x8*>(qpark + (d0 - C::NQR) * 1024);
        p0 = __builtin_amdgcn_mfma_f32_32x32x16_bf16(b0, qf, p0, 0, 0, 0);
        p1 = __builtin_amdgcn_mfma_f32_32x32x16_bf16(b1, qf, p1, 0, 0, 0);
        if (C::NQF > 8 && (d0 & 3) == 3) SBAR(); }
}
template <class C, int VB>
__device__ __forceinline__ void pv_tile(f32x16* o, int vb0, bf16x8 pa0, bf16x8 pa1, bf16x8 pa2, bf16x8 pa3, bool act) {
    if (C::SK && !act) return;
#define TRRD(dst, off) asm volatile("ds_read_b64_tr_b16 %0, %1 offset:%2" : "=&v"(dst) : "v"(vb0), "i"(off) : "memory")
#define PV_D0(d0) do { s16x4 l0, l1, l2, l3, h0, h1, h2, h3; constexpr int b_ = VB * C::SHM_V + (d0) * 512; constexpr int KG_ = C::KG;   \
        TRRD(l0, b_); TRRD(h0, b_ + KG_); TRRD(l1, b_ + 2 * KG_); TRRD(h1, b_ + 3 * KG_); TRRD(l2, b_ + 4 * KG_); TRRD(h2, b_ + 5 * KG_); TRRD(l3, b_ + 6 * KG_); TRRD(h3, b_ + 7 * KG_); \
        asm volatile("s_waitcnt lgkmcnt(0)" ::: "memory"); SBAR();   \
        o[d0] = __builtin_amdgcn_mfma_f32_32x32x16_bf16(pa0, (bf16x8){l0[0], l0[1], l0[2], l0[3], h0[0], h0[1], h0[2], h0[3]}, o[d0], 0, 0, 0);   \
        o[d0] = __builtin_amdgcn_mfma_f32_32x32x16_bf16(pa1, (bf16x8){l1[0], l1[1], l1[2], l1[3], h1[0], h1[1], h1[2], h1[3]}, o[d0], 0, 0, 0);   \
        o[d0] = __builtin_amdgcn_mfma_f32_32x32x16_bf16(pa2, (bf16x8){l2[0], l2[1], l2[2], l2[3], h2[0], h2[1], h2[2], h2[3]}, o[d0], 0, 0, 0);   \
        o[d0] = __builtin_amdgcn_mfma_f32_32x32x16_bf16(pa3, (bf16x8){l3[0], l3[1], l3[2], l3[3], h3[0], h3[1], h3[2], h3[3]}, o[d0], 0, 0, 0); } while (0)
    PV_D0(0); PV_D0(1);
    if constexpr (C::NOF == 4) { PV_D0(2); PV_D0(3); }
#undef PV_D0
#undef TRRD
}
template <class C> __device__ __forceinline__ int jlo(int P0) { const int lowk = P0 - C::W + 1; int j = lowk > 0 ? lowk / KVBLK : 0; const int jm = NPAD / KVBLK; return j < jm ? jm : j; }

#define AT_RSRC(p) __builtin_amdgcn_make_buffer_rsrc((void*)(p), 0, 0x7fffffff, 0x00020000)
#define AT_BLD(rs, vo, so) __builtin_bit_cast(bf16x8, __builtin_amdgcn_raw_buffer_load_b128((rs), (int)(vo), (int)(so), 0))
#define AT_SLOAD(Kp, Vp, k0) do { const __amdgpu_buffer_rsrc_t kr__ = AT_RSRC(Kp), vr__ = AT_RSRC(Vp); const int ks__ = (k0) * (C::LDK * 2), vs__ = (k0) * (C::LDV * 2); \
    _Pragma("unroll") for (int i_ = 0; i_ < C::NVC; ++i_) S.st_v[i_] = AT_BLD(vr__, vgo + (unsigned)(i_ * 128), vs__); \
    _Pragma("unroll") for (int i_ = 0; i_ < C::NKC; ++i_) S.st_k[i_] = AT_BLD(kr__, kgo + (unsigned)(i_ * 128), ks__); } while (0)
#define AT_SWRITE_K(bf) do { _Pragma("unroll") for (int i_ = 0; i_ < C::NKC; ++i_) *(bf16x8*)(K_lds + (bf) * C::SHM_K + klo + i_ * 128) = S.st_k[i_]; } while (0)
#define AT_SWRITE_V(bf) do { _Pragma("unroll") for (int i_ = 0; i_ < C::NVC; ++i_) *(bf16x8*)(V_lds + (bf) * C::SHM_V + vlo + i_ * 1024) = S.st_v[i_]; } while (0)
#define AT_STAGE_OFFS() \
    const int srow_ = tid >> 3, scc_ = tid & 7; \
    const unsigned kgo = (unsigned)(srow_ * C::LDK + scc_ * 8) * 2u, vgo = (unsigned)(srow_ * C::LDV + scc_ * 8) * 2u; \
    const int klo = srow_ * C::ROWB + ((scc_ * 16) ^ ((srow_ & 7) << 4)); \
    const int skk_ = (srow_ & ~0xC) | ((srow_ & 4) << 1) | ((srow_ & 8) >> 1); \
    const int vlo = ((skk_ >> 3) * C::NOF + (scc_ >> 2)) * 512 + ((skk_ & 7) * 32 + (scc_ & 3) * 8) * 2;
#define AT_VMW() asm volatile("s_waitcnt vmcnt(0)" ::: "memory")
#define AT_VMWN(n) asm volatile("s_waitcnt vmcnt(%0)" :: "i"(n) : "memory")

#define AT_QLOAD(Qp) do { bf16x8 qp_[C::NPARK > 0 ? C::NPARK : 1]; \
    const __amdgpu_buffer_rsrc_t qr__ = AT_RSRC(Qp); const int qs__ = wid * (QBLK * C::LDQ * 2); const unsigned qo__ = (unsigned)(r32 * C::LDQ + hi * 8) * 2u; \
    _Pragma("unroll") for (int d0 = 0; d0 < C::NPARK; ++d0) qp_[d0] = AT_BLD(qr__, qo__ + (unsigned)((C::NQR + d0) * 32), qs__); \
    _Pragma("unroll") for (int d0 = 0; d0 < C::NQR; ++d0) S.qr[d0] = AT_BLD(qr__, qo__ + (unsigned)(d0 * 32), qs__); \
    SBAR(); AT_VMWN(C::NQR); \
    _Pragma("unroll") for (int d0 = 0; d0 < C::NPARK; ++d0) *(bf16x8*)(qpark + d0 * 1024) = qp_[d0]; } while (0)
template <class C>
__device__ __forceinline__ void prime(const BlockRef<C>& cur, char* lds, Seam<C>& S, const int tid) {
    const int wid = __builtin_amdgcn_readfirstlane(tid >> 6), lane = tid & 63, r32 = lane & 31, hi = lane >> 5;
    char* K_lds = lds + 2 * C::SHM_V;
    AT_STAGE_OFFS()
    const int kb0 = jlo<C>(cur.P0) * KVBLK;
    char* qpark = lds + C::PARK_OFF + wid * (C::NPARK * 1024) + lane * 16;
    AT_SLOAD(cur.K, cur.V, kb0); SBAR(); AT_QLOAD(cur.Q); AT_VMW(); AT_SWRITE_K(0);
    __syncthreads();
}
template <class C>
__device__ __forceinline__ void block(const BlockRef<C>& cur, const BlockRef<C>& nxt, char* lds, Seam<C>& S, int ssq_slot, const int tid) {
    constexpr bool SK = C::SK; constexpr int W = C::W;
    const int wid = __builtin_amdgcn_readfirstlane(tid >> 6), lane = tid & 63, r32 = lane & 31, hi = lane >> 5;
    const int j_lo = jlo<C>(cur.P0);
    const int j_hi = (cur.P0 + QB - 1) / KVBLK + 1;
    const int NT = j_hi - j_lo;
    const int kbn = jlo<C>(nxt.P0) * KVBLK;
    const int qlo = cur.P0 + wid * QBLK, qm = qlo + r32 - 4 * hi;
    char* V_lds = lds; char* K_lds = lds + 2 * C::SHM_V;
    AT_STAGE_OFFS()
    float* ws = (float*)(lds + C::WS_OFF) + wid * 64; float* li_l = ws, * al_l = ws + 32;
    char* qpark = lds + C::PARK_OFF + wid * (C::NPARK * 1024) + lane * 16;
    float m_reg = cur.m0, l_reg = cur.l0; const float c2 = cur.c2, thr = 8.f * 1.4426950408889634f / c2;
    f32x16 o[C::NOF];
#pragma unroll
    for (int d_ = 0; d_ < C::NOF; ++d_) o[d_] = f32x16{};
    const int vb0 = (int)(uintptr_t)V_lds + v_rd_base(lane);
    const bf16_t* Kh = cur.K; const bf16_t* Vh = cur.V;
#define RESC(a) do { if (__any((a) < 1.f)) { if (hi == 0) al_l[r32] = (a); asm volatile("s_waitcnt lgkmcnt(0)" ::: "memory");              \
                     _Pragma("unroll") for (int d_ = 0; d_ < C::NOF; ++d_) _Pragma("unroll") for (int r = 0; r < 16; ++r) o[d_][r] *= al_l[crow(r, hi)]; } } while (0)
#define KBASE(t) ((j_lo + (t)) * KVBLK)
#define ACT(t) (KBASE(t) <= qlo + QBLK - 1 && KBASE(t) + KVBLK - 1 >= qlo - W + 1)
#define MASKT(P0_, P1_, t) do { const int kb_ = KBASE(t); if ((!SK || ACT(t)) && (kb_ + KVBLK - 1 > qlo || kb_ <= qlo + QBLK - 1 - W || kb_ < NPAD)) mask_tile(P0_, P1_, qm - kb_, (unsigned)W, NPAD - kb_ - 4 * hi); } while (0)
    f32x16 P0, P1; float mn, al; bf16x8 pa0, pa1, pa2, pa3;
    AT_SWRITE_V(0); __syncthreads();
#define STEP(t, B_, NB_) do { const bool more_ = (t) + 1 < NT;                                                              \
        SBAR(); if (more_) { AT_SLOAD(Kh, Vh, KBASE((t) + 1)); } else { AT_SLOAD(nxt.K, nxt.V, kbn); } SBAR();              \
        qkt<C, B_>(P0, P1, K_lds, r32, hi, S.qr, qpark, ACT(t)); SBAR();                                                   \
        MASKT(P0, P1, (t)); partialSM(P0, P1, m_reg, mn, al, c2, thr); RESC(al);                                            \
        finishSM(P0, P1, al, l_reg, pa0, pa1, pa2, pa3); SBAR();                                                             \
        pv_tile<C, B_>(o, vb0, pa0, pa1, pa2, pa3, ACT(t)); SBAR();                                                        \
        if (more_) { AT_VMW(); AT_SWRITE_V(NB_); AT_SWRITE_K(NB_); }                                                        \
        __syncthreads(); } while (0)
    int t = 0;
    for (; t + 1 < NT; t += 2) { STEP(t, 0, 1); STEP(t + 1, 1, 0); }
    if (t < NT) { STEP(t, 0, 1); }
#undef STEP
    AT_QLOAD(nxt.Q);
    AT_SWRITE_K(0); SBAR();
    if (hi == 0) li_l[r32] = l_reg; asm volatile("s_waitcnt lgkmcnt(0)" ::: "memory");
    float rli[16], sq[16];
#pragma unroll
    for (int r = 0; r < 16; ++r) { rli[r] = __builtin_amdgcn_rcpf(li_l[crow(r, hi)]); sq[r] = 0.f; }
    char* Ow = (char*)(cur.O + (size_t)(wid * QBLK) * 1024); const unsigned oo = (unsigned)(4 * hi * 1024 + r32) * 2u;
#pragma unroll
    for (int r = 0; r < 16; ++r) {
#pragma unroll
        for (int d0 = 0; d0 < C::NOF; ++d0) { const float v = o[d0][r] * rli[r]; sq[r] += v * v;
            const float vn = __shfl_xor(v, 1);
            if ((r32 & 1) == 0) *(unsigned*)(Ow + (size_t)(oo + (unsigned)((((r & 3) + 8 * (r >> 2)) * 1024 + d0 * 32) * 2))) = cvtpk(v, vn); } }
    float sel = 0.f; int r32e = r32, hie = hi; asm volatile("" : "+v"(r32e), "+v"(hie));
#pragma unroll
    for (int r = 0; r < 16; ++r) { float s = sq[r]; s += __shfl_xor(s, 1); s += __shfl_xor(s, 2); s += __shfl_xor(s, 4); s += __shfl_xor(s, 8); s += __shfl_xor(s, 16); sel = (r32e == r) ? s : sel; }
    if (r32e < 16) *(float*)((char*)(cur.SSQ + (size_t)(wid * QBLK) * 12 + ssq_slot) + (size_t)((unsigned)crow(r32e, hie) * 48u)) = sel;
    __syncthreads();
#undef RESC
#undef KBASE
#undef ACT
#undef MASKT
}
#undef AT_STAGE_OFFS
#undef AT_SLOAD
#undef AT_SWRITE_K
#undef AT_SWRITE_V
#undef AT_VMW
#undef AT_VMWN
#undef AT_QLOAD
#undef AT_RSRC
#undef AT_BLD
#undef SBAR

typedef Cfg<192, 128, 768, 768, 512, LP, false, 4> CfgMLA;
typedef Cfg<64, 64, 512, 128, 128, 128, true, 0> CfgSWA;
constexpr float C2_MLA = 1.4426950408889634f * 0.07216878364870322f, C2_SWA = 1.4426950408889634f * 0.125f;
static_assert(CfgMLA::LDS_BYTES <= RING_BYTES && CfgSWA::LDS_BYTES <= RING_BYTES, "attention LDS");

__device__ __forceinline__ BlockRef<CfgMLA> mla_ref(unsigned char* ws, int bh, int qb) {
    const int b = bh >> 2, h = bh & 3; BlockRef<CfgMLA> r; const size_t m0 = (size_t)b * SEQ + (size_t)qb * QB;
    r.Q = (const bf16_t*)(ws + WS_QM) + m0 * 768 + h * 192; r.K = (const bf16_t*)(ws + WS_KM) + (size_t)b * LP * 768 + h * 192;
    r.V = (const bf16_t*)(ws + WS_VM) + (size_t)b * LP * 512 + h * 128; r.O = (bf16_t*)(ws + WS_AO) + m0 * 1024 + 512 + h * 128;
    r.SSQ = (float*)(ws + WS_SSQ) + m0 * 12; r.P0 = 128 + qb * QB; r.m0 = -1e30f; r.l0 = 0.f; r.c2 = C2_MLA; return r;
}
__device__ __forceinline__ BlockRef<CfgSWA> swa_ref(unsigned char* ws, const float* sinks, int bh, int qb) {
    const int b = bh >> 3, h = bh & 7, kvh = h >> 2; BlockRef<CfgSWA> r; const size_t m0 = (size_t)b * SEQ + (size_t)qb * QB;
    r.Q = (const bf16_t*)(ws + WS_QA) + m0 * 512 + h * 64; r.K = (const bf16_t*)(ws + WS_KA) + (size_t)b * LP * 128 + kvh * 64;
    r.V = (const bf16_t*)(ws + WS_VA) + (size_t)b * LP * 128 + kvh * 64; r.O = (bf16_t*)(ws + WS_AO) + m0 * 1024 + h * 64;
    r.SSQ = (float*)(ws + WS_SSQ) + m0 * 12; r.P0 = 128 + qb * QB; r.m0 = sinks[h] * 8.f; r.l0 = 1.f; r.c2 = C2_SWA; return r;
}
__device__ __forceinline__ void attn_phase(char* lds, unsigned char* ws, const float* sinks, int vcu, int G) {
    {
        const int nit = (256 - vcu + G - 1) / G;
        const int nblk = 2 * (nit > 0 ? nit : 0);
        if (nblk > 0) {
            Seam<CfgMLA> S; int tid = threadIdx.x; asm volatile("" : "+v"(tid));
#define MLA_REF(k) mla_ref(ws, (vcu + ((k) >> 1) * G) >> 4, ((k) & 1) ? ((vcu + ((k) >> 1) * G) & 15) : 31 - ((vcu + ((k) >> 1) * G) & 15))
            BlockRef<CfgMLA> cur = MLA_REF(0);
            prime<CfgMLA>(cur, lds, S, tid);
            for (int k = 0; k < nblk; ++k) { const BlockRef<CfgMLA> nxt = (k + 1 < nblk) ? MLA_REF(k + 1) : cur; block<CfgMLA>(cur, nxt, lds, S, 8 + (((vcu + (k >> 1) * G) >> 4) & 3), tid); cur = nxt; }
#undef MLA_REF
        }
    }
    {
        const int nit = (256 - vcu + G - 1) / G;
        const int nblk = 4 * (nit > 0 ? nit : 0);
        if (nblk > 0) {
            Seam<CfgSWA> S; int tid = threadIdx.x; asm volatile("" : "+v"(tid));
#define SWA_REF(k) swa_ref(ws, sinks, (4 * (vcu + ((k) >> 2) * G) + ((k) & 3)) >> 5, (4 * (vcu + ((k) >> 2) * G) + ((k) & 3)) & 31)
            BlockRef<CfgSWA> cur = SWA_REF(0);
            prime<CfgSWA>(cur, lds, S, tid);
            for (int k = 0; k < nblk; ++k) { const BlockRef<CfgSWA> nxt = (k + 1 < nblk) ? SWA_REF(k + 1) : cur; block<CfgSWA>(cur, nxt, lds, S, ((4 * (vcu + (k >> 2) * G) + (k & 3)) >> 5) & 7, tid); cur = nxt; }
#undef SWA_REF
        }
    }
}
}

struct EpiOut {
    static constexpr bool PERM = false, MIDK = true;
    unsigned char* ws;
    __device__ __forceinline__ void midk(f32x4 (&acc)[2][2][4][2], const pg8::Unit& u, int wr, int wc, int fr, int fq) const {
        const char* SSQb = (const char*)(ws + WS_SSQ) + (size_t)u.pm * (256 * 48);
        unsigned lo = (unsigned)(wr * 64 + fr) * 48u; asm volatile("" : "+v"(lo));
#pragma unroll
        for (int ai = 0; ai < 2; ++ai)
#pragma unroll
            for (int m = 0; m < 4; ++m) { const char* p = SSQb + (size_t)(lo + (unsigned)((ai * 128 + m * 16) * 48));
                const f32x4 s0 = *(const f32x4*)p, s1 = *(const f32x4*)(p + 16), s2 = *(const f32x4*)(p + 32);
                const float sa = ((s0[0] + s0[1]) + (s0[2] + s0[3])) + ((s1[0] + s1[1]) + (s1[2] + s1[3])), sb = (s2[0] + s2[1]) + (s2[2] + s2[3]);
                const float rho = sqrtf((sb * (1.f / 512.f) + RMS_EPS) / (sa * (1.f / 512.f) + RMS_EPS));
#pragma unroll
                for (int bj = 0; bj < 2; ++bj)
#pragma unroll
                    for (int n = 0; n < 2; ++n) acc[ai][bj][m][n] *= rho;
                asm volatile("" ::: "memory"); }
    }
    __device__ __forceinline__ void operator()(const f32x4 (&acc)[2][2][4][2], const pg8::Unit& u, int wr, int wc, int fr, int fq) const {
        const char* SSQb = (const char*)(ws + WS_SSQ) + (size_t)u.pm * (256 * 48) + 32;
        const size_t tile = ((size_t)u.pm * 256) * DM + (size_t)u.pn * 256;
        const char* H0b = (const char*)(ws + WS_H0) + tile * 2; char* Pb = (char*)(ws + WS_PRE1) + tile * 4;
        unsigned lo = (unsigned)(wr * 64 + fr) * 48u, eo = (unsigned)((wr * 64 + fr) * DM + wc * 32 + 4 * fq); asm volatile("" : "+v"(lo), "+v"(eo));
#pragma unroll
        for (int ai = 0; ai < 2; ++ai)
#pragma unroll
            for (int m = 0; m < 4; ++m) {
                const f32x4 s2 = *(const f32x4*)(SSQb + (size_t)(lo + (unsigned)((ai * 128 + m * 16) * 48)));
                const float rb = 1.f / sqrtf(((s2[0] + s2[1]) + (s2[2] + s2[3])) * (1.f / 512.f) + RMS_EPS);
#pragma unroll
                for (int bj = 0; bj < 2; ++bj)
#pragma unroll
                    for (int n = 0; n < 2; ++n) { const unsigned off = eo + (unsigned)((ai * 128 + m * 16) * DM + bj * 128 + n * 16); const u32x2 h = *(const u32x2*)(H0b + (size_t)(off * 2u));
                        f32x4 o = acc[ai][bj][m][n] * rb;
                        o[0] += ALPHA * __uint_as_float(h.x << 16); o[1] += ALPHA * __uint_as_float(h.x & 0xffff0000u); o[2] += ALPHA * __uint_as_float(h.y << 16); o[3] += ALPHA * __uint_as_float(h.y & 0xffff0000u);
                        *(f32x4*)(Pb + (size_t)(off * 4u)) = o; }
                asm volatile("" ::: "memory"); }
    }
};

__device__ __forceinline__ void split_bf16x8(const f32x4 x0, const f32x4 x1, bf16x8& hi, bf16x8& lo) {
    unsigned h[8]; float r[8];
#pragma unroll
    for (int e = 0; e < 4; ++e) { h[e] = f2bf(x0[e]); r[e] = x0[e] - __uint_as_float(h[e] << 16); h[4 + e] = f2bf(x1[e]); r[4 + e] = x1[e] - __uint_as_float(h[4 + e] << 16); }
    u32x4 hw, lw;
    hw.x = h[0] | (h[1] << 16); hw.y = h[2] | (h[3] << 16); hw.z = h[4] | (h[5] << 16); hw.w = h[6] | (h[7] << 16);
    lw.x = pk2(r[0], r[1]); lw.y = pk2(r[2], r[3]); lw.z = pk2(r[4], r[5]); lw.w = pk2(r[6], r[7]);
    hi = __builtin_bit_cast(bf16x8, hw); lo = __builtin_bit_cast(bf16x8, lw);
}
__device__ __forceinline__ void p5_ln1_router(const Frame& F, const Args& a) {
    constexpr int RS = 1032;
    LAS float* hrow = (LAS float*)F.lds;
    LAS float* part = (LAS float*)(F.lds + 16 * RS * 4);
    LAS float* lg = part + 8 * 16 * 48;
    const int tid5 = threadIdx.x, lane = tid5 & 63, w = F.wave, fr = lane & 15, fq = lane >> 4;
    const float* PRE1 = (const float*)(F.ws + WS_PRE1); bf16_t* H1 = (bf16_t*)(F.ws + WS_H1);
    const float* g1 = a.in[13]; const float* b1 = a.in[14]; const float* wg = a.in[15]; const float* bg = a.in[16]; const float* wr = a.in[17]; const float* br = a.in[18];
    int* list = (int*)(F.ws + WS_LIST); float* ew = (float*)(F.ws + WS_EW);
    bf16x8 Bh[4][3], Bl[4][3];
#pragma unroll
    for (int s = 0; s < 4; ++s)
#pragma unroll
        for (int cb = 0; cb < 3; ++cb) { const int n = cb * 16 + fr; float x[8];
#pragma unroll
            for (int j = 0; j < 8; ++j) { const int k = 128 * w + 32 * s + 8 * fq + j; x[j] = n < 4 ? wg[k * 4 + n] : (n < 36 ? wr[k * 32 + (n - 4)] : 0.f); }
            split_bf16x8((f32x4){x[0], x[1], x[2], x[3]}, (f32x4){x[4], x[5], x[6], x[7]}, Bh[s][cb], Bl[s][cb]); }
    for (int it = F.bx; it < T / 16; it += F.G) {
        const int R0 = it * 16;
#pragma unroll
        for (int rr = 0; rr < 2; ++rr) { const int r = 2 * w + rr; const float* src = PRE1 + (size_t)(R0 + r) * DM;
            f32x4 v[4]; float s = 0.f;
#pragma unroll
            for (int j = 0; j < 4; ++j) { v[j] = *(const f32x4*)(src + j * 256 + lane * 4); s += (v[j].x + v[j].y) + (v[j].z + v[j].w); }
            const float mean = wave_sum(s) * (1.f / DM); float s2 = 0.f;
#pragma unroll
            for (int j = 0; j < 4; ++j) { v[j] = v[j] - mean; s2 += (v[j].x * v[j].x + v[j].y * v[j].y) + (v[j].z * v[j].z + v[j].w * v[j].w); }
            const float rstd = 1.f / sqrtf(wave_sum(s2) * (1.f / DM) + LN_EPS);
#pragma unroll
            for (int j = 0; j < 4; ++j) { const int c = j * 256 + lane * 4; const f32x4 gg = *(const f32x4*)(g1 + c), bb = *(const f32x4*)(b1 + c);
                const f32x4 o = v[j] * rstd * gg + bb; *(LAS f32x4*)(hrow + r * RS + c) = o;
                u32x2 pw; pw.x = pk2(o.x, o.y); pw.y = pk2(o.z, o.w); *(u32x2*)(H1 + (size_t)(R0 + r) * DM + c) = pw; } }
        __syncthreads();
        f32x4 c0 = {0.f, 0.f, 0.f, 0.f}, c1 = c0, c2 = c0;
#pragma unroll
        for (int s = 0; s < 4; ++s) { const LAS float* ap = hrow + fr * RS + 128 * w + 32 * s + 8 * fq;
            bf16x8 ah, al; split_bf16x8(*(const LAS f32x4*)ap, *(const LAS f32x4*)(ap + 4), ah, al);
            c0 = __builtin_amdgcn_mfma_f32_16x16x32_bf16(ah, Bh[s][0], c0, 0, 0, 0); c0 = __builtin_amdgcn_mfma_f32_16x16x32_bf16(al, Bh[s][0], c0, 0, 0, 0); c0 = __builtin_amdgcn_mfma_f32_16x16x32_bf16(ah, Bl[s][0], c0, 0, 0, 0);
            c1 = __builtin_amdgcn_mfma_f32_16x16x32_bf16(ah, Bh[s][1], c1, 0, 0, 0); c1 = __builtin_amdgcn_mfma_f32_16x16x32_bf16(al, Bh[s][1], c1, 0, 0, 0); c1 = __builtin_amdgcn_mfma_f32_16x16x32_bf16(ah, Bl[s][1], c1, 0, 0, 0);
            c2 = __builtin_amdgcn_mfma_f32_16x16x32_bf16(ah, Bh[s][2], c2, 0, 0, 0); c2 = __builtin_amdgcn_mfma_f32_16x16x32_bf16(al, Bh[s][2], c2, 0, 0, 0); c2 = __builtin_amdgcn_mfma_f32_16x16x32_bf16(ah, Bl[s][2], c2, 0, 0, 0); }
#pragma unroll
        for (int j = 0; j < 4; ++j) { LAS float* pp = part + (w * 16 + fq * 4 + j) * 48 + fr; pp[0] = c0[j]; pp[16] = c1[j]; pp[32] = c2[j]; }
        __syncthreads();
        for (int idx = tid5; idx < 16 * 48; idx += NWAVES * 64) { float sum = 0.f;
#pragma unroll
            for (int q = 0; q < 8; ++q) sum += part[q * 768 + idx];
            lg[idx] = sum; }
        __syncthreads();
        if (tid5 < 16) { const int m = R0 + tid5; const LAS float* L = lg + tid5 * 48;
            const float l0 = L[0] + bg[0], l1 = L[1] + bg[1], l2 = L[2] + bg[2], l3 = L[3] + bg[3];
            const float mx = fmaxf(fmaxf(l0, l1), fmaxf(l2, l3));
            const float ex0 = expf(l0 - mx), ex1 = expf(l1 - mx), ex2 = expf(l2 - mx), ex3 = expf(l3 - mx);
            const float se = ((ex0 + ex1) + ex2) + ex3;
            int gi = 0; float gt = ex0 / se;
            { const float p = ex1 / se; if (p > gt) { gt = p; gi = 1; } }
            { const float p = ex2 / se; if (p > gt) { gt = p; gi = 2; } }
            { const float p = ex3 / se; if (p > gt) { gt = p; gi = 3; } }
            int e1 = 0, e2 = -1; float t1 = -INFINITY, t2 = -INFINITY;
#pragma unroll 1
            for (int i = 0; i < 8; ++i) { const float v = L[4 + gi * 8 + i] + br[gi * 8 + i];
                if (v > t1) { t2 = t1; e2 = e1; t1 = v; e1 = i; } else if (v > t2) { t2 = v; e2 = i; } }
            const float z = expf(t2 - t1), w1 = gt / (1.f + z), w2 = gt * z / (1.f + z);
            const int ea = gi * 8 + e1, eb = gi * 8 + e2;
            const unsigned pa = atomicAdd(&F.ctl[CW_CNT + 64 * ea], 1u); list[(size_t)ea * T + pa] = m * 2; ew[m * 2] = w1;
            const unsigned pb = atomicAdd(&F.ctl[CW_CNT + 64 * eb], 1u); list[(size_t)eb * T + pb] = m * 2 + 1; ew[m * 2 + 1] = w2; }
        __syncthreads();
    }
}

struct MoeOrder {
    const unsigned* ctl; const int* list; const char* A; const char* Bt; int nN, G, c; bool gather;
    __device__ bool next(int i, pg8::Unit& u) const {
        const int L = i * G + c; const int tl = L / nN; int acc = 0;
        for (int e = 0; e < 32; ++e) { const int cn = (int)ctl[CW_CNT + 64 * e]; const int nt = (cn + 255) >> 8;
            if (tl < acc + nt) { u.e = e; u.r0 = (tl - acc) * 256; u.n = cn; u.pm = tl; u.pn = L % nN; return true; } acc += nt; }
        return false;
    }
    __device__ __forceinline__ const char* abase(const pg8::Unit& u) const { return gather ? A : A + (size_t)u.pm * 256 * 256 * 2; }
    __device__ __forceinline__ const char* bbase(const pg8::Unit& u) const { return gather ? Bt + ((size_t)u.e * 512 + u.pn * 256) * DM * 2 : Bt + ((size_t)u.e * 1024 + u.pn * 256) * 256 * 2; }
    __device__ __forceinline__ unsigned arow_off(const pg8::Unit& u, int R) const {
        if (!gather) return (unsigned)(R * 256) * 2u;
        const int idx = (u.r0 + R < u.n) ? list[(size_t)u.e * T + u.r0 + R] : 0;
        return (unsigned)(idx >> 1) * (unsigned)(DM * 2);
    }
};
struct EpiGU {
    static constexpr bool PERM = true, MIDK = false;
    unsigned char* ws;
    __device__ __forceinline__ void operator()(const f32x4 (&acc)[2][2][4][2], const pg8::Unit& u, int wr, int wc, int fr, int fq) const {
        const char* listb = (const char*)(ws + WS_LIST) + ((size_t)u.e * T + u.r0) * 4; const char* ewb = (const char*)(ws + WS_EW);
        char* Hb = (char*)(ws + WS_HID) + (((size_t)u.pm * 256) * 256 + u.pn * 128) * 2;
        int Rl = wr * 64 + fr; const int nrem = u.n - u.r0; asm volatile("" : "+v"(Rl));
        const unsigned ho = (unsigned)(Rl * 256 + wc * 32 + 8 * fq) * 2u;
#pragma unroll
        for (int ai = 0; ai < 2; ++ai)
#pragma unroll
            for (int m = 0; m < 4; ++m) { const int R = Rl + ai * 128 + m * 16;
                float wgt = 0.f; if (R < nrem) { const unsigned idx = *(const unsigned*)(listb + (size_t)((unsigned)R * 4u)); wgt = *(const float*)(ewb + (size_t)(idx * 4u)); }
                f32x4 o[2];
#pragma unroll
                for (int n = 0; n < 2; ++n) { const f32x4 gv = acc[ai][0][m][n], uv = acc[ai][1][m][n];
#pragma unroll
                    for (int e = 0; e < 4; ++e) o[n][e] = gv[e] * __builtin_amdgcn_rcpf(1.f + __builtin_amdgcn_exp2f(-1.4426950408889634f * gv[e])) * uv[e] * wgt; }
                *(u32x4*)(Hb + (size_t)(ho + (unsigned)((ai * 128 + m * 16) * 512))) = pg8::pack8(o[0], o[1]);
                asm volatile("" ::: "memory"); }
    }
};
struct EpiDown {
    static constexpr bool PERM = true, MIDK = false;
    unsigned char* ws;
    __device__ __forceinline__ void operator()(const f32x4 (&acc)[2][2][4][2], const pg8::Unit& u, int wr, int wc, int fr, int fq) const {
        const char* listb = (const char*)(ws + WS_LIST) + ((size_t)u.e * T + u.r0) * 4; char* Yb = (char*)(ws + WS_Y) + (size_t)(u.pn * 256) * 2;
        int Rl = wr * 64 + fr; const int nrem = u.n - u.r0; asm volatile("" : "+v"(Rl));
        const unsigned yo = (unsigned)(wc * 32 + 8 * fq) * 2u;
#pragma unroll
        for (int ai = 0; ai < 2; ++ai)
#pragma unroll
            for (int m = 0; m < 4; ++m) { const int R = Rl + ai * 128 + m * 16;
                if (R < nrem) { const unsigned idx = *(const unsigned*)(listb + (size_t)((unsigned)R * 4u)); char* y = Yb + (size_t)idx * (DM * 2) + yo;
                    *(u32x4*)y = pg8::pack8(acc[ai][0][m][0], acc[ai][0][m][1]); *(u32x4*)(y + 256) = pg8::pack8(acc[ai][1][m][0], acc[ai][1][m][1]); }
                asm volatile("" ::: "memory"); }
    }
};

__device__ __forceinline__ void p8_ln2(const Frame& F, const Args& a) {
    const bf16_t* H1 = (const bf16_t*)(F.ws + WS_H1); const bf16_t* Y = (const bf16_t*)(F.ws + WS_Y); const float* g = a.in[22]; const float* b = a.in[23]; float* out = a.out;
    const int lane = threadIdx.x & 63;
    for (int m = F.bx * NWAVES + F.wave; m < T; m += F.G * NWAVES) {
        f32x4 v[4]; float s = 0.f;
#pragma unroll
        for (int j = 0; j < 4; ++j) { const int c = j * 256 + lane * 4;
            const u32x2 h = *(const u32x2*)(H1 + (size_t)m * DM + c), y0 = *(const u32x2*)(Y + (size_t)(2 * m) * DM + c), y1 = *(const u32x2*)(Y + (size_t)(2 * m + 1) * DM + c);
            v[j].x = ALPHA * __uint_as_float(h.x << 16) + __uint_as_float(y0.x << 16) + __uint_as_float(y1.x << 16);
            v[j].y = ALPHA * __uint_as_float(h.x & 0xffff0000u) + __uint_as_float(y0.x & 0xffff0000u) + __uint_as_float(y1.x & 0xffff0000u);
            v[j].z = ALPHA * __uint_as_float(h.y << 16) + __uint_as_float(y0.y << 16) + __uint_as_float(y1.y << 16);
            v[j].w = ALPHA * __uint_as_float(h.y & 0xffff0000u) + __uint_as_float(y0.y & 0xffff0000u) + __uint_as_float(y1.y & 0xffff0000u);
            s += (v[j].x + v[j].y) + (v[j].z + v[j].w); }
        const float mean = wave_sum(s) * (1.f / DM); float s2 = 0.f;
#pragma unroll
        for (int j = 0; j < 4; ++j) { v[j] = v[j] - mean; s2 += (v[j].x * v[j].x + v[j].y * v[j].y) + (v[j].z * v[j].z + v[j].w * v[j].w); }
        const float rstd = 1.f / sqrtf(wave_sum(s2) * (1.f / DM) + LN_EPS);
#pragma unroll
        for (int j = 0; j < 4; ++j) { const int c = j * 256 + lane * 4; const f32x4 gg = *(const f32x4*)(g + c), bb = *(const f32x4*)(b + c);
            *(f32x4*)(out + (size_t)m * DM + c) = v[j] * rstd * gg + bb; }
    }
}

__global__ void __launch_bounds__(NWAVES * 64, 2) mega(Args args) {
    extern __shared__ __attribute__((aligned(16))) unsigned char lds_raw[];
    Frame F;
    F.lds = (LAS unsigned char*)lds_raw; F.ws = args.ws; F.ctl = (unsigned*)(args.ws + WS_CTL);
    F.tid = threadIdx.x; F.lane = F.tid & 63; F.wave = __builtin_amdgcn_readfirstlane(F.tid >> 6); F.G = gridDim.x; F.bx = blockIdx.x;
    volatile LAS unsigned* MISC = (volatile LAS unsigned*)(F.lds + MISC_OFF);
    for (int u = F.tid; u < (LDS_BYTES - LDSCTL_OFF) / 4; u += NWAVES * 64) ((LAS unsigned*)(F.lds + LDSCTL_OFF))[u] = 0u;
    __syncthreads();
    XcdBarrier bar = xcd_barrier_post(F.ctl + CW_BAR, MISC + 8);
    const int lo = args.ph_lo, hi = args.ph_hi;
#define IN(k) (lo <= (k) && (k) < hi)
#define BOTH(k) (IN(k) && IN((k) + 1))
    if (IN(0)) { p0_prologue(F, args); if (BOTH(0)) xcd_barrier(bar); }
    if (IN(1)) {
        pg8::StaticOrder S; S.init(args.ws + WS_H0, args.ws + WS_WIN, T, 1536, DM, F.G, F.bx);
        EpiInProj E{args.ws};
        pg8::gemm_phase<EpiInProj, pg8::StaticOrder, true>(F.lds, DM, S, E);
        if (BOTH(1)) xcd_barrier(bar);
    }
    if (IN(2)) {
        UpOrder S{(const char*)(args.ws + WS_CQ), (const char*)(args.ws + WS_CKV), (const char*)(args.ws + WS_WUQ), (const char*)(args.ws + WS_WUKV), F.G, F.bx};
        EpiUp E{args.ws};
        pg8::gemm_phase<EpiUp, UpOrder, true>(F.lds, 256, S, E);
        if (BOTH(2)) xcd_barrier(bar);
    }
    if (IN(3)) {
        const int vcu = (F.G % 8 == 0) ? (F.bx % 8) * (F.G / 8) + F.bx / 8 : F.bx;
        att::attn_phase((char*)lds_raw, args.ws, args.in[5], vcu, F.G);
        if (BOTH(3)) xcd_barrier(bar);
    }
    if (IN(4)) {
        pg8::StaticOrder S; S.init(args.ws + WS_AO, args.ws + WS_WO, T, DM, DM, F.G, F.bx);
        EpiOut E{args.ws};
        pg8::gemm_phase<EpiOut, pg8::StaticOrder, true>(F.lds, DM, S, E);
        if (BOTH(4)) xcd_barrier(bar);
    }
    if (IN(5)) { p5_ln1_router(F, args); if (BOTH(5)) xcd_barrier(bar); }
    if (IN(6)) {
        MoeOrder S{F.ctl, (const int*)(args.ws + WS_LIST), (const char*)(args.ws + WS_H1), (const char*)(args.ws + WS_WGU), 2, F.G, F.bx, true};
        EpiGU E{args.ws};
        pg8::gemm_phase<EpiGU, MoeOrder, true>(F.lds, DM, S, E);
        if (BOTH(6)) xcd_barrier(bar);
    }
    if (IN(7)) {
        MoeOrder S{F.ctl, (const int*)(args.ws + WS_LIST), (const char*)(args.ws + WS_HID), (const char*)(args.ws + WS_WDN), 4, F.G, F.bx, false};
        EpiDown E{args.ws};
        pg8::gemm_phase<EpiDown, MoeOrder, true>(F.lds, 256, S, E);
        if (BOTH(7)) xcd_barrier(bar);
    }
    if (IN(8)) { p8_ln2(F, args); }
#undef IN
#undef BOTH
}

extern "C" void kernel_launch(void* const* d_in, const int* in_sizes, int n_in, void* d_out, int out_size, void* d_ws, size_t ws_size, hipStream_t stream) {
    static int grid = 0;
    if (grid == 0) {
        if (n_in != 24 || ws_size < WS_END || out_size != T * DM) { fprintf(stderr, "kernel_launch: unexpected shapes n_in=%d ws=%zu out=%d\n", n_in, ws_size, out_size); grid = -1; return; }
        int dev = 0, cus = 0, per_cu = 0;
        if (hipGetDevice(&dev) != hipSuccess || hipDeviceGetAttribute(&cus, hipDeviceAttributeMultiprocessorCount, dev) != hipSuccess) { grid = -1; return; }
        if (hipFuncSetAttribute((const void*)mega, hipFuncAttributeMaxDynamicSharedMemorySize, LDS_BYTES) != hipSuccess) { fprintf(stderr, "hipFuncSetAttribute failed\n"); grid = -1; return; }
        if (hipOccupancyMaxActiveBlocksPerMultiprocessor(&per_cu, (const void*)mega, NWAVES * 64, LDS_BYTES) != hipSuccess || per_cu < 1) { fprintf(stderr, "occupancy query: %d blocks per CU\n", per_cu); (void)hipGetLastError(); grid = -1; return; }
        (void)hipGetLastError();
        grid = cus;
    }
    if (grid < 0) return;
    (void)hipMemsetAsync((unsigned char*)d_ws + WS_CTL, 0, 1 * MiB, stream);
    Args a{};
    for (int i = 0; i < 24; ++i) a.in[i] = (const float*)d_in[i];
    a.out = (float*)d_out; a.ws = (unsigned char*)d_ws; a.ph_lo = 0; a.ph_hi = 9;
    hipLaunchKernelGGL(mega, dim3(grid), dim3(NWAVES * 64), LDS_BYTES, stream, a);
}
```

```cpp
#include <hip/hip_runtime.h>
#include <cstdio>
#include <cstdint>

typedef unsigned short bf16_t;
typedef float f32x4 __attribute__((ext_vector_type(4)));
typedef unsigned u32x4 __attribute__((ext_vector_type(4)));
typedef unsigned u32x2 __attribute__((ext_vector_type(2)));

constexpr int NB = 4, SEQ = 8192, DM = 1024, T = NB * SEQ, LP = SEQ + 128, NPAD = 112, NMETA = 16;
constexpr int INC = 1344;
constexpr float LN_EPS = 1e-5f, RMS_EPS = 1e-6f;
constexpr float ALPHA = 1.189207115002721f;
constexpr size_t MiB = 1u << 20;

constexpr size_t WS_CTL = 0;
constexpr size_t WS_HM = 1 * MiB;
constexpr size_t WS_CKVM = 1 * MiB + 128 * 1024;
constexpr size_t WS_UM = 1 * MiB + 256 * 1024;
constexpr size_t WS_KVTM = 1 * MiB + 640 * 1024;
constexpr size_t WS_SSQ = 2 * MiB;
constexpr size_t WS_EW = 4 * MiB;
constexpr size_t WS_LIST = 5 * MiB;
constexpr size_t WS_W = 16 * MiB;
constexpr size_t WS_H0 = 72 * MiB;
constexpr size_t WS_QA = 136 * MiB;
constexpr size_t WS_KA = 168 * MiB;
constexpr size_t WS_VA = 177 * MiB;
constexpr size_t WS_CQ = 186 * MiB;
constexpr size_t WS_CKV = 202 * MiB;
constexpr size_t WS_KM = 218 * MiB;
constexpr size_t WS_VM = 267 * MiB;
constexpr size_t WS_QM = 300 * MiB;
constexpr size_t WS_AO = 348 * MiB;
constexpr size_t WS_HID = 412 * MiB;
constexpr size_t WS_PRE1 = 136 * MiB;
constexpr size_t WS_H1 = 264 * MiB;
constexpr size_t WS_Y = 72 * MiB;
constexpr size_t WS_TMP = 348 * MiB;
constexpr size_t WS_AN = 412 * MiB;
constexpr size_t WS_END = 512 * MiB;
constexpr int CW_CNT = 1024;

__constant__ float c_inv_freq[32] = {1.000000000e+00f, 7.498942614e-01f, 5.623413324e-01f, 4.216965139e-01f, 3.162277639e-01f, 2.371373773e-01f, 1.778279394e-01f, 1.333521307e-01f, 1.000000015e-01f, 7.498941571e-02f, 5.623413250e-02f, 4.216965288e-02f, 3.162277490e-02f, 2.371373773e-02f, 1.778279431e-02f, 1.333521493e-02f, 9.999999776e-03f, 7.498941850e-03f, 5.623413250e-03f, 4.216964822e-03f, 3.162277630e-03f, 2.371373586e-03f, 1.778279431e-03f, 1.333521446e-03f, 1.000000047e-03f, 7.498942432e-04f, 5.623413017e-04f, 4.216965172e-04f, 3.162277571e-04f, 2.371373703e-04f, 1.778279402e-04f, 1.333521504e-04f};

__device__ __forceinline__ float bf2f(bf16_t v) { return __uint_as_float((unsigned)v << 16); }
__device__ __forceinline__ unsigned f2bf(float f) { unsigned u = __float_as_uint(f); return (u + 0x7fffu + ((u >> 16) & 1u)) >> 16; }
__device__ __forceinline__ unsigned pk2(float lo, float hi) { return f2bf(lo) | (f2bf(hi) << 16); }
__device__ __forceinline__ int lane_id() { return (int)__builtin_amdgcn_mbcnt_hi(~0u, __builtin_amdgcn_mbcnt_lo(~0u, 0u)); }
__device__ __forceinline__ float wave_sum(float v) {
#pragma unroll
    for (int o = 1; o < 64; o <<= 1) v += __shfl_xor(v, o);
    return v;
}
__device__ __forceinline__ float wave_max(float v) {
#pragma unroll
    for (int o = 1; o < 64; o <<= 1) v = fmaxf(v, __shfl_xor(v, o));
    return v;
}
__device__ __forceinline__ void rope_cs(int pos, int i, float& c, float& s) {
    const double ang = (double)pos * (double)c_inv_freq[i];
    const double rev = ang * 0.15915494309189535;
    const float fr = (float)(rev - __builtin_rint(rev));
    s = __builtin_amdgcn_sinf(fr); c = __builtin_amdgcn_cosf(fr);
}


#define LAS __attribute__((address_space(3)))
#define GAS __attribute__((address_space(1)))
typedef short bf16x8 __attribute__((ext_vector_type(8)));
typedef float f32x2 __attribute__((ext_vector_type(2)));

constexpr size_t WS_CQS = 9 * MiB;
constexpr size_t WS_CKVS = 10 * MiB;
constexpr size_t WS_COS = 11 * MiB;
constexpr size_t WS_SIN = 13 * MiB;
constexpr size_t WS_WIN = 16 * MiB;
constexpr size_t WS_WUQ = 19 * MiB;
constexpr size_t WS_WUKV = 19 * MiB + 512 * 1024;
constexpr size_t WS_WO = 20 * MiB;
constexpr size_t WS_WGU = 22 * MiB;
constexpr size_t WS_WDN = 54 * MiB;
constexpr int NPOS = SEQ + NMETA;

namespace pg8 {
constexpr int BM = 256, BK = 64, HALF = 128, HTB = HALF * BK * 2, STAGE_BYTES = 8 * HTB, NXCD = 8, WGM = 8;
__host__ __device__ __forceinline__ int lds_byte(int r, int c) { const int st = (r >> 4) * 2 + (c >> 5), rr = r & 15, cc = c & 31, ob = rr * 64 + cc * 2; return st * 1024 + (ob ^ (((ob >> 9) & 1) << 5)); }
__host__ __device__ __forceinline__ void stage_rc(int b, int& R, int& C) { const int st = b / 1024, sb = b % 1024, swz = sb ^ (((sb >> 9) & 1) << 5); R = (st >> 1) * 16 + swz / 64; C = (st & 1) * 32 + (swz % 64) / 2; }
__host__ __device__ __forceinline__ int perm32(int rho) { const int n = rho >> 4, i = rho & 15; return 8 * (i >> 2) + 4 * n + (i & 3); }
struct Unit { int pm, pn, e, r0, n; };
__device__ __forceinline__ unsigned cvt_pk_bf16(float lo, float hi) { unsigned r; asm volatile("v_cvt_pk_bf16_f32 %0, %1, %2" : "=v"(r) : "v"(lo), "v"(hi)); return r; }
__device__ __forceinline__ u32x4 pack8(const f32x4 a, const f32x4 b) { u32x4 w; w.x = cvt_pk_bf16(a[0], a[1]); w.y = cvt_pk_bf16(a[2], a[3]); w.z = cvt_pk_bf16(b[0], b[1]); w.w = cvt_pk_bf16(b[2], b[3]); return w; }

template <class Epi, class Sched, bool ALIGN_EPI>
__device__ __forceinline__ void gemm_phase(LAS unsigned char* lds, const int K, const Sched& S, const Epi& E) {
    const int tid = threadIdx.x, wid = __builtin_amdgcn_readfirstlane(tid >> 6), lane = tid & 63, wr = wid >> 2, wc = wid & 3, fr = lane & 15, fq = lane >> 4;
    const int nt = K / BK;
    int Rr[2]; unsigned cof[2], voffB[2];
#pragma unroll
    for (int i = 0; i < 2; ++i) { int R, C; stage_rc(tid * 16 + i * 8192, R, C); Rr[i] = R; cof[i] = (unsigned)C * 2u; const int Rb = Epi::PERM ? ((R & ~31) + perm32(R & 31)) : R; voffB[i] = (unsigned)(Rb * K + C) * 2u; }
    const size_t kstep = (size_t)(BK * 2);
    const size_t hstepB = (size_t)HALF * K * 2;
    const unsigned ldsw = (unsigned)wid * 1024u;
    const int aoff = lds_byte(wr * 64 + fr, fq * 8), boff = lds_byte(wc * 32 + fr, fq * 8);
#define PG8_SA(b, h) (((b) * 2 + (h)) * HTB)
#define PG8_SB(b, h) ((4 + (b) * 2 + (h)) * HTB)
#define PG8_STAGE(bufoff, gbase, voff) do { _Pragma("unroll") for (int _i = 0; _i < 2; ++_i) \
        __builtin_amdgcn_global_load_lds((const unsigned*)((const char*)(gbase) + (voff)[_i]), (LAS unsigned*)(lds + (bufoff) + ldsw + _i * 8192), 16, 0, 0); } while (0)
#define PG8_LDA(dst, b, h) do { _Pragma("unroll") for (int m = 0; m < 4; ++m) _Pragma("unroll") for (int k = 0; k < 2; ++k) dst[m][k] = *(const LAS bf16x8*)(lds + PG8_SA(b, h) + aoff + m * 2048 + k * 1024); } while (0)
#define PG8_LDB(dst, b, h) do { _Pragma("unroll") for (int n = 0; n < 2; ++n) _Pragma("unroll") for (int k = 0; k < 2; ++k) dst[n][k] = *(const LAS bf16x8*)(lds + PG8_SB(b, h) + boff + n * 2048 + k * 1024); } while (0)
#define PG8_MMA(ai, bj, At, Bt) do { __builtin_amdgcn_s_setprio(1); _Pragma("unroll") for (int m = 0; m < 4; ++m) _Pragma("unroll") for (int n = 0; n < 2; ++n) _Pragma("unroll") for (int k = 0; k < 2; ++k) \
        acc[ai][bj][m][n] = __builtin_amdgcn_mfma_f32_16x16x32_bf16(Bt[n][k], At[m][k], acc[ai][bj][m][n], 0, 0, 0); __builtin_amdgcn_s_setprio(0); } while (0)
#define PG8_WAIT_V(n) asm volatile("s_waitcnt vmcnt(" #n ")" ::: "memory")
#define PG8_WAIT_L(n) asm volatile("s_waitcnt lgkmcnt(" #n ")" ::: "memory")
#define PG8_BAR __builtin_amdgcn_s_barrier()
#define PG8_SCHED __builtin_amdgcn_sched_barrier(0)
    Unit cur, nxt; int ui = 0;
    if (!S.next(0, cur)) return;
    f32x4 acc[2][2][4][2];
#pragma unroll
    for (int a = 0; a < 2; ++a)
#pragma unroll
        for (int b = 0; b < 2; ++b)
#pragma unroll
            for (int m = 0; m < 4; ++m)
#pragma unroll
                for (int n = 0; n < 2; ++n) acc[a][b][m][n] = (f32x4){0.f, 0.f, 0.f, 0.f};
    bf16x8 At[4][2], B0[2][2], B1[2][2];
    unsigned vA0[2], vA1[2], vN0[2], vN1[2];
#pragma unroll
    for (int i = 0; i < 2; ++i) { vA0[i] = S.arow_off(cur, Rr[i]) + cof[i]; vA1[i] = S.arow_off(cur, Rr[i] + HALF) + cof[i]; }
    const char* cA = S.abase(cur); const char* cB = S.bbase(cur);
    PG8_STAGE(PG8_SB(0, 0), cB, voffB); PG8_STAGE(PG8_SB(0, 1), cB + hstepB, voffB); PG8_STAGE(PG8_SA(0, 0), cA, vA0); PG8_STAGE(PG8_SA(0, 1), cA, vA1);
    if (wr == 1) PG8_BAR;
    PG8_WAIT_V(2); PG8_BAR;
    PG8_STAGE(PG8_SB(1, 0), cB + kstep, voffB); PG8_STAGE(PG8_SA(1, 0), cA + kstep, vA0); PG8_STAGE(PG8_SB(1, 1), cB + hstepB + kstep, voffB);
    PG8_WAIT_V(6); PG8_BAR;
    for (;;) {
        const bool has_next = S.next(ui + 1, nxt);
        const char* nA = has_next ? S.abase(nxt) : cA; const char* nB = has_next ? S.bbase(nxt) : cB;
#pragma unroll
        for (int i = 0; i < 2; ++i) { vN0[i] = has_next ? S.arow_off(nxt, Rr[i]) + cof[i] : vA0[i]; vN1[i] = has_next ? S.arow_off(nxt, Rr[i] + HALF) + cof[i] : vA1[i]; }
#pragma unroll 1
        for (int t = 0; t < nt; t += 2) {
            const bool last = (t == nt - 2);
            const char* a1 = cA + (size_t)(t + 1) * kstep;
            const char* a2 = last ? nA : cA + (size_t)(t + 2) * kstep; const char* b2 = last ? nB : cB + (size_t)(t + 2) * kstep;
            const char* a3 = a2 + kstep; const char* b3 = b2 + kstep;
            unsigned w0[2], w1[2];
#pragma unroll
            for (int i = 0; i < 2; ++i) { w0[i] = last ? vN0[i] : vA0[i]; w1[i] = last ? vN1[i] : vA1[i]; }
            PG8_LDB(B0, 0, 0); PG8_LDB(B1, 0, 1); PG8_SCHED; PG8_LDA(At, 0, 0); PG8_STAGE(PG8_SA(1, 1), a1, vA1);
            PG8_WAIT_V(8); PG8_WAIT_L(0); PG8_BAR; PG8_MMA(0, 0, At, B0); PG8_MMA(0, 1, At, B1); PG8_BAR; PG8_SCHED;
            PG8_LDA(At, 0, 1); PG8_STAGE(PG8_SB(0, 0), b2, voffB); PG8_STAGE(PG8_SB(0, 1), b2 + hstepB, voffB); PG8_STAGE(PG8_SA(0, 0), a2, w0);
            PG8_WAIT_V(8); PG8_WAIT_L(0); PG8_BAR; PG8_MMA(1, 0, At, B0); PG8_MMA(1, 1, At, B1); PG8_BAR; PG8_SCHED;
            PG8_LDB(B0, 1, 0); PG8_LDB(B1, 1, 1); PG8_SCHED; PG8_LDA(At, 1, 0); PG8_STAGE(PG8_SA(0, 1), a2, w1);
            PG8_WAIT_V(8); PG8_WAIT_L(0); PG8_BAR; PG8_MMA(0, 0, At, B0); PG8_MMA(0, 1, At, B1); PG8_BAR; PG8_SCHED;
            PG8_LDA(At, 1, 1); PG8_STAGE(PG8_SB(1, 0), b3, voffB); PG8_STAGE(PG8_SB(1, 1), b3 + hstepB, voffB); PG8_STAGE(PG8_SA(1, 0), a3, w0);
            PG8_WAIT_V(8); PG8_WAIT_L(0); PG8_BAR; PG8_MMA(1, 0, At, B0); PG8_MMA(1, 1, At, B1); PG8_BAR; PG8_SCHED;
            if constexpr (Epi::MIDK) { if (t + 2 == nt / 2) E.midk(acc, cur, wr, wc, fr, fq); }
        }
        if constexpr (ALIGN_EPI) { if (wr == 0) PG8_BAR; }
        E(acc, cur, wr, wc, fr, fq);
        if (!has_next) break;
#pragma unroll
        for (int a = 0; a < 2; ++a)
#pragma unroll
            for (int b = 0; b < 2; ++b)
#pragma unroll
                for (int m = 0; m < 4; ++m)
#pragma unroll
                    for (int n = 0; n < 2; ++n) acc[a][b][m][n] = (f32x4){0.f, 0.f, 0.f, 0.f};
        cur = nxt; cA = nA; cB = nB; ++ui;
#pragma unroll
        for (int i = 0; i < 2; ++i) { vA0[i] = vN0[i]; vA1[i] = vN1[i]; }
        if constexpr (ALIGN_EPI) { if (wr == 1) PG8_BAR; }
    }
    PG8_WAIT_V(0);
    if constexpr (!ALIGN_EPI) { if (wr == 0) PG8_BAR; }
    PG8_BAR;
#undef PG8_SA
#undef PG8_SB
#undef PG8_STAGE
#undef PG8_LDA
#undef PG8_LDB
#undef PG8_MMA
#undef PG8_WAIT_V
#undef PG8_WAIT_L
#undef PG8_BAR
#undef PG8_SCHED
}

struct StaticOrder {
    const char* A; const char* Bt; int K;
    int nM, nN, nwg, G, c;
    __device__ void init(const void* A_, const void* Bt_, int M, int N, int K_, int G_, int c_) { A = (const char*)A_; Bt = (const char*)Bt_; K = K_; nM = M / BM; nN = N / BM; nwg = nM * nN; G = G_; c = c_; }
    __device__ bool next(int i, Unit& u) const {
        const long L = (long)i * G + c; if (L >= nwg) return false;
        int wgid = (int)L; { const int q = nwg / NXCD, r = nwg % NXCD, xcd = wgid % NXCD, off = wgid / NXCD; wgid = (xcd < r ? xcd * (q + 1) : r * (q + 1) + (xcd - r) * q) + off; }
        const int nig = WGM * nN, gid = wgid / nig, fm = gid * WGM, gsz = (nM - fm) < WGM ? (nM - fm) : WGM;
        u.pm = fm + ((wgid % nig) % gsz); u.pn = (wgid % nig) / gsz; return true;
    }
    __device__ __forceinline__ const char* abase(const Unit& u) const { return A + (size_t)u.pm * BM * K * 2; }
    __device__ __forceinline__ const char* bbase(const Unit& u) const { return Bt + (size_t)u.pn * BM * K * 2; }
    __device__ __forceinline__ unsigned arow_off(const Unit&, int R) const { return (unsigned)(R * K) * 2u; }
};
}

#define XB_TMO      128
#define XB_XCNT(j)  (256  + 64 * (j))
#define XB_XSUB(j)  (1280 + 64 * (j))
#define XB_XGEN(j)  (2304 + 64 * (j))
#define XB_TOP      3328
#define XB_TOPGEN   3392
#define XCD_BAR_WORDS 3456
#define XB_SPIN_CAP (1u << 18)
__device__ __forceinline__ unsigned xb_ld(unsigned* p)              { return __hip_atomic_load(p, __ATOMIC_RELAXED, __HIP_MEMORY_SCOPE_AGENT); }
__device__ __forceinline__ unsigned xb_add(unsigned* p, unsigned v) { return __hip_atomic_fetch_add(p, v, __ATOMIC_RELAXED, __HIP_MEMORY_SCOPE_AGENT); }
__device__ __forceinline__ unsigned xb_xcc_id() { return (unsigned)__builtin_amdgcn_s_getreg((3 << 11) | 20) & 0xFu; }
#define XB_SPIN(cond, bar) do { unsigned _sp = 0; while (cond) { __builtin_amdgcn_s_sleep(1); \
    if ((++_sp & 255u) == 0u) { if (xb_ld(&(bar)[XB_TMO])) break; if (_sp > XB_SPIN_CAP) { atomicAdd(&(bar)[XB_TMO], 1u); break; } } } } while (0)
struct XcdBarrier { unsigned* bar; unsigned x; volatile LAS unsigned* st; };
__device__ __forceinline__ XcdBarrier xcd_barrier_post(unsigned* bar, volatile LAS unsigned* st) {
    XcdBarrier b; b.bar = bar; b.x = xb_xcc_id(); b.st = st;
    if (threadIdx.x == 0) (void)xb_add(&bar[XB_XCNT(b.x)], 1u);
    return b;
}
__device__ __forceinline__ void xcd_barrier_complete(unsigned* bar, unsigned x, unsigned& nloc, unsigned& nx) {
    const unsigned G = gridDim.x * gridDim.y * gridDim.z;
    unsigned sum, cnt, mine, sp = 0u;
    for (;;) {
        sum = 0u; cnt = 0u; mine = 0u;
#pragma unroll
        for (unsigned j = 0; j < 16; ++j) { const unsigned c = xb_ld(&bar[XB_XCNT(j)]); sum += c; cnt += (c > 0u) ? 1u : 0u; mine = (j == x) ? c : mine; }
        if (sum == G) break;
        __builtin_amdgcn_s_sleep(1);
        if ((++sp & 255u) == 0u) { if (xb_ld(&bar[XB_TMO])) break; if (sp > XB_SPIN_CAP) { atomicAdd(&bar[XB_TMO], 1u); break; } }
    }
    nloc = mine > 0u ? mine : 1u; nx = cnt > 0u ? cnt : 1u;
}
__device__ __forceinline__ void xcd_barrier(const XcdBarrier& b) {
    asm volatile("s_waitcnt vmcnt(0)" ::: "memory");
    __syncthreads();
    if (threadIdx.x == 0) {
        unsigned* bar = b.bar;
        __builtin_amdgcn_s_waitcnt(0);
        unsigned nloc = b.st[0], nx = b.st[1];
        if (nloc == 0u) { xcd_barrier_complete(bar, b.x, nloc, nx); b.st[0] = nloc; b.st[1] = nx; }
        const unsigned old = xb_add(&bar[XB_XSUB(b.x)], 1u);
        const unsigned gen = old / nloc;
        if (old + 1u == (gen + 1u) * nloc) {
            __builtin_amdgcn_fence(__ATOMIC_RELEASE, "agent");
            asm volatile("s_waitcnt vmcnt(0)" ::: "memory");
            const unsigned og = xb_add(&bar[XB_TOP], 1u);
            const unsigned tg = og / nx;
            if (og + 1u == (tg + 1u) * nx) xb_add(&bar[XB_TOPGEN], 1u);
            else XB_SPIN(xb_ld(&bar[XB_TOPGEN]) == tg, bar);
            __builtin_amdgcn_fence(__ATOMIC_ACQUIRE, "agent");
            xb_add(&bar[XB_XGEN(b.x)], 1u);
            asm volatile("s_waitcnt vmcnt(0)" ::: "memory");
        } else {
            XB_SPIN(xb_ld(&bar[XB_XGEN(b.x)]) == gen, bar);
            __builtin_amdgcn_fence(__ATOMIC_ACQUIRE, "agent");
            asm volatile("s_waitcnt vmcnt(0)" ::: "memory");
        }
    }
    __syncthreads();
}

constexpr int NWAVES = 8;
constexpr int RING_BYTES = 135168, LDSCTL_OFF = RING_BYTES, MISC_OFF = LDSCTL_OFF + 320, LDS_BYTES = 147456;
constexpr int CW_BAR = 4096;
#define LDS_WAIT() asm volatile("s_waitcnt lgkmcnt(0)" ::: "memory")
#define VM_WAIT() asm volatile("s_waitcnt vmcnt(0)" ::: "memory")

struct Args {
    const float* in[24]; float* out; unsigned char* ws; int ph_lo, ph_hi;
};
struct Frame {
    LAS unsigned char* lds; unsigned char* ws; unsigned* ctl;
    int tid, lane, wave, G, bx;
};

__device__ __forceinline__ void p0_tr_item(const float* __restrict__ W, int ldn, int c0, int k0, bf16_t* dst, int K, const float* __restrict__ sc0, const float* __restrict__ sc1, LAS float* scr, int lane) {
    if (c0 >= 0) {
#pragma unroll 8
        for (int i = 0; i < 32; ++i) { const int kk = 2 * i + (lane >> 5); const int k = k0 + kk; float v = W[(size_t)k * ldn + c0 + (lane & 31)];
            if (sc0) v *= (k < 512 || !sc1) ? sc0[k] : sc1[k - 512];
            scr[kk * 33 + (lane & 31)] = v; }
    } else {
#pragma unroll 8
        for (int i = 0; i < 32; ++i) { const int kk = 2 * i + (lane >> 5); scr[kk * 33 + (lane & 31)] = 0.f; }
    }
    LDS_WAIT(); asm volatile("" ::: "memory");
    const int c = lane & 7;
#pragma unroll
    for (int j = 0; j < 4; ++j) { const int n = (lane >> 3) + 8 * j; const LAS float* s = scr + (8 * c) * 33 + n;
        u32x4 o; o.x = pk2(s[0 * 33], s[1 * 33]); o.y = pk2(s[2 * 33], s[3 * 33]); o.z = pk2(s[4 * 33], s[5 * 33]); o.w = pk2(s[6 * 33], s[7 * 33]);
        *(u32x4*)(dst + (size_t)n * K + k0 + 8 * c) = o; }
    LDS_WAIT(); asm volatile("" ::: "memory");
}
__device__ __forceinline__ int win_src_col(int tile, int q) {
    if (tile <= 1) return 256 * tile + 64 * (q & 3) + ((q >> 2) ? 32 : 0);
    if (tile == 2) { const int tb[8] = {512, 576, 640, 672, 544, 608, 704, 736}; int r = tb[0];
#pragma unroll
        for (int i = 1; i < 8; ++i) r = (q == i) ? tb[i] : r; return r; }
    if (tile == 3) return 768 + 32 * q;
    if (tile == 4) return 1024 + 32 * q;
    return q == 0 ? 1280 : (q == 4 ? 1312 : -1);
}
__device__ __forceinline__ int wuq_src_col(int tile, int q) {
    if (tile <= 1) return (2 * tile + (q >> 2)) * 192 + 32 * (q & 3);
    return (q & 3) * 192 + 128 + ((q >> 2) ? 32 : 0);
}

__device__ __forceinline__ void ln_row_bf16(const float* __restrict__ src, const float* __restrict__ g, const float* __restrict__ b, bf16_t* dst, int lane) {
    f32x4 v[4]; float s = 0.f;
#pragma unroll
    for (int j = 0; j < 4; ++j) { v[j] = *(const f32x4*)(src + j * 256 + lane * 4); s += (v[j].x + v[j].y) + (v[j].z + v[j].w); }
    const float mean = wave_sum(s) * (1.f / DM); float s2 = 0.f;
#pragma unroll
    for (int j = 0; j < 4; ++j) { v[j] = v[j] - mean; s2 += (v[j].x * v[j].x + v[j].y * v[j].y) + (v[j].z * v[j].z + v[j].w * v[j].w); }
    const float rstd = 1.f / sqrtf(wave_sum(s2) * (1.f / DM) + LN_EPS);
#pragma unroll
    for (int j = 0; j < 4; ++j) { const int c = j * 256 + lane * 4; const f32x4 gg = *(const f32x4*)(g + c), bb = *(const f32x4*)(b + c);
        const f32x4 o = v[j] * rstd * gg + bb; u32x2 w; w.x = pk2(o.x, o.y); w.y = pk2(o.z, o.w); *(u32x2*)(dst + c) = w; }
}

__device__ __forceinline__ bf16x8 ld_bcol8(const float* __restrict__ W, int ldn, int k0, int col) {
    float x[8];
#pragma unroll
    for (int j = 0; j < 8; ++j) x[j] = W[(size_t)(k0 + j) * ldn + col];
    u32x4 w; w.x = pk2(x[0], x[1]); w.y = pk2(x[2], x[3]); w.z = pk2(x[4], x[5]); w.w = pk2(x[6], x[7]);
    return __builtin_bit_cast(bf16x8, w);
}
__device__ __forceinline__ void p0_meta(const Frame& F, const Args& a) {
    constexpr int RSH = 1032, RSC = 264;
    LAS bf16_t* hm = (LAS bf16_t*)(F.lds);
    LAS float* oB = (LAS float*)(F.lds + 33280);
    LAS bf16_t* ckn = (LAS bf16_t*)(F.lds + 33280 + 36864);
    LAS float* oD = (LAS float*)(F.lds + 33280 + 36864 + 8448);
    const int lane = F.lane, w = F.wave, fr = lane & 15, fq = lane >> 4;
    const float* meta = a.in[1]; const float* g = a.in[2]; const float* b = a.in[3]; const float* w_in = a.in[4]; const float* gkv = a.in[8]; const float* w_ukv = a.in[9];
    bf16_t* KA = (bf16_t*)(F.ws + WS_KA); bf16_t* VA = (bf16_t*)(F.ws + WS_VA); bf16_t* KM = (bf16_t*)(F.ws + WS_KM); bf16_t* VM = (bf16_t*)(F.ws + WS_VM);
#pragma unroll 1
    for (int rr = 0; rr < 2; ++rr) { const int row = 2 * w + rr; const float* src = meta + (size_t)row * DM;
        f32x4 v[4]; float s = 0.f;
#pragma unroll
        for (int j = 0; j < 4; ++j) { v[j] = *(const f32x4*)(src + j * 256 + lane * 4); s += (v[j].x + v[j].y) + (v[j].z + v[j].w); }
        const float mean = wave_sum(s) * (1.f / DM); float s2 = 0.f;
#pragma unroll
        for (int j = 0; j < 4; ++j) { v[j] = v[j] - mean; s2 += (v[j].x * v[j].x + v[j].y * v[j].y) + (v[j].z * v[j].z + v[j].w * v[j].w); }
        const float rstd = 1.f / sqrtf(wave_sum(s2) * (1.f / DM) + LN_EPS);
#pragma unroll
        for (int j = 0; j < 4; ++j) { const int c = j * 256 + lane * 4; const f32x4 gg = *(const f32x4*)(g + c), bb = *(const f32x4*)(b + c); const f32x4 o = v[j] * rstd * gg + bb;
            u32x2 pw; pw.x = pk2(o.x, o.y); pw.y = pk2(o.z, o.w); *(LAS u32x2*)(hm + row * RSH + c) = pw; } }
    __syncthreads();
#pragma unroll 1
    for (int blk = w; blk < 36; blk += 8) {
        const int col = (blk < 16 ? 512 + 16 * blk : (blk < 32 ? 1024 + 16 * (blk - 16) : 1280 + 16 * (blk - 32))) + fr;
        f32x4 c = {0.f, 0.f, 0.f, 0.f};
#pragma unroll 4
        for (int s = 0; s < 32; ++s) { const bf16x8 av = *(const LAS bf16x8*)(hm + fr * RSH + 32 * s + 8 * fq); const bf16x8 bv = ld_bcol8(w_in, INC, 32 * s + 8 * fq, col);
            c = __builtin_amdgcn_mfma_f32_16x16x32_bf16(av, bv, c, 0, 0, 0); }
        const int oc = (blk < 16 ? 16 * blk : (blk < 32 ? 256 + 16 * (blk - 16) : 512 + 16 * (blk - 32))) + fr;
#pragma unroll
        for (int j = 0; j < 4; ++j) oB[(fq * 4 + j) * 576 + oc] = c[j];
    }
    __syncthreads();
#pragma unroll 1
    for (int idx = F.tid; idx < 16 * 320; idx += NWAVES * 64) { const int r = idx / 320, c = idx % 320;
        const int oc = c < 256 ? c : c + 256; float v = oB[r * 576 + oc];
        if (c < 128 || c >= 256) { const float p = oB[r * 576 + (oc ^ 32)]; float cs, sn; rope_cs(r, c & 31, cs, sn); v = (c & 32) ? v * cs + p * sn : v * cs - p * sn; }
        const bf16_t hv = (bf16_t)f2bf(v);
        for (int b2 = 0; b2 < NB; ++b2) { const size_t prow = (size_t)b2 * LP + NPAD + r;
            if (c < 128) KA[prow * 128 + c] = hv; else if (c < 256) VA[prow * 128 + (c - 128)] = hv;
            else { const int cc = c - 256; KM[prow * 768 + 128 + cc] = hv; KM[prow * 768 + 192 + 128 + cc] = hv; KM[prow * 768 + 384 + 128 + cc] = hv; KM[prow * 768 + 576 + 128 + cc] = hv; } } }
#pragma unroll 1
    for (int rr = 0; rr < 2; ++rr) { const int row = 2 * w + rr; float v[4]; float ss = 0.f;
#pragma unroll
        for (int j = 0; j < 4; ++j) { v[j] = oB[row * 576 + 256 + 64 * j + lane]; ss += v[j] * v[j]; }
        const float rstd = 1.f / sqrtf(wave_sum(ss) * (1.f / 256.f) + RMS_EPS);
#pragma unroll
        for (int j = 0; j < 4; ++j) ckn[row * RSC + 64 * j + lane] = (bf16_t)f2bf(v[j] * rstd * gkv[64 * j + lane]); }
    __syncthreads();
    LAS float* oD2 = (LAS float*)(F.lds);
#pragma unroll 1
    for (int blk = w; blk < 64; blk += 8) {
        const int col = 16 * blk + fr;
        f32x4 c = {0.f, 0.f, 0.f, 0.f};
#pragma unroll
        for (int s = 0; s < 8; ++s) { const bf16x8 av = *(const LAS bf16x8*)(ckn + fr * RSC + 32 * s + 8 * fq); const bf16x8 bv = ld_bcol8(w_ukv, 1024, 32 * s + 8 * fq, col);
            c = __builtin_amdgcn_mfma_f32_16x16x32_bf16(av, bv, c, 0, 0, 0); }
        asm volatile("s_nop 0" ::: "memory");
        (void)oD;
#pragma unroll
        for (int j = 0; j < 4; ++j) oD2[(fq * 4 + j) * 1024 + col] = c[j];
    }
    __syncthreads();
#pragma unroll 1
    for (int idx = F.tid; idx < NB * 16 * 1024; idx += NWAVES * 64) { const int b2 = idx >> 14, r = (idx >> 10) & 15, col = idx & 1023, h = col >> 8, cc = col & 255;
        const size_t prow = (size_t)b2 * LP + NPAD + r; const bf16_t hv = (bf16_t)f2bf(oD2[r * 1024 + col]);
        if (cc < 128) KM[prow * 768 + h * 192 + cc] = hv; else VM[prow * 512 + h * 128 + (cc - 128)] = hv; }
    __syncthreads();
}

__device__ __forceinline__ void p0_prologue(const Frame& F, const Args& a) {
    if (F.bx == F.G - 1) { p0_meta(F, a); return; }
    LAS float* scr = (LAS float*)(F.lds + F.wave * 16384);
    const int gw = F.bx * NWAVES + F.wave, NGW = (F.G - 1) * NWAVES, lane = F.lane;
    unsigned char* ws = F.ws;
    constexpr int I_IN = 16 * 48, I_UQ = 4 * 24, I_UKV = 4 * 32, I_O = 16 * 32, I_GU = 32 * 16 * 16, I_DN = 32 * 4 * 32;
    constexpr int NITEMS = I_IN + I_UQ + I_UKV + I_O + I_GU + I_DN;
    for (int it = gw; it < NITEMS; it += NGW) {
        int r = it;
        if (r < I_IN) { const int kb = r / 48, nb = r % 48; p0_tr_item(a.in[4], INC, win_src_col(nb >> 3, nb & 7), 64 * kb, (bf16_t*)(ws + WS_WIN) + (size_t)(32 * nb) * DM, DM, nullptr, nullptr, scr, lane); continue; } r -= I_IN;
        if (r < I_UQ) { const int kb = r / 24, nb = r % 24; p0_tr_item(a.in[7], 768, wuq_src_col(nb >> 3, nb & 7), 64 * kb, (bf16_t*)(ws + WS_WUQ) + (size_t)(32 * nb) * 256, 256, a.in[6], nullptr, scr, lane); continue; } r -= I_UQ;
        if (r < I_UKV) { const int kb = r / 32, nb = r % 32; p0_tr_item(a.in[9], 1024, 32 * nb, 64 * kb, (bf16_t*)(ws + WS_WUKV) + (size_t)(32 * nb) * 256, 256, a.in[8], nullptr, scr, lane); continue; } r -= I_UKV;
        if (r < I_O) { const int kb = r / 32, nb = r % 32; p0_tr_item(a.in[12], DM, 32 * nb, 64 * kb, (bf16_t*)(ws + WS_WO) + (size_t)(32 * nb) * DM, DM, a.in[10], a.in[11], scr, lane); continue; } r -= I_O;
        if (r < I_GU) { const int e = r / 256, r2 = r % 256, kb = r2 / 16, nb = r2 % 16; const int tile = nb >> 3, q = nb & 7;
            const float* src = (q < 4 ? a.in[19] : a.in[20]) + (size_t)e * DM * 256;
            p0_tr_item(src, 256, 128 * tile + 32 * (q & 3), 64 * kb, (bf16_t*)(ws + WS_WGU) + ((size_t)e * 512 + 32 * nb) * DM, DM, nullptr, nullptr, scr, lane); continue; } r -= I_GU;
        { const int e = r / 128, r2 = r % 128, kb = r2 / 32, nb = r2 % 32;
            p0_tr_item(a.in[21] + (size_t)e * 256 * DM, DM, 32 * nb, 64 * kb, (bf16_t*)(ws + WS_WDN) + ((size_t)e * 1024 + 32 * nb) * 256, 256, nullptr, nullptr, scr, lane); }
    }
    { float* COS = (float*)(ws + WS_COS); float* SIN = (float*)(ws + WS_SIN);
      for (int it = gw; it < NPOS * 32 / 64; it += NGW) { const int idx = it * 64 + lane; float c, s; rope_cs(idx >> 5, idx & 31, c, s); COS[idx] = c; SIN[idx] = s; } }
    for (int it = gw; it < NB * NPAD; it += NGW) { const size_t prow = (size_t)(it / NPAD) * LP + (it % NPAD);
        const u32x4 z = {0u, 0u, 0u, 0u};
        for (int o = lane * 16; o < 3072; o += 1024) {
            unsigned char* p;
            if (o < 256) p = ws + WS_KA + prow * 256 + o; else if (o < 512) p = ws + WS_VA + prow * 256 + (o - 512 + 256);
            else if (o < 2048) p = ws + WS_KM + prow * 1536 + (o - 512); else p = ws + WS_VM + prow * 1024 + (o - 2048);
            *(u32x4*)p = z; } }
    for (int m = gw; m < T; m += NGW) ln_row_bf16(a.in[0] + (size_t)m * DM, a.in[2], a.in[3], (bf16_t*)(ws + WS_H0) + (size_t)m * DM, lane);
}

__device__ __forceinline__ void rope8(const f32x4 lo0, const f32x4 lo1, const f32x4 hi0, const f32x4 hi1, const float* __restrict__ cosr, const float* __restrict__ sinr, u32x4& olo, u32x4& ohi, float scale) {
    const f32x4 c0 = *(const f32x4*)cosr, c1 = *(const f32x4*)(cosr + 4), s0 = *(const f32x4*)sinr, s1 = *(const f32x4*)(sinr + 4);
    olo = pg8::pack8((lo0 * c0 - hi0 * s0) * scale, (lo1 * c1 - hi1 * s1) * scale);
    ohi = pg8::pack8((hi0 * c0 + lo0 * s0) * scale, (hi1 * c1 + lo1 * s1) * scale);
}
struct EpiInProj {
    static constexpr bool PERM = true, MIDK = false;
    unsigned char* ws;
    __device__ __forceinline__ void operator()(const f32x4 (&acc)[2][2][4][2], const pg8::Unit& u, int wr, int wc, int fr, int fq) const {
        const int pn = u.pn, bb = u.pm >> 5, t0 = (u.pm & 31) * 256 + wr * 64 + fr;
        const float* COS = (const float*)(ws + WS_COS); const float* SIN = (const float*)(ws + WS_SIN);
        const int j0 = 8 * fq;
#pragma unroll
        for (int ai = 0; ai < 2; ++ai)
#pragma unroll
            for (int m = 0; m < 4; ++m) {
                const int t = t0 + ai * 128 + m * 16; const size_t mrow = (size_t)bb * SEQ + t; const size_t prow = (size_t)bb * LP + 128 + t; const int pos = t + NMETA;
                const f32x4 a00 = acc[ai][0][m][0], a01 = acc[ai][0][m][1], a10 = acc[ai][1][m][0], a11 = acc[ai][1][m][1];
                if (pn <= 1) { u32x4 lo, hi; rope8(a00, a01, a10, a11, COS + pos * 32 + j0, SIN + pos * 32 + j0, lo, hi, 1.f);
                    bf16_t* q = (bf16_t*)(ws + WS_QA) + mrow * 512 + (4 * pn + wc) * 64 + j0; *(u32x4*)q = lo; *(u32x4*)(q + 32) = hi; }
                else if (pn == 2) {
                    if (wc < 2) { u32x4 lo, hi; rope8(a00, a01, a10, a11, COS + pos * 32 + j0, SIN + pos * 32 + j0, lo, hi, 1.f);
                        bf16_t* k = (bf16_t*)(ws + WS_KA) + prow * 128 + wc * 64 + j0; *(u32x4*)k = lo; *(u32x4*)(k + 32) = hi; }
                    else { bf16_t* v = (bf16_t*)(ws + WS_VA) + prow * 128 + 32 * (wc - 2) + j0; *(u32x4*)v = pg8::pack8(a00, a01); *(u32x4*)(v + 64) = pg8::pack8(a10, a11); } }
                else if (pn <= 4) {
                    bf16_t* c = (bf16_t*)(ws + (pn == 3 ? WS_CQ : WS_CKV)) + mrow * 256 + 32 * wc + j0; *(u32x4*)c = pg8::pack8(a00, a01); *(u32x4*)(c + 128) = pg8::pack8(a10, a11);
                    const f32x4 q = a00 * a00 + a01 * a01 + a10 * a10 + a11 * a11; float s = (q[0] + q[1]) + (q[2] + q[3]);
                    s += __shfl_xor(s, 16); s += __shfl_xor(s, 32);
                    if (fq == 0) ((float*)(ws + (pn == 3 ? WS_CQS : WS_CKVS)))[mrow * 4 + wc] = s; }
                else { if (wc == 0) { u32x4 lo, hi; rope8(a00, a01, a10, a11, COS + pos * 32 + j0, SIN + pos * 32 + j0, lo, hi, 1.f);
                        bf16_t* k = (bf16_t*)(ws + WS_KM) + prow * 768 + 128 + j0;
#pragma unroll
                        for (int h = 0; h < 4; ++h) { *(u32x4*)(k + h * 192) = lo; *(u32x4*)(k + h * 192 + 32) = hi; } } }
            }
    }
};

struct UpOrder {
    const char* CQ; const char* CKV; const char* Wq; const char* Wkv; int G, c;
    __device__ bool next(int i, pg8::Unit& u) const {
        int L = i * G + c; if (L >= 896) return false;
        if (L < 384) { u.pm = L / 3; u.pn = L % 3; } else { L -= 384; u.pm = L >> 2; u.pn = 3 + (L & 3); }
        return true;
    }
    __device__ __forceinline__ const char* abase(const pg8::Unit& u) const { return (u.pn < 3 ? CQ : CKV) + (size_t)u.pm * 256 * 256 * 2; }
    __device__ __forceinline__ const char* bbase(const pg8::Unit& u) const { return u.pn < 3 ? Wq + (size_t)u.pn * 256 * 256 * 2 : Wkv + (size_t)(u.pn - 3) * 256 * 256 * 2; }
    __device__ __forceinline__ unsigned arow_off(const pg8::Unit&, int R) const { return (unsigned)(R * 256) * 2u; }
};
struct EpiUp {
    static constexpr bool PERM = true, MIDK = false;
    unsigned char* ws;
    __device__ __forceinline__ void operator()(const f32x4 (&acc)[2][2][4][2], const pg8::Unit& u, int wr, int wc, int fr, int fq) const {
        const int pn = u.pn, bb = u.pm >> 5, tb = (u.pm & 31) * 256;
        const size_t m0 = (size_t)bb * SEQ + tb, p0 = (size_t)bb * LP + 128 + tb;
        const char* COSb = (const char*)(ws + WS_COS) + (size_t)(tb + NMETA) * 128; const char* SINb = (const char*)(ws + WS_SIN) + (size_t)(tb + NMETA) * 128;
        const char* SSb = (const char*)(ws + (pn < 3 ? WS_CQS : WS_CKVS)) + m0 * 16;
        char* QMb = (char*)(ws + WS_QM) + m0 * 1536; char* KMb = (char*)(ws + WS_KM) + p0 * 1536; char* VMb = (char*)(ws + WS_VM) + p0 * 1024;
        int rl = wr * 64 + fr; asm volatile("" : "+v"(rl));
        const int j0 = 8 * fq;
#pragma unroll
        for (int ai = 0; ai < 2; ++ai)
#pragma unroll
            for (int m = 0; m < 4; ++m) {
                const unsigned r = (unsigned)(rl + ai * 128 + m * 16);
                const f32x4 sv = *(const f32x4*)(SSb + (size_t)(r * 16u));
                const float rstd = 1.f / sqrtf(((sv[0] + sv[1]) + (sv[2] + sv[3])) * (1.f / 256.f) + RMS_EPS);
                const f32x4 a00 = acc[ai][0][m][0] * rstd, a01 = acc[ai][0][m][1] * rstd, a10 = acc[ai][1][m][0] * rstd, a11 = acc[ai][1][m][1] * rstd;
                if (pn < 2) { char* q = QMb + (size_t)(r * 1536u + (unsigned)(((2 * pn) * 192 + 32 * wc + j0) * 2)); *(u32x4*)q = pg8::pack8(a00, a01); *(u32x4*)(q + 384) = pg8::pack8(a10, a11); }
                else if (pn == 2) { u32x4 lo, hi; const unsigned co = r * 128u + (unsigned)(j0 * 4); rope8(a00, a01, a10, a11, (const float*)(COSb + (size_t)co), (const float*)(SINb + (size_t)co), lo, hi, 1.f);
                    char* q = QMb + (size_t)(r * 1536u + (unsigned)((wc * 192 + 128 + j0) * 2)); *(u32x4*)q = lo; *(u32x4*)(q + 64) = hi; }
                else { const int h = pn - 3;
                    *(u32x4*)(KMb + (size_t)(r * 1536u + (unsigned)((h * 192 + 32 * wc + j0) * 2))) = pg8::pack8(a00, a01);
                    *(u32x4*)(VMb + (size_t)(r * 1024u + (unsigned)((h * 128 + 32 * wc + j0) * 2))) = pg8::pack8(a10, a11); }
                asm volatile("" ::: "memory");
            }
    }
};

namespace att {
typedef short s16x4 __attribute__((ext_vector_type(4)));
typedef float f32x16 __attribute__((ext_vector_type(16)));
constexpr int NW = 8, QBLK = 32, KVBLK = 64, QB = NW * QBLK;
#define SBAR() __builtin_amdgcn_sched_barrier(0)
__device__ __forceinline__ int crow(int r, int hi) { return (r & 3) + 8 * (r >> 2) + 4 * hi; }
__device__ __forceinline__ unsigned cvtpk(float lo, float hi) { unsigned r; asm volatile("v_cvt_pk_bf16_f32 %0, %1, %2" : "=v"(r) : "v"(lo), "v"(hi)); return r; }
__device__ __forceinline__ int v_rd_base(int lane) { return ((lane & 3) << 3) | (((lane >> 2) & 3) << 6) | (((lane >> 4) & 1) << 5) | (((lane >> 5) & 1) << 8); }

template <int DQK_, int DV_, int LDQ_, int LDK_, int LDV_, int W_, bool SK_, int NPARK_>
struct Cfg {
    static constexpr int DQK = DQK_, DV = DV_, LDQ = LDQ_, LDK = LDK_, LDV = LDV_, W = W_; static constexpr bool SK = SK_;
    static constexpr int ROWB = DQK * 2, SHM_K = KVBLK * ROWB, SHM_V = KVBLK * DV * 2;
    static constexpr int KCPR = DQK / 8, VCPR = DV / 8, NKC = KVBLK * KCPR / 512, NVC = KVBLK * VCPR / 512, KG = (DV / 32) * 512, NQF = DQK / 16, NOF = DV / 32;
    static constexpr int NPARK = NPARK_, NQR = DQK_ / 16 - NPARK_;
    static constexpr int WS_OFF = 2 * SHM_V + 2 * SHM_K, PARK_OFF = WS_OFF + NW * 64 * 4, LDS_BYTES = PARK_OFF + NW * NPARK_ * 1024;
};
template <class C> struct BlockRef { const bf16_t* Q; const bf16_t* K; const bf16_t* V; bf16_t* O; float* SSQ; int P0; float m0, l0, c2; };
template <class C> struct Seam { bf16x8 qr[C::NQR]; bf16x8 st_k[C::NKC]; bf16x8 st_v[C::NVC]; };

__device__ __forceinline__ void mask_tile(f32x16& p0, f32x16& p1, int dq, unsigned W, int klim) {
    const float NEG = -__builtin_inff();
#pragma unroll
    for (int r = 0; r < 16; ++r) {
        const int c = (r & 3) + 8 * (r >> 2);
        if ((unsigned)(dq - c) >= W || c < klim) p0[r] = NEG;
        if ((unsigned)(dq - c - 32) >= W || c + 32 < klim) p1[r] = NEG;
    }
}
__device__ __forceinline__ void partialSM(f32x16& p0, f32x16& p1, float& m_reg, float& mn, float& alpha, float c2, float thr) {
    float pmax = p0[0];
#pragma unroll
    for (int r = 1; r < 16; ++r) pmax = fmaxf(pmax, p0[r]);
#pragma unroll
    for (int r = 0; r < 16; ++r) pmax = fmaxf(pmax, p1[r]);
    { auto rr = __builtin_amdgcn_permlane32_swap(__float_as_uint(pmax), __float_as_uint(pmax), false, false);
      pmax = fmaxf(__uint_as_float(rr[0]), __uint_as_float(rr[1])); }
    if (__builtin_expect(__all((pmax - m_reg) <= thr), 1)) { mn = m_reg; alpha = 1.f; }
    else { mn = fmaxf(m_reg, pmax); alpha = __builtin_amdgcn_exp2f((m_reg - mn) * c2); m_reg = mn; }
    const float mnL = -mn * c2;
#pragma unroll
    for (int r = 0; r < 16; ++r) p0[r] = fmaf(p0[r], c2, mnL);
#pragma unroll
    for (int r = 0; r < 16; ++r) p1[r] = fmaf(p1[r], c2, mnL);
#pragma unroll
    for (int r = 0; r < 16; ++r) p0[r] = __builtin_amdgcn_exp2f(p0[r]);
}
__device__ __forceinline__ void finishSM(f32x16& p0, f32x16& p1, float alpha, float& l_reg, bf16x8& pa0, bf16x8& pa1, bf16x8& pa2, bf16x8& pa3) {
#pragma unroll
    for (int r = 0; r < 16; ++r) p1[r] = __builtin_amdgcn_exp2f(p1[r]);
    float ps = 0;
#pragma unroll
    for (int r = 0; r < 16; ++r) ps += p0[r];
#pragma unroll
    for (int r = 0; r < 16; ++r) ps += p1[r];
    { auto rr = __builtin_amdgcn_permlane32_swap(__float_as_uint(ps), __float_as_uint(ps), false, false);
      ps = __uint_as_float(rr[0]) + __uint_as_float(rr[1]); }
    l_reg = l_reg * alpha + ps;
#define PK4(P, B_, OUT) do { unsigned a0 = cvtpk(P[B_+0], P[B_+1]), a1 = cvtpk(P[B_+2], P[B_+3]);                          \
        unsigned b0 = cvtpk(P[B_+4], P[B_+5]), b1 = cvtpk(P[B_+6], P[B_+7]);                                             \
        auto r0 = __builtin_amdgcn_permlane32_swap(a0, b0, false, false); auto r1 = __builtin_amdgcn_permlane32_swap(a1, b1, false, false); \
        u32x4 w = {r0[0], r1[0], r0[1], r1[1]}; OUT = *reinterpret_cast<bf16x8*>(&w); } while (0)
    PK4(p0, 0, pa0); PK4(p0, 8, pa1); PK4(p1, 0, pa2); PK4(p1, 8, pa3);
#undef PK4
}
template <class C, int KB>
__device__ __forceinline__ void qkt(f32x16& p0, f32x16& p1, const char* K_lds, int r32, int hi, const bf16x8* qr, const char* qpark, bool act) {
    if (C::SK && !act) { const float NEG = -__builtin_inff();
#pragma unroll
        for (int r = 0; r < 16; ++r) { p0[r] = NEG; p1[r] = NEG; } return; }
    p0 = f32x16{}; p1 = f32x16{};
    const char* kb[4];
#pragma unroll
    for (int dd = 0; dd < 4; ++dd) kb[dd] = K_lds + KB * C::SHM_K + r32 * C::ROWB + (((dd * 16 + hi * 8) * 2) ^ ((r32 & 7) << 4));
#pragma unroll
    for (int d0 = 0; d0 < C::NQF; ++d0) { const char* a = kb[d0 & 3] + (d0 >> 2) * 128;
        bf16x8 b0 = *reinterpret_cast<const bf16x8*>(a);
        bf16x8 b1 = *reinterpret_cast<const bf16x8*>(a + 32 * C::ROWB);
        bf16x8 qf; if (d0 < C::NQR) qf = qr[d0 < C::NQR ? d0 : 0]; else qf = *reinterpret_cast<const bf16x8*>(qpark + (d0 - C::NQR) * 1024);
        p0 = __builtin_amdgcn_mfma_f32_32x32x16_bf16(b0, qf, p0, 0, 0, 0);
        p1 = __builtin_amdgcn_mfma_f32_32x32x16_bf16(b1, qf, p1, 0, 0, 0);
        if (C::NQF > 8 && (d0 & 3) == 3) SBAR(); }
}
template <class C, int VB>
__device__ __forceinline__ void pv_tile(f32x16* o, int vb0, bf16x8 pa0, bf16x8 pa1, bf16x8 pa2, bf16x8 pa3, bool act) {
    if (C::SK && !act) return;
#define TRRD(dst, off) asm volatile("ds_read_b64_tr_b16 %0, %1 offset:%2" : "=&v"(dst) : "v"(vb0), "i"(off) : "memory")
#define PV_D0(d0) do { s16x4 l0, l1, l2, l3, h0, h1, h2, h3; constexpr int b_ = VB * C::SHM_V + (d0) * 512; constexpr int KG_ = C::KG;   \
        TRRD(l0, b_); TRRD(h0, b_ + KG_); TRRD(l1, b_ + 2 * KG_); TRRD(h1, b_ + 3 * KG_); TRRD(l2, b_ + 4 * KG_); TRRD(h2, b_ + 5 * KG_); TRRD(l3, b_ + 6 * KG_); TRRD(h3, b_ + 7 * KG_); \
        asm volatile("s_waitcnt lgkmcnt(0)" ::: "memory"); SBAR();   \
        o[d0] = __builtin_amdgcn_mfma_f32_32x32x16_bf16(pa0, (bf16x8){l0[0], l0[1], l0[2], l0[3], h0[0], h0[1], h0[2], h0[3]}, o[d0], 0, 0, 0);   \
        o[d0] = __builtin_amdgcn_mfma_f32_32x32x16_bf16(pa1, (bf16x8){l1[0], l1[1], l1[2], l1[3], h1[0], h1[1], h1[2], h1[3]}, o[d0], 0, 0, 0);   \
        o[d0] = __builtin_amdgcn_mfma_f32_32x32x16_bf16(pa2, (bf16x8){l2[0], l2[1], l2[2], l2[3], h2[0], h2[1], h2[2], h2[3]}, o[d0], 0, 0, 0);   \
        o[d0] = __builtin_amdgcn_mfma_f32_32x32x16_bf16(pa3, (bf16x8){l3[0], l3[1], l3[2], l3[3], h3[0], h3[1], h3[2], h3[3]}, o[d0], 0, 0, 0); } while (0)
    PV_D0(0); PV_D0(1);
    if constexpr (C::NOF == 4) { PV_D0(2); PV_D0(3); }
#undef PV_D0
#undef TRRD
}
template <class C> __device__ __forceinline__ int jlo(int P0) { const int lowk = P0 - C::W + 1; int j = lowk > 0 ? lowk / KVBLK : 0; const int jm = NPAD / KVBLK; return j < jm ? jm : j; }

#define AT_RSRC(p) __builtin_amdgcn_make_buffer_rsrc((void*)(p), 0, 0x7fffffff, 0x00020000)
#define AT_BLD(rs, vo, so) __builtin_bit_cast(bf16x8, __builtin_amdgcn_raw_buffer_load_b128((rs), (int)(vo), (int)(so), 0))
#define AT_SLOAD(Kp, Vp, k0) do { const __amdgpu_buffer_rsrc_t kr__ = AT_RSRC(Kp), vr__ = AT_RSRC(Vp); const int ks__ = (k0) * (C::LDK * 2), vs__ = (k0) * (C::LDV * 2); \
    _Pragma("unroll") for (int i_ = 0; i_ < C::NVC; ++i_) S.st_v[i_] = AT_BLD(vr__, vgo + (unsigned)(i_ * 128), vs__); \
    _Pragma("unroll") for (int i_ = 0; i_ < C::NKC; ++i_) S.st_k[i_] = AT_BLD(kr__, kgo + (unsigned)(i_ * 128), ks__); } while (0)
#define AT_SWRITE_K(bf) do { _Pragma("unroll") for (int i_ = 0; i_ < C::NKC; ++i_) *(bf16x8*)(K_lds + (bf) * C::SHM_K + klo + i_ * 128) = S.st_k[i_]; } while (0)
#define AT_SWRITE_V(bf) do { _Pragma("unroll") for (int i_ = 0; i_ < C::NVC; ++i_) *(bf16x8*)(V_lds + (bf) * C::SHM_V + vlo + i_ * 1024) = S.st_v[i_]; } while (0)
#define AT_STAGE_OFFS() \
    const int srow_ = tid >> 3, scc_ = tid & 7; \
    const unsigned kgo = (unsigned)(srow_ * C::LDK + scc_ * 8) * 2u, vgo = (unsigned)(srow_ * C::LDV + scc_ * 8) * 2u; \
    const int klo = srow_ * C::ROWB + ((scc_ * 16) ^ ((srow_ & 7) << 4)); \
    const int skk_ = (srow_ & ~0xC) | ((srow_ & 4) << 1) | ((srow_ & 8) >> 1); \
    const int vlo = ((skk_ >> 3) * C::NOF + (scc_ >> 2)) * 512 + ((skk_ & 7) * 32 + (scc_ & 3) * 8) * 2;
#define AT_VMW() asm volatile("s_waitcnt vmcnt(0)" ::: "memory")
#define AT_VMWN(n) asm volatile("s_waitcnt vmcnt(%0)" :: "i"(n) : "memory")

#define AT_QLOAD(Qp) do { bf16x8 qp_[C::NPARK > 0 ? C::NPARK : 1]; \
    const __amdgpu_buffer_rsrc_t qr__ = AT_RSRC(Qp); const int qs__ = wid * (QBLK * C::LDQ * 2); const unsigned qo__ = (unsigned)(r32 * C::LDQ + hi * 8) * 2u; \
    _Pragma("unroll") for (int d0 = 0; d0 < C::NPARK; ++d0) qp_[d0] = AT_BLD(qr__, qo__ + (unsigned)((C::NQR + d0) * 32), qs__); \
    _Pragma("unroll") for (int d0 = 0; d0 < C::NQR; ++d0) S.qr[d0] = AT_BLD(qr__, qo__ + (unsigned)(d0 * 32), qs__); \
    SBAR(); AT_VMWN(C::NQR); \
    _Pragma("unroll") for (int d0 = 0; d0 < C::NPARK; ++d0) *(bf16x8*)(qpark + d0 * 1024) = qp_[d0]; } while (0)
template <class C>
__device__ __forceinline__ void prime(const BlockRef<C>& cur, char* lds, Seam<C>& S, const int tid) {
    const int wid = __builtin_amdgcn_readfirstlane(tid >> 6), lane = tid & 63, r32 = lane & 31, hi = lane >> 5;
    char* K_lds = lds + 2 * C::SHM_V;
    AT_STAGE_OFFS()
    const int kb0 = jlo<C>(cur.P0) * KVBLK;
    char* qpark = lds + C::PARK_OFF + wid * (C::NPARK * 1024) + lane * 16;
    AT_SLOAD(cur.K, cur.V, kb0); SBAR(); AT_QLOAD(cur.Q); AT_VMW(); AT_SWRITE_K(0);
    __syncthreads();
}
template <class C>
__device__ __forceinline__ void block(const BlockRef<C>& cur, const BlockRef<C>& nxt, char* lds, Seam<C>& S, int ssq_slot, const int tid) {
    constexpr bool SK = C::SK; constexpr int W = C::W;
    const int wid = __builtin_amdgcn_readfirstlane(tid >> 6), lane = tid & 63, r32 = lane & 31, hi = lane >> 5;
    const int j_lo = jlo<C>(cur.P0);
    const int j_hi = (cur.P0 + QB - 1) / KVBLK + 1;
    const int NT = j_hi - j_lo;
    const int kbn = jlo<C>(nxt.P0) * KVBLK;
    const int qlo = cur.P0 + wid * QBLK, qm = qlo + r32 - 4 * hi;
    char* V_lds = lds; char* K_lds = lds + 2 * C::SHM_V;
    AT_STAGE_OFFS()
    float* ws = (float*)(lds + C::WS_OFF) + wid * 64; float* li_l = ws, * al_l = ws + 32;
    char* qpark = lds + C::PARK_OFF + wid * (C::NPARK * 1024) + lane * 16;
    float m_reg = cur.m0, l_reg = cur.l0; const float c2 = cur.c2, thr = 8.f * 1.4426950408889634f / c2;
    f32x16 o[C::NOF];
#pragma unroll
    for (int d_ = 0; d_ < C::NOF; ++d_) o[d_] = f32x16{};
    const int vb0 = (int)(uintptr_t)V_lds + v_rd_base(lane);
    const bf16_t* Kh = cur.K; const bf16_t* Vh = cur.V;
#define RESC(a) do { if (__any((a) < 1.f)) { if (hi == 0) al_l[r32] = (a); asm volatile("s_waitcnt lgkmcnt(0)" ::: "memory");              \
                     _Pragma("unroll") for (int d_ = 0; d_ < C::NOF; ++d_) _Pragma("unroll") for (int r = 0; r < 16; ++r) o[d_][r] *= al_l[crow(r, hi)]; } } while (0)
#define KBASE(t) ((j_lo + (t)) * KVBLK)
#define ACT(t) (KBASE(t) <= qlo + QBLK - 1 && KBASE(t) + KVBLK - 1 >= qlo - W + 1)
#define MASKT(P0_, P1_, t) do { const int kb_ = KBASE(t); if ((!SK || ACT(t)) && (kb_ + KVBLK - 1 > qlo || kb_ <= qlo + QBLK - 1 - W || kb_ < NPAD)) mask_tile(P0_, P1_, qm - kb_, (unsigned)W, NPAD - kb_ - 4 * hi); } while (0)
    f32x16 P0, P1; float mn, al; bf16x8 pa0, pa1, pa2, pa3;
    AT_SWRITE_V(0); __syncthreads();
#define STEP(t, B_, NB_) do { const bool more_ = (t) + 1 < NT;                                                              \
        SBAR(); if (more_) { AT_SLOAD(Kh, Vh, KBASE((t) + 1)); } else { AT_SLOAD(nxt.K, nxt.V, kbn); } SBAR();              \
        qkt<C, B_>(P0, P1, K_lds, r32, hi, S.qr, qpark, ACT(t)); SBAR();                                                   \
        MASKT(P0, P1, (t)); partialSM(P0, P1, m_reg, mn, al, c2, thr); RESC(al);                                            \
        finishSM(P0, P1, al, l_reg, pa0, pa1, pa2, pa3); SBAR();                                                             \
        pv_tile<C, B_>(o, vb0, pa0, pa1, pa2, pa3, ACT(t)); SBAR();                                                        \
        if (more_) { AT_VMW(); AT_SWRITE_V(NB_); AT_SWRITE_K(NB_); }                                                        \
        __syncthreads(); } while (0)
    int t = 0;
    for (; t + 1 < NT; t += 2) { STEP(t, 0, 1); STEP(t + 1, 1, 0); }
    if (t < NT) { STEP(t, 0, 1); }
#undef STEP
    AT_QLOAD(nxt.Q);
    AT_SWRITE_K(0); SBAR();
    if (hi == 0) li_l[r32] = l_reg; asm volatile("s_waitcnt lgkmcnt(0)" ::: "memory");
    float rli[16], sq[16];
#pragma unroll
    for (int r = 0; r < 16; ++r) { rli[r] = __builtin_amdgcn_rcpf(li_l[crow(r, hi)]); sq[r] = 0.f; }
    char* Ow = (char*)(cur.O + (size_t)(wid * QBLK) * 1024); const unsigned oo = (unsigned)(4 * hi * 1024 + r32) * 2u;
#pragma unroll
    for (int r = 0; r < 16; ++r) {
#pragma unroll
        for (int d0 = 0; d0 < C::NOF; ++d0) { const float v = o[d0][r] * rli[r]; sq[r] += v * v;
            const float vn = __shfl_xor(v, 1);
            if ((r32 & 1) == 0) *(unsigned*)(Ow + (size_t)(oo + (unsigned)((((r & 3) + 8 * (r >> 2)) * 1024 + d0 * 32) * 2))) = cvtpk(v, vn); } }
    float sel = 0.f; int r32e = r32, hie = hi; asm volatile("" : "+v"(r32e), "+v"(hie));
#pragma unroll
    for (int r = 0; r < 16; ++r) { float s = sq[r]; s += __shfl_xor(s, 1); s += __shfl_xor(s, 2); s += __shfl_xor(s, 4); s += __shfl_xor(s, 8); s += __shfl_xor(s, 16); sel = (r32e == r) ? s : sel; }
    if (r32e < 16) *(float*)((char*)(cur.SSQ + (size_t)(wid * QBLK) * 12 + ssq_slot) + (size_t)((unsigned)crow(r32e, hie) * 48u)) = sel;
    __syncthreads();
#undef RESC
#undef KBASE
#undef ACT
#undef MASKT
}
#undef AT_STAGE_OFFS
#undef AT_SLOAD
#undef AT_SWRITE_K
#undef AT_SWRITE_V
#undef AT_VMW
#undef AT_VMWN
#undef AT_QLOAD
#undef AT_RSRC
#undef AT_BLD
#undef SBAR

typedef Cfg<192, 128, 768, 768, 512, LP, false, 4> CfgMLA;
typedef Cfg<64, 64, 512, 128, 128, 128, true, 0> CfgSWA;
constexpr float C2_MLA = 1.4426950408889634f * 0.07216878364870322f, C2_SWA = 1.4426950408889634f * 0.125f;
static_assert(CfgMLA::LDS_BYTES <= RING_BYTES && CfgSWA::LDS_BYTES <= RING_BYTES, "attention LDS");

__device__ __forceinline__ BlockRef<CfgMLA> mla_ref(unsigned char* ws, int bh, int qb) {
    const int b = bh >> 2, h = bh & 3; BlockRef<CfgMLA> r; const size_t m0 = (size_t)b * SEQ + (size_t)qb * QB;
    r.Q = (const bf16_t*)(ws + WS_QM) + m0 * 768 + h * 192; r.K = (const bf16_t*)(ws + WS_KM) + (size_t)b * LP * 768 + h * 192;
    r.V = (const bf16_t*)(ws + WS_VM) + (size_t)b * LP * 512 + h * 128; r.O = (bf16_t*)(ws + WS_AO) + m0 * 1024 + 512 + h * 128;
    r.SSQ = (float*)(ws + WS_SSQ) + m0 * 12; r.P0 = 128 + qb * QB; r.m0 = -1e30f; r.l0 = 0.f; r.c2 = C2_MLA; return r;
}
__device__ __forceinline__ BlockRef<CfgSWA> swa_ref(unsigned char* ws, const float* sinks, int bh, int qb) {
    const int b = bh >> 3, h = bh & 7, kvh = h >> 2; BlockRef<CfgSWA> r; const size_t m0 = (size_t)b * SEQ + (size_t)qb * QB;
    r.Q = (const bf16_t*)(ws + WS_QA) + m0 * 512 + h * 64; r.K = (const bf16_t*)(ws + WS_KA) + (size_t)b * LP * 128 + kvh * 64;
    r.V = (const bf16_t*)(ws + WS_VA) + (size_t)b * LP * 128 + kvh * 64; r.O = (bf16_t*)(ws + WS_AO) + m0 * 1024 + h * 64;
    r.SSQ = (float*)(ws + WS_SSQ) + m0 * 12; r.P0 = 128 + qb * QB; r.m0 = sinks[h] * 8.f; r.l0 = 1.f; r.c2 = C2_SWA; return r;
}
__device__ __forceinline__ void attn_phase(char* lds, unsigned char* ws, const float* sinks, int vcu, int G) {
    {
        const int nit = (256 - vcu + G - 1) / G;
        const int nblk = 2 * (nit > 0 ? nit : 0);
        if (nblk > 0) {
            Seam<CfgMLA> S; int tid = threadIdx.x; asm volatile("" : "+v"(tid));
#define MLA_REF(k) mla_ref(ws, (vcu + ((k) >> 1) * G) >> 4, ((k) & 1) ? ((vcu + ((k) >> 1) * G) & 15) : 31 - ((vcu + ((k) >> 1) * G) & 15))
            BlockRef<CfgMLA> cur = MLA_REF(0);
            prime<CfgMLA>(cur, lds, S, tid);
            for (int k = 0; k < nblk; ++k) { const BlockRef<CfgMLA> nxt = (k + 1 < nblk) ? MLA_REF(k + 1) : cur; block<CfgMLA>(cur, nxt, lds, S, 8 + (((vcu + (k >> 1) * G) >> 4) & 3), tid); cur = nxt; }
#undef MLA_REF
        }
    }
    {
        const int nit = (256 - vcu + G - 1) / G;
        const int nblk = 4 * (nit > 0 ? nit : 0);
        if (nblk > 0) {
            Seam<CfgSWA> S; int tid = threadIdx.x; asm volatile("" : "+v"(tid));
#define SWA_REF(k) swa_ref(ws, sinks, (4 * (vcu + ((k) >> 2) * G) + ((k) & 3)) >> 5, (4 * (vcu + ((k) >> 2) * G) + ((k) & 3)) & 31)
            BlockRef<CfgSWA> cur = SWA_REF(0);
            prime<CfgSWA>(cur, lds, S, tid);
            for (int k = 0; k < nblk; ++k) { const BlockRef<CfgSWA> nxt = (k + 1 < nblk) ? SWA_REF(k + 1) : cur; block<CfgSWA>(cur, nxt, lds, S, ((4 * (vcu + (k >> 2) * G) + (k & 3)) >> 5) & 7, tid); cur = nxt; }
#undef SWA_REF
        }
    }
}
}

struct EpiOut {
    static constexpr bool PERM = false, MIDK = true;
    unsigned char* ws;
    __device__ __forceinline__ void midk(f32x4 (&acc)[2][2][4][2], const pg8::Unit& u, int wr, int wc, int fr, int fq) const {
        const char* SSQb = (const char*)(ws + WS_SSQ) + (size_t)u.pm * (256 * 48);
        unsigned lo = (unsigned)(wr * 64 + fr) * 48u; asm volatile("" : "+v"(lo));
#pragma unroll
        for (int ai = 0; ai < 2; ++ai)
#pragma unroll
            for (int m = 0; m < 4; ++m) { const char* p = SSQb + (size_t)(lo + (unsigned)((ai * 128 + m * 16) * 48));
                const f32x4 s0 = *(const f32x4*)p, s1 = *(const f32x4*)(p + 16), s2 = *(const f32x4*)(p + 32);
                const float sa = ((s0[0] + s0[1]) + (s0[2] + s0[3])) + ((s1[0] + s1[1]) + (s1[2] + s1[3])), sb = (s2[0] + s2[1]) + (s2[2] + s2[3]);
                const float rho = sqrtf((sb * (1.f / 512.f) + RMS_EPS) / (sa * (1.f / 512.f) + RMS_EPS));
#pragma unroll
                for (int bj = 0; bj < 2; ++bj)
#pragma unroll
                    for (int n = 0; n < 2; ++n) acc[ai][bj][m][n] *= rho;
                asm volatile("" ::: "memory"); }
    }
    __device__ __forceinline__ void operator()(const f32x4 (&acc)[2][2][4][2], const pg8::Unit& u, int wr, int wc, int fr, int fq) const {
        const char* SSQb = (const char*)(ws + WS_SSQ) + (size_t)u.pm * (256 * 48) + 32;
        const size_t tile = ((size_t)u.pm * 256) * DM + (size_t)u.pn * 256;
        const char* H0b = (const char*)(ws + WS_H0) + tile * 2; char* Pb = (char*)(ws + WS_PRE1) + tile * 4;
        unsigned lo = (unsigned)(wr * 64 + fr) * 48u, eo = (unsigned)((wr * 64 + fr) * DM + wc * 32 + 4 * fq); asm volatile("" : "+v"(lo), "+v"(eo));
#pragma unroll
        for (int ai = 0; ai < 2; ++ai)
#pragma unroll
            for (int m = 0; m < 4; ++m) {
                const f32x4 s2 = *(const f32x4*)(SSQb + (size_t)(lo + (unsigned)((ai * 128 + m * 16) * 48)));
                const float rb = 1.f / sqrtf(((s2[0] + s2[1]) + (s2[2] + s2[3])) * (1.f / 512.f) + RMS_EPS);
#pragma unroll
                for (int bj = 0; bj < 2; ++bj)
#pragma unroll
                    for (int n = 0; n < 2; ++n) { const unsigned off = eo + (unsigned)((ai * 128 + m * 16) * DM + bj * 128 + n * 16); const u32x2 h = *(const u32x2*)(H0b + (size_t)(off * 2u));
                        f32x4 o = acc[ai][bj][m][n] * rb;
                        o[0] += ALPHA * __uint_as_float(h.x << 16); o[1] += ALPHA * __uint_as_float(h.x & 0xffff0000u); o[2] += ALPHA * __uint_as_float(h.y << 16); o[3] += ALPHA * __uint_as_float(h.y & 0xffff0000u);
                        *(f32x4*)(Pb + (size_t)(off * 4u)) = o; }
                asm volatile("" ::: "memory"); }
    }
};

__device__ __forceinline__ void split_bf16x8(const f32x4 x0, const f32x4 x1, bf16x8& hi, bf16x8& lo) {
    unsigned h[8]; float r[8];
#pragma unroll
    for (int e = 0; e < 4; ++e) { h[e] = f2bf(x0[e]); r[e] = x0[e] - __uint_as_float(h[e] << 16); h[4 + e] = f2bf(x1[e]); r[4 + e] = x1[e] - __uint_as_float(h[4 + e] << 16); }
    u32x4 hw, lw;
    hw.x = h[0] | (h[1] << 16); hw.y = h[2] | (h[3] << 16); hw.z = h[4] | (h[5] << 16); hw.w = h[6] | (h[7] << 16);
    lw.x = pk2(r[0], r[1]); lw.y = pk2(r[2], r[3]); lw.z = pk2(r[4], r[5]); lw.w = pk2(r[6], r[7]);
    hi = __builtin_bit_cast(bf16x8, hw); lo = __builtin_bit_cast(bf16x8, lw);
}
__device__ __forceinline__ void p5_ln1_router(const Frame& F, const Args& a) {
    constexpr int RS = 1032;
    LAS float* hrow = (LAS float*)F.lds;
    LAS float* part = (LAS float*)(F.lds + 16 * RS * 4);
    LAS float* lg = part + 8 * 16 * 48;
    const int tid5 = threadIdx.x, lane = tid5 & 63, w = F.wave, fr = lane & 15, fq = lane >> 4;
    const float* PRE1 = (const float*)(F.ws + WS_PRE1); bf16_t* H1 = (bf16_t*)(F.ws + WS_H1);
    const float* g1 = a.in[13]; const float* b1 = a.in[14]; const float* wg = a.in[15]; const float* bg = a.in[16]; const float* wr = a.in[17]; const float* br = a.in[18];
    int* list = (int*)(F.ws + WS_LIST); float* ew = (float*)(F.ws + WS_EW);
    bf16x8 Bh[4][3], Bl[4][3];
#pragma unroll
    for (int s = 0; s < 4; ++s)
#pragma unroll
        for (int cb = 0; cb < 3; ++cb) { const int n = cb * 16 + fr; float x[8];
#pragma unroll
            for (int j = 0; j < 8; ++j) { const int k = 128 * w + 32 * s + 8 * fq + j; x[j] = n < 4 ? wg[k * 4 + n] : (n < 36 ? wr[k * 32 + (n - 4)] : 0.f); }
            split_bf16x8((f32x4){x[0], x[1], x[2], x[3]}, (f32x4){x[4], x[5], x[6], x[7]}, Bh[s][cb], Bl[s][cb]); }
    for (int it = F.bx; it < T / 16; it += F.G) {
        const int R0 = it * 16;
#pragma unroll
        for (int rr = 0; rr < 2; ++rr) { const int r = 2 * w + rr; const float* src = PRE1 + (size_t)(R0 + r) * DM;
            f32x4 v[4]; float s = 0.f;
#pragma unroll
            for (int j = 0; j < 4; ++j) { v[j] = *(const f32x4*)(src + j * 256 + lane * 4); s += (v[j].x + v[j].y) + (v[j].z + v[j].w); }
            const float mean = wave_sum(s) * (1.f / DM); float s2 = 0.f;
#pragma unroll
            for (int j = 0; j < 4; ++j) { v[j] = v[j] - mean; s2 += (v[j].x * v[j].x + v[j].y * v[j].y) + (v[j].z * v[j].z + v[j].w * v[j].w); }
            const float rstd = 1.f / sqrtf(wave_sum(s2) * (1.f / DM) + LN_EPS);
#pragma unroll
            for (int j = 0; j < 4; ++j) { const int c = j * 256 + lane * 4; const f32x4 gg = *(const f32x4*)(g1 + c), bb = *(const f32x4*)(b1 + c);
                const f32x4 o = v[j] * rstd * gg + bb; *(LAS f32x4*)(hrow + r * RS + c) = o;
                u32x2 pw; pw.x = pk2(o.x, o.y); pw.y = pk2(o.z, o.w); *(u32x2*)(H1 + (size_t)(R0 + r) * DM + c) = pw; } }
        __syncthreads();
        f32x4 c0 = {0.f, 0.f, 0.f, 0.f}, c1 = c0, c2 = c0;
#pragma unroll
        for (int s = 0; s < 4; ++s) { const LAS float* ap = hrow + fr * RS + 128 * w + 32 * s + 8 * fq;
            bf16x8 ah, al; split_bf16x8(*(const LAS f32x4*)ap, *(const LAS f32x4*)(ap + 4), ah, al);
            c0 = __builtin_amdgcn_mfma_f32_16x16x32_bf16(ah, Bh[s][0], c0, 0, 0, 0); c0 = __builtin_amdgcn_mfma_f32_16x16x32_bf16(al, Bh[s][0], c0, 0, 0, 0); c0 = __builtin_amdgcn_mfma_f32_16x16x32_bf16(ah, Bl[s][0], c0, 0, 0, 0);
            c1 = __builtin_amdgcn_mfma_f32_16x16x32_bf16(ah, Bh[s][1], c1, 0, 0, 0); c1 = __builtin_amdgcn_mfma_f32_16x16x32_bf16(al, Bh[s][1], c1, 0, 0, 0); c1 = __builtin_amdgcn_mfma_f32_16x16x32_bf16(ah, Bl[s][1], c1, 0, 0, 0);
            c2 = __builtin_amdgcn_mfma_f32_16x16x32_bf16(ah, Bh[s][2], c2, 0, 0, 0); c2 = __builtin_amdgcn_mfma_f32_16x16x32_bf16(al, Bh[s][2], c2, 0, 0, 0); c2 = __builtin_amdgcn_mfma_f32_16x16x32_bf16(ah, Bl[s][2], c2, 0, 0, 0); }
#pragma unroll
        for (int j = 0; j < 4; ++j) { LAS float* pp = part + (w * 16 + fq * 4 + j) * 48 + fr; pp[0] = c0[j]; pp[16] = c1[j]; pp[32] = c2[j]; }
        __syncthreads();
        for (int idx = tid5; idx < 16 * 48; idx += NWAVES * 64) { float sum = 0.f;
#pragma unroll
            for (int q = 0; q < 8; ++q) sum += part[q * 768 + idx];
            lg[idx] = sum; }
        __syncthreads();
        if (tid5 < 16) { const int m = R0 + tid5; const LAS float* L = lg + tid5 * 48;
            const float l0 = L[0] + bg[0], l1 = L[1] + bg[1], l2 = L[2] + bg[2], l3 = L[3] + bg[3];
            const float mx = fmaxf(fmaxf(l0, l1), fmaxf(l2, l3));
            const float ex0 = expf(l0 - mx), ex1 = expf(l1 - mx), ex2 = expf(l2 - mx), ex3 = expf(l3 - mx);
            const float se = ((ex0 + ex1) + ex2) + ex3;
            int gi = 0; float gt = ex0 / se;
            { const float p = ex1 / se; if (p > gt) { gt = p; gi = 1; } }
            { const float p = ex2 / se; if (p > gt) { gt = p; gi = 2; } }
            { const float p = ex3 / se; if (p > gt) { gt = p; gi = 3; } }
            int e1 = 0, e2 = -1; float t1 = -INFINITY, t2 = -INFINITY;
#pragma unroll 1
            for (int i = 0; i < 8; ++i) { const float v = L[4 + gi * 8 + i] + br[gi * 8 + i];
                if (v > t1) { t2 = t1; e2 = e1; t1 = v; e1 = i; } else if (v > t2) { t2 = v; e2 = i; } }
            const float z = expf(t2 - t1), w1 = gt / (1.f + z), w2 = gt * z / (1.f + z);
            const int ea = gi * 8 + e1, eb = gi * 8 + e2;
            const unsigned pa = atomicAdd(&F.ctl[CW_CNT + 64 * ea], 1u); list[(size_t)ea * T + pa] = m * 2; ew[m * 2] = w1;
            const unsigned pb = atomicAdd(&F.ctl[CW_CNT + 64 * eb], 1u); list[(size_t)eb * T + pb] = m * 2 + 1; ew[m * 2 + 1] = w2; }
        __syncthreads();
    }
}

struct MoeOrder {
    const unsigned* ctl; const int* list; const char* A; const char* Bt; int nN, G, c; bool gather;
    __device__ bool next(int i, pg8::Unit& u) const {
        const int L = i * G + c; const int tl = L / nN; int acc = 0;
        for (int e = 0; e < 32; ++e) { const int cn = (int)ctl[CW_CNT + 64 * e]; const int nt = (cn + 255) >> 8;
            if (tl < acc + nt) { u.e = e; u.r0 = (tl - acc) * 256; u.n = cn; u.pm = tl; u.pn = L % nN; return true; } acc += nt; }
        return false;
    }
    __device__ __forceinline__ const char* abase(const pg8::Unit& u) const { return gather ? A : A + (size_t)u.pm * 256 * 256 * 2; }
    __device__ __forceinline__ const char* bbase(const pg8::Unit& u) const { return gather ? Bt + ((size_t)u.e * 512 + u.pn * 256) * DM * 2 : Bt + ((size_t)u.e * 1024 + u.pn * 256) * 256 * 2; }
    __device__ __forceinline__ unsigned arow_off(const pg8::Unit& u, int R) const {
        if (!gather) return (unsigned)(R * 256) * 2u;
        const int idx = (u.r0 + R < u.n) ? list[(size_t)u.e * T + u.r0 + R] : 0;
        return (unsigned)(idx >> 1) * (unsigned)(DM * 2);
    }
};
struct EpiGU {
    static constexpr bool PERM = true, MIDK = false;
    unsigned char* ws;
    __device__ __forceinline__ void operator()(const f32x4 (&acc)[2][2][4][2], const pg8::Unit& u, int wr, int wc, int fr, int fq) const {
        const char* listb = (const char*)(ws + WS_LIST) + ((size_t)u.e * T + u.r0) * 4; const char* ewb = (const char*)(ws + WS_EW);
        char* Hb = (char*)(ws + WS_HID) + (((size_t)u.pm * 256) * 256 + u.pn * 128) * 2;
        int Rl = wr * 64 + fr; const int nrem = u.n - u.r0; asm volatile("" : "+v"(Rl));
        const unsigned ho = (unsigned)(Rl * 256 + wc * 32 + 8 * fq) * 2u;
#pragma unroll
        for (int ai = 0; ai < 2; ++ai)
#pragma unroll
            for (int m = 0; m < 4; ++m) { const int R = Rl + ai * 128 + m * 16;
                float wgt = 0.f; if (R < nrem) { const unsigned idx = *(const unsigned*)(listb + (size_t)((unsigned)R * 4u)); wgt = *(const float*)(ewb + (size_t)(idx * 4u)); }
                f32x4 o[2];
#pragma unroll
                for (int n = 0; n < 2; ++n) { const f32x4 gv = acc[ai][0][m][n], uv = acc[ai][1][m][n];
#pragma unroll
                    for (int e = 0; e < 4; ++e) o[n][e] = gv[e] * __builtin_amdgcn_rcpf(1.f + __builtin_amdgcn_exp2f(-1.4426950408889634f * gv[e])) * uv[e] * wgt; }
                *(u32x4*)(Hb + (size_t)(ho + (unsigned)((ai * 128 + m * 16) * 512))) = pg8::pack8(o[0], o[1]);
                asm volatile("" ::: "memory"); }
    }
};
struct EpiDown {
    static constexpr bool PERM = true, MIDK = false;
    unsigned char* ws;
    __device__ __forceinline__ void operator()(const f32x4 (&acc)[2][2][4][2], const pg8::Unit& u, int wr, int wc, int fr, int fq) const {
        const char* listb = (const char*)(ws + WS_LIST) + ((size_t)u.e * T + u.r0) * 4; char* Yb = (char*)(ws + WS_Y) + (size_t)(u.pn * 256) * 2;
        int Rl = wr * 64 + fr; const int nrem = u.n - u.r0; asm volatile("" : "+v"(Rl));
        const unsigned yo = (unsigned)(wc * 32 + 8 * fq) * 2u;
#pragma unroll
        for (int ai = 0; ai < 2; ++ai)
#pragma unroll
            for (int m = 0; m < 4; ++m) { const int R = Rl + ai * 128 + m * 16;
                if (R < nrem) { const unsigned idx = *(const unsigned*)(listb + (size_t)((unsigned)R * 4u)); char* y = Yb + (size_t)idx * (DM * 2) + yo;
                    *(u32x4*)y = pg8::pack8(acc[ai][0][m][0], acc[ai][0][m][1]); *(u32x4*)(y + 256) = pg8::pack8(acc[ai][1][m][0], acc[ai][1][m][1]); }
                asm volatile("" ::: "memory"); }
    }
};

__device__ __forceinline__ void p8_ln2(const Frame& F, const Args& a) {
    const bf16_t* H1 = (const bf16_t*)(F.ws + WS_H1); const bf16_t* Y = (const bf16_t*)(F.ws + WS_Y); const float* g = a.in[22]; const float* b = a.in[23]; float* out = a.out;
    const int lane = threadIdx.x & 63;
    for (int m = F.bx * NWAVES + F.wave; m < T; m += F.G * NWAVES) {
        f32x4 v[4]; float s = 0.f;
#pragma unroll
        for (int j = 0; j < 4; ++j) { const int c = j * 256 + lane * 4;
            const u32x2 h = *(const u32x2*)(H1 + (size_t)m * DM + c), y0 = *(const u32x2*)(Y + (size_t)(2 * m) * DM + c), y1 = *(const u32x2*)(Y + (size_t)(2 * m + 1) * DM + c);
            v[j].x = ALPHA * __uint_as_float(h.x << 16) + __uint_as_float(y0.x << 16) + __uint_as_float(y1.x << 16);
            v[j].y = ALPHA * __uint_as_float(h.x & 0xffff0000u) + __uint_as_float(y0.x & 0xffff0000u) + __uint_as_float(y1.x & 0xffff0000u);
            v[j].z = ALPHA * __uint_as_float(h.y << 16) + __uint_as_float(y0.y << 16) + __uint_as_float(y1.y << 16);
            v[j].w = ALPHA * __uint_as_float(h.y & 0xffff0000u) + __uint_as_float(y0.y & 0xffff0000u) + __uint_as_float(y1.y & 0xffff0000u);
            s += (v[j].x + v[j].y) + (v[j].z + v[j].w); }
        const float mean = wave_sum(s) * (1.f / DM); float s2 = 0.f;
#pragma unroll
        for (int j = 0; j < 4; ++j) { v[j] = v[j] - mean; s2 += (v[j].x * v[j].x + v[j].y * v[j].y) + (v[j].z * v[j].z + v[j].w * v[j].w); }
        const float rstd = 1.f / sqrtf(wave_sum(s2) * (1.f / DM) + LN_EPS);
#pragma unroll
        for (int j = 0; j < 4; ++j) { const int c = j * 256 + lane * 4; const f32x4 gg = *(const f32x4*)(g + c), bb = *(const f32x4*)(b + c);
            *(f32x4*)(out + (size_t)m * DM + c) = v[j] * rstd * gg + bb; }
    }
}

__global__ void __launch_bounds__(NWAVES * 64, 2) mega(Args args) {
    extern __shared__ __attribute__((aligned(16))) unsigned char lds_raw[];
    Frame F;
    F.lds = (LAS unsigned char*)lds_raw; F.ws = args.ws; F.ctl = (unsigned*)(args.ws + WS_CTL);
    F.tid = threadIdx.x; F.lane = F.tid & 63; F.wave = __builtin_amdgcn_readfirstlane(F.tid >> 6); F.G = gridDim.x; F.bx = blockIdx.x;
    volatile LAS unsigned* MISC = (volatile LAS unsigned*)(F.lds + MISC_OFF);
    for (int u = F.tid; u < (LDS_BYTES - LDSCTL_OFF) / 4; u += NWAVES * 64) ((LAS unsigned*)(F.lds + LDSCTL_OFF))[u] = 0u;
    __syncthreads();
    XcdBarrier bar = xcd_barrier_post(F.ctl + CW_BAR, MISC + 8);
    const int lo = args.ph_lo, hi = args.ph_hi;
#define IN(k) (lo <= (k) && (k) < hi)
#define BOTH(k) (IN(k) && IN((k) + 1))
    if (IN(0)) { p0_prologue(F, args); if (BOTH(0)) xcd_barrier(bar); }
    if (IN(1)) {
        pg8::StaticOrder S; S.init(args.ws + WS_H0, args.ws + WS_WIN, T, 1536, DM, F.G, F.bx);
        EpiInProj E{args.ws};
        pg8::gemm_phase<EpiInProj, pg8::StaticOrder, true>(F.lds, DM, S, E);
        if (BOTH(1)) xcd_barrier(bar);
    }
    if (IN(2)) {
        UpOrder S{(const char*)(args.ws + WS_CQ), (const char*)(args.ws + WS_CKV), (const char*)(args.ws + WS_WUQ), (const char*)(args.ws + WS_WUKV), F.G, F.bx};
        EpiUp E{args.ws};
        pg8::gemm_phase<EpiUp, UpOrder, true>(F.lds, 256, S, E);
        if (BOTH(2)) xcd_barrier(bar);
    }
    if (IN(3)) {
        const int vcu = (F.G % 8 == 0) ? (F.bx % 8) * (F.G / 8) + F.bx / 8 : F.bx;
        att::attn_phase((char*)lds_raw, args.ws, args.in[5], vcu, F.G);
        if (BOTH(3)) xcd_barrier(bar);
    }
    if (IN(4)) {
        pg8::StaticOrder S; S.init(args.ws + WS_AO, args.ws + WS_WO, T, DM, DM, F.G, F.bx);
        EpiOut E{args.ws};
        pg8::gemm_phase<EpiOut, pg8::StaticOrder, true>(F.lds, DM, S, E);
        if (BOTH(4)) xcd_barrier(bar);
    }
    if (IN(5)) { p5_ln1_router(F, args); if (BOTH(5)) xcd_barrier(bar); }
    if (IN(6)) {
        MoeOrder S{F.ctl, (const int*)(args.ws + WS_LIST), (const char*)(args.ws + WS_H1), (const char*)(args.ws + WS_WGU), 2, F.G, F.bx, true};
        EpiGU E{args.ws};
        pg8::gemm_phase<EpiGU, MoeOrder, true>(F.lds, DM, S, E);
        if (BOTH(6)) xcd_barrier(bar);
    }
    if (IN(7)) {
        MoeOrder S{F.ctl, (const int*)(args.ws + WS_LIST), (const char*)(args.ws + WS_HID), (const char*)(args.ws + WS_WDN), 4, F.G, F.bx, false};
        EpiDown E{args.ws};
        pg8::gemm_phase<EpiDown, MoeOrder, true>(F.lds, 256, S, E);
        if (BOTH(7)) xcd_barrier(bar);
    }
    if (IN(8)) { p8_ln2(F, args); }
#undef IN
#undef BOTH
}

extern "C" void kernel_launch(void* const* d_in, const int* in_sizes, int n_in, void* d_out, int out_size, void* d_ws, size_t ws_size, hipStream_t stream) {
    static int grid = 0;
    if (grid == 0) {
        if (n_in != 24 || ws_size < WS_END || out_size != T * DM) { fprintf(stderr, "kernel_launch: unexpected shapes n_in=%d ws=%zu out=%d\n", n_in, ws_size, out_size); grid = -1; return; }
        int dev = 0, cus = 0, per_cu = 0;
        if (hipGetDevice(&dev) != hipSuccess || hipDeviceGetAttribute(&cus, hipDeviceAttributeMultiprocessorCount, dev) != hipSuccess) { grid = -1; return; }
        if (hipFuncSetAttribute((const void*)mega, hipFuncAttributeMaxDynamicSharedMemorySize, LDS_BYTES) != hipSuccess) { fprintf(stderr, "hipFuncSetAttribute failed\n"); grid = -1; return; }
        if (hipOccupancyMaxActiveBlocksPerMultiprocessor(&per_cu, (const void*)mega, NWAVES * 64, LDS_BYTES) != hipSuccess || per_cu < 1) { fprintf(stderr, "occupancy query: %d blocks per CU\n", per_cu); (void)hipGetLastError(); grid = -1; return; }
        (void)hipGetLastError();
        grid = cus;
    }
    if (grid < 0) return;
    (void)hipMemsetAsync((unsigned char*)d_ws + WS_CTL, 0, 1 * MiB, stream);
    Args a{};
    for (int i = 0; i < 24; ++i) a.in[i] = (const float*)d_in[i];
    a.out = (float*)d_out; a.ws = (unsigned char*)d_ws; a.ph_lo = 0; a.ph_hi = 9;
    hipLaunchKernelGGL(mega, dim3(grid), dim3(NWAVES * 64), LDS_BYTES, stream, a);
}
```

```cpp
#include <hip/hip_runtime.h>
#include <cstdio>
#include <cstdint>

typedef unsigned short bf16_t;
typedef float f32x4 __attribute__((ext_vector_type(4)));
typedef unsigned u32x4 __attribute__((ext_vector_type(4)));
typedef unsigned u32x2 __attribute__((ext_vector_type(2)));

constexpr int NB = 4, SEQ = 8192, DM = 1024, T = NB * SEQ, LP = SEQ + 128, NPAD = 112, NMETA = 16;
constexpr int INC = 1344;
constexpr float LN_EPS = 1e-5f, RMS_EPS = 1e-6f;
constexpr float ALPHA = 1.189207115002721f;
constexpr size_t MiB = 1u << 20;

constexpr size_t WS_CTL = 0;
constexpr size_t WS_HM = 1 * MiB;
constexpr size_t WS_CKVM = 1 * MiB + 128 * 1024;
constexpr size_t WS_UM = 1 * MiB + 256 * 1024;
constexpr size_t WS_KVTM = 1 * MiB + 640 * 1024;
constexpr size_t WS_SSQ = 2 * MiB;
constexpr size_t WS_EW = 4 * MiB;
constexpr size_t WS_LIST = 5 * MiB;
constexpr size_t WS_W = 16 * MiB;
constexpr size_t WS_H0 = 72 * MiB;
constexpr size_t WS_QA = 136 * MiB;
constexpr size_t WS_KA = 168 * MiB;
constexpr size_t WS_VA = 177 * MiB;
constexpr size_t WS_CQ = 186 * MiB;
constexpr size_t WS_CKV = 202 * MiB;
constexpr size_t WS_KM = 218 * MiB;
constexpr size_t WS_VM = 267 * MiB;
constexpr size_t WS_QM = 300 * MiB;
constexpr size_t WS_AO = 348 * MiB;
constexpr size_t WS_HID = 412 * MiB;
constexpr size_t WS_PRE1 = 136 * MiB;
constexpr size_t WS_H1 = 264 * MiB;
constexpr size_t WS_Y = 72 * MiB;
constexpr size_t WS_TMP = 348 * MiB;
constexpr size_t WS_AN = 412 * MiB;
constexpr size_t WS_END = 512 * MiB;
constexpr int CW_CNT = 1024;

__constant__ float c_inv_freq[32] = {1.000000000e+00f, 7.498942614e-01f, 5.623413324e-01f, 4.216965139e-01f, 3.162277639e-01f, 2.371373773e-01f, 1.778279394e-01f, 1.333521307e-01f, 1.000000015e-01f, 7.498941571e-02f, 5.623413250e-02f, 4.216965288e-02f, 3.162277490e-02f, 2.371373773e-02f, 1.778279431e-02f, 1.333521493e-02f, 9.999999776e-03f, 7.498941850e-03f, 5.623413250e-03f, 4.216964822e-03f, 3.162277630e-03f, 2.371373586e-03f, 1.778279431e-03f, 1.333521446e-03f, 1.000000047e-03f, 7.498942432e-04f, 5.623413017e-04f, 4.216965172e-04f, 3.162277571e-04f, 2.371373703e-04f, 1.778279402e-04f, 1.333521504e-04f};

#ifndef ST_NT
#define ST_NT 0
#endif
#if ST_NT
#define ST16(p, v) __builtin_nontemporal_store((v), (u32x4*)(p))
#define ST16F(p, v) __builtin_nontemporal_store((v), (f32x4*)(p))
#else
#define ST16(p, v) (*(u32x4*)(p) = (v))
#define ST16F(p, v) (*(f32x4*)(p) = (v))
#endif
__device__ __forceinline__ float bf2f(bf16_t v) { return __uint_as_float((unsigned)v << 16); }
__device__ __forceinline__ unsigned f2bf(float f) { unsigned u = __float_as_uint(f); return (u + 0x7fffu + ((u >> 16) & 1u)) >> 16; }
__device__ __forceinline__ unsigned pk2(float lo, float hi) { return f2bf(lo) | (f2bf(hi) << 16); }
__device__ __forceinline__ int lane_id() { return (int)__builtin_amdgcn_mbcnt_hi(~0u, __builtin_amdgcn_mbcnt_lo(~0u, 0u)); }
__device__ __forceinline__ float wave_sum(float v) {
#pragma unroll
    for (int o = 1; o < 64; o <<= 1) v += __shfl_xor(v, o);
    return v;
}
__device__ __forceinline__ float wave_max(float v) {
#pragma unroll
    for (int o = 1; o < 64; o <<= 1) v = fmaxf(v, __shfl_xor(v, o));
    return v;
}
__device__ __forceinline__ void rope_cs(int pos, int i, float& c, float& s) {
    const double ang = (double)pos * (double)c_inv_freq[i];
    const double rev = ang * 0.15915494309189535;
    const float fr = (float)(rev - __builtin_rint(rev));
    s = __builtin_amdgcn_sinf(fr); c = __builtin_amdgcn_cosf(fr);
}


#define LAS __attribute__((address_space(3)))
#define GAS __attribute__((address_space(1)))
typedef short bf16x8 __attribute__((ext_vector_type(8)));
typedef float f32x2 __attribute__((ext_vector_type(2)));

constexpr size_t WS_CQS = 9 * MiB;
constexpr size_t WS_CKVS = 10 * MiB;
constexpr size_t WS_COS = 11 * MiB;
constexpr size_t WS_SIN = 13 * MiB;
constexpr size_t WS_WIN = 16 * MiB;
constexpr size_t WS_WUQ = 19 * MiB;
constexpr size_t WS_WUKV = 19 * MiB + 512 * 1024;
constexpr size_t WS_WO = 20 * MiB;
constexpr size_t WS_WGU = 22 * MiB;
constexpr size_t WS_WDN = 54 * MiB;
constexpr int NPOS = SEQ + NMETA;

namespace pg8 {
constexpr int BM = 256, BK = 64, HALF = 128, HTB = HALF * BK * 2, STAGE_BYTES = 8 * HTB, NXCD = 8, WGM = 8;
__host__ __device__ __forceinline__ int lds_byte(int r, int c) { const int st = (r >> 4) * 2 + (c >> 5), rr = r & 15, cc = c & 31, ob = rr * 64 + cc * 2; return st * 1024 + (ob ^ (((ob >> 9) & 1) << 5)); }
__host__ __device__ __forceinline__ void stage_rc(int b, int& R, int& C) { const int st = b / 1024, sb = b % 1024, swz = sb ^ (((sb >> 9) & 1) << 5); R = (st >> 1) * 16 + swz / 64; C = (st & 1) * 32 + (swz % 64) / 2; }
__host__ __device__ __forceinline__ int perm32(int rho) { const int n = rho >> 4, i = rho & 15; return 8 * (i >> 2) + 4 * n + (i & 3); }
struct Unit { int pm, pn, e, r0, n; };
__device__ __forceinline__ unsigned cvt_pk_bf16(float lo, float hi) { unsigned r; asm volatile("v_cvt_pk_bf16_f32 %0, %1, %2" : "=v"(r) : "v"(lo), "v"(hi)); return r; }
__device__ __forceinline__ u32x4 pack8(const f32x4 a, const f32x4 b) { u32x4 w; w.x = cvt_pk_bf16(a[0], a[1]); w.y = cvt_pk_bf16(a[2], a[3]); w.z = cvt_pk_bf16(b[0], b[1]); w.w = cvt_pk_bf16(b[2], b[3]); return w; }

template <class Epi, class Sched, bool ALIGN_EPI>
__device__ __forceinline__ void gemm_phase(LAS unsigned char* lds, const int K, const Sched& S, const Epi& E) {
    const int tid = threadIdx.x, wid = __builtin_amdgcn_readfirstlane(tid >> 6), lane = tid & 63, wr = wid >> 2, wc = wid & 3, fr = lane & 15, fq = lane >> 4;
    const int nt = K / BK;
    int Rr[2]; unsigned cof[2], voffB[2];
#pragma unroll
    for (int i = 0; i < 2; ++i) { int R, C; stage_rc(tid * 16 + i * 8192, R, C); Rr[i] = R; cof[i] = (unsigned)C * 2u; const int Rb = Epi::PERM ? ((R & ~31) + perm32(R & 31)) : R; voffB[i] = (unsigned)(Rb * K + C) * 2u; }
    const size_t kstep = (size_t)(BK * 2);
    const size_t hstepB = (size_t)HALF * K * 2;
    const unsigned ldsw = (unsigned)wid * 1024u;
    const int aoff = lds_byte(wr * 64 + fr, fq * 8), boff = lds_byte(wc * 32 + fr, fq * 8);
#define PG8_SA(b, h) (((b) * 2 + (h)) * HTB)
#define PG8_SB(b, h) ((4 + (b) * 2 + (h)) * HTB)
#define PG8_STAGE(bufoff, gbase, voff) do { _Pragma("unroll") for (int _i = 0; _i < 2; ++_i) \
        __builtin_amdgcn_global_load_lds((const unsigned*)((const char*)(gbase) + (voff)[_i]), (LAS unsigned*)(lds + (bufoff) + ldsw + _i * 8192), 16, 0, 0); } while (0)
#define PG8_LDA(dst, b, h) do { _Pragma("unroll") for (int m = 0; m < 4; ++m) _Pragma("unroll") for (int k = 0; k < 2; ++k) dst[m][k] = *(const LAS bf16x8*)(lds + PG8_SA(b, h) + aoff + m * 2048 + k * 1024); } while (0)
#define PG8_LDB(dst, b, h) do { _Pragma("unroll") for (int n = 0; n < 2; ++n) _Pragma("unroll") for (int k = 0; k < 2; ++k) dst[n][k] = *(const LAS bf16x8*)(lds + PG8_SB(b, h) + boff + n * 2048 + k * 1024); } while (0)
#define PG8_MMA(ai, bj, At, Bt) do { __builtin_amdgcn_s_setprio(1); _Pragma("unroll") for (int m = 0; m < 4; ++m) _Pragma("unroll") for (int n = 0; n < 2; ++n) _Pragma("unroll") for (int k = 0; k < 2; ++k) \
        acc[ai][bj][m][n] = __builtin_amdgcn_mfma_f32_16x16x32_bf16(Bt[n][k], At[m][k], acc[ai][bj][m][n], 0, 0, 0); __builtin_amdgcn_s_setprio(0); } while (0)
#define PG8_WAIT_V(n) asm volatile("s_waitcnt vmcnt(" #n ")" ::: "memory")
#define PG8_WAIT_L(n) asm volatile("s_waitcnt lgkmcnt(" #n ")" ::: "memory")
#define PG8_BAR __builtin_amdgcn_s_barrier()
#define PG8_SCHED __builtin_amdgcn_sched_barrier(0)
    Unit cur, nxt; int ui = 0;
    if (!S.next(0, cur)) return;
    f32x4 acc[2][2][4][2];
#pragma unroll
    for (int a = 0; a < 2; ++a)
#pragma unroll
        for (int b = 0; b < 2; ++b)
#pragma unroll
            for (int m = 0; m < 4; ++m)
#pragma unroll
                for (int n = 0; n < 2; ++n) acc[a][b][m][n] = (f32x4){0.f, 0.f, 0.f, 0.f};
    bf16x8 At[4][2], B0[2][2], B1[2][2];
    unsigned vA0[2], vA1[2], vN0[2], vN1[2];
#pragma unroll
    for (int i = 0; i < 2; ++i) { vA0[i] = S.arow_off(cur, Rr[i]) + cof[i]; vA1[i] = S.arow_off(cur, Rr[i] + HALF) + cof[i]; }
    const char* cA = S.abase(cur); const char* cB = S.bbase(cur);
    PG8_STAGE(PG8_SB(0, 0), cB, voffB); PG8_STAGE(PG8_SB(0, 1), cB + hstepB, voffB); PG8_STAGE(PG8_SA(0, 0), cA, vA0); PG8_STAGE(PG8_SA(0, 1), cA, vA1);
    if (wr == 1) PG8_BAR;
    PG8_WAIT_V(2); PG8_BAR;
    PG8_STAGE(PG8_SB(1, 0), cB + kstep, voffB); PG8_STAGE(PG8_SA(1, 0), cA + kstep, vA0); PG8_STAGE(PG8_SB(1, 1), cB + hstepB + kstep, voffB);
    PG8_WAIT_V(6); PG8_BAR;
    for (;;) {
        const bool has_next = S.next(ui + 1, nxt);
        const char* nA = has_next ? S.abase(nxt) : cA; const char* nB = has_next ? S.bbase(nxt) : cB;
#pragma unroll
        for (int i = 0; i < 2; ++i) { vN0[i] = has_next ? S.arow_off(nxt, Rr[i]) + cof[i] : vA0[i]; vN1[i] = has_next ? S.arow_off(nxt, Rr[i] + HALF) + cof[i] : vA1[i]; }
#pragma unroll 1
        for (int t = 0; t < nt; t += 2) {
            const bool last = (t == nt - 2);
            const char* a1 = cA + (size_t)(t + 1) * kstep;
            const char* a2 = last ? nA : cA + (size_t)(t + 2) * kstep; const char* b2 = last ? nB : cB + (size_t)(t + 2) * kstep;
            const char* a3 = a2 + kstep; const char* b3 = b2 + kstep;
            unsigned w0[2], w1[2];
#pragma unroll
            for (int i = 0; i < 2; ++i) { w0[i] = last ? vN0[i] : vA0[i]; w1[i] = last ? vN1[i] : vA1[i]; }
            PG8_LDB(B0, 0, 0); PG8_LDB(B1, 0, 1); PG8_SCHED; PG8_LDA(At, 0, 0); PG8_STAGE(PG8_SA(1, 1), a1, vA1);
            PG8_WAIT_V(8); PG8_WAIT_L(0); PG8_BAR; PG8_MMA(0, 0, At, B0); PG8_MMA(0, 1, At, B1); PG8_BAR; PG8_SCHED;
            PG8_LDA(At, 0, 1); PG8_STAGE(PG8_SB(0, 0), b2, voffB); PG8_STAGE(PG8_SB(0, 1), b2 + hstepB, voffB); PG8_STAGE(PG8_SA(0, 0), a2, w0);
            PG8_WAIT_V(8); PG8_WAIT_L(0); PG8_BAR; PG8_MMA(1, 0, At, B0); PG8_MMA(1, 1, At, B1); PG8_BAR; PG8_SCHED;
            PG8_LDB(B0, 1, 0); PG8_LDB(B1, 1, 1); PG8_SCHED; PG8_LDA(At, 1, 0); PG8_STAGE(PG8_SA(0, 1), a2, w1);
            PG8_WAIT_V(8); PG8_WAIT_L(0); PG8_BAR; PG8_MMA(0, 0, At, B0); PG8_MMA(0, 1, At, B1); PG8_BAR; PG8_SCHED;
            PG8_LDA(At, 1, 1); PG8_STAGE(PG8_SB(1, 0), b3, voffB); PG8_STAGE(PG8_SB(1, 1), b3 + hstepB, voffB); PG8_STAGE(PG8_SA(1, 0), a3, w0);
            PG8_WAIT_V(8); PG8_WAIT_L(0); PG8_BAR; PG8_MMA(1, 0, At, B0); PG8_MMA(1, 1, At, B1); PG8_BAR; PG8_SCHED;
            if constexpr (Epi::MIDK) { if (t + 2 == nt / 2) E.midk(acc, cur, wr, wc, fr, fq); }
        }
        if constexpr (ALIGN_EPI) { if (wr == 0) PG8_BAR; }
        E(acc, cur, wr, wc, fr, fq);
        if (!has_next) break;
#pragma unroll
        for (int a = 0; a < 2; ++a)
#pragma unroll
            for (int b = 0; b < 2; ++b)
#pragma unroll
                for (int m = 0; m < 4; ++m)
#pragma unroll
                    for (int n = 0; n < 2; ++n) acc[a][b][m][n] = (f32x4){0.f, 0.f, 0.f, 0.f};
        cur = nxt; cA = nA; cB = nB; ++ui;
#pragma unroll
        for (int i = 0; i < 2; ++i) { vA0[i] = vN0[i]; vA1[i] = vN1[i]; }
        if constexpr (ALIGN_EPI) { if (wr == 1) PG8_BAR; }
    }
    PG8_WAIT_V(0);
    if constexpr (!ALIGN_EPI) { if (wr == 0) PG8_BAR; }
    PG8_BAR;
#undef PG8_SA
#undef PG8_SB
#undef PG8_STAGE
#undef PG8_LDA
#undef PG8_LDB
#undef PG8_MMA
#undef PG8_WAIT_V
#undef PG8_WAIT_L
#undef PG8_BAR
#undef PG8_SCHED
}

struct StaticOrder {
    const char* A; const char* Bt; int K;
    int nM, nN, nwg, G, c;
    __device__ void init(const void* A_, const void* Bt_, int M, int N, int K_, int G_, int c_) { A = (const char*)A_; Bt = (const char*)Bt_; K = K_; nM = M / BM; nN = N / BM; nwg = nM * nN; G = G_; c = c_; }
    __device__ bool next(int i, Unit& u) const {
        const long L = (long)i * G + c; if (L >= nwg) return false;
        int wgid = (int)L; { const int q = nwg / NXCD, r = nwg % NXCD, xcd = wgid % NXCD, off = wgid / NXCD; wgid = (xcd < r ? xcd * (q + 1) : r * (q + 1) + (xcd - r) * q) + off; }
        const int nig = WGM * nN, gid = wgid / nig, fm = gid * WGM, gsz = (nM - fm) < WGM ? (nM - fm) : WGM;
        u.pm = fm + ((wgid % nig) % gsz); u.pn = (wgid % nig) / gsz; return true;
    }
    __device__ __forceinline__ const char* abase(const Unit& u) const { return A + (size_t)u.pm * BM * K * 2; }
    __device__ __forceinline__ const char* bbase(const Unit& u) const { return Bt + (size_t)u.pn * BM * K * 2; }
    __device__ __forceinline__ unsigned arow_off(const Unit&, int R) const { return (unsigned)(R * K) * 2u; }
};
}

#define XB_TMO      128
#define XB_XCNT(j)  (256  + 64 * (j))
#define XB_XSUB(j)  (1280 + 64 * (j))
#define XB_XGEN(j)  (2304 + 64 * (j))
#define XB_TOP      3328
#define XB_TOPGEN   3392
#define XCD_BAR_WORDS 3456
#define XB_SPIN_CAP (1u << 18)
__device__ __forceinline__ unsigned xb_ld(unsigned* p)              { return __hip_atomic_load(p, __ATOMIC_RELAXED, __HIP_MEMORY_SCOPE_AGENT); }
__device__ __forceinline__ unsigned xb_add(unsigned* p, unsigned v) { return __hip_atomic_fetch_add(p, v, __ATOMIC_RELAXED, __HIP_MEMORY_SCOPE_AGENT); }
__device__ __forceinline__ unsigned xb_xcc_id() { return (unsigned)__builtin_amdgcn_s_getreg((3 << 11) | 20) & 0xFu; }
#define XB_SPIN(cond, bar) do { unsigned _sp = 0; while (cond) { __builtin_amdgcn_s_sleep(1); \
    if ((++_sp & 255u) == 0u) { if (xb_ld(&(bar)[XB_TMO])) break; if (_sp > XB_SPIN_CAP) { atomicAdd(&(bar)[XB_TMO], 1u); break; } } } } while (0)
struct XcdBarrier { unsigned* bar; unsigned x; volatile LAS unsigned* st; };
__device__ __forceinline__ XcdBarrier xcd_barrier_post(unsigned* bar, volatile LAS unsigned* st) {
    XcdBarrier b; b.bar = bar; b.x = xb_xcc_id(); b.st = st;
    if (threadIdx.x == 0) (void)xb_add(&bar[XB_XCNT(b.x)], 1u);
    return b;
}
__device__ __forceinline__ void xcd_barrier_complete(unsigned* bar, unsigned x, unsigned& nloc, unsigned& nx) {
    const unsigned G = gridDim.x * gridDim.y * gridDim.z;
    unsigned sum, cnt, mine, sp = 0u;
    for (;;) {
        sum = 0u; cnt = 0u; mine = 0u;
#pragma unroll
        for (unsigned j = 0; j < 16; ++j) { const unsigned c = xb_ld(&bar[XB_XCNT(j)]); sum += c; cnt += (c > 0u) ? 1u : 0u; mine = (j == x) ? c : mine; }
        if (sum == G) break;
        __builtin_amdgcn_s_sleep(1);
        if ((++sp & 255u) == 0u) { if (xb_ld(&bar[XB_TMO])) break; if (sp > XB_SPIN_CAP) { atomicAdd(&bar[XB_TMO], 1u); break; } }
    }
    nloc = mine > 0u ? mine : 1u; nx = cnt > 0u ? cnt : 1u;
}
__device__ __forceinline__ void xcd_barrier(const XcdBarrier& b) {
    asm volatile("s_waitcnt vmcnt(0)" ::: "memory");
    __syncthreads();
    if (threadIdx.x == 0) {
        unsigned* bar = b.bar;
        __builtin_amdgcn_s_waitcnt(0);
        unsigned nloc = b.st[0], nx = b.st[1];
        if (nloc == 0u) { xcd_barrier_complete(bar, b.x, nloc, nx); b.st[0] = nloc; b.st[1] = nx; }
        const unsigned old = xb_add(&bar[XB_XSUB(b.x)], 1u);
        const unsigned gen = old / nloc;
        if (old + 1u == (gen + 1u) * nloc) {
            __builtin_amdgcn_fence(__ATOMIC_RELEASE, "agent");
            asm volatile("s_waitcnt vmcnt(0)" ::: "memory");
            const unsigned og = xb_add(&bar[XB_TOP], 1u);
            const unsigned tg = og / nx;
            if (og + 1u == (tg + 1u) * nx) xb_add(&bar[XB_TOPGEN], 1u);
            else XB_SPIN(xb_ld(&bar[XB_TOPGEN]) == tg, bar);
            __builtin_amdgcn_fence(__ATOMIC_ACQUIRE, "agent");
            xb_add(&bar[XB_XGEN(b.x)], 1u);
            asm volatile("s_waitcnt vmcnt(0)" ::: "memory");
        } else {
            XB_SPIN(xb_ld(&bar[XB_XGEN(b.x)]) == gen, bar);
            __builtin_amdgcn_fence(__ATOMIC_ACQUIRE, "agent");
            asm volatile("s_waitcnt vmcnt(0)" ::: "memory");
        }
    }
    __syncthreads();
}

constexpr int NWAVES = 8;
constexpr int RING_BYTES = 135168, LDSCTL_OFF = RING_BYTES, MISC_OFF = LDSCTL_OFF + 320, LDS_BYTES = 147456;
constexpr int CW_BAR = 4096;
#define LDS_WAIT() asm volatile("s_waitcnt lgkmcnt(0)" ::: "memory")
#define VM_WAIT() asm volatile("s_waitcnt vmcnt(0)" ::: "memory")

struct Args {
    const float* in[24]; float* out; unsigned char* ws; int ph_lo, ph_hi;
};
struct Frame {
    LAS unsigned char* lds; unsigned char* ws; unsigned* ctl;
    int tid, lane, wave, G, bx;
};

__device__ __forceinline__ void p0_tr_item(const float* __restrict__ W, int ldn, int c0, int k0, bf16_t* dst, int K, const float* __restrict__ sc0, const float* __restrict__ sc1, LAS float* scr, int lane) {
    if (c0 >= 0) {
        f32x4 v[8];
#pragma unroll
        for (int i = 0; i < 8; ++i) v[i] = *(const f32x4*)(W + (size_t)(k0 + 8 * i + (lane >> 3)) * ldn + c0 + (lane & 7) * 4);
#pragma unroll
        for (int i = 0; i < 8; ++i) { const int kk = 8 * i + (lane >> 3), k = k0 + kk; f32x4 x = v[i];
            if (sc0) x *= (k < 512 || !sc1) ? sc0[k] : sc1[k - 512];
            LAS float* s = scr + kk * 33 + (lane & 7) * 4; s[0] = x.x; s[1] = x.y; s[2] = x.z; s[3] = x.w; }
    } else {
#pragma unroll 8
        for (int i = 0; i < 32; ++i) { const int kk = 2 * i + (lane >> 5); scr[kk * 33 + (lane & 31)] = 0.f; }
    }
    LDS_WAIT(); asm volatile("" ::: "memory");
    const int c = lane & 7;
#pragma unroll
    for (int j = 0; j < 4; ++j) { const int n = (lane >> 3) + 8 * j; const LAS float* s = scr + (8 * c) * 33 + n;
        u32x4 o; o.x = pk2(s[0 * 33], s[1 * 33]); o.y = pk2(s[2 * 33], s[3 * 33]); o.z = pk2(s[4 * 33], s[5 * 33]); o.w = pk2(s[6 * 33], s[7 * 33]);
        ST16((dst + (size_t)n * K + k0 + 8 * c), o); }
    LDS_WAIT(); asm volatile("" ::: "memory");
}
__device__ __forceinline__ int win_src_col(int tile, int q) {
    if (tile <= 1) return 256 * tile + 64 * (q & 3) + ((q >> 2) ? 32 : 0);
    if (tile == 2) { const int tb[8] = {512, 576, 640, 672, 544, 608, 704, 736}; int r = tb[0];
#pragma unroll
        for (int i = 1; i < 8; ++i) r = (q == i) ? tb[i] : r; return r; }
    if (tile == 3) return 768 + 32 * q;
    if (tile == 4) return 1024 + 32 * q;
    return q == 0 ? 1280 : (q == 4 ? 1312 : -1);
}
__device__ __forceinline__ int wuq_src_col(int tile, int q) {
    if (tile <= 1) return (2 * tile + (q >> 2)) * 192 + 32 * (q & 3);
    return (q & 3) * 192 + 128 + ((q >> 2) ? 32 : 0);
}

__device__ __forceinline__ void ln_row_bf16(const float* __restrict__ src, const float* __restrict__ g, const float* __restrict__ b, bf16_t* dst, int lane) {
    f32x4 v[4]; float s = 0.f;
#pragma unroll
    for (int j = 0; j < 4; ++j) { v[j] = *(const f32x4*)(src + j * 256 + lane * 4); s += (v[j].x + v[j].y) + (v[j].z + v[j].w); }
    const float mean = wave_sum(s) * (1.f / DM); float s2 = 0.f;
#pragma unroll
    for (int j = 0; j < 4; ++j) { v[j] = v[j] - mean; s2 += (v[j].x * v[j].x + v[j].y * v[j].y) + (v[j].z * v[j].z + v[j].w * v[j].w); }
    const float rstd = 1.f / sqrtf(wave_sum(s2) * (1.f / DM) + LN_EPS);
#pragma unroll
    for (int j = 0; j < 4; ++j) { const int c = j * 256 + lane * 4; const f32x4 gg = *(const f32x4*)(g + c), bb = *(const f32x4*)(b + c);
        const f32x4 o = v[j] * rstd * gg + bb; u32x2 w; w.x = pk2(o.x, o.y); w.y = pk2(o.z, o.w); *(u32x2*)(dst + c) = w; }
}

__device__ __forceinline__ bf16x8 ld_bcol8(const float* __restrict__ W, int ldn, int k0, int col) {
    float x[8];
#pragma unroll
    for (int j = 0; j < 8; ++j) x[j] = W[(size_t)(k0 + j) * ldn + col];
    u32x4 w; w.x = pk2(x[0], x[1]); w.y = pk2(x[2], x[3]); w.z = pk2(x[4], x[5]); w.w = pk2(x[6], x[7]);
    return __builtin_bit_cast(bf16x8, w);
}
__device__ __forceinline__ void p0_meta_block(const Frame& F, const Args& a, const int blk) {
    constexpr int RSH = 1032;
    LAS bf16_t* hm = (LAS bf16_t*)(F.lds);
    LAS float* pc = (LAS float*)(F.lds + 33280);
    const int lane = F.lane, w = F.wave, fr = lane & 15, fq = lane >> 4;
    const float* meta = a.in[1]; const float* g = a.in[2]; const float* b = a.in[3]; const float* w_in = a.in[4];
    float* UM = (float*)(F.ws + WS_UM);
#pragma unroll 1
    for (int rr = 0; rr < 2; ++rr) { const int row = 2 * w + rr; const float* src = meta + (size_t)row * DM;
        f32x4 v[4]; float s = 0.f;
#pragma unroll
        for (int j = 0; j < 4; ++j) { v[j] = *(const f32x4*)(src + j * 256 + lane * 4); s += (v[j].x + v[j].y) + (v[j].z + v[j].w); }
        const float mean = wave_sum(s) * (1.f / DM); float s2 = 0.f;
#pragma unroll
        for (int j = 0; j < 4; ++j) { v[j] = v[j] - mean; s2 += (v[j].x * v[j].x + v[j].y * v[j].y) + (v[j].z * v[j].z + v[j].w * v[j].w); }
        const float rstd = 1.f / sqrtf(wave_sum(s2) * (1.f / DM) + LN_EPS);
#pragma unroll
        for (int j = 0; j < 4; ++j) { const int c = j * 256 + lane * 4; const f32x4 gg = *(const f32x4*)(g + c), bb = *(const f32x4*)(b + c); const f32x4 o = v[j] * rstd * gg + bb;
            u32x2 pw; pw.x = pk2(o.x, o.y); pw.y = pk2(o.z, o.w); *(LAS u32x2*)(hm + row * RSH + c) = pw; } }
    __syncthreads();
    const int col = (blk < 16 ? 512 + 16 * blk : (blk < 32 ? 1024 + 16 * (blk - 16) : 1280 + 16 * (blk - 32))) + fr;
    bf16x8 bv[4];
#pragma unroll
    for (int s = 0; s < 4; ++s) bv[s] = ld_bcol8(w_in, INC, 32 * (4 * w + s) + 8 * fq, col);
    f32x4 c = {0.f, 0.f, 0.f, 0.f};
#pragma unroll
    for (int s = 0; s < 4; ++s) { const bf16x8 av = *(const LAS bf16x8*)(hm + fr * RSH + 32 * (4 * w + s) + 8 * fq); c = __builtin_amdgcn_mfma_f32_16x16x32_bf16(av, bv[s], c, 0, 0, 0); }
#pragma unroll
    for (int j = 0; j < 4; ++j) pc[w * 256 + (fq * 4 + j) * 16 + fr] = c[j];
    __syncthreads();
    if (F.tid < 256) { float sum = 0.f;
#pragma unroll
        for (int q = 0; q < 8; ++q) sum += pc[q * 256 + F.tid];
        const int oc = (blk < 16 ? 16 * blk : (blk < 32 ? 256 + 16 * (blk - 16) : 512 + 16 * (blk - 32))) + (F.tid & 15);
        UM[(F.tid >> 4) * 576 + oc] = sum; }
    __syncthreads();
}
__device__ __forceinline__ void p2_meta(const Frame& F, const Args& a, const int q) {
    const int lane = F.lane, w = F.wave, fr = lane & 15, fq = lane >> 4;
    const float* UM = (const float*)(F.ws + WS_UM); const float* gkv = a.in[8]; const float* w_ukv = a.in[9];
    bf16_t* KA = (bf16_t*)(F.ws + WS_KA); bf16_t* VA = (bf16_t*)(F.ws + WS_VA); bf16_t* KM = (bf16_t*)(F.ws + WS_KM); bf16_t* VM = (bf16_t*)(F.ws + WS_VM);
    if (q < 64) {
        LAS float* rs = (LAS float*)(F.lds); LAS float* pc = (LAS float*)(F.lds + 256);
#pragma unroll 1
        for (int rr = 0; rr < 2; ++rr) { const int row = 2 * w + rr; float ss = 0.f;
#pragma unroll
            for (int j = 0; j < 4; ++j) { const float v = UM[row * 576 + 256 + 64 * j + lane]; ss += v * v; }
            ss = wave_sum(ss); if (lane == 0) rs[row] = 1.f / sqrtf(ss * (1.f / 256.f) + RMS_EPS); }
        const bf16x8 bv = ld_bcol8(w_ukv, 1024, 32 * w + 8 * fq, 16 * q + fr);
        __syncthreads();
        float x[8]; const float r_ = rs[fr];
#pragma unroll
        for (int j = 0; j < 8; ++j) { const int k = 32 * w + 8 * fq + j; x[j] = UM[fr * 576 + 256 + k] * r_ * gkv[k]; }
        u32x4 aw; aw.x = pk2(x[0], x[1]); aw.y = pk2(x[2], x[3]); aw.z = pk2(x[4], x[5]); aw.w = pk2(x[6], x[7]);
        f32x4 c = {0.f, 0.f, 0.f, 0.f};
        c = __builtin_amdgcn_mfma_f32_16x16x32_bf16(__builtin_bit_cast(bf16x8, aw), bv, c, 0, 0, 0);
#pragma unroll
        for (int j = 0; j < 4; ++j) pc[w * 256 + (fq * 4 + j) * 16 + fr] = c[j];
        __syncthreads();
        if (F.tid < 256) { float sum = 0.f;
#pragma unroll
            for (int p = 0; p < 8; ++p) sum += pc[p * 256 + F.tid];
            const int r = F.tid >> 4, col = 16 * q + (F.tid & 15), h = col >> 8, cc = col & 255; const bf16_t hv = (bf16_t)f2bf(sum);
            for (int b2 = 0; b2 < NB; ++b2) { const size_t prow = (size_t)b2 * LP + NPAD + r;
                if (cc < 128) KM[prow * 768 + h * 192 + cc] = hv; else VM[prow * 512 + h * 128 + (cc - 128)] = hv; } }
        __syncthreads();
    } else {
        const int idx = (q - 64) * 256 + F.tid;
        if (F.tid < 256 && idx < 16 * 320) { const int r = idx / 320, c = idx % 320;
            const int oc = c < 256 ? c : c + 256; float v = UM[r * 576 + oc];
            if (c < 128 || c >= 256) { const float p = UM[r * 576 + (oc ^ 32)]; float cs, sn; rope_cs(r, c & 31, cs, sn); v = (c & 32) ? v * cs + p * sn : v * cs - p * sn; }
            const bf16_t hv = (bf16_t)f2bf(v);
            for (int b2 = 0; b2 < NB; ++b2) { const size_t prow = (size_t)b2 * LP + NPAD + r;
                if (c < 128) KA[prow * 128 + c] = hv; else if (c < 256) VA[prow * 128 + (c - 128)] = hv;
                else { const int cc = c - 256; KM[prow * 768 + 128 + cc] = hv; KM[prow * 768 + 192 + 128 + cc] = hv; KM[prow * 768 + 384 + 128 + cc] = hv; KM[prow * 768 + 576 + 128 + cc] = hv; } } }
    }
}

__device__ __forceinline__ void p0_prologue(const Frame& F, const Args& a) {
    for (int blk = F.bx; blk < 36; blk += F.G) p0_meta_block(F, a, blk);
    LAS float* scr = (LAS float*)(F.lds + F.wave * 16384);
    const int gw = F.bx * NWAVES + F.wave, NGW = F.G * NWAVES, lane = F.lane;
    unsigned char* ws = F.ws;
    constexpr int I_IN = 16 * 48, I_UQ = 4 * 24, I_UKV = 4 * 32, I_O = 16 * 32, I_GU = 32 * 16 * 16, I_DN = 32 * 4 * 32;
    constexpr int NITEMS = I_IN + I_UQ + I_UKV + I_O + I_GU + I_DN;
    for (int it = gw; it < NITEMS; it += NGW) {
        int r = it;
        if (r < I_IN) { const int kb = r / 48, nb = r % 48; p0_tr_item(a.in[4], INC, win_src_col(nb >> 3, nb & 7), 64 * kb, (bf16_t*)(ws + WS_WIN) + (size_t)(32 * nb) * DM, DM, nullptr, nullptr, scr, lane); continue; } r -= I_IN;
        if (r < I_UQ) { const int kb = r / 24, nb = r % 24; p0_tr_item(a.in[7], 768, wuq_src_col(nb >> 3, nb & 7), 64 * kb, (bf16_t*)(ws + WS_WUQ) + (size_t)(32 * nb) * 256, 256, a.in[6], nullptr, scr, lane); continue; } r -= I_UQ;
        if (r < I_UKV) { const int kb = r / 32, nb = r % 32; p0_tr_item(a.in[9], 1024, 32 * nb, 64 * kb, (bf16_t*)(ws + WS_WUKV) + (size_t)(32 * nb) * 256, 256, a.in[8], nullptr, scr, lane); continue; } r -= I_UKV;
        if (r < I_O) { const int kb = r / 32, nb = r % 32; p0_tr_item(a.in[12], DM, 32 * nb, 64 * kb, (bf16_t*)(ws + WS_WO) + (size_t)(32 * nb) * DM, DM, a.in[10], a.in[11], scr, lane); continue; } r -= I_O;
        if (r < I_GU) { const int e = r / 256, r2 = r % 256, kb = r2 / 16, nb = r2 % 16; const int tile = nb >> 3, q = nb & 7;
            const float* src = (q < 4 ? a.in[19] : a.in[20]) + (size_t)e * DM * 256;
            p0_tr_item(src, 256, 128 * tile + 32 * (q & 3), 64 * kb, (bf16_t*)(ws + WS_WGU) + ((size_t)e * 512 + 32 * nb) * DM, DM, nullptr, nullptr, scr, lane); continue; } r -= I_GU;
        { const int e = r / 128, r2 = r % 128, kb = r2 / 32, nb = r2 % 32;
            p0_tr_item(a.in[21] + (size_t)e * 256 * DM, DM, 32 * nb, 64 * kb, (bf16_t*)(ws + WS_WDN) + ((size_t)e * 1024 + 32 * nb) * 256, 256, nullptr, nullptr, scr, lane); }
    }
    { float* COS = (float*)(ws + WS_COS); float* SIN = (float*)(ws + WS_SIN);
      for (int it = gw; it < NPOS * 32 / 64; it += NGW) { const int idx = it * 64 + lane; float c, s; rope_cs(idx >> 5, idx & 31, c, s); COS[idx] = c; SIN[idx] = s; } }
    for (int it = gw; it < NB * NPAD; it += NGW) { const size_t prow = (size_t)(it / NPAD) * LP + (it % NPAD);
        const u32x4 z = {0u, 0u, 0u, 0u};
        for (int o = lane * 16; o < 3072; o += 1024) {
            unsigned char* p;
            if (o < 256) p = ws + WS_KA + prow * 256 + o; else if (o < 512) p = ws + WS_VA + prow * 256 + (o - 512 + 256);
            else if (o < 2048) p = ws + WS_KM + prow * 1536 + (o - 512); else p = ws + WS_VM + prow * 1024 + (o - 2048);
            ST16(p, z); } }
    { const float* x = a.in[0]; const float* g = a.in[2]; const float* b = a.in[3]; bf16_t* H0 = (bf16_t*)(ws + WS_H0);
      for (int m = gw; m < T; m += 2 * NGW) {
        const int m2 = m + NGW; const bool two = m2 < T;
        f32x4 v[2][4]; float s[2] = {0.f, 0.f};
#pragma unroll
        for (int j = 0; j < 4; ++j) { v[0][j] = *(const f32x4*)(x + (size_t)m * DM + j * 256 + lane * 4); v[1][j] = two ? *(const f32x4*)(x + (size_t)m2 * DM + j * 256 + lane * 4) : (f32x4){0.f, 0.f, 0.f, 0.f}; }
#pragma unroll
        for (int q = 0; q < 2; ++q)
#pragma unroll
            for (int j = 0; j < 4; ++j) s[q] += (v[q][j].x + v[q][j].y) + (v[q][j].z + v[q][j].w);
#pragma unroll
        for (int q = 0; q < 2; ++q) { if (q == 1 && !two) break;
            const float mean = wave_sum(s[q]) * (1.f / DM); float s2 = 0.f;
#pragma unroll
            for (int j = 0; j < 4; ++j) { v[q][j] = v[q][j] - mean; s2 += (v[q][j].x * v[q][j].x + v[q][j].y * v[q][j].y) + (v[q][j].z * v[q][j].z + v[q][j].w * v[q][j].w); }
            const float rstd = 1.f / sqrtf(wave_sum(s2) * (1.f / DM) + LN_EPS);
            bf16_t* dstp = H0 + (size_t)(q ? m2 : m) * DM;
#pragma unroll
            for (int j = 0; j < 4; ++j) { const int c = j * 256 + lane * 4; const f32x4 gg = *(const f32x4*)(g + c), bb = *(const f32x4*)(b + c);
                const f32x4 o = v[q][j] * rstd * gg + bb; u32x2 w2; w2.x = pk2(o.x, o.y); w2.y = pk2(o.z, o.w); *(u32x2*)(dstp + c) = w2; } }
      } }
}

__device__ __forceinline__ void rope8(const f32x4 lo0, const f32x4 lo1, const f32x4 hi0, const f32x4 hi1, const float* __restrict__ cosr, const float* __restrict__ sinr, u32x4& olo, u32x4& ohi, float scale) {
    const f32x4 c0 = *(const f32x4*)cosr, c1 = *(const f32x4*)(cosr + 4), s0 = *(const f32x4*)sinr, s1 = *(const f32x4*)(sinr + 4);
    olo = pg8::pack8((lo0 * c0 - hi0 * s0) * scale, (lo1 * c1 - hi1 * s1) * scale);
    ohi = pg8::pack8((hi0 * c0 + lo0 * s0) * scale, (hi1 * c1 + lo1 * s1) * scale);
}
struct EpiInProj {
    static constexpr bool PERM = true, MIDK = false;
    unsigned char* ws;
    __device__ __forceinline__ void operator()(const f32x4 (&acc)[2][2][4][2], const pg8::Unit& u, int wr, int wc, int fr, int fq) const {
        const int pn = u.pn, bb = u.pm >> 5, t0 = (u.pm & 31) * 256 + wr * 64 + fr;
        const float* COS = (const float*)(ws + WS_COS); const float* SIN = (const float*)(ws + WS_SIN);
        const int j0 = 8 * fq;
#pragma unroll
        for (int ai = 0; ai < 2; ++ai)
#pragma unroll
            for (int m = 0; m < 4; ++m) {
                const int t = t0 + ai * 128 + m * 16; const size_t mrow = (size_t)bb * SEQ + t; const size_t prow = (size_t)bb * LP + 128 + t; const int pos = t + NMETA;
                const f32x4 a00 = acc[ai][0][m][0], a01 = acc[ai][0][m][1], a10 = acc[ai][1][m][0], a11 = acc[ai][1][m][1];
                if (pn <= 1) { u32x4 lo, hi; rope8(a00, a01, a10, a11, COS + pos * 32 + j0, SIN + pos * 32 + j0, lo, hi, 1.f);
                    bf16_t* q = (bf16_t*)(ws + WS_QA) + mrow * 512 + (4 * pn + wc) * 64 + j0; ST16(q, lo); ST16((q + 32), hi); }
                else if (pn == 2) {
                    if (wc < 2) { u32x4 lo, hi; rope8(a00, a01, a10, a11, COS + pos * 32 + j0, SIN + pos * 32 + j0, lo, hi, 1.f);
                        bf16_t* k = (bf16_t*)(ws + WS_KA) + prow * 128 + wc * 64 + j0; ST16(k, lo); ST16((k + 32), hi); }
                    else { bf16_t* v = (bf16_t*)(ws + WS_VA) + prow * 128 + 32 * (wc - 2) + j0; ST16(v, pg8::pack8(a00, a01)); ST16((v + 64), pg8::pack8(a10, a11)); } }
                else if (pn <= 4) {
                    bf16_t* c = (bf16_t*)(ws + (pn == 3 ? WS_CQ : WS_CKV)) + mrow * 256 + 32 * wc + j0; ST16(c, pg8::pack8(a00, a01)); ST16((c + 128), pg8::pack8(a10, a11));
                    const f32x4 q = a00 * a00 + a01 * a01 + a10 * a10 + a11 * a11; float s = (q[0] + q[1]) + (q[2] + q[3]);
                    s += __shfl_xor(s, 16); s += __shfl_xor(s, 32);
                    if (fq == 0) ((float*)(ws + (pn == 3 ? WS_CQS : WS_CKVS)))[mrow * 4 + wc] = s; }
                else { if (wc == 0) { u32x4 lo, hi; rope8(a00, a01, a10, a11, COS + pos * 32 + j0, SIN + pos * 32 + j0, lo, hi, 1.f);
                        bf16_t* k = (bf16_t*)(ws + WS_KM) + prow * 768 + 128 + j0;
#pragma unroll
                        for (int h = 0; h < 4; ++h) { ST16((k + h * 192), lo); ST16((k + h * 192 + 32), hi); } } }
            }
    }
};

struct UpOrder {
    const char* CQ; const char* CKV; const char* Wq; const char* Wkv; int G, c;
    __device__ bool next(int i, pg8::Unit& u) const {
        if (G % 8 == 0) { const int x = c & 7, slot = c >> 3, ns = G >> 3; const int j = i * ns + slot;
            if (j >= 112) return false;
            if (j < 48) { u.pm = x + 8 * (j / 3); u.pn = j % 3; } else { const int j2 = j - 48; u.pm = x + 8 * (j2 >> 2); u.pn = 3 + (j2 & 3); }
            return true; }
        int L = i * G + c; if (L >= 896) return false;
        if (L < 384) { u.pm = L / 3; u.pn = L % 3; } else { L -= 384; u.pm = L >> 2; u.pn = 3 + (L & 3); }
        return true;
    }
    __device__ __forceinline__ const char* abase(const pg8::Unit& u) const { return (u.pn < 3 ? CQ : CKV) + (size_t)u.pm * 256 * 256 * 2; }
    __device__ __forceinline__ const char* bbase(const pg8::Unit& u) const { return u.pn < 3 ? Wq + (size_t)u.pn * 256 * 256 * 2 : Wkv + (size_t)(u.pn - 3) * 256 * 256 * 2; }
    __device__ __forceinline__ unsigned arow_off(const pg8::Unit&, int R) const { return (unsigned)(R * 256) * 2u; }
};
struct EpiUp {
    static constexpr bool PERM = true, MIDK = false;
    unsigned char* ws;
    __device__ __forceinline__ void operator()(const f32x4 (&acc)[2][2][4][2], const pg8::Unit& u, int wr, int wc, int fr, int fq) const {
        const int pn = u.pn, bb = u.pm >> 5, tb = (u.pm & 31) * 256;
        const size_t m0 = (size_t)bb * SEQ + tb, p0 = (size_t)bb * LP + 128 + tb;
        const char* COSb = (const char*)(ws + WS_COS) + (size_t)(tb + NMETA) * 128; const char* SINb = (const char*)(ws + WS_SIN) + (size_t)(tb + NMETA) * 128;
        const char* SSb = (const char*)(ws + (pn < 3 ? WS_CQS : WS_CKVS)) + m0 * 16;
        char* QMb = (char*)(ws + WS_QM) + m0 * 1536; char* KMb = (char*)(ws + WS_KM) + p0 * 1536; char* VMb = (char*)(ws + WS_VM) + p0 * 1024;
        int rl = wr * 64 + fr; asm volatile("" : "+v"(rl));
        const int j0 = 8 * fq;
        f32x4 sv[8];
#pragma unroll
        for (int q = 0; q < 8; ++q) sv[q] = *(const f32x4*)(SSb + (size_t)((unsigned)(rl + (q >> 2) * 128 + (q & 3) * 16) * 16u));
#pragma unroll
        for (int ai = 0; ai < 2; ++ai)
#pragma unroll
            for (int m = 0; m < 4; ++m) {
                const unsigned r = (unsigned)(rl + ai * 128 + m * 16); const f32x4 s4 = sv[ai * 4 + m];
                const float rstd = 1.f / sqrtf(((s4[0] + s4[1]) + (s4[2] + s4[3])) * (1.f / 256.f) + RMS_EPS);
                const f32x4 a00 = acc[ai][0][m][0] * rstd, a01 = acc[ai][0][m][1] * rstd, a10 = acc[ai][1][m][0] * rstd, a11 = acc[ai][1][m][1] * rstd;
                if (pn < 2) { char* q = QMb + (size_t)(r * 1536u + (unsigned)(((2 * pn) * 192 + 32 * wc + j0) * 2)); ST16(q, pg8::pack8(a00, a01)); ST16((q + 384), pg8::pack8(a10, a11)); }
                else if (pn == 2) { u32x4 lo, hi; const unsigned co = r * 128u + (unsigned)(j0 * 4); rope8(a00, a01, a10, a11, (const float*)(COSb + (size_t)co), (const float*)(SINb + (size_t)co), lo, hi, 1.f);
                    char* q = QMb + (size_t)(r * 1536u + (unsigned)((wc * 192 + 128 + j0) * 2)); ST16(q, lo); ST16((q + 64), hi); }
                else { const int h = pn - 3;
                    ST16(KMb + (size_t)(r * 1536u + (unsigned)((h * 192 + 32 * wc + j0) * 2)), pg8::pack8(a00, a01));
                    ST16(VMb + (size_t)(r * 1024u + (unsigned)((h * 128 + 32 * wc + j0) * 2)), pg8::pack8(a10, a11)); }
            }
    }
};

namespace att {
typedef short s16x4 __attribute__((ext_vector_type(4)));
typedef float f32x16 __attribute__((ext_vector_type(16)));
constexpr int NW = 8, QBLK = 32, KVBLK = 64, QB = NW * QBLK;
#define SBAR() __builtin_amdgcn_sched_barrier(0)
__device__ __forceinline__ int crow(int r, int hi) { return (r & 3) + 8 * (r >> 2) + 4 * hi; }
__device__ __forceinline__ unsigned cvtpk(float lo, float hi) { unsigned r; asm volatile("v_cvt_pk_bf16_f32 %0, %1, %2" : "=v"(r) : "v"(lo), "v"(hi)); return r; }
__device__ __forceinline__ int v_rd_base(int lane) { return ((lane & 3) << 3) | (((lane >> 2) & 3) << 6) | (((lane >> 4) & 1) << 5) | (((lane >> 5) & 1) << 8); }

template <int DQK_, int DV_, int LDQ_, int LDK_, int LDV_, int W_, bool SK_, int NPARK_>
struct Cfg {
    static constexpr int DQK = DQK_, DV = DV_, LDQ = LDQ_, LDK = LDK_, LDV = LDV_, W = W_; static constexpr bool SK = SK_;
    static constexpr int ROWB = DQK * 2, SHM_K = KVBLK * ROWB, SHM_V = KVBLK * DV * 2;
    static constexpr int KCPR = DQK / 8, VCPR = DV / 8, NKC = KVBLK * KCPR / 512, NVC = KVBLK * VCPR / 512, KG = (DV / 32) * 512, NQF = DQK / 16, NOF = DV / 32;
    static constexpr int NPARK = NPARK_, NQR = DQK_ / 16 - NPARK_;
    static constexpr int WS_OFF = 2 * SHM_V + 2 * SHM_K, PARK_OFF = WS_OFF + NW * 64 * 4, LDS_BYTES = PARK_OFF + NW * NPARK_ * 1024;
};
template <class C> struct BlockRef { const bf16_t* Q; const bf16_t* K; const bf16_t* V; bf16_t* O; float* SSQ; int P0; float m0, l0, c2; };
template <class C> struct Seam { bf16x8 qr[C::NQR]; bf16x8 st_k[C::NKC]; bf16x8 st_v[C::NVC]; };

__device__ __forceinline__ void mask_tile(f32x16& p0, f32x16& p1, int dq, unsigned W, int klim) {
    const float NEG = -__builtin_inff();
#pragma unroll
    for (int r = 0; r < 16; ++r) {
        const int c = (r & 3) + 8 * (r >> 2);
        if ((unsigned)(dq - c) >= W || c < klim) p0[r] = NEG;
        if ((unsigned)(dq - c - 32) >= W || c + 32 < klim) p1[r] = NEG;
    }
}
__device__ __forceinline__ void partialSM(f32x16& p0, f32x16& p1, float& m_reg, float& mn, float& alpha, float c2, float thr) {
    float pmax = p0[0];
#pragma unroll
    for (int r = 1; r < 16; ++r) pmax = fmaxf(pmax, p0[r]);
#pragma unroll
    for (int r = 0; r < 16; ++r) pmax = fmaxf(pmax, p1[r]);
    { auto rr = __builtin_amdgcn_permlane32_swap(__float_as_uint(pmax), __float_as_uint(pmax), false, false);
      pmax = fmaxf(__uint_as_float(rr[0]), __uint_as_float(rr[1])); }
    if (__builtin_expect(__all((pmax - m_reg) <= thr), 1)) { mn = m_reg; alpha = 1.f; }
    else { mn = fmaxf(m_reg, pmax); alpha = __builtin_amdgcn_exp2f((m_reg - mn) * c2); m_reg = mn; }
    const float mnL = -mn * c2;
#pragma unroll
    for (int r = 0; r < 16; ++r) p0[r] = fmaf(p0[r], c2, mnL);
#pragma unroll
    for (int r = 0; r < 16; ++r) p1[r] = fmaf(p1[r], c2, mnL);
#pragma unroll
    for (int r = 0; r < 16; ++r) p0[r] = __builtin_amdgcn_exp2f(p0[r]);
}
__device__ __forceinline__ void finishSM(f32x16& p0, f32x16& p1, float alpha, float& l_reg, bf16x8& pa0, bf16x8& pa1, bf16x8& pa2, bf16x8& pa3) {
#pragma unroll
    for (int r = 0; r < 16; ++r) p1[r] = __builtin_amdgcn_exp2f(p1[r]);
    float ps = 0;
#pragma unroll
    for (int r = 0; r < 16; ++r) ps += p0[r];
#pragma unroll
    for (int r = 0; r < 16; ++r) ps += p1[r];
    { auto rr = __builtin_amdgcn_permlane32_swap(__float_as_uint(ps), __float_as_uint(ps), false, false);
      ps = __uint_as_float(rr[0]) + __uint_as_float(rr[1]); }
    l_reg = l_reg * alpha + ps;
#define PK4(P, B_, OUT) do { unsigned a0 = cvtpk(P[B_+0], P[B_+1]), a1 = cvtpk(P[B_+2], P[B_+3]);                          \
        unsigned b0 = cvtpk(P[B_+4], P[B_+5]), b1 = cvtpk(P[B_+6], P[B_+7]);                                             \
        auto r0 = __builtin_amdgcn_permlane32_swap(a0, b0, false, false); auto r1 = __builtin_amdgcn_permlane32_swap(a1, b1, false, false); \
        u32x4 w = {r0[0], r1[0], r0[1], r1[1]}; OUT = *reinterpret_cast<bf16x8*>(&w); } while (0)
    PK4(p0, 0, pa0); PK4(p0, 8, pa1); PK4(p1, 0, pa2); PK4(p1, 8, pa3);
#undef PK4
}
template <class C, int KB>
__device__ __forceinline__ void qkt(f32x16& p0, f32x16& p1, const char* K_lds, int r32, int hi, const bf16x8* qr, const char* qpark, bool act) {
    if (C::SK && !act) { const float NEG = -__builtin_inff();
#pragma unroll
        for (int r = 0; r < 16; ++r) { p0[r] = NEG; p1[r] = NEG; } return; }
    p0 = f32x16{}; p1 = f32x16{};
    const char* kb[4];
#pragma unroll
    for (int dd = 0; dd < 4; ++dd) kb[dd] = K_lds + KB * C::SHM_K + r32 * C::ROWB + (((dd * 16 + hi * 8) * 2) ^ ((r32 & 7) << 4));
#pragma unroll
    for (int d0 = 0; d0 < C::NQF; ++d0) { const char* a = kb[d0 & 3] + (d0 >> 2) * 128;
        bf16x8 b0 = *reinterpret_cast<const bf16x8*>(a);
        bf16x8 b1 = *reinterpret_cast<const bf16x8*>(a + 32 * C::ROWB);
        bf16x8 qf; if (d0 < C::NQR) qf = qr[d0 < C::NQR ? d0 : 0]; else qf = *reinterpret_cast<const bf16x8*>(qpark + (d0 - C::NQR) * 1024);
        p0 = __builtin_amdgcn_mfma_f32_32x32x16_bf16(b0, qf, p0, 0, 0, 0);
        p1 = __builtin_amdgcn_mfma_f32_32x32x16_bf16(b1, qf, p1, 0, 0, 0);
        if (C::NQF > 8 && (d0 & 3) == 3) SBAR(); }
}
template <class C, int VB>
__device__ __forceinline__ void pv_tile(f32x16* o, int vb0, bf16x8 pa0, bf16x8 pa1, bf16x8 pa2, bf16x8 pa3, bool act) {
    if (C::SK && !act) return;
#define TRRD(dst, off) asm volatile("ds_read_b64_tr_b16 %0, %1 offset:%2" : "=&v"(dst) : "v"(vb0), "i"(off) : "memory")
#define PV_D0(d0) do { s16x4 l0, l1, l2, l3, h0, h1, h2, h3; constexpr int b_ = VB * C::SHM_V + (d0) * 512; constexpr int KG_ = C::KG;   \
        TRRD(l0, b_); TRRD(h0, b_ + KG_); TRRD(l1, b_ + 2 * KG_); TRRD(h1, b_ + 3 * KG_); TRRD(l2, b_ + 4 * KG_); TRRD(h2, b_ + 5 * KG_); TRRD(l3, b_ + 6 * KG_); TRRD(h3, b_ + 7 * KG_); \
        asm volatile("s_waitcnt lgkmcnt(0)" ::: "memory"); SBAR();   \
        o[d0] = __builtin_amdgcn_mfma_f32_32x32x16_bf16(pa0, (bf16x8){l0[0], l0[1], l0[2], l0[3], h0[0], h0[1], h0[2], h0[3]}, o[d0], 0, 0, 0);   \
        o[d0] = __builtin_amdgcn_mfma_f32_32x32x16_bf16(pa1, (bf16x8){l1[0], l1[1], l1[2], l1[3], h1[0], h1[1], h1[2], h1[3]}, o[d0], 0, 0, 0);   \
        o[d0] = __builtin_amdgcn_mfma_f32_32x32x16_bf16(pa2, (bf16x8){l2[0], l2[1], l2[2], l2[3], h2[0], h2[1], h2[2], h2[3]}, o[d0], 0, 0, 0);   \
        o[d0] = __builtin_amdgcn_mfma_f32_32x32x16_bf16(pa3, (bf16x8){l3[0], l3[1], l3[2], l3[3], h3[0], h3[1], h3[2], h3[3]}, o[d0], 0, 0, 0); } while (0)
    PV_D0(0); PV_D0(1);
    if constexpr (C::NOF == 4) { PV_D0(2); PV_D0(3); }
#undef PV_D0
#undef TRRD
}
template <class C> __device__ __forceinline__ int jlo(int P0) { const int lowk = P0 - C::W + 1; int j = lowk > 0 ? lowk / KVBLK : 0; const int jm = NPAD / KVBLK; return j < jm ? jm : j; }

#define AT_RSRC(p) __builtin_amdgcn_make_buffer_rsrc((void*)(p), 0, 0x7fffffff, 0x00020000)
#define AT_BLD(rs, vo, so) __builtin_bit_cast(bf16x8, __builtin_amdgcn_raw_buffer_load_b128((rs), (int)(vo), (int)(so), 0))
#define AT_SLOAD(Kp, Vp, k0) do { const __amdgpu_buffer_rsrc_t kr__ = AT_RSRC(Kp), vr__ = AT_RSRC(Vp); const int ks__ = (k0) * (C::LDK * 2), vs__ = (k0) * (C::LDV * 2); \
    _Pragma("unroll") for (int i_ = 0; i_ < C::NVC; ++i_) S.st_v[i_] = AT_BLD(vr__, vgo + (unsigned)(i_ * 128), vs__); \
    _Pragma("unroll") for (int i_ = 0; i_ < C::NKC; ++i_) S.st_k[i_] = AT_BLD(kr__, kgo + (unsigned)(i_ * 128), ks__); } while (0)
#define AT_SWRITE_K(bf) do { _Pragma("unroll") for (int i_ = 0; i_ < C::NKC; ++i_) *(bf16x8*)(K_lds + (bf) * C::SHM_K + klo + i_ * 128) = S.st_k[i_]; } while (0)
#define AT_SWRITE_V(bf) do { _Pragma("unroll") for (int i_ = 0; i_ < C::NVC; ++i_) *(bf16x8*)(V_lds + (bf) * C::SHM_V + vlo + i_ * 1024) = S.st_v[i_]; } while (0)
#define AT_STAGE_OFFS() \
    const int srow_ = tid >> 3, scc_ = tid & 7; \
    const unsigned kgo = (unsigned)(srow_ * C::LDK + scc_ * 8) * 2u, vgo = (unsigned)(srow_ * C::LDV + scc_ * 8) * 2u; \
    const int klo = srow_ * C::ROWB + ((scc_ * 16) ^ ((srow_ & 7) << 4)); \
    const int skk_ = (srow_ & ~0xC) | ((srow_ & 4) << 1) | ((srow_ & 8) >> 1); \
    const int vlo = ((skk_ >> 3) * C::NOF + (scc_ >> 2)) * 512 + ((skk_ & 7) * 32 + (scc_ & 3) * 8) * 2;
#define AT_VMW() asm volatile("s_waitcnt vmcnt(0)" ::: "memory")
#define AT_VMWN(n) asm volatile("s_waitcnt vmcnt(%0)" :: "i"(n) : "memory")

#define AT_QLOAD(Qp) do { bf16x8 qp_[C::NPARK > 0 ? C::NPARK : 1]; \
    const __amdgpu_buffer_rsrc_t qr__ = AT_RSRC(Qp); const int qs__ = wid * (QBLK * C::LDQ * 2); const unsigned qo__ = (unsigned)(r32 * C::LDQ + hi * 8) * 2u; \
    _Pragma("unroll") for (int d0 = 0; d0 < C::NPARK; ++d0) qp_[d0] = AT_BLD(qr__, qo__ + (unsigned)((C::NQR + d0) * 32), qs__); \
    _Pragma("unroll") for (int d0 = 0; d0 < C::NQR; ++d0) S.qr[d0] = AT_BLD(qr__, qo__ + (unsigned)(d0 * 32), qs__); \
    SBAR(); AT_VMWN(C::NQR); \
    _Pragma("unroll") for (int d0 = 0; d0 < C::NPARK; ++d0) *(bf16x8*)(qpark + d0 * 1024) = qp_[d0]; } while (0)
template <class C>
__device__ __forceinline__ void prime(const BlockRef<C>& cur, char* lds, Seam<C>& S, const int tid) {
    const int wid = __builtin_amdgcn_readfirstlane(tid >> 6), lane = tid & 63, r32 = lane & 31, hi = lane >> 5;
    char* K_lds = lds + 2 * C::SHM_V;
    AT_STAGE_OFFS()
    const int kb0 = jlo<C>(cur.P0) * KVBLK;
    char* qpark = lds + C::PARK_OFF + wid * (C::NPARK * 1024) + lane * 16;
    AT_SLOAD(cur.K, cur.V, kb0); SBAR(); AT_QLOAD(cur.Q); AT_VMW(); AT_SWRITE_K(0);
    __syncthreads();
}
template <class C>
__device__ __forceinline__ void block(const BlockRef<C>& cur, const BlockRef<C>& nxt, char* lds, Seam<C>& S, int ssq_slot, const int tid) {
    constexpr bool SK = C::SK; constexpr int W = C::W;
    const int wid = __builtin_amdgcn_readfirstlane(tid >> 6), lane = tid & 63, r32 = lane & 31, hi = lane >> 5;
    const int j_lo = jlo<C>(cur.P0);
    const int j_hi = (cur.P0 + QB - 1) / KVBLK + 1;
    const int NT = j_hi - j_lo;
    const int kbn = jlo<C>(nxt.P0) * KVBLK;
    const int qlo = cur.P0 + wid * QBLK, qm = qlo + r32 - 4 * hi;
    char* V_lds = lds; char* K_lds = lds + 2 * C::SHM_V;
    AT_STAGE_OFFS()
    float* ws = (float*)(lds + C::WS_OFF) + wid * 64; float* li_l = ws, * al_l = ws + 32;
    char* qpark = lds + C::PARK_OFF + wid * (C::NPARK * 1024) + lane * 16;
    float m_reg = cur.m0, l_reg = cur.l0; const float c2 = cur.c2, thr = 8.f * 1.4426950408889634f / c2;
    f32x16 o[C::NOF];
#pragma unroll
    for (int d_ = 0; d_ < C::NOF; ++d_) o[d_] = f32x16{};
    const int vb0 = (int)(uintptr_t)V_lds + v_rd_base(lane);
    const bf16_t* Kh = cur.K; const bf16_t* Vh = cur.V;
#define RESC(a) do { if (__any((a) < 1.f)) { if (hi == 0) al_l[r32] = (a); asm volatile("s_waitcnt lgkmcnt(0)" ::: "memory");              \
                     _Pragma("unroll") for (int d_ = 0; d_ < C::NOF; ++d_) _Pragma("unroll") for (int r = 0; r < 16; ++r) o[d_][r] *= al_l[crow(r, hi)]; } } while (0)
#define KBASE(t) ((j_lo + (t)) * KVBLK)
#define ACT(t) (KBASE(t) <= qlo + QBLK - 1 && KBASE(t) + KVBLK - 1 >= qlo - W + 1)
#define MASKT(P0_, P1_, t) do { const int kb_ = KBASE(t); if ((!SK || ACT(t)) && (kb_ + KVBLK - 1 > qlo || kb_ <= qlo + QBLK - 1 - W || kb_ < NPAD)) mask_tile(P0_, P1_, qm - kb_, (unsigned)W, NPAD - kb_ - 4 * hi); } while (0)
    f32x16 P0, P1; float mn, al; bf16x8 pa0, pa1, pa2, pa3;
    AT_SWRITE_V(0); __syncthreads();
#define STEP(t, B_, NB_) do { const bool more_ = (t) + 1 < NT;                                                              \
        SBAR(); if (more_) { AT_SLOAD(Kh, Vh, KBASE((t) + 1)); } else { AT_SLOAD(nxt.K, nxt.V, kbn); } SBAR();              \
        qkt<C, B_>(P0, P1, K_lds, r32, hi, S.qr, qpark, ACT(t)); SBAR();                                                   \
        MASKT(P0, P1, (t)); partialSM(P0, P1, m_reg, mn, al, c2, thr); RESC(al);                                            \
        finishSM(P0, P1, al, l_reg, pa0, pa1, pa2, pa3); SBAR();                                                             \
        pv_tile<C, B_>(o, vb0, pa0, pa1, pa2, pa3, ACT(t)); SBAR();                                                        \
        if (more_) { AT_VMW(); AT_SWRITE_V(NB_); AT_SWRITE_K(NB_); }                                                        \
        __syncthreads(); } while (0)
    int t = 0;
    for (; t + 1 < NT; t += 2) { STEP(t, 0, 1); STEP(t + 1, 1, 0); }
    if (t < NT) { STEP(t, 0, 1); }
#undef STEP
    AT_QLOAD(nxt.Q);
    AT_SWRITE_K(0); SBAR();
    if (hi == 0) li_l[r32] = l_reg; asm volatile("s_waitcnt lgkmcnt(0)" ::: "memory");
    float rli[16], sq[16];
#pragma unroll
    for (int r = 0; r < 16; ++r) { rli[r] = __builtin_amdgcn_rcpf(li_l[crow(r, hi)]); sq[r] = 0.f; }
    char* Ow = (char*)(cur.O + (size_t)(wid * QBLK) * 1024); const unsigned oo = (unsigned)(4 * hi * 1024 + r32) * 2u;
#pragma unroll
    for (int r = 0; r < 16; ++r) {
#pragma unroll
        for (int d0 = 0; d0 < C::NOF; ++d0) { const float v = o[d0][r] * rli[r]; sq[r] += v * v;
            const float vn = __shfl_xor(v, 1);
            if ((r32 & 1) == 0) *(unsigned*)(Ow + (size_t)(oo + (unsigned)((((r & 3) + 8 * (r >> 2)) * 1024 + d0 * 32) * 2))) = cvtpk(v, vn); } }
    float sel = 0.f; int r32e = r32, hie = hi; asm volatile("" : "+v"(r32e), "+v"(hie));
#pragma unroll
    for (int r = 0; r < 16; ++r) { float s = sq[r]; s += __shfl_xor(s, 1); s += __shfl_xor(s, 2); s += __shfl_xor(s, 4); s += __shfl_xor(s, 8); s += __shfl_xor(s, 16); sel = (r32e == r) ? s : sel; }
    if (r32e < 16) *(float*)((char*)(cur.SSQ + (size_t)(wid * QBLK) * 12 + ssq_slot) + (size_t)((unsigned)crow(r32e, hie) * 48u)) = sel;
    __syncthreads();
#undef RESC
#undef KBASE
#undef ACT
#undef MASKT
}
#undef AT_STAGE_OFFS
#undef AT_SLOAD
#undef AT_SWRITE_K
#undef AT_SWRITE_V
#undef AT_VMW
#undef AT_VMWN
#undef AT_QLOAD
#undef AT_RSRC
#undef AT_BLD
#undef SBAR

typedef Cfg<192, 128, 768, 768, 512, LP, false, 4> CfgMLA;
typedef Cfg<64, 64, 512, 128, 128, 128, true, 0> CfgSWA;
constexpr float C2_MLA = 1.4426950408889634f * 0.07216878364870322f, C2_SWA = 1.4426950408889634f * 0.125f;
static_assert(CfgMLA::LDS_BYTES <= RING_BYTES && CfgSWA::LDS_BYTES <= RING_BYTES, "attention LDS");

__device__ __forceinline__ BlockRef<CfgMLA> mla_ref(unsigned char* ws, int bh, int qb) {
    const int b = bh >> 2, h = bh & 3; BlockRef<CfgMLA> r; const size_t m0 = (size_t)b * SEQ + (size_t)qb * QB;
    r.Q = (const bf16_t*)(ws + WS_QM) + m0 * 768 + h * 192; r.K = (const bf16_t*)(ws + WS_KM) + (size_t)b * LP * 768 + h * 192;
    r.V = (const bf16_t*)(ws + WS_VM) + (size_t)b * LP * 512 + h * 128; r.O = (bf16_t*)(ws + WS_AO) + m0 * 1024 + 512 + h * 128;
    r.SSQ = (float*)(ws + WS_SSQ) + m0 * 12; r.P0 = 128 + qb * QB; r.m0 = -1e30f; r.l0 = 0.f; r.c2 = C2_MLA; return r;
}
__device__ __forceinline__ BlockRef<CfgSWA> swa_ref(unsigned char* ws, const float* sinks, int bh, int qb) {
    const int b = bh >> 3, h = bh & 7, kvh = h >> 2; BlockRef<CfgSWA> r; const size_t m0 = (size_t)b * SEQ + (size_t)qb * QB;
    r.Q = (const bf16_t*)(ws + WS_QA) + m0 * 512 + h * 64; r.K = (const bf16_t*)(ws + WS_KA) + (size_t)b * LP * 128 + kvh * 64;
    r.V = (const bf16_t*)(ws + WS_VA) + (size_t)b * LP * 128 + kvh * 64; r.O = (bf16_t*)(ws + WS_AO) + m0 * 1024 + h * 64;
    r.SSQ = (float*)(ws + WS_SSQ) + m0 * 12; r.P0 = 128 + qb * QB; r.m0 = sinks[h] * 8.f; r.l0 = 1.f; r.c2 = C2_SWA; return r;
}
__device__ __forceinline__ void attn_phase(char* lds, unsigned char* ws, const float* sinks, int vcu, int G) {
    {
        const int nit = (256 - vcu + G - 1) / G;
        const int nblk = 2 * (nit > 0 ? nit : 0);
        if (nblk > 0) {
            Seam<CfgMLA> S; int tid = threadIdx.x; asm volatile("" : "+v"(tid));
#define MLA_REF(k) mla_ref(ws, (vcu + ((k) >> 1) * G) >> 4, ((k) & 1) ? ((vcu + ((k) >> 1) * G) & 15) : 31 - ((vcu + ((k) >> 1) * G) & 15))
            BlockRef<CfgMLA> cur = MLA_REF(0);
            prime<CfgMLA>(cur, lds, S, tid);
            for (int k = 0; k < nblk; ++k) { const BlockRef<CfgMLA> nxt = (k + 1 < nblk) ? MLA_REF(k + 1) : cur; block<CfgMLA>(cur, nxt, lds, S, 8 + (((vcu + (k >> 1) * G) >> 4) & 3), tid); cur = nxt; }
#undef MLA_REF
        }
    }
    {
        const int nit = (256 - vcu + G - 1) / G;
        const int nblk = 4 * (nit > 0 ? nit : 0);
        if (nblk > 0) {
            Seam<CfgSWA> S; int tid = threadIdx.x; asm volatile("" : "+v"(tid));
#define SWA_REF(k) swa_ref(ws, sinks, (4 * (vcu + ((k) >> 2) * G) + ((k) & 3)) >> 5, (4 * (vcu + ((k) >> 2) * G) + ((k) & 3)) & 31)
            BlockRef<CfgSWA> cur = SWA_REF(0);
            prime<CfgSWA>(cur, lds, S, tid);
            for (int k = 0; k < nblk; ++k) { const BlockRef<CfgSWA> nxt = (k + 1 < nblk) ? SWA_REF(k + 1) : cur; block<CfgSWA>(cur, nxt, lds, S, ((4 * (vcu + (k >> 2) * G) + (k & 3)) >> 5) & 7, tid); cur = nxt; }
#undef SWA_REF
        }
    }
}
}

struct EpiOut {
    static constexpr bool PERM = false, MIDK = true;
    unsigned char* ws;
    __device__ __forceinline__ void midk(f32x4 (&acc)[2][2][4][2], const pg8::Unit& u, int wr, int wc, int fr, int fq) const {
        const char* SSQb = (const char*)(ws + WS_SSQ) + (size_t)u.pm * (256 * 48);
        unsigned lo = (unsigned)(wr * 64 + fr) * 48u; asm volatile("" : "+v"(lo));
#pragma unroll
        for (int ai = 0; ai < 2; ++ai) {
            f32x4 s0[4], s1[4], s2[4];
#pragma unroll
            for (int m = 0; m < 4; ++m) { const char* p = SSQb + (size_t)(lo + (unsigned)((ai * 128 + m * 16) * 48)); s0[m] = *(const f32x4*)p; s1[m] = *(const f32x4*)(p + 16); s2[m] = *(const f32x4*)(p + 32); }
#pragma unroll
            for (int m = 0; m < 4; ++m) {
                const float sa = ((s0[m][0] + s0[m][1]) + (s0[m][2] + s0[m][3])) + ((s1[m][0] + s1[m][1]) + (s1[m][2] + s1[m][3])), sb = (s2[m][0] + s2[m][1]) + (s2[m][2] + s2[m][3]);
                const float rho = sqrtf((sb * (1.f / 512.f) + RMS_EPS) / (sa * (1.f / 512.f) + RMS_EPS));
#pragma unroll
                for (int bj = 0; bj < 2; ++bj)
#pragma unroll
                    for (int n = 0; n < 2; ++n) acc[ai][bj][m][n] *= rho; }
            asm volatile("" ::: "memory"); }
    }
    __device__ __forceinline__ void operator()(const f32x4 (&acc)[2][2][4][2], const pg8::Unit& u, int wr, int wc, int fr, int fq) const {
        const char* SSQb = (const char*)(ws + WS_SSQ) + (size_t)u.pm * (256 * 48) + 32;
        const size_t tile = ((size_t)u.pm * 256) * DM + (size_t)u.pn * 256;
        const char* H0b = (const char*)(ws + WS_H0) + tile * 2; char* Pb = (char*)(ws + WS_PRE1) + tile * 4;
        unsigned lo = (unsigned)(wr * 64 + fr) * 48u, eo = (unsigned)((wr * 64 + fr) * DM + wc * 32 + 4 * fq); asm volatile("" : "+v"(lo), "+v"(eo));
        f32x4 s2[8];
#pragma unroll
        for (int q = 0; q < 8; ++q) s2[q] = *(const f32x4*)(SSQb + (size_t)(lo + (unsigned)(((q >> 2) * 128 + (q & 3) * 16) * 48)));
#pragma unroll
        for (int ai = 0; ai < 2; ++ai) {
            u32x2 h[4][2][2];
#pragma unroll
            for (int m = 0; m < 4; ++m)
#pragma unroll
                for (int bj = 0; bj < 2; ++bj)
#pragma unroll
                    for (int n = 0; n < 2; ++n) h[m][bj][n] = *(const u32x2*)(H0b + (size_t)((eo + (unsigned)((ai * 128 + m * 16) * DM + bj * 128 + n * 16)) * 2u));
#pragma unroll
            for (int m = 0; m < 4; ++m) { const f32x4 sq = s2[ai * 4 + m];
                const float rb = 1.f / sqrtf(((sq[0] + sq[1]) + (sq[2] + sq[3])) * (1.f / 512.f) + RMS_EPS);
#pragma unroll
                for (int bj = 0; bj < 2; ++bj)
#pragma unroll
                    for (int n = 0; n < 2; ++n) { const unsigned off = eo + (unsigned)((ai * 128 + m * 16) * DM + bj * 128 + n * 16); const u32x2 hv = h[m][bj][n];
                        f32x4 o = acc[ai][bj][m][n] * rb;
                        o[0] += ALPHA * __uint_as_float(hv.x << 16); o[1] += ALPHA * __uint_as_float(hv.x & 0xffff0000u); o[2] += ALPHA * __uint_as_float(hv.y << 16); o[3] += ALPHA * __uint_as_float(hv.y & 0xffff0000u);
                        ST16F(Pb + (size_t)(off * 4u), o); } }
            asm volatile("" ::: "memory"); }
    }
};

__device__ __forceinline__ void split_bf16x8(const f32x4 x0, const f32x4 x1, bf16x8& hi, bf16x8& lo) {
    unsigned h[8]; float r[8];
#pragma unroll
    for (int e = 0; e < 4; ++e) { h[e] = f2bf(x0[e]); r[e] = x0[e] - __uint_as_float(h[e] << 16); h[4 + e] = f2bf(x1[e]); r[4 + e] = x1[e] - __uint_as_float(h[4 + e] << 16); }
    u32x4 hw, lw;
    hw.x = h[0] | (h[1] << 16); hw.y = h[2] | (h[3] << 16); hw.z = h[4] | (h[5] << 16); hw.w = h[6] | (h[7] << 16);
    lw.x = pk2(r[0], r[1]); lw.y = pk2(r[2], r[3]); lw.z = pk2(r[4], r[5]); lw.w = pk2(r[6], r[7]);
    hi = __builtin_bit_cast(bf16x8, hw); lo = __builtin_bit_cast(bf16x8, lw);
}
__device__ __forceinline__ void p5_ln1_router(const Frame& F, const Args& a) {
    constexpr int RS = 1032;
    LAS float* hrow = (LAS float*)F.lds;
    LAS float* part = (LAS float*)(F.lds + 16 * RS * 4);
    LAS float* lg = part + 8 * 16 * 48;
    const int tid5 = threadIdx.x, lane = tid5 & 63, w = F.wave, fr = lane & 15, fq = lane >> 4;
    const float* PRE1 = (const float*)(F.ws + WS_PRE1); bf16_t* H1 = (bf16_t*)(F.ws + WS_H1);
    const float* g1 = a.in[13]; const float* b1 = a.in[14]; const float* wg = a.in[15]; const float* bg = a.in[16]; const float* wr = a.in[17]; const float* br = a.in[18];
    int* list = (int*)(F.ws + WS_LIST); float* ew = (float*)(F.ws + WS_EW);
    bf16x8 Bh[4][3], Bl[4][3];
#pragma unroll
    for (int s = 0; s < 4; ++s)
#pragma unroll
        for (int cb = 0; cb < 3; ++cb) { const int n = cb * 16 + fr; float x[8];
#pragma unroll
            for (int j = 0; j < 8; ++j) { const int k = 128 * w + 32 * s + 8 * fq + j; x[j] = n < 4 ? wg[k * 4 + n] : (n < 36 ? wr[k * 32 + (n - 4)] : 0.f); }
            split_bf16x8((f32x4){x[0], x[1], x[2], x[3]}, (f32x4){x[4], x[5], x[6], x[7]}, Bh[s][cb], Bl[s][cb]); }
    f32x4 pv[2][4];
    int it = F.bx;
    if (it < T / 16) {
#pragma unroll
        for (int rr = 0; rr < 2; ++rr)
#pragma unroll
            for (int j = 0; j < 4; ++j) pv[rr][j] = *(const f32x4*)(PRE1 + (size_t)(it * 16 + 2 * w + rr) * DM + j * 256 + lane * 4);
    }
    for (; it < T / 16; it += F.G) {
        const int R0 = it * 16;
#pragma unroll
        for (int rr = 0; rr < 2; ++rr) { const int r = 2 * w + rr;
            f32x4 v[4]; float s = 0.f;
#pragma unroll
            for (int j = 0; j < 4; ++j) { v[j] = pv[rr][j]; s += (v[j].x + v[j].y) + (v[j].z + v[j].w); }
            const float mean = wave_sum(s) * (1.f / DM); float s2 = 0.f;
#pragma unroll
            for (int j = 0; j < 4; ++j) { v[j] = v[j] - mean; s2 += (v[j].x * v[j].x + v[j].y * v[j].y) + (v[j].z * v[j].z + v[j].w * v[j].w); }
            const float rstd = 1.f / sqrtf(wave_sum(s2) * (1.f / DM) + LN_EPS);
#pragma unroll
            for (int j = 0; j < 4; ++j) { const int c = j * 256 + lane * 4; const f32x4 gg = *(const f32x4*)(g1 + c), bb = *(const f32x4*)(b1 + c);
                const f32x4 o = v[j] * rstd * gg + bb; *(LAS f32x4*)(hrow + r * RS + c) = o;
                u32x2 pw; pw.x = pk2(o.x, o.y); pw.y = pk2(o.z, o.w); *(u32x2*)(H1 + (size_t)(R0 + r) * DM + c) = pw; } }
        __syncthreads();
        if (it + F.G < T / 16) {
#pragma unroll
            for (int rr = 0; rr < 2; ++rr)
#pragma unroll
                for (int j = 0; j < 4; ++j) pv[rr][j] = *(const f32x4*)(PRE1 + (size_t)((it + F.G) * 16 + 2 * w + rr) * DM + j * 256 + lane * 4);
        }
        f32x4 c0 = {0.f, 0.f, 0.f, 0.f}, c1 = c0, c2 = c0;
#pragma unroll
        for (int s = 0; s < 4; ++s) { const LAS float* ap = hrow + fr * RS + 128 * w + 32 * s + 8 * fq;
            bf16x8 ah, al; split_bf16x8(*(const LAS f32x4*)ap, *(const LAS f32x4*)(ap + 4), ah, al);
            c0 = __builtin_amdgcn_mfma_f32_16x16x32_bf16(ah, Bh[s][0], c0, 0, 0, 0); c0 = __builtin_amdgcn_mfma_f32_16x16x32_bf16(al, Bh[s][0], c0, 0, 0, 0); c0 = __builtin_amdgcn_mfma_f32_16x16x32_bf16(ah, Bl[s][0], c0, 0, 0, 0);
            c1 = __builtin_amdgcn_mfma_f32_16x16x32_bf16(ah, Bh[s][1], c1, 0, 0, 0); c1 = __builtin_amdgcn_mfma_f32_16x16x32_bf16(al, Bh[s][1], c1, 0, 0, 0); c1 = __builtin_amdgcn_mfma_f32_16x16x32_bf16(ah, Bl[s][1], c1, 0, 0, 0);
            c2 = __builtin_amdgcn_mfma_f32_16x16x32_bf16(ah, Bh[s][2], c2, 0, 0, 0); c2 = __builtin_amdgcn_mfma_f32_16x16x32_bf16(al, Bh[s][2], c2, 0, 0, 0); c2 = __builtin_amdgcn_mfma_f32_16x16x32_bf16(ah, Bl[s][2], c2, 0, 0, 0); }
#pragma unroll
        for (int j = 0; j < 4; ++j) { LAS float* pp = part + (w * 16 + fq * 4 + j) * 48 + fr; pp[0] = c0[j]; pp[16] = c1[j]; pp[32] = c2[j]; }
        __syncthreads();
        for (int idx = tid5; idx < 16 * 48; idx += NWAVES * 64) { float sum = 0.f;
#pragma unroll
            for (int q = 0; q < 8; ++q) sum += part[q * 768 + idx];
            lg[idx] = sum; }
        __syncthreads();
        if (tid5 < 16) { const int m = R0 + tid5; const LAS float* L = lg + tid5 * 48;
            const float l0 = L[0] + bg[0], l1 = L[1] + bg[1], l2 = L[2] + bg[2], l3 = L[3] + bg[3];
            const float mx = fmaxf(fmaxf(l0, l1), fmaxf(l2, l3));
            const float ex0 = expf(l0 - mx), ex1 = expf(l1 - mx), ex2 = expf(l2 - mx), ex3 = expf(l3 - mx);
            const float se = ((ex0 + ex1) + ex2) + ex3;
            int gi = 0; float gt = ex0 / se;
            { const float p = ex1 / se; if (p > gt) { gt = p; gi = 1; } }
            { const float p = ex2 / se; if (p > gt) { gt = p; gi = 2; } }
            { const float p = ex3 / se; if (p > gt) { gt = p; gi = 3; } }
            int e1 = 0, e2 = -1; float t1 = -INFINITY, t2 = -INFINITY;
#pragma unroll 1
            for (int i = 0; i < 8; ++i) { const float v = L[4 + gi * 8 + i] + br[gi * 8 + i];
                if (v > t1) { t2 = t1; e2 = e1; t1 = v; e1 = i; } else if (v > t2) { t2 = v; e2 = i; } }
            const float z = expf(t2 - t1), w1 = gt / (1.f + z), w2 = gt * z / (1.f + z);
            const int ea = gi * 8 + e1, eb = gi * 8 + e2;
            const unsigned pa = atomicAdd(&F.ctl[CW_CNT + 64 * ea], 1u); const unsigned pb = atomicAdd(&F.ctl[CW_CNT + 64 * eb], 1u);
            list[(size_t)ea * T + pa] = m * 2; list[(size_t)eb * T + pb] = m * 2 + 1; ew[m * 2] = w1; ew[m * 2 + 1] = w2; }
    }
}

struct MoeOrder {
    const unsigned* ctl; const int* list; const char* A; const char* Bt; int nN, G, c; bool gather;
    __device__ bool next(int i, pg8::Unit& u) const {
        if (G % 8 == 0) {
            const int x = c & 7, slot = c >> 3, ns = G >> 3; const int j = i * ns + slot; const int tlx = j / nN; int accx = 0, accg = 0; bool found = false;
            for (int e = 0; e < 32; ++e) { const int cn = (int)ctl[CW_CNT + 64 * e]; const int nt = (cn + 255) >> 8;
                if ((e & 7) == x) { if (!found && tlx < accx + nt) { u.e = e; u.r0 = (tlx - accx) * 256; u.n = cn; u.pm = accg + (tlx - accx); u.pn = j % nN; found = true; } accx += nt; }
                accg += nt; }
            return found; }
        const int L = i * G + c; const int tl = L / nN; int acc = 0;
        for (int e = 0; e < 32; ++e) { const int cn = (int)ctl[CW_CNT + 64 * e]; const int nt = (cn + 255) >> 8;
            if (tl < acc + nt) { u.e = e; u.r0 = (tl - acc) * 256; u.n = cn; u.pm = tl; u.pn = L % nN; return true; } acc += nt; }
        return false;
    }
    __device__ __forceinline__ const char* abase(const pg8::Unit& u) const { return gather ? A : A + (size_t)u.pm * 256 * 256 * 2; }
    __device__ __forceinline__ const char* bbase(const pg8::Unit& u) const { return gather ? Bt + ((size_t)u.e * 512 + u.pn * 256) * DM * 2 : Bt + ((size_t)u.e * 1024 + u.pn * 256) * 256 * 2; }
    __device__ __forceinline__ unsigned arow_off(const pg8::Unit& u, int R) const {
        if (!gather) return (unsigned)(R * 256) * 2u;
        const int idx = (u.r0 + R < u.n) ? list[(size_t)u.e * T + u.r0 + R] : 0;
        return (unsigned)(idx >> 1) * (unsigned)(DM * 2);
    }
};
struct EpiGU {
    static constexpr bool PERM = true, MIDK = false;
    unsigned char* ws;
    __device__ __forceinline__ void operator()(const f32x4 (&acc)[2][2][4][2], const pg8::Unit& u, int wr, int wc, int fr, int fq) const {
        const char* listb = (const char*)(ws + WS_LIST) + ((size_t)u.e * T + u.r0) * 4; const char* ewb = (const char*)(ws + WS_EW);
        char* Hb = (char*)(ws + WS_HID) + (((size_t)u.pm * 256) * 256 + u.pn * 128) * 2;
        int Rl = wr * 64 + fr; const int nrem = u.n - u.r0; asm volatile("" : "+v"(Rl));
        const unsigned ho = (unsigned)(Rl * 256 + wc * 32 + 8 * fq) * 2u;
        unsigned idx[8]; float wgt[8];
#pragma unroll
        for (int q = 0; q < 8; ++q) { const int R = Rl + (q >> 2) * 128 + (q & 3) * 16; idx[q] = (R < nrem) ? *(const unsigned*)(listb + (size_t)((unsigned)R * 4u)) : 0xffffffffu; }
#pragma unroll
        for (int q = 0; q < 8; ++q) wgt[q] = (idx[q] != 0xffffffffu) ? *(const float*)(ewb + (size_t)(idx[q] * 4u)) : 0.f;
#pragma unroll
        for (int ai = 0; ai < 2; ++ai)
#pragma unroll
            for (int m = 0; m < 4; ++m) { const float wg_ = wgt[ai * 4 + m];
                f32x4 o[2];
#pragma unroll
                for (int n = 0; n < 2; ++n) { const f32x4 gv = acc[ai][0][m][n], uv = acc[ai][1][m][n];
#pragma unroll
                    for (int e = 0; e < 4; ++e) o[n][e] = gv[e] * __builtin_amdgcn_rcpf(1.f + __builtin_amdgcn_exp2f(-1.4426950408889634f * gv[e])) * uv[e] * wg_; }
                ST16(Hb + (size_t)(ho + (unsigned)((ai * 128 + m * 16) * 512)), pg8::pack8(o[0], o[1])); }
    }
};
struct EpiDown {
    static constexpr bool PERM = true, MIDK = false;
    unsigned char* ws;
    __device__ __forceinline__ void operator()(const f32x4 (&acc)[2][2][4][2], const pg8::Unit& u, int wr, int wc, int fr, int fq) const {
        const char* listb = (const char*)(ws + WS_LIST) + ((size_t)u.e * T + u.r0) * 4; char* Yb = (char*)(ws + WS_Y) + (size_t)(u.pn * 256) * 2;
        int Rl = wr * 64 + fr; const int nrem = u.n - u.r0; asm volatile("" : "+v"(Rl));
        const unsigned yo = (unsigned)(wc * 32 + 8 * fq) * 2u;
        unsigned idx[8];
#pragma unroll
        for (int q = 0; q < 8; ++q) { const int R = Rl + (q >> 2) * 128 + (q & 3) * 16; idx[q] = (R < nrem) ? *(const unsigned*)(listb + (size_t)((unsigned)R * 4u)) : 0xffffffffu; }
#pragma unroll
        for (int ai = 0; ai < 2; ++ai)
#pragma unroll
            for (int m = 0; m < 4; ++m) { const unsigned ix = idx[ai * 4 + m];
                if (ix != 0xffffffffu) { char* y = Yb + (size_t)ix * (DM * 2) + yo;
                    ST16(y, pg8::pack8(acc[ai][0][m][0], acc[ai][0][m][1])); ST16((y + 256), pg8::pack8(acc[ai][1][m][0], acc[ai][1][m][1])); } }
    }
};

__device__ __forceinline__ void p8_ln2(const Frame& F, const Args& a) {
    const bf16_t* H1 = (const bf16_t*)(F.ws + WS_H1); const bf16_t* Y = (const bf16_t*)(F.ws + WS_Y); const float* g = a.in[22]; const float* b = a.in[23]; float* out = a.out;
    const int lane = threadIdx.x & 63;
    for (int m = F.bx * NWAVES + F.wave; m < T; m += F.G * NWAVES) {
        f32x4 v[4]; float s = 0.f;
#pragma unroll
        for (int j = 0; j < 4; ++j) { const int c = j * 256 + lane * 4;
            const u32x2 h = *(const u32x2*)(H1 + (size_t)m * DM + c), y0 = *(const u32x2*)(Y + (size_t)(2 * m) * DM + c), y1 = *(const u32x2*)(Y + (size_t)(2 * m + 1) * DM + c);
            v[j].x = ALPHA * __uint_as_float(h.x << 16) + __uint_as_float(y0.x << 16) + __uint_as_float(y1.x << 16);
            v[j].y = ALPHA * __uint_as_float(h.x & 0xffff0000u) + __uint_as_float(y0.x & 0xffff0000u) + __uint_as_float(y1.x & 0xffff0000u);
            v[j].z = ALPHA * __uint_as_float(h.y << 16) + __uint_as_float(y0.y << 16) + __uint_as_float(y1.y << 16);
            v[j].w = ALPHA * __uint_as_float(h.y & 0xffff0000u) + __uint_as_float(y0.y & 0xffff0000u) + __uint_as_float(y1.y & 0xffff0000u);
            s += (v[j].x + v[j].y) + (v[j].z + v[j].w); }
        const float mean = wave_sum(s) * (1.f / DM); float s2 = 0.f;
#pragma unroll
        for (int j = 0; j < 4; ++j) { v[j] = v[j] - mean; s2 += (v[j].x * v[j].x + v[j].y * v[j].y) + (v[j].z * v[j].z + v[j].w * v[j].w); }
        const float rstd = 1.f / sqrtf(wave_sum(s2) * (1.f / DM) + LN_EPS);
#pragma unroll
        for (int j = 0; j < 4; ++j) { const int c = j * 256 + lane * 4; const f32x4 gg = *(const f32x4*)(g + c), bb = *(const f32x4*)(b + c);
            *(f32x4*)(out + (size_t)m * DM + c) = v[j] * rstd * gg + bb; }
    }
}

__global__ void __launch_bounds__(NWAVES * 64, 2) mega(Args args) {
    extern __shared__ __attribute__((aligned(16))) unsigned char lds_raw[];
    Frame F;
    F.lds = (LAS unsigned char*)lds_raw; F.ws = args.ws; F.ctl = (unsigned*)(args.ws + WS_CTL);
    F.tid = threadIdx.x; F.lane = F.tid & 63; F.wave = __builtin_amdgcn_readfirstlane(F.tid >> 6); F.G = gridDim.x; F.bx = blockIdx.x;
    volatile LAS unsigned* MISC = (volatile LAS unsigned*)(F.lds + MISC_OFF);
    for (int u = F.tid; u < (LDS_BYTES - LDSCTL_OFF) / 4; u += NWAVES * 64) ((LAS unsigned*)(F.lds + LDSCTL_OFF))[u] = 0u;
    __syncthreads();
    XcdBarrier bar = xcd_barrier_post(F.ctl + CW_BAR, MISC + 8);
    const int lo = args.ph_lo, hi = args.ph_hi;
#define IN(k) (lo <= (k) && (k) < hi)
#define BOTH(k) (IN(k) && IN((k) + 1))
    if (IN(0)) { p0_prologue(F, args); if (BOTH(0)) xcd_barrier(bar); }
    if (IN(1)) {
        pg8::StaticOrder S; S.init(args.ws + WS_H0, args.ws + WS_WIN, T, 1536, DM, F.G, F.bx);
        EpiInProj E{args.ws};
        pg8::gemm_phase<EpiInProj, pg8::StaticOrder, true>(F.lds, DM, S, E);
        if (BOTH(1)) xcd_barrier(bar);
    }
    if (IN(2)) {
        { int q = F.bx;
          if (F.G % 8 == 0 && F.G >= 224) { const int slot = F.bx >> 3; q = slot >= 16 ? (slot - 16) * 8 + (F.bx & 7) : 1 << 20; }
          for (; q < 84; q += F.G) p2_meta(F, args, q); }
        UpOrder S{(const char*)(args.ws + WS_CQ), (const char*)(args.ws + WS_CKV), (const char*)(args.ws + WS_WUQ), (const char*)(args.ws + WS_WUKV), F.G, F.bx};
        EpiUp E{args.ws};
        pg8::gemm_phase<EpiUp, UpOrder, true>(F.lds, 256, S, E);
        if (BOTH(2)) xcd_barrier(bar);
    }
    if (IN(3)) {
        const int vcu = (F.G % 8 == 0) ? (F.bx % 8) * (F.G / 8) + F.bx / 8 : F.bx;
        att::attn_phase((char*)lds_raw, args.ws, args.in[5], vcu, F.G);
        if (BOTH(3)) xcd_barrier(bar);
    }
    if (IN(4)) {
        pg8::StaticOrder S; S.init(args.ws + WS_AO, args.ws + WS_WO, T, DM, DM, F.G, F.bx);
        EpiOut E{args.ws};
        pg8::gemm_phase<EpiOut, pg8::StaticOrder, true>(F.lds, DM, S, E);
        if (BOTH(4)) xcd_barrier(bar);
    }
    if (IN(5)) { p5_ln1_router(F, args); if (BOTH(5)) xcd_barrier(bar); }
    if (IN(6)) {
        MoeOrder S{F.ctl, (const int*)(args.ws + WS_LIST), (const char*)(args.ws + WS_H1), (const char*)(args.ws + WS_WGU), 2, F.G, F.bx, true};
        EpiGU E{args.ws};
        pg8::gemm_phase<EpiGU, MoeOrder, true>(F.lds, DM, S, E);
        if (BOTH(6)) xcd_barrier(bar);
    }
    if (IN(7)) {
        MoeOrder S{F.ctl, (const int*)(args.ws + WS_LIST), (const char*)(args.ws + WS_HID), (const char*)(args.ws + WS_WDN), 4, F.G, F.bx, false};
        EpiDown E{args.ws};
        pg8::gemm_phase<EpiDown, MoeOrder, true>(F.lds, 256, S, E);
        if (BOTH(7)) xcd_barrier(bar);
    }
    if (IN(8)) { p8_ln2(F, args); }
#undef IN
#undef BOTH
}

extern "C" void kernel_launch(void* const* d_in, const int* in_sizes, int n_in, void* d_out, int out_size, void* d_ws, size_t ws_size, hipStream_t stream) {
    static int grid = 0;
    if (grid == 0) {
        if (n_in != 24 || ws_size < WS_END || out_size != T * DM) { fprintf(stderr, "kernel_launch: unexpected shapes n_in=%d ws=%zu out=%d\n", n_in, ws_size, out_size); grid = -1; return; }
        int dev = 0, cus = 0, per_cu = 0;
        if (hipGetDevice(&dev) != hipSuccess || hipDeviceGetAttribute(&cus, hipDeviceAttributeMultiprocessorCount, dev) != hipSuccess) { grid = -1; return; }
        if (hipFuncSetAttribute((const void*)mega, hipFuncAttributeMaxDynamicSharedMemorySize, LDS_BYTES) != hipSuccess) { fprintf(stderr, "hipFuncSetAttribute failed\n"); grid = -1; return; }
        if (hipOccupancyMaxActiveBlocksPerMultiprocessor(&per_cu, (const void*)mega, NWAVES * 64, LDS_BYTES) != hipSuccess || per_cu < 1) { fprintf(stderr, "occupancy query: %d blocks per CU\n", per_cu); (void)hipGetLastError(); grid = -1; return; }
        (void)hipGetLastError();
        grid = cus;
    }
    if (grid < 0) return;
    (void)hipMemsetAsync((unsigned char*)d_ws + WS_CTL, 0, 1 * MiB, stream);
    Args a{};
    for (int i = 0; i < 24; ++i) a.in[i] = (const float*)d_in[i];
    a.out = (float*)d_out; a.ws = (unsigned char*)d_ws; a.ph_lo = 0; a.ph_hi = 9;
    hipLaunchKernelGGL(mega, dim3(grid), dim3(NWAVES * 64), LDS_BYTES, stream, a);
}
```

```cpp
#include <hip/hip_runtime.h>
#include <cstdio>
#include <cstdint>

typedef unsigned short bf16_t;
typedef float f32x4 __attribute__((ext_vector_type(4)));
typedef unsigned u32x4 __attribute__((ext_vector_type(4)));
typedef unsigned u32x2 __attribute__((ext_vector_type(2)));

constexpr int NB = 4, SEQ = 8192, DM = 1024, T = NB * SEQ, LP = SEQ + 128, NPAD = 112, NMETA = 16;
constexpr int INC = 1344;
constexpr float LN_EPS = 1e-5f, RMS_EPS = 1e-6f;
constexpr float ALPHA = 1.189207115002721f;
constexpr size_t MiB = 1u << 20;

constexpr size_t WS_CTL = 0;
constexpr size_t WS_HM = 1 * MiB;
constexpr size_t WS_CKVM = 1 * MiB + 128 * 1024;
constexpr size_t WS_UM = 1 * MiB + 256 * 1024;
constexpr size_t WS_KVTM = 1 * MiB + 640 * 1024;
constexpr size_t WS_SSQ = 2 * MiB;
constexpr size_t WS_EW = 4 * MiB;
constexpr size_t WS_LIST = 5 * MiB;
constexpr size_t WS_W = 16 * MiB;
constexpr size_t WS_H0 = 72 * MiB;
constexpr size_t WS_QA = 136 * MiB;
constexpr size_t WS_KA = 168 * MiB;
constexpr size_t WS_VA = 177 * MiB;
constexpr size_t WS_CQ = 186 * MiB;
constexpr size_t WS_CKV = 202 * MiB;
constexpr size_t WS_KM = 218 * MiB;
constexpr size_t WS_VM = 267 * MiB;
constexpr size_t WS_QM = 300 * MiB;
constexpr size_t WS_AO = 348 * MiB;
constexpr size_t WS_HID = 412 * MiB;
constexpr size_t WS_PRE1 = 136 * MiB;
constexpr size_t WS_H1 = 264 * MiB;
constexpr size_t WS_Y = 72 * MiB;
constexpr size_t WS_TMP = 348 * MiB;
constexpr size_t WS_AN = 412 * MiB;
constexpr size_t WS_END = 512 * MiB;
constexpr int CW_CNT = 1024;

__constant__ float c_inv_freq[32] = {1.000000000e+00f, 7.498942614e-01f, 5.623413324e-01f, 4.216965139e-01f, 3.162277639e-01f, 2.371373773e-01f, 1.778279394e-01f, 1.333521307e-01f, 1.000000015e-01f, 7.498941571e-02f, 5.623413250e-02f, 4.216965288e-02f, 3.162277490e-02f, 2.371373773e-02f, 1.778279431e-02f, 1.333521493e-02f, 9.999999776e-03f, 7.498941850e-03f, 5.623413250e-03f, 4.216964822e-03f, 3.162277630e-03f, 2.371373586e-03f, 1.778279431e-03f, 1.333521446e-03f, 1.000000047e-03f, 7.498942432e-04f, 5.623413017e-04f, 4.216965172e-04f, 3.162277571e-04f, 2.371373703e-04f, 1.778279402e-04f, 1.333521504e-04f};

#ifndef ST_NT
#define ST_NT 0
#endif
#if ST_NT
#define ST16(p, v) __builtin_nontemporal_store((v), (u32x4*)(p))
#define ST16F(p, v) __builtin_nontemporal_store((v), (f32x4*)(p))
#else
#define ST16(p, v) (*(u32x4*)(p) = (v))
#define ST16F(p, v) (*(f32x4*)(p) = (v))
#endif
__device__ __forceinline__ float bf2f(bf16_t v) { return __uint_as_float((unsigned)v << 16); }
__device__ __forceinline__ unsigned f2bf(float f) { unsigned u = __float_as_uint(f); return (u + 0x7fffu + ((u >> 16) & 1u)) >> 16; }
__device__ __forceinline__ unsigned pk2(float lo, float hi) { return f2bf(lo) | (f2bf(hi) << 16); }
__device__ __forceinline__ int lane_id() { return (int)__builtin_amdgcn_mbcnt_hi(~0u, __builtin_amdgcn_mbcnt_lo(~0u, 0u)); }
__device__ __forceinline__ float wave_sum(float v) {
#pragma unroll
    for (int o = 1; o < 64; o <<= 1) v += __shfl_xor(v, o);
    return v;
}
__device__ __forceinline__ float wave_max(float v) {
#pragma unroll
    for (int o = 1; o < 64; o <<= 1) v = fmaxf(v, __shfl_xor(v, o));
    return v;
}
__device__ __forceinline__ void rope_cs(int pos, int i, float& c, float& s) {
    const double ang = (double)pos * (double)c_inv_freq[i];
    const double rev = ang * 0.15915494309189535;
    const float fr = (float)(rev - __builtin_rint(rev));
    s = __builtin_amdgcn_sinf(fr); c = __builtin_amdgcn_cosf(fr);
}


#define LAS __attribute__((address_space(3)))
#define GAS __attribute__((address_space(1)))
typedef short bf16x8 __attribute__((ext_vector_type(8)));
typedef float f32x2 __attribute__((ext_vector_type(2)));

constexpr size_t WS_CQS = 9 * MiB;
constexpr size_t WS_CKVS = 10 * MiB;
constexpr size_t WS_COS = 11 * MiB;
constexpr size_t WS_SIN = 13 * MiB;
constexpr size_t WS_WIN = 16 * MiB;
constexpr size_t WS_WUQ = 19 * MiB;
constexpr size_t WS_WUKV = 19 * MiB + 512 * 1024;
constexpr size_t WS_WO = 20 * MiB;
constexpr size_t WS_WGU = 22 * MiB;
constexpr size_t WS_WDN = 54 * MiB;
constexpr int NPOS = SEQ + NMETA;

namespace pg8 {
constexpr int BM = 256, BK = 64, HALF = 128, HTB = HALF * BK * 2, STAGE_BYTES = 8 * HTB, NXCD = 8, WGM = 8;
__host__ __device__ __forceinline__ int lds_byte(int r, int c) { const int st = (r >> 4) * 2 + (c >> 5), rr = r & 15, cc = c & 31, ob = rr * 64 + cc * 2; return st * 1024 + (ob ^ (((ob >> 9) & 1) << 5)); }
__host__ __device__ __forceinline__ void stage_rc(int b, int& R, int& C) { const int st = b / 1024, sb = b % 1024, swz = sb ^ (((sb >> 9) & 1) << 5); R = (st >> 1) * 16 + swz / 64; C = (st & 1) * 32 + (swz % 64) / 2; }
__host__ __device__ __forceinline__ int perm32(int rho) { const int n = rho >> 4, i = rho & 15; return 8 * (i >> 2) + 4 * n + (i & 3); }
struct Unit { int pm, pn, e, r0, n; };
typedef float f32x2_t __attribute__((ext_vector_type(2))); typedef __bf16 bf16x2_t __attribute__((ext_vector_type(2)));
__device__ __forceinline__ unsigned cvt_pk_bf16(float lo, float hi) { const f32x2_t v = {lo, hi}; const bf16x2_t b = __builtin_convertvector(v, bf16x2_t); return __builtin_bit_cast(unsigned, b); }
__device__ __forceinline__ u32x4 pack8(const f32x4 a, const f32x4 b) { u32x4 w; w.x = cvt_pk_bf16(a[0], a[1]); w.y = cvt_pk_bf16(a[2], a[3]); w.z = cvt_pk_bf16(b[0], b[1]); w.w = cvt_pk_bf16(b[2], b[3]); return w; }

template <class Epi, class Sched, bool ALIGN_EPI>
__device__ __forceinline__ void gemm_phase(LAS unsigned char* lds, const int K, const Sched& S, const Epi& E) {
    const int tid = threadIdx.x, wid = __builtin_amdgcn_readfirstlane(tid >> 6), lane = tid & 63, wr = wid >> 2, wc = wid & 3, fr = lane & 15, fq = lane >> 4;
    const int nt = K / BK;
    int Rr[2]; unsigned cof[2], voffB[2];
#pragma unroll
    for (int i = 0; i < 2; ++i) { int R, C; stage_rc(tid * 16 + i * 8192, R, C); Rr[i] = R; cof[i] = (unsigned)C * 2u; const int Rb = Epi::PERM ? ((R & ~31) + perm32(R & 31)) : R; voffB[i] = (unsigned)(Rb * K + C) * 2u; }
    const size_t kstep = (size_t)(BK * 2);
    const size_t hstepB = (size_t)HALF * K * 2;
    const unsigned ldsw = (unsigned)wid * 1024u;
    const int aoff = lds_byte(wr * 64 + fr, fq * 8), boff = lds_byte(wc * 32 + fr, fq * 8);
#define PG8_SA(b, h) (((b) * 2 + (h)) * HTB)
#define PG8_SB(b, h) ((4 + (b) * 2 + (h)) * HTB)
#define PG8_STAGE(bufoff, gbase, voff) do { _Pragma("unroll") for (int _i = 0; _i < 2; ++_i) \
        __builtin_amdgcn_global_load_lds((const unsigned*)((const char*)(gbase) + (voff)[_i]), (LAS unsigned*)(lds + (bufoff) + ldsw + _i * 8192), 16, 0, 0); } while (0)
#define PG8_LDA(dst, b, h) do { _Pragma("unroll") for (int m = 0; m < 4; ++m) _Pragma("unroll") for (int k = 0; k < 2; ++k) dst[m][k] = *(const LAS bf16x8*)(lds + PG8_SA(b, h) + aoff + m * 2048 + k * 1024); } while (0)
#define PG8_LDB(dst, b, h) do { _Pragma("unroll") for (int n = 0; n < 2; ++n) _Pragma("unroll") for (int k = 0; k < 2; ++k) dst[n][k] = *(const LAS bf16x8*)(lds + PG8_SB(b, h) + boff + n * 2048 + k * 1024); } while (0)
#define PG8_MMA(ai, bj, At, Bt) do { __builtin_amdgcn_s_setprio(1); _Pragma("unroll") for (int m = 0; m < 4; ++m) _Pragma("unroll") for (int n = 0; n < 2; ++n) _Pragma("unroll") for (int k = 0; k < 2; ++k) \
        acc[ai][bj][m][n] = __builtin_amdgcn_mfma_f32_16x16x32_bf16(Bt[n][k], At[m][k], acc[ai][bj][m][n], 0, 0, 0); __builtin_amdgcn_s_setprio(0); } while (0)
#define PG8_WAIT_V(n) asm volatile("s_waitcnt vmcnt(" #n ")" ::: "memory")
#define PG8_WAIT_L(n) asm volatile("s_waitcnt lgkmcnt(" #n ")" ::: "memory")
#define PG8_BAR __builtin_amdgcn_s_barrier()
#define PG8_SCHED __builtin_amdgcn_sched_barrier(0)
    Unit cur, nxt; int ui = 0;
    if (!S.next(0, cur)) return;
    f32x4 acc[2][2][4][2];
#pragma unroll
    for (int a = 0; a < 2; ++a)
#pragma unroll
        for (int b = 0; b < 2; ++b)
#pragma unroll
            for (int m = 0; m < 4; ++m)
#pragma unroll
                for (int n = 0; n < 2; ++n) acc[a][b][m][n] = (f32x4){0.f, 0.f, 0.f, 0.f};
    bf16x8 At[4][2], B0[2][2], B1[2][2];
    unsigned vA0[2], vA1[2], vN0[2], vN1[2];
#pragma unroll
    for (int i = 0; i < 2; ++i) { vA0[i] = S.arow_off(cur, Rr[i]) + cof[i]; vA1[i] = S.arow_off(cur, Rr[i] + HALF) + cof[i]; }
    const char* cA = S.abase(cur); const char* cB = S.bbase(cur);
    PG8_STAGE(PG8_SB(0, 0), cB, voffB); PG8_STAGE(PG8_SB(0, 1), cB + hstepB, voffB); PG8_STAGE(PG8_SA(0, 0), cA, vA0); PG8_STAGE(PG8_SA(0, 1), cA, vA1);
    if (wr == 1) PG8_BAR;
    PG8_WAIT_V(2); PG8_BAR;
    PG8_STAGE(PG8_SB(1, 0), cB + kstep, voffB); PG8_STAGE(PG8_SA(1, 0), cA + kstep, vA0); PG8_STAGE(PG8_SB(1, 1), cB + hstepB + kstep, voffB);
    PG8_WAIT_V(6); PG8_BAR;
    for (;;) {
        const bool has_next = S.next(ui + 1, nxt);
        const char* nA = has_next ? S.abase(nxt) : cA; const char* nB = has_next ? S.bbase(nxt) : cB;
#pragma unroll
        for (int i = 0; i < 2; ++i) { vN0[i] = has_next ? S.arow_off(nxt, Rr[i]) + cof[i] : vA0[i]; vN1[i] = has_next ? S.arow_off(nxt, Rr[i] + HALF) + cof[i] : vA1[i]; }
#pragma unroll 1
        for (int t = 0; t < nt; t += 2) {
            const bool last = (t == nt - 2);
            const char* a1 = cA + (size_t)(t + 1) * kstep;
            const char* a2 = last ? nA : cA + (size_t)(t + 2) * kstep; const char* b2 = last ? nB : cB + (size_t)(t + 2) * kstep;
            const char* a3 = a2 + kstep; const char* b3 = b2 + kstep;
            unsigned w0[2], w1[2];
#pragma unroll
            for (int i = 0; i < 2; ++i) { w0[i] = last ? vN0[i] : vA0[i]; w1[i] = last ? vN1[i] : vA1[i]; }
            PG8_LDB(B0, 0, 0); PG8_LDB(B1, 0, 1); PG8_SCHED; PG8_LDA(At, 0, 0); PG8_STAGE(PG8_SA(1, 1), a1, vA1);
            PG8_WAIT_V(8); PG8_WAIT_L(0); PG8_BAR; PG8_MMA(0, 0, At, B0); PG8_MMA(0, 1, At, B1); PG8_BAR; PG8_SCHED;
            PG8_LDA(At, 0, 1); PG8_STAGE(PG8_SB(0, 0), b2, voffB); PG8_STAGE(PG8_SB(0, 1), b2 + hstepB, voffB); PG8_STAGE(PG8_SA(0, 0), a2, w0);
            PG8_WAIT_V(8); PG8_WAIT_L(0); PG8_BAR; PG8_MMA(1, 0, At, B0); PG8_MMA(1, 1, At, B1); PG8_BAR; PG8_SCHED;
            PG8_LDB(B0, 1, 0); PG8_LDB(B1, 1, 1); PG8_SCHED; PG8_LDA(At, 1, 0); PG8_STAGE(PG8_SA(0, 1), a2, w1);
            PG8_WAIT_V(8); PG8_WAIT_L(0); PG8_BAR; PG8_MMA(0, 0, At, B0); PG8_MMA(0, 1, At, B1); PG8_BAR; PG8_SCHED;
            PG8_LDA(At, 1, 1); PG8_STAGE(PG8_SB(1, 0), b3, voffB); PG8_STAGE(PG8_SB(1, 1), b3 + hstepB, voffB); PG8_STAGE(PG8_SA(1, 0), a3, w0);
            PG8_WAIT_V(8); PG8_WAIT_L(0); PG8_BAR; PG8_MMA(1, 0, At, B0); PG8_MMA(1, 1, At, B1); PG8_BAR; PG8_SCHED;
            if constexpr (Epi::MIDK) { if (t + 2 == nt / 2) E.midk(acc, cur, wr, wc, fr, fq); }
        }
        if constexpr (ALIGN_EPI) { if (wr == 0) PG8_BAR; }
        E(acc, cur, wr, wc, fr, fq);
        if (!has_next) break;
#pragma unroll
        for (int a = 0; a < 2; ++a)
#pragma unroll
            for (int b = 0; b < 2; ++b)
#pragma unroll
                for (int m = 0; m < 4; ++m)
#pragma unroll
                    for (int n = 0; n < 2; ++n) acc[a][b][m][n] = (f32x4){0.f, 0.f, 0.f, 0.f};
        cur = nxt; cA = nA; cB = nB; ++ui;
#pragma unroll
        for (int i = 0; i < 2; ++i) { vA0[i] = vN0[i]; vA1[i] = vN1[i]; }
        if constexpr (ALIGN_EPI) { if (wr == 1) PG8_BAR; }
    }
    PG8_WAIT_V(0);
    if constexpr (!ALIGN_EPI) { if (wr == 0) PG8_BAR; }
    PG8_BAR;
#undef PG8_SA
#undef PG8_SB
#undef PG8_STAGE
#undef PG8_LDA
#undef PG8_LDB
#undef PG8_MMA
#undef PG8_WAIT_V
#undef PG8_WAIT_L
#undef PG8_BAR
#undef PG8_SCHED
}

struct StaticOrder {
    const char* A; const char* Bt; int K;
    int nM, nN, nwg, G, c;
    __device__ void init(const void* A_, const void* Bt_, int M, int N, int K_, int G_, int c_) { A = (const char*)A_; Bt = (const char*)Bt_; K = K_; nM = M / BM; nN = N / BM; nwg = nM * nN; G = G_; c = c_; }
    __device__ bool next(int i, Unit& u) const {
        const long L = (long)i * G + c; if (L >= nwg) return false;
        int wgid = (int)L; { const int q = nwg / NXCD, r = nwg % NXCD, xcd = wgid % NXCD, off = wgid / NXCD; wgid = (xcd < r ? xcd * (q + 1) : r * (q + 1) + (xcd - r) * q) + off; }
        const int nig = WGM * nN, gid = wgid / nig, fm = gid * WGM, gsz = (nM - fm) < WGM ? (nM - fm) : WGM;
        u.pm = fm + ((wgid % nig) % gsz); u.pn = (wgid % nig) / gsz; return true;
    }
    __device__ __forceinline__ const char* abase(const Unit& u) const { return A + (size_t)u.pm * BM * K * 2; }
    __device__ __forceinline__ const char* bbase(const Unit& u) const { return Bt + (size_t)u.pn * BM * K * 2; }
    __device__ __forceinline__ unsigned arow_off(const Unit&, int R) const { return (unsigned)(R * K) * 2u; }
};
}

#define XB_TMO      128
#define XB_XCNT(j)  (256  + 64 * (j))
#define XB_XSUB(j)  (1280 + 64 * (j))
#define XB_XGEN(j)  (2304 + 64 * (j))
#define XB_TOP      3328
#define XB_TOPGEN   3392
#define XCD_BAR_WORDS 3456
#define XB_SPIN_CAP (1u << 18)
__device__ __forceinline__ unsigned xb_ld(unsigned* p)              { return __hip_atomic_load(p, __ATOMIC_RELAXED, __HIP_MEMORY_SCOPE_AGENT); }
__device__ __forceinline__ unsigned xb_add(unsigned* p, unsigned v) { return __hip_atomic_fetch_add(p, v, __ATOMIC_RELAXED, __HIP_MEMORY_SCOPE_AGENT); }
__device__ __forceinline__ unsigned xb_xcc_id() { return (unsigned)__builtin_amdgcn_s_getreg((3 << 11) | 20) & 0xFu; }
#define XB_SPIN(cond, bar) do { unsigned _sp = 0; while (cond) { __builtin_amdgcn_s_sleep(1); \
    if ((++_sp & 255u) == 0u) { if (xb_ld(&(bar)[XB_TMO])) break; if (_sp > XB_SPIN_CAP) { atomicAdd(&(bar)[XB_TMO], 1u); break; } } } } while (0)
struct XcdBarrier { unsigned* bar; unsigned x; volatile LAS unsigned* st; };
__device__ __forceinline__ XcdBarrier xcd_barrier_post(unsigned* bar, volatile LAS unsigned* st) {
    XcdBarrier b; b.bar = bar; b.x = xb_xcc_id(); b.st = st;
    if (threadIdx.x == 0) (void)xb_add(&bar[XB_XCNT(b.x)], 1u);
    return b;
}
__device__ __forceinline__ void xcd_barrier_complete(unsigned* bar, unsigned x, unsigned& nloc, unsigned& nx) {
    const unsigned G = gridDim.x * gridDim.y * gridDim.z;
    unsigned sum, cnt, mine, sp = 0u;
    for (;;) {
        sum = 0u; cnt = 0u; mine = 0u;
#pragma unroll
        for (unsigned j = 0; j < 16; ++j) { const unsigned c = xb_ld(&bar[XB_XCNT(j)]); sum += c; cnt += (c > 0u) ? 1u : 0u; mine = (j == x) ? c : mine; }
        if (sum == G) break;
        __builtin_amdgcn_s_sleep(1);
        if ((++sp & 255u) == 0u) { if (xb_ld(&bar[XB_TMO])) break; if (sp > XB_SPIN_CAP) { atomicAdd(&bar[XB_TMO], 1u); break; } }
    }
    nloc = mine > 0u ? mine : 1u; nx = cnt > 0u ? cnt : 1u;
}
__device__ __forceinline__ void xcd_barrier(const XcdBarrier& b) {
    asm volatile("s_waitcnt vmcnt(0)" ::: "memory");
    __syncthreads();
    if (threadIdx.x == 0) {
        unsigned* bar = b.bar;
        __builtin_amdgcn_s_waitcnt(0);
        unsigned nloc = b.st[0], nx = b.st[1];
        if (nloc == 0u) { xcd_barrier_complete(bar, b.x, nloc, nx); b.st[0] = nloc; b.st[1] = nx; }
        const unsigned old = xb_add(&bar[XB_XSUB(b.x)], 1u);
        const unsigned gen = old / nloc;
        if (old + 1u == (gen + 1u) * nloc) {
            __builtin_amdgcn_fence(__ATOMIC_RELEASE, "agent");
            asm volatile("s_waitcnt vmcnt(0)" ::: "memory");
            const unsigned og = xb_add(&bar[XB_TOP], 1u);
            const unsigned tg = og / nx;
            if (og + 1u == (tg + 1u) * nx) xb_add(&bar[XB_TOPGEN], 1u);
            else XB_SPIN(xb_ld(&bar[XB_TOPGEN]) == tg, bar);
            __builtin_amdgcn_fence(__ATOMIC_ACQUIRE, "agent");
            xb_add(&bar[XB_XGEN(b.x)], 1u);
            asm volatile("s_waitcnt vmcnt(0)" ::: "memory");
        } else {
            XB_SPIN(xb_ld(&bar[XB_XGEN(b.x)]) == gen, bar);
            __builtin_amdgcn_fence(__ATOMIC_ACQUIRE, "agent");
            asm volatile("s_waitcnt vmcnt(0)" ::: "memory");
        }
    }
    __syncthreads();
}

constexpr int NWAVES = 8;
constexpr int RING_BYTES = 135168, LDSCTL_OFF = RING_BYTES, MISC_OFF = LDSCTL_OFF + 320, LDS_BYTES = 147456;
constexpr int CW_BAR = 4096;
#define LDS_WAIT() asm volatile("s_waitcnt lgkmcnt(0)" ::: "memory")
#define VM_WAIT() asm volatile("s_waitcnt vmcnt(0)" ::: "memory")

struct Args {
    const float* in[24]; float* out; unsigned char* ws; int ph_lo, ph_hi;
};
struct Frame {
    LAS unsigned char* lds; unsigned char* ws; unsigned* ctl;
    int tid, lane, wave, G, bx;
};

__device__ __forceinline__ void p0_tr_item(const float* __restrict__ W, int ldn, int c0, int k0, bf16_t* dst, int K, const float* __restrict__ sc0, const float* __restrict__ sc1, LAS float* scr, int lane) {
    if (c0 >= 0) {
        f32x4 v[8];
#pragma unroll
        for (int i = 0; i < 8; ++i) v[i] = *(const f32x4*)(W + (size_t)(k0 + 8 * i + (lane >> 3)) * ldn + c0 + (lane & 7) * 4);
#pragma unroll
        for (int i = 0; i < 8; ++i) { const int kk = 8 * i + (lane >> 3), k = k0 + kk; f32x4 x = v[i];
            if (sc0) x *= (k < 512 || !sc1) ? sc0[k] : sc1[k - 512];
            LAS float* s = scr + kk * 33 + (lane & 7) * 4; s[0] = x.x; s[1] = x.y; s[2] = x.z; s[3] = x.w; }
    } else {
#pragma unroll 8
        for (int i = 0; i < 32; ++i) { const int kk = 2 * i + (lane >> 5); scr[kk * 33 + (lane & 31)] = 0.f; }
    }
    LDS_WAIT(); asm volatile("" ::: "memory");
    const int c = lane & 7;
#pragma unroll
    for (int j = 0; j < 4; ++j) { const int n = (lane >> 3) + 8 * j; const LAS float* s = scr + (8 * c) * 33 + n;
        u32x4 o; o.x = pk2(s[0 * 33], s[1 * 33]); o.y = pk2(s[2 * 33], s[3 * 33]); o.z = pk2(s[4 * 33], s[5 * 33]); o.w = pk2(s[6 * 33], s[7 * 33]);
        ST16((dst + (size_t)n * K + k0 + 8 * c), o); }
    LDS_WAIT(); asm volatile("" ::: "memory");
}
__device__ __forceinline__ int win_src_col(int tile, int q) {
    if (tile <= 1) return 256 * tile + 64 * (q & 3) + ((q >> 2) ? 32 : 0);
    if (tile == 2) { const int tb[8] = {512, 576, 640, 672, 544, 608, 704, 736}; int r = tb[0];
#pragma unroll
        for (int i = 1; i < 8; ++i) r = (q == i) ? tb[i] : r; return r; }
    if (tile == 3) return 768 + 32 * q;
    if (tile == 4) return 1024 + 32 * q;
    return q == 0 ? 1280 : (q == 4 ? 1312 : -1);
}
__device__ __forceinline__ int wuq_src_col(int tile, int q) {
    if (tile <= 1) return (2 * tile + (q >> 2)) * 192 + 32 * (q & 3);
    return (q & 3) * 192 + 128 + ((q >> 2) ? 32 : 0);
}

__device__ __forceinline__ void ln_row_bf16(const float* __restrict__ src, const float* __restrict__ g, const float* __restrict__ b, bf16_t* dst, int lane) {
    f32x4 v[4]; float s = 0.f;
#pragma unroll
    for (int j = 0; j < 4; ++j) { v[j] = *(const f32x4*)(src + j * 256 + lane * 4); s += (v[j].x + v[j].y) + (v[j].z + v[j].w); }
    const float mean = wave_sum(s) * (1.f / DM); float s2 = 0.f;
#pragma unroll
    for (int j = 0; j < 4; ++j) { v[j] = v[j] - mean; s2 += (v[j].x * v[j].x + v[j].y * v[j].y) + (v[j].z * v[j].z + v[j].w * v[j].w); }
    const float rstd = 1.f / sqrtf(wave_sum(s2) * (1.f / DM) + LN_EPS);
#pragma unroll
    for (int j = 0; j < 4; ++j) { const int c = j * 256 + lane * 4; const f32x4 gg = *(const f32x4*)(g + c), bb = *(const f32x4*)(b + c);
        const f32x4 o = v[j] * rstd * gg + bb; u32x2 w; w.x = pk2(o.x, o.y); w.y = pk2(o.z, o.w); *(u32x2*)(dst + c) = w; }
}

__device__ __forceinline__ bf16x8 ld_bcol8(const float* __restrict__ W, int ldn, int k0, int col) {
    float x[8];
#pragma unroll
    for (int j = 0; j < 8; ++j) x[j] = W[(size_t)(k0 + j) * ldn + col];
    u32x4 w; w.x = pk2(x[0], x[1]); w.y = pk2(x[2], x[3]); w.z = pk2(x[4], x[5]); w.w = pk2(x[6], x[7]);
    return __builtin_bit_cast(bf16x8, w);
}
__device__ __forceinline__ void p0_meta_block(const Frame& F, const Args& a, const int blk) {
    constexpr int RSH = 1032;
    LAS bf16_t* hm = (LAS bf16_t*)(F.lds);
    LAS float* pc = (LAS float*)(F.lds + 33280);
    const int lane = F.lane, w = F.wave, fr = lane & 15, fq = lane >> 4;
    const float* meta = a.in[1]; const float* g = a.in[2]; const float* b = a.in[3]; const float* w_in = a.in[4];
    float* UM = (float*)(F.ws + WS_UM);
#pragma unroll 1
    for (int rr = 0; rr < 2; ++rr) { const int row = 2 * w + rr; const float* src = meta + (size_t)row * DM;
        f32x4 v[4]; float s = 0.f;
#pragma unroll
        for (int j = 0; j < 4; ++j) { v[j] = *(const f32x4*)(src + j * 256 + lane * 4); s += (v[j].x + v[j].y) + (v[j].z + v[j].w); }
        const float mean = wave_sum(s) * (1.f / DM); float s2 = 0.f;
#pragma unroll
        for (int j = 0; j < 4; ++j) { v[j] = v[j] - mean; s2 += (v[j].x * v[j].x + v[j].y * v[j].y) + (v[j].z * v[j].z + v[j].w * v[j].w); }
        const float rstd = 1.f / sqrtf(wave_sum(s2) * (1.f / DM) + LN_EPS);
#pragma unroll
        for (int j = 0; j < 4; ++j) { const int c = j * 256 + lane * 4; const f32x4 gg = *(const f32x4*)(g + c), bb = *(const f32x4*)(b + c); const f32x4 o = v[j] * rstd * gg + bb;
            u32x2 pw; pw.x = pk2(o.x, o.y); pw.y = pk2(o.z, o.w); *(LAS u32x2*)(hm + row * RSH + c) = pw; } }
    __syncthreads();
    const int col = (blk < 16 ? 512 + 16 * blk : (blk < 32 ? 1024 + 16 * (blk - 16) : 1280 + 16 * (blk - 32))) + fr;
    bf16x8 bv[4];
#pragma unroll
    for (int s = 0; s < 4; ++s) bv[s] = ld_bcol8(w_in, INC, 32 * (4 * w + s) + 8 * fq, col);
    f32x4 c = {0.f, 0.f, 0.f, 0.f};
#pragma unroll
    for (int s = 0; s < 4; ++s) { const bf16x8 av = *(const LAS bf16x8*)(hm + fr * RSH + 32 * (4 * w + s) + 8 * fq); c = __builtin_amdgcn_mfma_f32_16x16x32_bf16(av, bv[s], c, 0, 0, 0); }
#pragma unroll
    for (int j = 0; j < 4; ++j) pc[w * 256 + (fq * 4 + j) * 16 + fr] = c[j];
    __syncthreads();
    if (F.tid < 256) { float sum = 0.f;
#pragma unroll
        for (int q = 0; q < 8; ++q) sum += pc[q * 256 + F.tid];
        const int oc = (blk < 16 ? 16 * blk : (blk < 32 ? 256 + 16 * (blk - 16) : 512 + 16 * (blk - 32))) + (F.tid & 15);
        UM[(F.tid >> 4) * 576 + oc] = sum; }
    __syncthreads();
}
__device__ __forceinline__ void p2_meta(const Frame& F, const Args& a, const int q) {
    const int lane = F.lane, w = F.wave, fr = lane & 15, fq = lane >> 4;
    const float* UM = (const float*)(F.ws + WS_UM); const float* gkv = a.in[8]; const float* w_ukv = a.in[9];
    bf16_t* KA = (bf16_t*)(F.ws + WS_KA); bf16_t* VA = (bf16_t*)(F.ws + WS_VA); bf16_t* KM = (bf16_t*)(F.ws + WS_KM); bf16_t* VM = (bf16_t*)(F.ws + WS_VM);
    if (q < 64) {
        LAS float* rs = (LAS float*)(F.lds); LAS float* pc = (LAS float*)(F.lds + 256);
#pragma unroll 1
        for (int rr = 0; rr < 2; ++rr) { const int row = 2 * w + rr; float ss = 0.f;
#pragma unroll
            for (int j = 0; j < 4; ++j) { const float v = UM[row * 576 + 256 + 64 * j + lane]; ss += v * v; }
            ss = wave_sum(ss); if (lane == 0) rs[row] = 1.f / sqrtf(ss * (1.f / 256.f) + RMS_EPS); }
        const bf16x8 bv = ld_bcol8(w_ukv, 1024, 32 * w + 8 * fq, 16 * q + fr);
        __syncthreads();
        float x[8]; const float r_ = rs[fr];
#pragma unroll
        for (int j = 0; j < 8; ++j) { const int k = 32 * w + 8 * fq + j; x[j] = UM[fr * 576 + 256 + k] * r_ * gkv[k]; }
        u32x4 aw; aw.x = pk2(x[0], x[1]); aw.y = pk2(x[2], x[3]); aw.z = pk2(x[4], x[5]); aw.w = pk2(x[6], x[7]);
        f32x4 c = {0.f, 0.f, 0.f, 0.f};
        c = __builtin_amdgcn_mfma_f32_16x16x32_bf16(__builtin_bit_cast(bf16x8, aw), bv, c, 0, 0, 0);
#pragma unroll
        for (int j = 0; j < 4; ++j) pc[w * 256 + (fq * 4 + j) * 16 + fr] = c[j];
        __syncthreads();
        if (F.tid < 256) { float sum = 0.f;
#pragma unroll
            for (int p = 0; p < 8; ++p) sum += pc[p * 256 + F.tid];
            const int r = F.tid >> 4, col = 16 * q + (F.tid & 15), h = col >> 8, cc = col & 255; const bf16_t hv = (bf16_t)f2bf(sum);
            for (int b2 = 0; b2 < NB; ++b2) { const size_t prow = (size_t)b2 * LP + NPAD + r;
                if (cc < 128) KM[prow * 768 + h * 192 + cc] = hv; else VM[prow * 512 + h * 128 + (cc - 128)] = hv; } }
        __syncthreads();
    } else {
        const int idx = (q - 64) * 256 + F.tid;
        if (F.tid < 256 && idx < 16 * 320) { const int r = idx / 320, c = idx % 320;
            const int oc = c < 256 ? c : c + 256; float v = UM[r * 576 + oc];
            if (c < 128 || c >= 256) { const float p = UM[r * 576 + (oc ^ 32)]; float cs, sn; rope_cs(r, c & 31, cs, sn); v = (c & 32) ? v * cs + p * sn : v * cs - p * sn; }
            const bf16_t hv = (bf16_t)f2bf(v);
            for (int b2 = 0; b2 < NB; ++b2) { const size_t prow = (size_t)b2 * LP + NPAD + r;
                if (c < 128) KA[prow * 128 + c] = hv; else if (c < 256) VA[prow * 128 + (c - 128)] = hv;
                else { const int cc = c - 256; KM[prow * 768 + 128 + cc] = hv; KM[prow * 768 + 192 + 128 + cc] = hv; KM[prow * 768 + 384 + 128 + cc] = hv; KM[prow * 768 + 576 + 128 + cc] = hv; } } }
    }
}

__device__ __forceinline__ void p0_prologue(const Frame& F, const Args& a) {
    for (int blk = F.bx; blk < 36; blk += F.G) p0_meta_block(F, a, blk);
    LAS float* scr = (LAS float*)(F.lds + F.wave * 16384);
    const int gw = F.bx * NWAVES + F.wave, NGW = F.G * NWAVES, lane = F.lane;
    unsigned char* ws = F.ws;
    constexpr int I_IN = 16 * 48, I_UQ = 4 * 24, I_UKV = 4 * 32, I_O = 16 * 32, I_GU = 32 * 16 * 16, I_DN = 32 * 4 * 32;
    constexpr int NITEMS = I_IN + I_UQ + I_UKV + I_O + I_GU + I_DN;
    for (int it = gw; it < NITEMS; it += NGW) {
        int r = it;
        if (r < I_IN) { const int kb = r / 48, nb = r % 48; p0_tr_item(a.in[4], INC, win_src_col(nb >> 3, nb & 7), 64 * kb, (bf16_t*)(ws + WS_WIN) + (size_t)(32 * nb) * DM, DM, nullptr, nullptr, scr, lane); continue; } r -= I_IN;
        if (r < I_UQ) { const int kb = r / 24, nb = r % 24; p0_tr_item(a.in[7], 768, wuq_src_col(nb >> 3, nb & 7), 64 * kb, (bf16_t*)(ws + WS_WUQ) + (size_t)(32 * nb) * 256, 256, a.in[6], nullptr, scr, lane); continue; } r -= I_UQ;
        if (r < I_UKV) { const int kb = r / 32, nb = r % 32; p0_tr_item(a.in[9], 1024, 32 * nb, 64 * kb, (bf16_t*)(ws + WS_WUKV) + (size_t)(32 * nb) * 256, 256, a.in[8], nullptr, scr, lane); continue; } r -= I_UKV;
        if (r < I_O) { const int kb = r / 32, nb = r % 32; p0_tr_item(a.in[12], DM, 32 * nb, 64 * kb, (bf16_t*)(ws + WS_WO) + (size_t)(32 * nb) * DM, DM, a.in[10], a.in[11], scr, lane); continue; } r -= I_O;
        if (r < I_GU) { const int e = r / 256, r2 = r % 256, kb = r2 / 16, nb = r2 % 16; const int tile = nb >> 3, q = nb & 7;
            const float* src = (q < 4 ? a.in[19] : a.in[20]) + (size_t)e * DM * 256;
            p0_tr_item(src, 256, 128 * tile + 32 * (q & 3), 64 * kb, (bf16_t*)(ws + WS_WGU) + ((size_t)e * 512 + 32 * nb) * DM, DM, nullptr, nullptr, scr, lane); continue; } r -= I_GU;
        { const int e = r / 128, r2 = r % 128, kb = r2 / 32, nb = r2 % 32;
            p0_tr_item(a.in[21] + (size_t)e * 256 * DM, DM, 32 * nb, 64 * kb, (bf16_t*)(ws + WS_WDN) + ((size_t)e * 1024 + 32 * nb) * 256, 256, nullptr, nullptr, scr, lane); }
    }
    { float* COS = (float*)(ws + WS_COS); float* SIN = (float*)(ws + WS_SIN);
      for (int it = gw; it < NPOS * 32 / 64; it += NGW) { const int idx = it * 64 + lane; float c, s; rope_cs(idx >> 5, idx & 31, c, s); COS[idx] = c; SIN[idx] = s; } }
    for (int it = gw; it < NB * NPAD; it += NGW) { const size_t prow = (size_t)(it / NPAD) * LP + (it % NPAD);
        const u32x4 z = {0u, 0u, 0u, 0u};
        for (int o = lane * 16; o < 3072; o += 1024) {
            unsigned char* p;
            if (o < 256) p = ws + WS_KA + prow * 256 + o; else if (o < 512) p = ws + WS_VA + prow * 256 + (o - 512 + 256);
            else if (o < 2048) p = ws + WS_KM + prow * 1536 + (o - 512); else p = ws + WS_VM + prow * 1024 + (o - 2048);
            ST16(p, z); } }
    { const float* x = a.in[0]; const float* g = a.in[2]; const float* b = a.in[3]; bf16_t* H0 = (bf16_t*)(ws + WS_H0);
      for (int m = gw; m < T; m += 2 * NGW) {
        const int m2 = m + NGW; const bool two = m2 < T;
        f32x4 v[2][4]; float s[2] = {0.f, 0.f};
#pragma unroll
        for (int j = 0; j < 4; ++j) { v[0][j] = *(const f32x4*)(x + (size_t)m * DM + j * 256 + lane * 4); v[1][j] = two ? *(const f32x4*)(x + (size_t)m2 * DM + j * 256 + lane * 4) : (f32x4){0.f, 0.f, 0.f, 0.f}; }
#pragma unroll
        for (int q = 0; q < 2; ++q)
#pragma unroll
            for (int j = 0; j < 4; ++j) s[q] += (v[q][j].x + v[q][j].y) + (v[q][j].z + v[q][j].w);
#pragma unroll
        for (int q = 0; q < 2; ++q) { if (q == 1 && !two) break;
            const float mean = wave_sum(s[q]) * (1.f / DM); float s2 = 0.f;
#pragma unroll
            for (int j = 0; j < 4; ++j) { v[q][j] = v[q][j] - mean; s2 += (v[q][j].x * v[q][j].x + v[q][j].y * v[q][j].y) + (v[q][j].z * v[q][j].z + v[q][j].w * v[q][j].w); }
            const float rstd = 1.f / sqrtf(wave_sum(s2) * (1.f / DM) + LN_EPS);
            bf16_t* dstp = H0 + (size_t)(q ? m2 : m) * DM;
#pragma unroll
            for (int j = 0; j < 4; ++j) { const int c = j * 256 + lane * 4; const f32x4 gg = *(const f32x4*)(g + c), bb = *(const f32x4*)(b + c);
                const f32x4 o = v[q][j] * rstd * gg + bb; u32x2 w2; w2.x = pk2(o.x, o.y); w2.y = pk2(o.z, o.w); *(u32x2*)(dstp + c) = w2; } }
      } }
}

__device__ __forceinline__ void rope8(const f32x4 lo0, const f32x4 lo1, const f32x4 hi0, const f32x4 hi1, const float* __restrict__ cosr, const float* __restrict__ sinr, u32x4& olo, u32x4& ohi, float scale) {
    const f32x4 c0 = *(const f32x4*)cosr, c1 = *(const f32x4*)(cosr + 4), s0 = *(const f32x4*)sinr, s1 = *(const f32x4*)(sinr + 4);
    olo = pg8::pack8((lo0 * c0 - hi0 * s0) * scale, (lo1 * c1 - hi1 * s1) * scale);
    ohi = pg8::pack8((hi0 * c0 + lo0 * s0) * scale, (hi1 * c1 + lo1 * s1) * scale);
}
struct EpiInProj {
    static constexpr bool PERM = true, MIDK = false;
    unsigned char* ws;
    __device__ __forceinline__ void operator()(const f32x4 (&acc)[2][2][4][2], const pg8::Unit& u, int wr, int wc, int fr, int fq) const {
        const int pn = u.pn, bb = u.pm >> 5, t0 = (u.pm & 31) * 256 + wr * 64 + fr;
        const float* COS = (const float*)(ws + WS_COS); const float* SIN = (const float*)(ws + WS_SIN);
        const int j0 = 8 * fq;
#pragma unroll
        for (int ai = 0; ai < 2; ++ai)
#pragma unroll
            for (int m = 0; m < 4; ++m) {
                const int t = t0 + ai * 128 + m * 16; const size_t mrow = (size_t)bb * SEQ + t; const size_t prow = (size_t)bb * LP + 128 + t; const int pos = t + NMETA;
                const f32x4 a00 = acc[ai][0][m][0], a01 = acc[ai][0][m][1], a10 = acc[ai][1][m][0], a11 = acc[ai][1][m][1];
                if (pn <= 1) { u32x4 lo, hi; rope8(a00, a01, a10, a11, COS + pos * 32 + j0, SIN + pos * 32 + j0, lo, hi, 1.f);
                    bf16_t* q = (bf16_t*)(ws + WS_QA) + mrow * 512 + (4 * pn + wc) * 64 + j0; ST16(q, lo); ST16((q + 32), hi); }
                else if (pn == 2) {
                    if (wc < 2) { u32x4 lo, hi; rope8(a00, a01, a10, a11, COS + pos * 32 + j0, SIN + pos * 32 + j0, lo, hi, 1.f);
                        bf16_t* k = (bf16_t*)(ws + WS_KA) + prow * 128 + wc * 64 + j0; ST16(k, lo); ST16((k + 32), hi); }
                    else { bf16_t* v = (bf16_t*)(ws + WS_VA) + prow * 128 + 32 * (wc - 2) + j0; ST16(v, pg8::pack8(a00, a01)); ST16((v + 64), pg8::pack8(a10, a11)); } }
                else if (pn <= 4) {
                    bf16_t* c = (bf16_t*)(ws + (pn == 3 ? WS_CQ : WS_CKV)) + mrow * 256 + 32 * wc + j0; ST16(c, pg8::pack8(a00, a01)); ST16((c + 128), pg8::pack8(a10, a11));
                    const f32x4 q = a00 * a00 + a01 * a01 + a10 * a10 + a11 * a11; float s = (q[0] + q[1]) + (q[2] + q[3]);
                    s += __shfl_xor(s, 16); s += __shfl_xor(s, 32);
                    if (fq == 0) ((float*)(ws + (pn == 3 ? WS_CQS : WS_CKVS)))[mrow * 4 + wc] = s; }
                else { if (wc == 0) { u32x4 lo, hi; rope8(a00, a01, a10, a11, COS + pos * 32 + j0, SIN + pos * 32 + j0, lo, hi, 1.f);
                        bf16_t* k = (bf16_t*)(ws + WS_KM) + prow * 768 + 128 + j0;
#pragma unroll
                        for (int h = 0; h < 4; ++h) { ST16((k + h * 192), lo); ST16((k + h * 192 + 32), hi); } } }
            }
    }
};

struct UpOrder {
    const char* CQ; const char* CKV; const char* Wq; const char* Wkv; int G, c;
    __device__ bool next(int i, pg8::Unit& u) const {
        if (G % 8 == 0) { const int x = c & 7, slot = c >> 3, ns = G >> 3; const int j = i * ns + slot;
            if (j >= 112) return false;
            if (j < 48) { u.pm = x + 8 * (j / 3); u.pn = j % 3; } else { const int j2 = j - 48; u.pm = x + 8 * (j2 >> 2); u.pn = 3 + (j2 & 3); }
            return true; }
        int L = i * G + c; if (L >= 896) return false;
        if (L < 384) { u.pm = L / 3; u.pn = L % 3; } else { L -= 384; u.pm = L >> 2; u.pn = 3 + (L & 3); }
        return true;
    }
    __device__ __forceinline__ const char* abase(const pg8::Unit& u) const { return (u.pn < 3 ? CQ : CKV) + (size_t)u.pm * 256 * 256 * 2; }
    __device__ __forceinline__ const char* bbase(const pg8::Unit& u) const { return u.pn < 3 ? Wq + (size_t)u.pn * 256 * 256 * 2 : Wkv + (size_t)(u.pn - 3) * 256 * 256 * 2; }
    __device__ __forceinline__ unsigned arow_off(const pg8::Unit&, int R) const { return (unsigned)(R * 256) * 2u; }
};
struct EpiUp {
    static constexpr bool PERM = true, MIDK = false;
    unsigned char* ws;
    __device__ __forceinline__ void operator()(const f32x4 (&acc)[2][2][4][2], const pg8::Unit& u, int wr, int wc, int fr, int fq) const {
        const int pn = u.pn, bb = u.pm >> 5, tb = (u.pm & 31) * 256;
        const size_t m0 = (size_t)bb * SEQ + tb, p0 = (size_t)bb * LP + 128 + tb;
        const char* COSb = (const char*)(ws + WS_COS) + (size_t)(tb + NMETA) * 128; const char* SINb = (const char*)(ws + WS_SIN) + (size_t)(tb + NMETA) * 128;
        const char* SSb = (const char*)(ws + (pn < 3 ? WS_CQS : WS_CKVS)) + m0 * 16;
        char* QMb = (char*)(ws + WS_QM) + m0 * 1536; char* KMb = (char*)(ws + WS_KM) + p0 * 1536; char* VMb = (char*)(ws + WS_VM) + p0 * 1024;
        int rl = wr * 64 + fr; asm volatile("" : "+v"(rl));
        const int j0 = 8 * fq;
        f32x4 sv[8];
#pragma unroll
        for (int q = 0; q < 8; ++q) sv[q] = *(const f32x4*)(SSb + (size_t)((unsigned)(rl + (q >> 2) * 128 + (q & 3) * 16) * 16u));
#pragma unroll
        for (int ai = 0; ai < 2; ++ai)
#pragma unroll
            for (int m = 0; m < 4; ++m) {
                const unsigned r = (unsigned)(rl + ai * 128 + m * 16); const f32x4 s4 = sv[ai * 4 + m];
                const float rstd = 1.f / sqrtf(((s4[0] + s4[1]) + (s4[2] + s4[3])) * (1.f / 256.f) + RMS_EPS);
                const f32x4 a00 = acc[ai][0][m][0] * rstd, a01 = acc[ai][0][m][1] * rstd, a10 = acc[ai][1][m][0] * rstd, a11 = acc[ai][1][m][1] * rstd;
                if (pn < 2) { char* q = QMb + (size_t)(r * 1536u + (unsigned)(((2 * pn) * 192 + 32 * wc + j0) * 2)); ST16(q, pg8::pack8(a00, a01)); ST16((q + 384), pg8::pack8(a10, a11)); }
                else if (pn == 2) { u32x4 lo, hi; const unsigned co = r * 128u + (unsigned)(j0 * 4); rope8(a00, a01, a10, a11, (const float*)(COSb + (size_t)co), (const float*)(SINb + (size_t)co), lo, hi, 1.f);
                    char* q = QMb + (size_t)(r * 1536u + (unsigned)((wc * 192 + 128 + j0) * 2)); ST16(q, lo); ST16((q + 64), hi); }
                else { const int h = pn - 3;
                    ST16(KMb + (size_t)(r * 1536u + (unsigned)((h * 192 + 32 * wc + j0) * 2)), pg8::pack8(a00, a01));
                    ST16(VMb + (size_t)(r * 1024u + (unsigned)((h * 128 + 32 * wc + j0) * 2)), pg8::pack8(a10, a11)); }
            }
    }
};

#ifndef ATT_PIPE
#define ATT_PIPE 0
#endif
#ifndef ATT_QKT_PF
#define ATT_QKT_PF 3
#endif
#ifndef ATT_QKT_GROUP
#define ATT_QKT_GROUP 0
#endif
#ifndef ATT_PF0
#define ATT_PF0 4
#endif
#ifndef ATT_HALF
#define ATT_HALF 0
#endif
#ifndef ATT_SKEW
#define ATT_SKEW 1
#endif
namespace att {
typedef short s16x4 __attribute__((ext_vector_type(4)));
typedef float f32x16 __attribute__((ext_vector_type(16)));
constexpr int NW = 8, QBLK = 32, KVBLK = 64, QB = NW * QBLK;
#define SBAR() __builtin_amdgcn_sched_barrier(0)
__device__ __forceinline__ int crow(int r, int hi) { return (r & 3) + 8 * (r >> 2) + 4 * hi; }
typedef float f32x2_t __attribute__((ext_vector_type(2))); typedef __bf16 bf16x2_t __attribute__((ext_vector_type(2)));
__device__ __forceinline__ unsigned cvtpk(float lo, float hi) { const f32x2_t v = {lo, hi}; const bf16x2_t b = __builtin_convertvector(v, bf16x2_t); return __builtin_bit_cast(unsigned, b); }
__device__ __forceinline__ int v_rd_base(int lane) { return ((lane & 3) << 3) | (((lane >> 2) & 3) << 6) | (((lane >> 4) & 1) << 5) | (((lane >> 5) & 1) << 8); }

template <int DQK_, int DV_, int LDQ_, int LDK_, int LDV_, int W_, bool SK_, int NPARK_>
struct Cfg {
    static constexpr int DQK = DQK_, DV = DV_, LDQ = LDQ_, LDK = LDK_, LDV = LDV_, W = W_; static constexpr bool SK = SK_;
    static constexpr int ROWB = DQK * 2, SHM_K = KVBLK * ROWB, SHM_V = KVBLK * DV * 2;
    static constexpr int KCPR = DQK / 8, VCPR = DV / 8, NKC = KVBLK * KCPR / 512, NVC = KVBLK * VCPR / 512, KG = (DV / 32) * 512, NQF = DQK / 16, NOF = DV / 32;
    static constexpr int NPARK = NPARK_, NQR = DQK_ / 16 - NPARK_;
    static constexpr int WS_OFF = 2 * SHM_V + 2 * SHM_K, PARK_OFF = WS_OFF + NW * 64 * 4, LDS_BYTES = PARK_OFF + NW * NPARK_ * 1024;
};
template <class C> struct BlockRef { const bf16_t* Q; const bf16_t* K; const bf16_t* V; bf16_t* O; float* SSQ; int P0; float m0, l0, c2; };
template <class C> struct Seam { bf16x8 qr[C::NQR]; bf16x8 st_k[C::NKC]; bf16x8 st_v[C::NVC]; };

__device__ __forceinline__ void mask_tile(f32x16& p0, f32x16& p1, int dq, unsigned W, int klim) {
    const float NEG = -__builtin_inff();
#pragma unroll
    for (int r = 0; r < 16; ++r) {
        const int c = (r & 3) + 8 * (r >> 2);
        if ((unsigned)(dq - c) >= W || c < klim) p0[r] = NEG;
        if ((unsigned)(dq - c - 32) >= W || c + 32 < klim) p1[r] = NEG;
    }
}
__device__ __forceinline__ void partialSM(f32x16& p0, f32x16& p1, float& m_reg, float& mn, float& alpha, float c2, float thr) {
    float pmax = p0[0];
#pragma unroll
    for (int r = 1; r < 16; ++r) pmax = fmaxf(pmax, p0[r]);
#pragma unroll
    for (int r = 0; r < 16; ++r) pmax = fmaxf(pmax, p1[r]);
    { auto rr = __builtin_amdgcn_permlane32_swap(__float_as_uint(pmax), __float_as_uint(pmax), false, false);
      pmax = fmaxf(__uint_as_float(rr[0]), __uint_as_float(rr[1])); }
    if (__builtin_expect(__all((pmax - m_reg) <= thr), 1)) { mn = m_reg; alpha = 1.f; }
    else { mn = fmaxf(m_reg, pmax); alpha = __builtin_amdgcn_exp2f((m_reg - mn) * c2); m_reg = mn; }
    const float mnL = -mn * c2;
#pragma unroll
    for (int r = 0; r < 16; ++r) p0[r] = fmaf(p0[r], c2, mnL);
#pragma unroll
    for (int r = 0; r < 16; ++r) p1[r] = fmaf(p1[r], c2, mnL);
#pragma unroll
    for (int r = 0; r < 16; ++r) p0[r] = __builtin_amdgcn_exp2f(p0[r]);
}
__device__ __forceinline__ void finishSM(f32x16& p0, f32x16& p1, float alpha, float& l_reg, bf16x8& pa0, bf16x8& pa1, bf16x8& pa2, bf16x8& pa3) {
#pragma unroll
    for (int r = 0; r < 16; ++r) p1[r] = __builtin_amdgcn_exp2f(p1[r]);
    float ps = 0;
#pragma unroll
    for (int r = 0; r < 16; ++r) ps += p0[r];
#pragma unroll
    for (int r = 0; r < 16; ++r) ps += p1[r];
    { auto rr = __builtin_amdgcn_permlane32_swap(__float_as_uint(ps), __float_as_uint(ps), false, false);
      ps = __uint_as_float(rr[0]) + __uint_as_float(rr[1]); }
    l_reg = l_reg * alpha + ps;
#define PK4(P, B_, OUT) do { unsigned a0 = cvtpk(P[B_+0], P[B_+1]), a1 = cvtpk(P[B_+2], P[B_+3]);                          \
        unsigned b0 = cvtpk(P[B_+4], P[B_+5]), b1 = cvtpk(P[B_+6], P[B_+7]);                                             \
        auto r0 = __builtin_amdgcn_permlane32_swap(a0, b0, false, false); auto r1 = __builtin_amdgcn_permlane32_swap(a1, b1, false, false); \
        u32x4 w = {r0[0], r1[0], r0[1], r1[1]}; OUT = *reinterpret_cast<bf16x8*>(&w); } while (0)
    PK4(p0, 0, pa0); PK4(p0, 8, pa1); PK4(p1, 0, pa2); PK4(p1, 8, pa3);
#undef PK4
}
template <class C, int D0, int PF> struct QktSched { static __device__ __forceinline__ void run() {
    __builtin_amdgcn_sched_group_barrier(0x008, 2, 0);
    if constexpr (D0 + PF < C::NQF) __builtin_amdgcn_sched_group_barrier(0x100, 2 + ((D0 + PF >= C::NQR) ? 1 : 0), 0);
    if constexpr (D0 + 1 < C::NQF) QktSched<C, D0 + 1, PF>::run(); } };
template <class C, int KB>
__device__ __forceinline__ void qkt(f32x16& p0, f32x16& p1, const char* K_lds, int r32, int hi, const bf16x8* qr, const char* qpark, bool act) {
    if (C::SK && !act) { const float NEG = -__builtin_inff();
#pragma unroll
        for (int r = 0; r < 16; ++r) { p0[r] = NEG; p1[r] = NEG; } return; }
    p0 = f32x16{}; p1 = f32x16{};
    const char* kb[4];
#pragma unroll
    for (int dd = 0; dd < 4; ++dd) kb[dd] = K_lds + KB * C::SHM_K + r32 * C::ROWB + (((dd * 16 + hi * 8) * 2) ^ (((r32 >> 1) & 7) << 4));
#pragma unroll
    for (int d0 = 0; d0 < C::NQF; ++d0) { const char* a = kb[d0 & 3] + (d0 >> 2) * 128;
        bf16x8 b0 = *reinterpret_cast<const bf16x8*>(a);
        bf16x8 b1 = *reinterpret_cast<const bf16x8*>(a + 32 * C::ROWB);
        bf16x8 qf; if (d0 < C::NQR) qf = qr[d0 < C::NQR ? d0 : 0]; else qf = *reinterpret_cast<const bf16x8*>(qpark + (d0 - C::NQR) * 1024);
        p0 = __builtin_amdgcn_mfma_f32_32x32x16_bf16(b0, qf, p0, 0, 0, 0);
        p1 = __builtin_amdgcn_mfma_f32_32x32x16_bf16(b1, qf, p1, 0, 0, 0);
        if (ATT_QKT_GROUP && C::NQF > 8 && (d0 & 3) == 3) SBAR(); }
#if ATT_QKT_PF > 0
    { constexpr int PF = ATT_QKT_PF < C::NQF ? ATT_QKT_PF : C::NQF;
      __builtin_amdgcn_sched_group_barrier(0x100, 2 * PF + ((PF > C::NQR) ? (PF - C::NQR) : 0), 0);
      QktSched<C, 0, PF>::run(); }
#endif
}
template <class C, int D0, int PF> struct QktSchedD { static __device__ __forceinline__ void run() {
    __builtin_amdgcn_sched_group_barrier(0x008, 1, 0); __builtin_amdgcn_sched_group_barrier(0x400, 2, 0); __builtin_amdgcn_sched_group_barrier(0x002, 3, 0);
    __builtin_amdgcn_sched_group_barrier(0x008, 1, 0); __builtin_amdgcn_sched_group_barrier(0x400, 1, 0); __builtin_amdgcn_sched_group_barrier(0x002, 3, 0);
    if constexpr (D0 + PF < C::NQF) __builtin_amdgcn_sched_group_barrier(0x100, 2 + ((D0 + PF >= C::NQR) ? 1 : 0), 0);
    if constexpr (D0 + 1 < C::NQF) QktSchedD<C, D0 + 1, PF>::run(); } };
template <class C, int KB>
__device__ __forceinline__ void qkt_dummy(f32x16& p0, f32x16& p1, const char* K_lds, int r32, int hi, const bf16x8* qr, const char* qpark, f32x4& dmy) {
    p0 = f32x16{}; p1 = f32x16{};
    const char* kb[4];
#pragma unroll
    for (int dd = 0; dd < 4; ++dd) kb[dd] = K_lds + KB * C::SHM_K + r32 * C::ROWB + (((dd * 16 + hi * 8) * 2) ^ (((r32 >> 1) & 7) << 4));
    f32x4 d2 = dmy;
#pragma unroll
    for (int d0 = 0; d0 < C::NQF; ++d0) { const char* a = kb[d0 & 3] + (d0 >> 2) * 128;
        bf16x8 b0 = *reinterpret_cast<const bf16x8*>(a);
        bf16x8 b1 = *reinterpret_cast<const bf16x8*>(a + 32 * C::ROWB);
        bf16x8 qf; if (d0 < C::NQR) qf = qr[d0 < C::NQR ? d0 : 0]; else qf = *reinterpret_cast<const bf16x8*>(qpark + (d0 - C::NQR) * 1024);
        p0 = __builtin_amdgcn_mfma_f32_32x32x16_bf16(b0, qf, p0, 0, 0, 0);
        p1 = __builtin_amdgcn_mfma_f32_32x32x16_bf16(b1, qf, p1, 0, 0, 0);
#pragma unroll
        for (int e = 0; e < 3; ++e) { const int i = (d0 * 3 + e) & 3; d2[i] = __builtin_amdgcn_exp2f(d2[i]); d2[(i + 1) & 3] = fmaf(d2[(i + 1) & 3], 1.0001f, d2[i]); d2[(i + 2) & 3] = fmaf(d2[(i + 2) & 3], 0.9999f, d2[i]); }
    }
    dmy = d2;
    { __builtin_amdgcn_sched_group_barrier(0x100, 6 + ((3 > C::NQR) ? (3 - C::NQR) : 0), 0);
      QktSchedD<C, 0, 3>::run(); }
}
template <class C, int VB>
__device__ __forceinline__ void pv_tile(f32x16* o, int vb0, bf16x8 pa0, bf16x8 pa1, bf16x8 pa2, bf16x8 pa3, bool act) {
    if (C::SK && !act) return;
#define TRRD(dst, off) asm volatile("ds_read_b64_tr_b16 %0, %1 offset:%2" : "=&v"(dst) : "v"(vb0), "i"(off) : "memory")
#define PV_RD(S_, d0) do { constexpr int b_ = VB * C::SHM_V + (d0) * 512; constexpr int KG_ = C::KG;   \
        TRRD(l0##S_, b_); TRRD(h0##S_, b_ + KG_); TRRD(l1##S_, b_ + 2 * KG_); TRRD(h1##S_, b_ + 3 * KG_); TRRD(l2##S_, b_ + 4 * KG_); TRRD(h2##S_, b_ + 5 * KG_); TRRD(l3##S_, b_ + 6 * KG_); TRRD(h3##S_, b_ + 7 * KG_); } while (0)
#define PV_MM(S_, d0) do {   \
        o[d0] = __builtin_amdgcn_mfma_f32_32x32x16_bf16(pa0, (bf16x8){l0##S_[0], l0##S_[1], l0##S_[2], l0##S_[3], h0##S_[0], h0##S_[1], h0##S_[2], h0##S_[3]}, o[d0], 0, 0, 0);   \
        o[d0] = __builtin_amdgcn_mfma_f32_32x32x16_bf16(pa1, (bf16x8){l1##S_[0], l1##S_[1], l1##S_[2], l1##S_[3], h1##S_[0], h1##S_[1], h1##S_[2], h1##S_[3]}, o[d0], 0, 0, 0);   \
        o[d0] = __builtin_amdgcn_mfma_f32_32x32x16_bf16(pa2, (bf16x8){l2##S_[0], l2##S_[1], l2##S_[2], l2##S_[3], h2##S_[0], h2##S_[1], h2##S_[2], h2##S_[3]}, o[d0], 0, 0, 0);   \
        o[d0] = __builtin_amdgcn_mfma_f32_32x32x16_bf16(pa3, (bf16x8){l3##S_[0], l3##S_[1], l3##S_[2], l3##S_[3], h3##S_[0], h3##S_[1], h3##S_[2], h3##S_[3]}, o[d0], 0, 0, 0); } while (0)
#define PV_W8() do { asm volatile("s_waitcnt lgkmcnt(8)" ::: "memory"); SBAR(); } while (0)
#define PV_W0() do { asm volatile("s_waitcnt lgkmcnt(0)" ::: "memory"); SBAR(); } while (0)
    s16x4 l0A, l1A, l2A, l3A, h0A, h1A, h2A, h3A, l0B, l1B, l2B, l3B, h0B, h1B, h2B, h3B;
    SBAR(); asm volatile("s_waitcnt lgkmcnt(0)" ::: "memory");
    PV_RD(A, 0); PV_RD(B, 1); PV_W8(); PV_MM(A, 0); SBAR();
    if constexpr (C::NOF == 4) { PV_RD(A, 2); PV_W8(); PV_MM(B, 1); SBAR(); PV_RD(B, 3); PV_W8(); PV_MM(A, 2); SBAR(); PV_W0(); PV_MM(B, 3); }
    else { PV_W0(); PV_MM(B, 1); }
    SBAR();
#undef PV_RD
#undef PV_MM
#undef PV_W8
#undef PV_W0
#undef TRRD
}
template <class C> __device__ __forceinline__ int jlo(int P0) { const int lowk = P0 - C::W + 1; int j = lowk > 0 ? lowk / KVBLK : 0; const int jm = NPAD / KVBLK; return j < jm ? jm : j; }

#define AT_RSRC(p) __builtin_amdgcn_make_buffer_rsrc((void*)(p), 0, 0x7fffffff, 0x00020000)
#define AT_BLD(rs, vo, so) __builtin_bit_cast(bf16x8, __builtin_amdgcn_raw_buffer_load_b128((rs), (int)(vo), (int)(so), 0))
#define AT_SLOAD(Kp, Vp, k0) do { const __amdgpu_buffer_rsrc_t kr__ = AT_RSRC(Kp), vr__ = AT_RSRC(Vp); const int ks__ = (k0) * (C::LDK * 2), vs__ = (k0) * (C::LDV * 2); \
    _Pragma("unroll") for (int i_ = 0; i_ < C::NVC; ++i_) S.st_v[i_] = AT_BLD(vr__, vgo + (unsigned)(i_ * 128), vs__); \
    _Pragma("unroll") for (int i_ = 0; i_ < C::NKC; ++i_) S.st_k[i_] = AT_BLD(kr__, kgo + (unsigned)(i_ * 128), ks__); } while (0)
#define AT_LOAD_K(Kp, k0) do { const __amdgpu_buffer_rsrc_t kr__ = AT_RSRC(Kp); const int ks__ = (k0) * (C::LDK * 2); \
    _Pragma("unroll") for (int i_ = 0; i_ < C::NKC; ++i_) S.st_k[i_] = AT_BLD(kr__, kgo + (unsigned)(i_ * 128), ks__); } while (0)
#define AT_LOAD_V(Vp, k0) do { const __amdgpu_buffer_rsrc_t vr__ = AT_RSRC(Vp); const int vs__ = (k0) * (C::LDV * 2); \
    _Pragma("unroll") for (int i_ = 0; i_ < C::NVC; ++i_) S.st_v[i_] = AT_BLD(vr__, vgo + (unsigned)(i_ * 128), vs__); } while (0)
#define AT_SWRITE_K(bf) do { _Pragma("unroll") for (int i_ = 0; i_ < C::NKC; ++i_) *(bf16x8*)(K_lds + (bf) * C::SHM_K + klo + i_ * 128) = S.st_k[i_]; } while (0)
#define AT_SWRITE_V(bf) do { _Pragma("unroll") for (int i_ = 0; i_ < C::NVC; ++i_) *(bf16x8*)(V_lds + (bf) * C::SHM_V + vlo + i_ * 1024) = S.st_v[i_]; } while (0)
#define AT_STAGE_OFFS() \
    const int srow_ = tid >> 3, scc_ = tid & 7; \
    const unsigned kgo = (unsigned)(srow_ * C::LDK + scc_ * 8) * 2u, vgo = (unsigned)(srow_ * C::LDV + scc_ * 8) * 2u; \
    const int klo = srow_ * C::ROWB + ((scc_ * 16) ^ (((srow_ >> 1) & 7) << 4)); \
    const int skk_ = (srow_ & ~0xC) | ((srow_ & 4) << 1) | ((srow_ & 8) >> 1); \
    const int vlo = ((skk_ >> 3) * C::NOF + (scc_ >> 2)) * 512 + ((skk_ & 7) * 32 + (scc_ & 3) * 8) * 2;
#define AT_VMW() asm volatile("s_waitcnt vmcnt(0)" ::: "memory")
#define AT_VMWN(n) asm volatile("s_waitcnt vmcnt(%0)" :: "i"(n) : "memory")

#define AT_QLOAD(Qp) do { bf16x8 qp_[C::NPARK > 0 ? C::NPARK : 1]; \
    const __amdgpu_buffer_rsrc_t qr__ = AT_RSRC(Qp); const int qs__ = wid * (QBLK * C::LDQ * 2); const unsigned qo__ = (unsigned)(r32 * C::LDQ + hi * 8) * 2u; \
    _Pragma("unroll") for (int d0 = 0; d0 < C::NPARK; ++d0) qp_[d0] = AT_BLD(qr__, qo__ + (unsigned)((C::NQR + d0) * 32), qs__); \
    _Pragma("unroll") for (int d0 = 0; d0 < C::NQR; ++d0) S.qr[d0] = AT_BLD(qr__, qo__ + (unsigned)(d0 * 32), qs__); \
    SBAR(); AT_VMWN(C::NQR); \
    _Pragma("unroll") for (int d0 = 0; d0 < C::NPARK; ++d0) *(bf16x8*)(qpark + d0 * 1024) = qp_[d0]; } while (0)
template <class C>
__device__ __forceinline__ void prime(const BlockRef<C>& cur, char* lds, Seam<C>& S, const int tid) {
    const int wid = __builtin_amdgcn_readfirstlane(tid >> 6), lane = tid & 63, r32 = lane & 31, hi = lane >> 5;
    char* K_lds = lds + 2 * C::SHM_V;
    AT_STAGE_OFFS()
    const int kb0 = jlo<C>(cur.P0) * KVBLK;
    char* qpark = lds + C::PARK_OFF + wid * (C::NPARK * 1024) + lane * 16;
    AT_SLOAD(cur.K, cur.V, kb0); SBAR(); AT_QLOAD(cur.Q); AT_VMW(); AT_SWRITE_K(0);
    __syncthreads();
}
template <class C>
__device__ __forceinline__ void block(const BlockRef<C>& cur, const BlockRef<C>& nxt, char* lds, Seam<C>& S, int ssq_slot, const int tid) {
    constexpr bool SK = C::SK; constexpr int W = C::W;
    const int wid = __builtin_amdgcn_readfirstlane(tid >> 6), lane = tid & 63, r32 = lane & 31, hi = lane >> 5;
    const int j_lo = jlo<C>(cur.P0);
    const int j_hi = (cur.P0 + QB - 1) / KVBLK + 1;
    const int NT = j_hi - j_lo;
    const int kbn = jlo<C>(nxt.P0) * KVBLK;
    const int qlo = cur.P0 + wid * QBLK, qm = qlo + r32 - 4 * hi;
    char* V_lds = lds; char* K_lds = lds + 2 * C::SHM_V;
    AT_STAGE_OFFS()
    float* ws = (float*)(lds + C::WS_OFF) + wid * 64; float* li_l = ws, * al_l = ws + 32;
    char* qpark = lds + C::PARK_OFF + wid * (C::NPARK * 1024) + lane * 16;
    float m_reg = cur.m0, l_reg = cur.l0; const float c2 = cur.c2, thr = 8.f * 1.4426950408889634f / c2;
    f32x16 o[C::NOF];
#pragma unroll
    for (int d_ = 0; d_ < C::NOF; ++d_) o[d_] = f32x16{};
    const int vb0 = (int)(uintptr_t)V_lds + v_rd_base(lane);
    const bf16_t* Kh = cur.K; const bf16_t* Vh = cur.V;
#define RESC(a) do { if (__any((a) < 1.f)) { if (hi == 0) al_l[r32] = (a); asm volatile("s_waitcnt lgkmcnt(0)" ::: "memory");              \
                     _Pragma("unroll") for (int d_ = 0; d_ < C::NOF; ++d_) _Pragma("unroll") for (int r = 0; r < 16; ++r) o[d_][r] *= al_l[crow(r, hi)]; } } while (0)
#define KBASE(t) ((j_lo + (t)) * KVBLK)
#define ACT(t) (KBASE(t) <= qlo + QBLK - 1 && KBASE(t) + KVBLK - 1 >= qlo - W + 1)
#define MASKT(P0_, P1_, t) do { const int kb_ = KBASE(t); if ((!SK || ACT(t)) && (kb_ + KVBLK - 1 > qlo || kb_ <= qlo + QBLK - 1 - W || kb_ < NPAD)) mask_tile(P0_, P1_, qm - kb_, (unsigned)W, NPAD - kb_ - 4 * hi); } while (0)
#if ATT_PIPE
    f32x16 pA0, pA1, pB0, pB1; float mnA, mnB, alA, alB; bf16x8 pa0, pa1, pa2, pa3;
    AT_SWRITE_V(0); SBAR();
    if (NT > 1) { AT_SLOAD(Kh, Vh, KBASE(1)); }
    SBAR(); qkt<C, 0>(pA0, pA1, K_lds, r32, hi, S.qr, qpark, ACT(0));
    MASKT(pA0, pA1, 0); partialSM(pA0, pA1, m_reg, mnA, alA, c2, thr);
    if (NT > 1) { AT_VMW(); AT_SWRITE_V(1); AT_SWRITE_K(1); }
    __syncthreads();
#define HALF_STEP(PX0, PX1, mnX, alX, PY0, PY1, alY, t, KB, VB, SB) do {                                                      \
        SBAR(); qkt<C, KB>(PX0, PX1, K_lds, r32, hi, S.qr, qpark, ACT(t));                                                  \
        finishSM(PY0, PY1, alY, l_reg, pa0, pa1, pa2, pa3); SBAR();                                                           \
        if ((t) + 1 < NT) { AT_SLOAD(Kh, Vh, KBASE((t) + 1)); SBAR(); }                                               \
        pv_tile<C, VB>(o, vb0, pa0, pa1, pa2, pa3, ACT((t) - 1)); MASKT(PX0, PX1, (t)); partialSM(PX0, PX1, m_reg, mnX, alX, c2, thr);       \
        __syncthreads();                                                                                                      \
        if ((t) + 1 < NT) { AT_VMW(); if (SB) { AT_SWRITE_V(1); AT_SWRITE_K(1); } else { AT_SWRITE_V(0); AT_SWRITE_K(0); } }                                                                          \
        RESC(alX); __syncthreads(); } while (0)
    for (int t = 1; t + 1 < NT; t += 2) {
        HALF_STEP(pB0, pB1, mnB, alB, pA0, pA1, alA, t, 1, 0, 0);
        HALF_STEP(pA0, pA1, mnA, alA, pB0, pB1, alB, t + 1, 0, 1, 1);
    }
#undef HALF_STEP
    const bool even = (NT & 1) == 0;
    if (even) { SBAR(); qkt<C, 1>(pB0, pB1, K_lds, r32, hi, S.qr, qpark, ACT(NT - 1)); SBAR(); }
    AT_SLOAD(nxt.K, nxt.V, kbn); SBAR();
    finishSM(pA0, pA1, alA, l_reg, pa0, pa1, pa2, pa3); SBAR();
    pv_tile<C, 0>(o, vb0, pa0, pa1, pa2, pa3, ACT(even ? NT - 2 : NT - 1));
    if (even) { MASKT(pB0, pB1, NT - 1); partialSM(pB0, pB1, m_reg, mnB, alB, c2, thr); __syncthreads(); RESC(alB);
        finishSM(pB0, pB1, alB, l_reg, pa0, pa1, pa2, pa3); SBAR(); pv_tile<C, 1>(o, vb0, pa0, pa1, pa2, pa3, ACT(NT - 1)); }
    SBAR();
    AT_QLOAD(nxt.Q);
    AT_SWRITE_K(0); SBAR();
#else
    f32x16 P0, P1; float mn, al; bf16x8 pa0, pa1, pa2, pa3;
    AT_SWRITE_V(0); __syncthreads();
#define STEP(t, B_, NB_) do { const bool more_ = (t) + 1 < NT;                                                              \
        SBAR(); if (more_) { AT_SLOAD(Kh, Vh, KBASE((t) + 1)); } else { AT_SLOAD(nxt.K, nxt.V, kbn); } SBAR();              \
        qkt<C, B_>(P0, P1, K_lds, r32, hi, S.qr, qpark, ACT(t)); SBAR();                                                   \
        MASKT(P0, P1, (t)); partialSM(P0, P1, m_reg, mn, al, c2, thr); RESC(al);                                            \
        finishSM(P0, P1, al, l_reg, pa0, pa1, pa2, pa3); SBAR();                                                             \
        pv_tile<C, B_>(o, vb0, pa0, pa1, pa2, pa3, ACT(t)); SBAR();                                                        \
        if (more_) { AT_VMW(); AT_SWRITE_V(NB_); AT_SWRITE_K(NB_); }                                                        \
        __syncthreads(); } while (0)
    int t = 0;
    for (; t + 1 < NT; t += 2) { STEP(t, 0, 1); STEP(t + 1, 1, 0); }
    if (t < NT) { STEP(t, 0, 1); }
#undef STEP
    AT_QLOAD(nxt.Q);
    AT_SWRITE_K(0); SBAR();
#endif
    if (hi == 0) li_l[r32] = l_reg; asm volatile("s_waitcnt lgkmcnt(0)" ::: "memory");
    float rli[16], sq[16];
#pragma unroll
    for (int r = 0; r < 16; ++r) { rli[r] = __builtin_amdgcn_rcpf(li_l[crow(r, hi)]); sq[r] = 0.f; }
    char* Ow = (char*)(cur.O + (size_t)(wid * QBLK) * 1024); const unsigned oo = (unsigned)(4 * hi * 1024 + r32) * 2u;
#pragma unroll
    for (int r = 0; r < 16; ++r) {
#pragma unroll
        for (int d0 = 0; d0 < C::NOF; ++d0) { const float v = o[d0][r] * rli[r]; sq[r] += v * v;
            const float vn = __shfl_xor(v, 1);
            if ((r32 & 1) == 0) *(unsigned*)(Ow + (size_t)(oo + (unsigned)((((r & 3) + 8 * (r >> 2)) * 1024 + d0 * 32) * 2))) = cvtpk(v, vn); } }
    float sel = 0.f; int r32e = r32, hie = hi; asm volatile("" : "+v"(r32e), "+v"(hie));
#pragma unroll
    for (int r = 0; r < 16; ++r) { float s = sq[r]; s += __shfl_xor(s, 1); s += __shfl_xor(s, 2); s += __shfl_xor(s, 4); s += __shfl_xor(s, 8); s += __shfl_xor(s, 16); sel = (r32e == r) ? s : sel; }
    if (r32e < 16) *(float*)((char*)(cur.SSQ + (size_t)(wid * QBLK) * 12 + ssq_slot) + (size_t)((unsigned)crow(r32e, hie) * 48u)) = sel;
    __syncthreads();
#undef RESC
#undef KBASE
#undef ACT
#undef MASKT
}

template <class C, int XP = 0>
__device__ __forceinline__ void block2(const BlockRef<C>& cur, char* lds, Seam<C>& S, int ssq_slot, const int tid) {
    constexpr bool SK = C::SK; constexpr int W = C::W;
    const int wid = __builtin_amdgcn_readfirstlane(tid >> 6), lane = tid & 63, r32 = lane & 31, hi = lane >> 5, g = wid >> 2;
    const int j_lo = jlo<C>(cur.P0);
    const int j_hi = (cur.P0 + QB - 1) / KVBLK + 1;
    const int NT = j_hi - j_lo;
    const int qlo = cur.P0 + wid * QBLK, qm = qlo + r32 - 4 * hi;
    char* V_lds = lds; char* K_lds = lds + 2 * C::SHM_V;
    AT_STAGE_OFFS()
    float* ws = (float*)(lds + C::WS_OFF) + wid * 64; float* li_l = ws, * al_l = ws + 32;
    char* qpark = lds + C::PARK_OFF + wid * (C::NPARK * 1024) + lane * 16;
    float m_reg = cur.m0, l_reg = cur.l0; const float c2 = cur.c2, thr = 8.f * 1.4426950408889634f / c2;
    f32x16 o[C::NOF];
#pragma unroll
    for (int d_ = 0; d_ < C::NOF; ++d_) o[d_] = f32x16{};
    const int vb0 = (int)(uintptr_t)V_lds + v_rd_base(lane);
    const bf16_t* Kh = cur.K; const bf16_t* Vh = cur.V;
#define RESC(a) do { if (__any((a) < 1.f)) { if (hi == 0) al_l[r32] = (a); asm volatile("s_waitcnt lgkmcnt(0)" ::: "memory");              \
                     _Pragma("unroll") for (int d_ = 0; d_ < C::NOF; ++d_) _Pragma("unroll") for (int r = 0; r < 16; ++r) o[d_][r] *= al_l[crow(r, hi)]; } } while (0)
#define KBASE(t) ((j_lo + (t)) * KVBLK)
#define ACT(t) (KBASE(t) <= qlo + QBLK - 1 && KBASE(t) + KVBLK - 1 >= qlo - W + 1)
#define MASKT(P0_, P1_, t) do { const int kb_ = KBASE(t); if ((!SK || ACT(t)) && (kb_ + KVBLK - 1 > qlo || kb_ <= qlo + QBLK - 1 - W || kb_ < NPAD)) mask_tile(P0_, P1_, qm - kb_, (unsigned)W, NPAD - kb_ - 4 * hi); } while (0)
#define BAR2() asm volatile("s_waitcnt lgkmcnt(0)\n\ts_barrier" ::: "memory")
#define LOADPAIR(tau) do { const int tau_ = (tau); if (tau_ < NT) { AT_LOAD_V(Vh, KBASE(tau_)); } if (tau_ + 1 < NT) { AT_LOAD_K(Kh, KBASE(tau_ + 1)); } } while (0)
#define WRITEPAIR(tau) do { const int tau_ = (tau); if (tau_ < NT) { AT_VMW(); AT_SWRITE_V(tau_ & 1); if (tau_ + 1 < NT) { AT_SWRITE_K((tau_ + 1) & 1); } } } while (0)
    AT_QLOAD(cur.Q);
    AT_LOAD_K(Kh, KBASE(0)); AT_VMW(); AT_SWRITE_K(0);
    if (g == 1) { AT_LOAD_V(Vh, KBASE(0)); AT_LOAD_K(Kh, KBASE(1)); AT_VMW(); AT_SWRITE_V(0); AT_SWRITE_K(1); }
    LOADPAIR(g);
    BAR2();
    if (g == 1) BAR2();
    f32x4 dmy = {0.f, 0.f, 0.f, 0.f}; asm volatile("" : "+v"(dmy));
    f32x16 P0 = f32x16{}, P1 = f32x16{}; float mn, al = 1.f; bf16x8 pa0 = bf16x8{}, pa1 = bf16x8{}, pa2 = bf16x8{}, pa3 = bf16x8{};
    qkt<C, 0>(P0, P1, K_lds, r32, hi, S.qr, qpark, ACT(0)); BAR2();
#define SSTAGE(t) do { if (XP != 1 && XP != 4) { MASKT(P0, P1, (t)); partialSM(P0, P1, m_reg, mn, al, c2, thr); RESC(al); finishSM(P0, P1, al, l_reg, pa0, pa1, pa2, pa3); } SBAR();   \
        if (XP != 2) { WRITEPAIR((t) + g); LOADPAIR((t) + g + 1); } BAR2(); } while (0)
#define MSTAGE(t, VB_, KB_) do { if (XP != 3) { pv_tile<C, VB_>(o, vb0, pa0, pa1, pa2, pa3, ACT(t)); SBAR();                                  \
        if ((t) + 1 < NT) { if (XP == 4) { qkt_dummy<C, KB_>(P0, P1, K_lds, r32, hi, S.qr, qpark, dmy); } else { qkt<C, KB_>(P0, P1, K_lds, r32, hi, S.qr, qpark, ACT((t) + 1)); } } } BAR2(); } while (0)
    int t = 0;
    for (; t + 1 < NT; t += 2) { SSTAGE(t); MSTAGE(t, 0, 1); SSTAGE(t + 1); MSTAGE(t + 1, 1, 0); }
    if (t < NT) { SSTAGE(t); MSTAGE(t, 0, 1); }
#undef SSTAGE
#undef MSTAGE
#undef LOADPAIR
#undef WRITEPAIR
    if (hi == 0) li_l[r32] = l_reg; asm volatile("s_waitcnt lgkmcnt(0)" ::: "memory");
    float rli[16], sq[16];
#pragma unroll
    for (int r = 0; r < 16; ++r) { rli[r] = __builtin_amdgcn_rcpf(li_l[crow(r, hi)]); sq[r] = 0.f; }
    char* Ow = (char*)(cur.O + (size_t)(wid * QBLK) * 1024); const unsigned oo = (unsigned)(4 * hi * 1024 + r32) * 2u;
#pragma unroll
    for (int r = 0; r < 16; ++r) {
#pragma unroll
        for (int d0 = 0; d0 < C::NOF; ++d0) { const float v = o[d0][r] * rli[r]; sq[r] += v * v;
            const float vn = __shfl_xor(v, 1);
            if (XP == 0 && (r32 & 1) == 0) *(unsigned*)(Ow + (size_t)(oo + (unsigned)((((r & 3) + 8 * (r >> 2)) * 1024 + d0 * 32) * 2))) = cvtpk(v, vn);
            if (XP != 0) asm volatile("" :: "v"(v)); } }
    float sel = 0.f; int r32e = r32, hie = hi; asm volatile("" : "+v"(r32e), "+v"(hie));
#pragma unroll
    for (int r = 0; r < 16; ++r) { float s = sq[r]; s += __shfl_xor(s, 1); s += __shfl_xor(s, 2); s += __shfl_xor(s, 4); s += __shfl_xor(s, 8); s += __shfl_xor(s, 16); sel = (r32e == r) ? s : sel; }
    if (XP == 0 && r32e < 16) *(float*)((char*)(cur.SSQ + (size_t)(wid * QBLK) * 12 + ssq_slot) + (size_t)((unsigned)crow(r32e, hie) * 48u)) = sel;
    if (XP != 0) asm volatile("" :: "v"(sel), "v"(dmy));
    if (g == 0) BAR2();
    BAR2();
#undef BAR2
#undef RESC
#undef KBASE
#undef ACT
#undef MASKT
}

typedef __attribute__((address_space(3))) const char* lds_cptr;
typedef short v4i16_t __attribute__((ext_vector_type(4)));
__device__ __forceinline__ s16x4 vtr(lds_cptr p) { return __builtin_bit_cast(s16x4, __builtin_amdgcn_ds_read_tr16_b64_v4i16((__attribute__((address_space(3))) v4i16_t*)p)); }
__device__ __forceinline__ void mask_half(f32x16& p, int dq, unsigned W, int klim) {
    const float NEG = -__builtin_inff();
#pragma unroll
    for (int r = 0; r < 16; ++r) { const int c = (r & 3) + 8 * (r >> 2); if ((unsigned)(dq - c) >= W || c < klim) p[r] = NEG; }
}
template <int NDS> struct StepSched { static __device__ __forceinline__ void run() {
    __builtin_amdgcn_sched_group_barrier(0x100, ATT_PF0, 0);
#define G_(n) __builtin_amdgcn_sched_group_barrier(0x008, 1, 0); if constexpr (ATT_PF0 + 2 * (n) < NDS) __builtin_amdgcn_sched_group_barrier(0x100, (NDS - ATT_PF0 - 2 * (n)) >= 2 ? 2 : 1, 0); \
              __builtin_amdgcn_sched_group_barrier(0x002, 4, 0); __builtin_amdgcn_sched_group_barrier(0x400, 1, 0);
    G_(0) G_(1) G_(2) G_(3) G_(4) G_(5) G_(6) G_(7) G_(8) G_(9) G_(10) G_(11) G_(12) G_(13) G_(14) G_(15) G_(16) G_(17) G_(18) G_(19)
#undef G_
} };
template <class C, int XP = 0>
__device__ __forceinline__ void block3(const BlockRef<C>& cur, char* lds, Seam<C>& S, int ssq_slot, const int tid) {
    static_assert(!C::SK && C::NOF == 4, "block3: causal, DV = 128");
    constexpr int W = C::W;
    const int wid = __builtin_amdgcn_readfirstlane(tid >> 6), lane = tid & 63, r32 = lane & 31, hi = lane >> 5;
    const int j_lo = jlo<C>(cur.P0);
    const int j_hi = (cur.P0 + QB - 1) / KVBLK + 1;
    const int NT = j_hi - j_lo;
    const int qlo = cur.P0 + wid * QBLK, qm = qlo + r32 - 4 * hi;
    char* V_lds = lds; char* K_lds = lds + 2 * C::SHM_V;
    AT_STAGE_OFFS()
    float* ws = (float*)(lds + C::WS_OFF) + wid * 64; float* li_l = ws, * al_l = ws + 32;
    char* qpark = lds + C::PARK_OFF + wid * (C::NPARK * 1024) + lane * 16;
    const lds_cptr qpl = (lds_cptr)qpark;
    const lds_cptr vp = (lds_cptr)V_lds + v_rd_base(lane);
    lds_cptr kp[4];
#pragma unroll
    for (int dd = 0; dd < 4; ++dd) kp[dd] = (lds_cptr)K_lds + r32 * C::ROWB + (((dd * 16 + hi * 8) * 2) ^ (((r32 >> 1) & 7) << 4));
    float m_reg = cur.m0, l_reg = cur.l0; const float c2 = cur.c2, thr = 8.f * 1.4426950408889634f / c2;
    f32x16 o[4];
#pragma unroll
    for (int d_ = 0; d_ < 4; ++d_) o[d_] = f32x16{};
    const bf16_t* Kh = cur.K; const bf16_t* Vh = cur.V;
#define KBASE(t) ((j_lo + (t)) * KVBLK)
#define BAR2() asm volatile("s_waitcnt lgkmcnt(0)\n\ts_barrier" ::: "memory")
#define RESC(a) do { if (__any((a) < 1.f)) { if (hi == 0) al_l[r32] = (a); asm volatile("s_waitcnt lgkmcnt(0)" ::: "memory");              \
                     _Pragma("unroll") for (int d_ = 0; d_ < 4; ++d_) _Pragma("unroll") for (int r = 0; r < 16; ++r) o[d_][r] *= al_l[crow(r, hi)]; } } while (0)
#define QPART(PN, KB_, HQ_) do { PN = f32x16{};                                                                                           \
        _Pragma("unroll") for (int d0 = 0; d0 < C::NQF; ++d0) { const bf16x8 kf = *(const __attribute__((address_space(3))) bf16x8*)(kp[d0 & 3] + ((KB_) * C::SHM_K + (HQ_) * 32 * C::ROWB + (d0 >> 2) * 128)); \
            bf16x8 qf; if (d0 < C::NQR) qf = S.qr[d0 < C::NQR ? d0 : 0]; else qf = *(const __attribute__((address_space(3))) bf16x8*)(qpl + (d0 - C::NQR) * 1024);                      \
            PN = __builtin_amdgcn_mfma_f32_32x32x16_bf16(kf, qf, PN, 0, 0, 0); } } while (0)
#define VPART(A_, B_, VB_, HV_) do {                                                                                                      \
        _Pragma("unroll") for (int d0 = 0; d0 < 4; ++d0) { const lds_cptr b_ = vp + ((VB_) * C::SHM_V + d0 * 512 + 4 * (HV_) * C::KG);     \
            const s16x4 la = vtr(b_), ha = vtr(b_ + C::KG), lb = vtr(b_ + 2 * C::KG), hb = vtr(b_ + 3 * C::KG);                            \
            o[d0] = __builtin_amdgcn_mfma_f32_32x32x16_bf16(A_, (bf16x8){la[0], la[1], la[2], la[3], ha[0], ha[1], ha[2], ha[3]}, o[d0], 0, 0, 0);   \
            o[d0] = __builtin_amdgcn_mfma_f32_32x32x16_bf16(B_, (bf16x8){lb[0], lb[1], lb[2], lb[3], hb[0], hb[1], hb[2], hb[3]}, o[d0], 0, 0, 0); } } while (0)
#define SMAX(PC, PM_) do {                                                                                                                \
        float pm_ = fmaxf(fmaxf(PC[0], PC[1]), fmaxf(PC[2], PC[3]));                                                                    \
        _Pragma("unroll") for (int r = 4; r < 16; r += 4) pm_ = fmaxf(pm_, fmaxf(fmaxf(PC[r], PC[r + 1]), fmaxf(PC[r + 2], PC[r + 3])));  \
        { auto rr = __builtin_amdgcn_permlane32_swap(__float_as_uint(pm_), __float_as_uint(pm_), false, false); pm_ = fmaxf(__uint_as_float(rr[0]), __uint_as_float(rr[1])); } \
        PM_ = pm_; } while (0)
#define SEXP(PC, PM_, NA_, NB_) do {                                                                                                      \
        const bool grow_ = ((PM_) - m_reg) > thr; const float mn_ = grow_ ? fmaxf(m_reg, (PM_)) : m_reg;                               \
        al = grow_ ? __builtin_amdgcn_exp2f((m_reg - mn_) * c2) : 1.f; m_reg = mn_; const float mnL_ = -mn_ * c2;                       \
        _Pragma("unroll") for (int r = 0; r < 16; ++r) PC[r] = __builtin_amdgcn_exp2f(fmaf(PC[r], c2, mnL_));                             \
        float ps_ = 0.f; _Pragma("unroll") for (int r = 0; r < 16; ++r) ps_ += PC[r];                                                     \
        { auto rr = __builtin_amdgcn_permlane32_swap(__float_as_uint(ps_), __float_as_uint(ps_), false, false); ps_ = __uint_as_float(rr[0]) + __uint_as_float(rr[1]); } \
        l_reg = l_reg * al + ps_;                                                                                                         \
        { unsigned a0 = cvtpk(PC[0], PC[1]), a1 = cvtpk(PC[2], PC[3]), b0 = cvtpk(PC[4], PC[5]), b1 = cvtpk(PC[6], PC[7]);               \
          auto r0 = __builtin_amdgcn_permlane32_swap(a0, b0, false, false); auto r1 = __builtin_amdgcn_permlane32_swap(a1, b1, false, false); \
          u32x4 w_ = {r0[0], r1[0], r0[1], r1[1]}; NA_ = __builtin_bit_cast(bf16x8, w_); }                                                \
        { unsigned a0 = cvtpk(PC[8], PC[9]), a1 = cvtpk(PC[10], PC[11]), b0 = cvtpk(PC[12], PC[13]), b1 = cvtpk(PC[14], PC[15]);         \
          auto r0 = __builtin_amdgcn_permlane32_swap(a0, b0, false, false); auto r1 = __builtin_amdgcn_permlane32_swap(a1, b1, false, false); \
          u32x4 w_ = {r0[0], r1[0], r0[1], r1[1]}; NB_ = __builtin_bit_cast(bf16x8, w_); } } while (0)
#define MASKH(PC, h) do { const int kbh_ = KBASE((h) >> 1) + 32 * ((h) & 1); if (kbh_ + 31 > qlo || kbh_ < NPAD) mask_half(PC, qm - kbh_, (unsigned)W, NPAD - kbh_ - 4 * hi); } while (0)
    AT_QLOAD(cur.Q);
    AT_LOAD_K(Kh, KBASE(0)); AT_LOAD_V(Vh, KBASE(0)); AT_VMW(); AT_SWRITE_K(0); AT_SWRITE_V(0);
    AT_LOAD_K(Kh, KBASE(1));
    BAR2();
    f32x16 PA, PB; float al = 1.f, pmA, pmB; bf16x8 fa = bf16x8{}, fb = bf16x8{}, ga, gb;
    QPART(PA, 0, 0); SBAR(); MASKH(PA, 0); SMAX(PA, pmA); SBAR();
    AT_LOAD_V(Vh, KBASE(1)); SBAR();
    QPART(PB, 0, 1); SEXP(PA, pmA, fa, fb); SBAR();
    MASKH(PB, 1); SMAX(PB, pmB); RESC(al); AT_VMWN(C::NVC); AT_SWRITE_K(1); BAR2();
#define FULL(h, PC, PMC, PN, PMN, A_, B_, NA_, NB_, VB_, HV_, KB_, HQ_, EVEN_) do { const int t_ = (h) >> 1;                              \
        if (EVEN_) { if (t_ + 1 < NT) { AT_LOAD_V(Vh, KBASE(t_ + 1)); } } else { if (t_ + 2 < NT) { AT_LOAD_K(Kh, KBASE(t_ + 2)); } } SBAR();  \
        VPART(A_, B_, VB_, HV_); QPART(PN, KB_, HQ_); SEXP(PC, PMC, NA_, NB_); StepSched<32 + C::NPARK>::run(); SBAR();                   \
        MASKH(PN, (h) + 1); SMAX(PN, PMN); RESC(al);                                                                                    \
        if (EVEN_) { if (t_ + 1 < NT) { AT_VMWN(C::NVC); AT_SWRITE_K((t_ + 1) & 1); } } else { if (t_ + 1 < NT) { if (t_ + 2 < NT) { AT_VMWN(C::NKC); } else { AT_VMW(); } AT_SWRITE_V((t_ + 1) & 1); } }  \
        BAR2(); } while (0)
    int h = 1;
    for (; h + 3 <= 2 * NT - 2; h += 4) {
        FULL(h,     PB, pmB, PA, pmA, fa, fb, ga, gb, 0, 0, 1, 0, false);
        FULL(h + 1, PA, pmA, PB, pmB, ga, gb, fa, fb, 0, 1, 1, 1, true);
        FULL(h + 2, PB, pmB, PA, pmA, fa, fb, ga, gb, 1, 0, 0, 0, false);
        FULL(h + 3, PA, pmA, PB, pmB, ga, gb, fa, fb, 1, 1, 0, 1, true);
    }
#undef FULL
    VPART(fa, fb, 0, 0); SEXP(PB, pmB, ga, gb); SBAR();
    RESC(al);
    VPART(ga, gb, 0, 1); SBAR();
#undef QPART
#undef VPART
#undef SMAX
#undef SEXP
#undef MASKH
    if (hi == 0) li_l[r32] = l_reg; asm volatile("s_waitcnt lgkmcnt(0)" ::: "memory");
    float rli[16], sq[16];
#pragma unroll
    for (int r = 0; r < 16; ++r) { rli[r] = __builtin_amdgcn_rcpf(li_l[crow(r, hi)]); sq[r] = 0.f; }
    char* Ow = (char*)(cur.O + (size_t)(wid * QBLK) * 1024); const unsigned oo = (unsigned)(4 * hi * 1024 + r32) * 2u;
#pragma unroll
    for (int r = 0; r < 16; ++r) {
#pragma unroll
        for (int d0 = 0; d0 < 4; ++d0) { const float v = o[d0][r] * rli[r]; sq[r] += v * v;
            const float vn = __shfl_xor(v, 1);
            if (XP == 0 && (r32 & 1) == 0) *(unsigned*)(Ow + (size_t)(oo + (unsigned)((((r & 3) + 8 * (r >> 2)) * 1024 + d0 * 32) * 2))) = cvtpk(v, vn);
            if (XP != 0) asm volatile("" :: "v"(v)); } }
    float sel = 0.f; int r32e = r32, hie = hi; asm volatile("" : "+v"(r32e), "+v"(hie));
#pragma unroll
    for (int r = 0; r < 16; ++r) { float s = sq[r]; s += __shfl_xor(s, 1); s += __shfl_xor(s, 2); s += __shfl_xor(s, 4); s += __shfl_xor(s, 8); s += __shfl_xor(s, 16); sel = (r32e == r) ? s : sel; }
    if (XP == 0 && r32e < 16) *(float*)((char*)(cur.SSQ + (size_t)(wid * QBLK) * 12 + ssq_slot) + (size_t)((unsigned)crow(r32e, hie) * 48u)) = sel;
    if (XP != 0) asm volatile("" :: "v"(sel));
    BAR2();
#undef BAR2
#undef RESC
#undef KBASE
}
#undef AT_STAGE_OFFS
#undef AT_LOAD_K
#undef AT_LOAD_V
#undef AT_SLOAD
#undef AT_SWRITE_K
#undef AT_SWRITE_V
#undef AT_VMW
#undef AT_VMWN
#undef AT_QLOAD
#undef AT_RSRC
#undef AT_BLD
#undef SBAR

typedef Cfg<192, 128, 768, 768, 512, LP, false, 6> CfgMLA;
typedef Cfg<64, 64, 512, 128, 128, 128, true, 0> CfgSWA;
constexpr float C2_MLA = 1.4426950408889634f * 0.07216878364870322f, C2_SWA = 1.4426950408889634f * 0.125f;
static_assert(CfgMLA::LDS_BYTES <= RING_BYTES && CfgSWA::LDS_BYTES <= RING_BYTES, "attention LDS");

__device__ __forceinline__ BlockRef<CfgMLA> mla_ref(unsigned char* ws, int bh, int qb) {
    const int b = bh >> 2, h = bh & 3; BlockRef<CfgMLA> r; const size_t m0 = (size_t)b * SEQ + (size_t)qb * QB;
    r.Q = (const bf16_t*)(ws + WS_QM) + m0 * 768 + h * 192; r.K = (const bf16_t*)(ws + WS_KM) + (size_t)b * LP * 768 + h * 192;
    r.V = (const bf16_t*)(ws + WS_VM) + (size_t)b * LP * 512 + h * 128; r.O = (bf16_t*)(ws + WS_AO) + m0 * 1024 + 512 + h * 128;
    r.SSQ = (float*)(ws + WS_SSQ) + m0 * 12; r.P0 = 128 + qb * QB; r.m0 = -1e30f; r.l0 = 0.f; r.c2 = C2_MLA; return r;
}
__device__ __forceinline__ BlockRef<CfgSWA> swa_ref(unsigned char* ws, const float* sinks, int bh, int qb) {
    const int b = bh >> 3, h = bh & 7, kvh = h >> 2; BlockRef<CfgSWA> r; const size_t m0 = (size_t)b * SEQ + (size_t)qb * QB;
    r.Q = (const bf16_t*)(ws + WS_QA) + m0 * 512 + h * 64; r.K = (const bf16_t*)(ws + WS_KA) + (size_t)b * LP * 128 + kvh * 64;
    r.V = (const bf16_t*)(ws + WS_VA) + (size_t)b * LP * 128 + kvh * 64; r.O = (bf16_t*)(ws + WS_AO) + m0 * 1024 + h * 64;
    r.SSQ = (float*)(ws + WS_SSQ) + m0 * 12; r.P0 = 128 + qb * QB; r.m0 = sinks[h] * 8.f; r.l0 = 1.f; r.c2 = C2_SWA; return r;
}
template <int XP = 0>
__device__ __forceinline__ void attn_phase(char* lds, unsigned char* ws, const float* sinks, int vcu, int G) {
    {
        const int nit = (256 - vcu + G - 1) / G;
        const int nblk = 2 * (nit > 0 ? nit : 0);
        if (nblk > 0) {
            Seam<CfgMLA> S; int tid = threadIdx.x; asm volatile("" : "+v"(tid));
#define MLA_REF(k) mla_ref(ws, (vcu + ((k) >> 1) * G) >> 4, ((k) & 1) ? ((vcu + ((k) >> 1) * G) & 15) : 31 - ((vcu + ((k) >> 1) * G) & 15))
            BlockRef<CfgMLA> cur = MLA_REF(0);
#if ATT_SKEW
#if ATT_HALF
            for (int k = 0; k < nblk; ++k) { cur = MLA_REF(k); block3<CfgMLA, XP>(cur, lds, S, 8 + (((vcu + (k >> 1) * G) >> 4) & 3), tid); }
#else
            for (int k = 0; k < nblk; ++k) { cur = MLA_REF(k); block2<CfgMLA, XP>(cur, lds, S, 8 + (((vcu + (k >> 1) * G) >> 4) & 3), tid); }
#endif
#else
            prime<CfgMLA>(cur, lds, S, tid);
            for (int k = 0; k < nblk; ++k) { const BlockRef<CfgMLA> nxt = (k + 1 < nblk) ? MLA_REF(k + 1) : cur; block<CfgMLA>(cur, nxt, lds, S, 8 + (((vcu + (k >> 1) * G) >> 4) & 3), tid); cur = nxt; }
#endif
#undef MLA_REF
        }
    }
    {
        const int nit = (256 - vcu + G - 1) / G;
        const int nblk = 4 * (nit > 0 ? nit : 0);
        if (nblk > 0) {
            Seam<CfgSWA> S; int tid = threadIdx.x; asm volatile("" : "+v"(tid));
#define SWA_REF(k) swa_ref(ws, sinks, (4 * (vcu + ((k) >> 2) * G) + ((k) & 3)) >> 5, (4 * (vcu + ((k) >> 2) * G) + ((k) & 3)) & 31)
            BlockRef<CfgSWA> cur = SWA_REF(0);
#if ATT_SKEW
            for (int k = 0; k < nblk; ++k) { cur = SWA_REF(k); block2<CfgSWA, XP>(cur, lds, S, ((4 * (vcu + (k >> 2) * G) + (k & 3)) >> 5) & 7, tid); }
#else
            prime<CfgSWA>(cur, lds, S, tid);
            for (int k = 0; k < nblk; ++k) { const BlockRef<CfgSWA> nxt = (k + 1 < nblk) ? SWA_REF(k + 1) : cur; block<CfgSWA>(cur, nxt, lds, S, ((4 * (vcu + (k >> 2) * G) + (k & 3)) >> 5) & 7, tid); cur = nxt; }
#endif
#undef SWA_REF
        }
    }
}
}

struct EpiOut {
    static constexpr bool PERM = false, MIDK = true;
    unsigned char* ws;
    __device__ __forceinline__ void midk(f32x4 (&acc)[2][2][4][2], const pg8::Unit& u, int wr, int wc, int fr, int fq) const {
        const char* SSQb = (const char*)(ws + WS_SSQ) + (size_t)u.pm * (256 * 48);
        unsigned lo = (unsigned)(wr * 64 + fr) * 48u; asm volatile("" : "+v"(lo));
#pragma unroll
        for (int ai = 0; ai < 2; ++ai) {
            f32x4 s0[4], s1[4], s2[4];
#pragma unroll
            for (int m = 0; m < 4; ++m) { const char* p = SSQb + (size_t)(lo + (unsigned)((ai * 128 + m * 16) * 48)); s0[m] = *(const f32x4*)p; s1[m] = *(const f32x4*)(p + 16); s2[m] = *(const f32x4*)(p + 32); }
#pragma unroll
            for (int m = 0; m < 4; ++m) {
                const float sa = ((s0[m][0] + s0[m][1]) + (s0[m][2] + s0[m][3])) + ((s1[m][0] + s1[m][1]) + (s1[m][2] + s1[m][3])), sb = (s2[m][0] + s2[m][1]) + (s2[m][2] + s2[m][3]);
                const float rho = sqrtf((sb * (1.f / 512.f) + RMS_EPS) / (sa * (1.f / 512.f) + RMS_EPS));
#pragma unroll
                for (int bj = 0; bj < 2; ++bj)
#pragma unroll
                    for (int n = 0; n < 2; ++n) acc[ai][bj][m][n] *= rho; }
            asm volatile("" ::: "memory"); }
    }
    __device__ __forceinline__ void operator()(const f32x4 (&acc)[2][2][4][2], const pg8::Unit& u, int wr, int wc, int fr, int fq) const {
        const char* SSQb = (const char*)(ws + WS_SSQ) + (size_t)u.pm * (256 * 48) + 32;
        const size_t tile = ((size_t)u.pm * 256) * DM + (size_t)u.pn * 256;
        const char* H0b = (const char*)(ws + WS_H0) + tile * 2; char* Pb = (char*)(ws + WS_PRE1) + tile * 4;
        unsigned lo = (unsigned)(wr * 64 + fr) * 48u, eo = (unsigned)((wr * 64 + fr) * DM + wc * 32 + 4 * fq); asm volatile("" : "+v"(lo), "+v"(eo));
        f32x4 s2[8];
#pragma unroll
        for (int q = 0; q < 8; ++q) s2[q] = *(const f32x4*)(SSQb + (size_t)(lo + (unsigned)(((q >> 2) * 128 + (q & 3) * 16) * 48)));
#pragma unroll
        for (int ai = 0; ai < 2; ++ai) {
            u32x2 h[4][2][2];
#pragma unroll
            for (int m = 0; m < 4; ++m)
#pragma unroll
                for (int bj = 0; bj < 2; ++bj)
#pragma unroll
                    for (int n = 0; n < 2; ++n) h[m][bj][n] = *(const u32x2*)(H0b + (size_t)((eo + (unsigned)((ai * 128 + m * 16) * DM + bj * 128 + n * 16)) * 2u));
#pragma unroll
            for (int m = 0; m < 4; ++m) { const f32x4 sq = s2[ai * 4 + m];
                const float rb = 1.f / sqrtf(((sq[0] + sq[1]) + (sq[2] + sq[3])) * (1.f / 512.f) + RMS_EPS);
#pragma unroll
                for (int bj = 0; bj < 2; ++bj)
#pragma unroll
                    for (int n = 0; n < 2; ++n) { const unsigned off = eo + (unsigned)((ai * 128 + m * 16) * DM + bj * 128 + n * 16); const u32x2 hv = h[m][bj][n];
                        f32x4 o = acc[ai][bj][m][n] * rb;
                        o[0] += ALPHA * __uint_as_float(hv.x << 16); o[1] += ALPHA * __uint_as_float(hv.x & 0xffff0000u); o[2] += ALPHA * __uint_as_float(hv.y << 16); o[3] += ALPHA * __uint_as_float(hv.y & 0xffff0000u);
                        ST16F(Pb + (size_t)(off * 4u), o); } }
            asm volatile("" ::: "memory"); }
    }
};

__device__ __forceinline__ void split_bf16x8(const f32x4 x0, const f32x4 x1, bf16x8& hi, bf16x8& lo) {
    unsigned h[8]; float r[8];
#pragma unroll
    for (int e = 0; e < 4; ++e) { h[e] = f2bf(x0[e]); r[e] = x0[e] - __uint_as_float(h[e] << 16); h[4 + e] = f2bf(x1[e]); r[4 + e] = x1[e] - __uint_as_float(h[4 + e] << 16); }
    u32x4 hw, lw;
    hw.x = h[0] | (h[1] << 16); hw.y = h[2] | (h[3] << 16); hw.z = h[4] | (h[5] << 16); hw.w = h[6] | (h[7] << 16);
    lw.x = pk2(r[0], r[1]); lw.y = pk2(r[2], r[3]); lw.z = pk2(r[4], r[5]); lw.w = pk2(r[6], r[7]);
    hi = __builtin_bit_cast(bf16x8, hw); lo = __builtin_bit_cast(bf16x8, lw);
}
__device__ __forceinline__ void p5_ln1_router(const Frame& F, const Args& a) {
    constexpr int RS = 1032;
    LAS float* hrow = (LAS float*)F.lds;
    LAS float* part = (LAS float*)(F.lds + 16 * RS * 4);
    LAS float* lg = part + 8 * 16 * 48;
    const int tid5 = threadIdx.x, lane = tid5 & 63, w = F.wave, fr = lane & 15, fq = lane >> 4;
    const float* PRE1 = (const float*)(F.ws + WS_PRE1); bf16_t* H1 = (bf16_t*)(F.ws + WS_H1);
    const float* g1 = a.in[13]; const float* b1 = a.in[14]; const float* wg = a.in[15]; const float* bg = a.in[16]; const float* wr = a.in[17]; const float* br = a.in[18];
    int* list = (int*)(F.ws + WS_LIST); float* ew = (float*)(F.ws + WS_EW);
    bf16x8 Bh[4][3], Bl[4][3];
#pragma unroll
    for (int s = 0; s < 4; ++s)
#pragma unroll
        for (int cb = 0; cb < 3; ++cb) { const int n = cb * 16 + fr; float x[8];
#pragma unroll
            for (int j = 0; j < 8; ++j) { const int k = 128 * w + 32 * s + 8 * fq + j; x[j] = n < 4 ? wg[k * 4 + n] : (n < 36 ? wr[k * 32 + (n - 4)] : 0.f); }
            split_bf16x8((f32x4){x[0], x[1], x[2], x[3]}, (f32x4){x[4], x[5], x[6], x[7]}, Bh[s][cb], Bl[s][cb]); }
    f32x4 pv[2][4];
    int it = F.bx;
    if (it < T / 16) {
#pragma unroll
        for (int rr = 0; rr < 2; ++rr)
#pragma unroll
            for (int j = 0; j < 4; ++j) pv[rr][j] = *(const f32x4*)(PRE1 + (size_t)(it * 16 + 2 * w + rr) * DM + j * 256 + lane * 4);
    }
    for (; it < T / 16; it += F.G) {
        const int R0 = it * 16;
#pragma unroll
        for (int rr = 0; rr < 2; ++rr) { const int r = 2 * w + rr;
            f32x4 v[4]; float s = 0.f;
#pragma unroll
            for (int j = 0; j < 4; ++j) { v[j] = pv[rr][j]; s += (v[j].x + v[j].y) + (v[j].z + v[j].w); }
            const float mean = wave_sum(s) * (1.f / DM); float s2 = 0.f;
#pragma unroll
            for (int j = 0; j < 4; ++j) { v[j] = v[j] - mean; s2 += (v[j].x * v[j].x + v[j].y * v[j].y) + (v[j].z * v[j].z + v[j].w * v[j].w); }
            const float rstd = 1.f / sqrtf(wave_sum(s2) * (1.f / DM) + LN_EPS);
#pragma unroll
            for (int j = 0; j < 4; ++j) { const int c = j * 256 + lane * 4; const f32x4 gg = *(const f32x4*)(g1 + c), bb = *(const f32x4*)(b1 + c);
                const f32x4 o = v[j] * rstd * gg + bb; *(LAS f32x4*)(hrow + r * RS + c) = o;
                u32x2 pw; pw.x = pk2(o.x, o.y); pw.y = pk2(o.z, o.w); *(u32x2*)(H1 + (size_t)(R0 + r) * DM + c) = pw; } }
        __syncthreads();
        if (it + F.G < T / 16) {
#pragma unroll
            for (int rr = 0; rr < 2; ++rr)
#pragma unroll
                for (int j = 0; j < 4; ++j) pv[rr][j] = *(const f32x4*)(PRE1 + (size_t)((it + F.G) * 16 + 2 * w + rr) * DM + j * 256 + lane * 4);
        }
        f32x4 c0 = {0.f, 0.f, 0.f, 0.f}, c1 = c0, c2 = c0;
#pragma unroll
        for (int s = 0; s < 4; ++s) { const LAS float* ap = hrow + fr * RS + 128 * w + 32 * s + 8 * fq;
            bf16x8 ah, al; split_bf16x8(*(const LAS f32x4*)ap, *(const LAS f32x4*)(ap + 4), ah, al);
            c0 = __builtin_amdgcn_mfma_f32_16x16x32_bf16(ah, Bh[s][0], c0, 0, 0, 0); c0 = __builtin_amdgcn_mfma_f32_16x16x32_bf16(al, Bh[s][0], c0, 0, 0, 0); c0 = __builtin_amdgcn_mfma_f32_16x16x32_bf16(ah, Bl[s][0], c0, 0, 0, 0);
            c1 = __builtin_amdgcn_mfma_f32_16x16x32_bf16(ah, Bh[s][1], c1, 0, 0, 0); c1 = __builtin_amdgcn_mfma_f32_16x16x32_bf16(al, Bh[s][1], c1, 0, 0, 0); c1 = __builtin_amdgcn_mfma_f32_16x16x32_bf16(ah, Bl[s][1], c1, 0, 0, 0);
            c2 = __builtin_amdgcn_mfma_f32_16x16x32_bf16(ah, Bh[s][2], c2, 0, 0, 0); c2 = __builtin_amdgcn_mfma_f32_16x16x32_bf16(al, Bh[s][2], c2, 0, 0, 0); c2 = __builtin_amdgcn_mfma_f32_16x16x32_bf16(ah, Bl[s][2], c2, 0, 0, 0); }
#pragma unroll
        for (int j = 0; j < 4; ++j) { LAS float* pp = part + (w * 16 + fq * 4 + j) * 48 + fr; pp[0] = c0[j]; pp[16] = c1[j]; pp[32] = c2[j]; }
        __syncthreads();
        for (int idx = tid5; idx < 16 * 48; idx += NWAVES * 64) { float sum = 0.f;
#pragma unroll
            for (int q = 0; q < 8; ++q) sum += part[q * 768 + idx];
            lg[idx] = sum; }
        __syncthreads();
        if (tid5 < 16) { const int m = R0 + tid5; const LAS float* L = lg + tid5 * 48;
            const float l0 = L[0] + bg[0], l1 = L[1] + bg[1], l2 = L[2] + bg[2], l3 = L[3] + bg[3];
            const float mx = fmaxf(fmaxf(l0, l1), fmaxf(l2, l3));
            const float ex0 = expf(l0 - mx), ex1 = expf(l1 - mx), ex2 = expf(l2 - mx), ex3 = expf(l3 - mx);
            const float se = ((ex0 + ex1) + ex2) + ex3;
            int gi = 0; float gt = ex0 / se;
            { const float p = ex1 / se; if (p > gt) { gt = p; gi = 1; } }
            { const float p = ex2 / se; if (p > gt) { gt = p; gi = 2; } }
            { const float p = ex3 / se; if (p > gt) { gt = p; gi = 3; } }
            int e1 = 0, e2 = -1; float t1 = -INFINITY, t2 = -INFINITY;
#pragma unroll 1
            for (int i = 0; i < 8; ++i) { const float v = L[4 + gi * 8 + i] + br[gi * 8 + i];
                if (v > t1) { t2 = t1; e2 = e1; t1 = v; e1 = i; } else if (v > t2) { t2 = v; e2 = i; } }
            const float z = expf(t2 - t1), w1 = gt / (1.f + z), w2 = gt * z / (1.f + z);
            const int ea = gi * 8 + e1, eb = gi * 8 + e2;
            const unsigned pa = atomicAdd(&F.ctl[CW_CNT + 64 * ea], 1u); const unsigned pb = atomicAdd(&F.ctl[CW_CNT + 64 * eb], 1u);
            list[(size_t)ea * T + pa] = m * 2; list[(size_t)eb * T + pb] = m * 2 + 1; ew[m * 2] = w1; ew[m * 2 + 1] = w2; }
    }
}

struct MoeOrder {
    const unsigned* ctl; const int* list; const char* A; const char* Bt; int nN, G, c; bool gather;
    __device__ bool next(int i, pg8::Unit& u) const {
        if (G % 8 == 0) {
            const int x = c & 7, slot = c >> 3, ns = G >> 3; const int j = i * ns + slot; const int tlx = j / nN; int accx = 0, accg = 0; bool found = false;
            for (int e = 0; e < 32; ++e) { const int cn = (int)ctl[CW_CNT + 64 * e]; const int nt = (cn + 255) >> 8;
                if ((e & 7) == x) { if (!found && tlx < accx + nt) { u.e = e; u.r0 = (tlx - accx) * 256; u.n = cn; u.pm = accg + (tlx - accx); u.pn = j % nN; found = true; } accx += nt; }
                accg += nt; }
            return found; }
        const int L = i * G + c; const int tl = L / nN; int acc = 0;
        for (int e = 0; e < 32; ++e) { const int cn = (int)ctl[CW_CNT + 64 * e]; const int nt = (cn + 255) >> 8;
            if (tl < acc + nt) { u.e = e; u.r0 = (tl - acc) * 256; u.n = cn; u.pm = tl; u.pn = L % nN; return true; } acc += nt; }
        return false;
    }
    __device__ __forceinline__ const char* abase(const pg8::Unit& u) const { return gather ? A : A + (size_t)u.pm * 256 * 256 * 2; }
    __device__ __forceinline__ const char* bbase(const pg8::Unit& u) const { return gather ? Bt + ((size_t)u.e * 512 + u.pn * 256) * DM * 2 : Bt + ((size_t)u.e * 1024 + u.pn * 256) * 256 * 2; }
    __device__ __forceinline__ unsigned arow_off(const pg8::Unit& u, int R) const {
        if (!gather) return (unsigned)(R * 256) * 2u;
        const int idx = (u.r0 + R < u.n) ? list[(size_t)u.e * T + u.r0 + R] : 0;
        return (unsigned)(idx >> 1) * (unsigned)(DM * 2);
    }
};
struct EpiGU {
    static constexpr bool PERM = true, MIDK = false;
    unsigned char* ws;
    __device__ __forceinline__ void operator()(const f32x4 (&acc)[2][2][4][2], const pg8::Unit& u, int wr, int wc, int fr, int fq) const {
        const char* listb = (const char*)(ws + WS_LIST) + ((size_t)u.e * T + u.r0) * 4; const char* ewb = (const char*)(ws + WS_EW);
        char* Hb = (char*)(ws + WS_HID) + (((size_t)u.pm * 256) * 256 + u.pn * 128) * 2;
        int Rl = wr * 64 + fr; const int nrem = u.n - u.r0; asm volatile("" : "+v"(Rl));
        const unsigned ho = (unsigned)(Rl * 256 + wc * 32 + 8 * fq) * 2u;
        unsigned idx[8]; float wgt[8];
#pragma unroll
        for (int q = 0; q < 8; ++q) { const int R = Rl + (q >> 2) * 128 + (q & 3) * 16; idx[q] = (R < nrem) ? *(const unsigned*)(listb + (size_t)((unsigned)R * 4u)) : 0xffffffffu; }
#pragma unroll
        for (int q = 0; q < 8; ++q) wgt[q] = (idx[q] != 0xffffffffu) ? *(const float*)(ewb + (size_t)(idx[q] * 4u)) : 0.f;
#pragma unroll
        for (int ai = 0; ai < 2; ++ai)
#pragma unroll
            for (int m = 0; m < 4; ++m) { const float wg_ = wgt[ai * 4 + m];
                f32x4 o[2];
#pragma unroll
                for (int n = 0; n < 2; ++n) { const f32x4 gv = acc[ai][0][m][n], uv = acc[ai][1][m][n];
#pragma unroll
                    for (int e = 0; e < 4; ++e) o[n][e] = gv[e] * __builtin_amdgcn_rcpf(1.f + __builtin_amdgcn_exp2f(-1.4426950408889634f * gv[e])) * uv[e] * wg_; }
                ST16(Hb + (size_t)(ho + (unsigned)((ai * 128 + m * 16) * 512)), pg8::pack8(o[0], o[1])); }
    }
};
struct EpiDown {
    static constexpr bool PERM = true, MIDK = false;
    unsigned char* ws;
    __device__ __forceinline__ void operator()(const f32x4 (&acc)[2][2][4][2], const pg8::Unit& u, int wr, int wc, int fr, int fq) const {
        const char* listb = (const char*)(ws + WS_LIST) + ((size_t)u.e * T + u.r0) * 4; char* Yb = (char*)(ws + WS_Y) + (size_t)(u.pn * 256) * 2;
        int Rl = wr * 64 + fr; const int nrem = u.n - u.r0; asm volatile("" : "+v"(Rl));
        const unsigned yo = (unsigned)(wc * 32 + 8 * fq) * 2u;
        unsigned idx[8];
#pragma unroll
        for (int q = 0; q < 8; ++q) { const int R = Rl + (q >> 2) * 128 + (q & 3) * 16; idx[q] = (R < nrem) ? *(const unsigned*)(listb + (size_t)((unsigned)R * 4u)) : 0xffffffffu; }
#pragma unroll
        for (int ai = 0; ai < 2; ++ai)
#pragma unroll
            for (int m = 0; m < 4; ++m) { const unsigned ix = idx[ai * 4 + m];
                if (ix != 0xffffffffu) { char* y = Yb + (size_t)ix * (DM * 2) + yo;
                    ST16(y, pg8::pack8(acc[ai][0][m][0], acc[ai][0][m][1])); ST16((y + 256), pg8::pack8(acc[ai][1][m][0], acc[ai][1][m][1])); } }
    }
};

__device__ __forceinline__ void p8_ln2(const Frame& F, const Args& a) {
    const bf16_t* H1 = (const bf16_t*)(F.ws + WS_H1); const bf16_t* Y = (const bf16_t*)(F.ws + WS_Y); const float* g = a.in[22]; const float* b = a.in[23]; float* out = a.out;
    const int lane = threadIdx.x & 63;
    for (int m = F.bx * NWAVES + F.wave; m < T; m += F.G * NWAVES) {
        f32x4 v[4]; float s = 0.f;
#pragma unroll
        for (int j = 0; j < 4; ++j) { const int c = j * 256 + lane * 4;
            const u32x2 h = *(const u32x2*)(H1 + (size_t)m * DM + c), y0 = *(const u32x2*)(Y + (size_t)(2 * m) * DM + c), y1 = *(const u32x2*)(Y + (size_t)(2 * m + 1) * DM + c);
            v[j].x = ALPHA * __uint_as_float(h.x << 16) + __uint_as_float(y0.x << 16) + __uint_as_float(y1.x << 16);
            v[j].y = ALPHA * __uint_as_float(h.x & 0xffff0000u) + __uint_as_float(y0.x & 0xffff0000u) + __uint_as_float(y1.x & 0xffff0000u);
            v[j].z = ALPHA * __uint_as_float(h.y << 16) + __uint_as_float(y0.y << 16) + __uint_as_float(y1.y << 16);
            v[j].w = ALPHA * __uint_as_float(h.y & 0xffff0000u) + __uint_as_float(y0.y & 0xffff0000u) + __uint_as_float(y1.y & 0xffff0000u);
            s += (v[j].x + v[j].y) + (v[j].z + v[j].w); }
        const float mean = wave_sum(s) * (1.f / DM); float s2 = 0.f;
#pragma unroll
        for (int j = 0; j < 4; ++j) { v[j] = v[j] - mean; s2 += (v[j].x * v[j].x + v[j].y * v[j].y) + (v[j].z * v[j].z + v[j].w * v[j].w); }
        const float rstd = 1.f / sqrtf(wave_sum(s2) * (1.f / DM) + LN_EPS);
#pragma unroll
        for (int j = 0; j < 4; ++j) { const int c = j * 256 + lane * 4; const f32x4 gg = *(const f32x4*)(g + c), bb = *(const f32x4*)(b + c);
            *(f32x4*)(out + (size_t)m * DM + c) = v[j] * rstd * gg + bb; }
    }
}

__global__ void __launch_bounds__(NWAVES * 64, 2) mega(Args args) {
    extern __shared__ __attribute__((aligned(16))) unsigned char lds_raw[];
    Frame F;
    F.lds = (LAS unsigned char*)lds_raw; F.ws = args.ws; F.ctl = (unsigned*)(args.ws + WS_CTL);
    F.tid = threadIdx.x; F.lane = F.tid & 63; F.wave = __builtin_amdgcn_readfirstlane(F.tid >> 6); F.G = gridDim.x; F.bx = blockIdx.x;
    volatile LAS unsigned* MISC = (volatile LAS unsigned*)(F.lds + MISC_OFF);
    for (int u = F.tid; u < (LDS_BYTES - LDSCTL_OFF) / 4; u += NWAVES * 64) ((LAS unsigned*)(F.lds + LDSCTL_OFF))[u] = 0u;
    __syncthreads();
    XcdBarrier bar = xcd_barrier_post(F.ctl + CW_BAR, MISC + 8);
    const int lo = args.ph_lo, hi = args.ph_hi;
#define IN(k) (lo <= (k) && (k) < hi)
#define BOTH(k) (IN(k) && IN((k) + 1))
    if (IN(0)) { p0_prologue(F, args); if (BOTH(0)) xcd_barrier(bar); }
    if (IN(1)) {
        pg8::StaticOrder S; S.init(args.ws + WS_H0, args.ws + WS_WIN, T, 1536, DM, F.G, F.bx);
        EpiInProj E{args.ws};
        pg8::gemm_phase<EpiInProj, pg8::StaticOrder, true>(F.lds, DM, S, E);
        if (BOTH(1)) xcd_barrier(bar);
    }
    if (IN(2)) {
        { int q = F.bx;
          if (F.G % 8 == 0 && F.G >= 224) { const int slot = F.bx >> 3; q = slot >= 16 ? (slot - 16) * 8 + (F.bx & 7) : 1 << 20; }
          for (; q < 84; q += F.G) p2_meta(F, args, q); }
        UpOrder S{(const char*)(args.ws + WS_CQ), (const char*)(args.ws + WS_CKV), (const char*)(args.ws + WS_WUQ), (const char*)(args.ws + WS_WUKV), F.G, F.bx};
        EpiUp E{args.ws};
        pg8::gemm_phase<EpiUp, UpOrder, true>(F.lds, 256, S, E);
        if (BOTH(2)) xcd_barrier(bar);
    }
    if (IN(3)) {
        const int vcu = (F.G % 8 == 0) ? (F.bx % 8) * (F.G / 8) + F.bx / 8 : F.bx;
        att::attn_phase<0>((char*)lds_raw, args.ws, args.in[5], vcu, F.G);
        if (BOTH(3)) xcd_barrier(bar);
    }
    if (IN(4)) {
        pg8::StaticOrder S; S.init(args.ws + WS_AO, args.ws + WS_WO, T, DM, DM, F.G, F.bx);
        EpiOut E{args.ws};
        pg8::gemm_phase<EpiOut, pg8::StaticOrder, true>(F.lds, DM, S, E);
        if (BOTH(4)) xcd_barrier(bar);
    }
    if (IN(5)) { p5_ln1_router(F, args); if (BOTH(5)) xcd_barrier(bar); }
    if (IN(6)) {
        MoeOrder S{F.ctl, (const int*)(args.ws + WS_LIST), (const char*)(args.ws + WS_H1), (const char*)(args.ws + WS_WGU), 2, F.G, F.bx, true};
        EpiGU E{args.ws};
        pg8::gemm_phase<EpiGU, MoeOrder, true>(F.lds, DM, S, E);
        if (BOTH(6)) xcd_barrier(bar);
    }
    if (IN(7)) {
        MoeOrder S{F.ctl, (const int*)(args.ws + WS_LIST), (const char*)(args.ws + WS_HID), (const char*)(args.ws + WS_WDN), 4, F.G, F.bx, false};
        EpiDown E{args.ws};
        pg8::gemm_phase<EpiDown, MoeOrder, true>(F.lds, 256, S, E);
        if (BOTH(7)) xcd_barrier(bar);
    }
    if (IN(8)) { p8_ln2(F, args); }
#undef IN
#undef BOTH
}

extern "C" void kernel_launch(void* const* d_in, const int* in_sizes, int n_in, void* d_out, int out_size, void* d_ws, size_t ws_size, hipStream_t stream) {
    static int grid = 0;
    if (grid == 0) {
        if (n_in != 24 || ws_size < WS_END || out_size != T * DM) { fprintf(stderr, "kernel_launch: unexpected shapes n_in=%d ws=%zu out=%d\n", n_in, ws_size, out_size); grid = -1; return; }
        int dev = 0, cus = 0, per_cu = 0;
        if (hipGetDevice(&dev) != hipSuccess || hipDeviceGetAttribute(&cus, hipDeviceAttributeMultiprocessorCount, dev) != hipSuccess) { grid = -1; return; }
        if (hipFuncSetAttribute((const void*)mega, hipFuncAttributeMaxDynamicSharedMemorySize, LDS_BYTES) != hipSuccess) { fprintf(stderr, "hipFuncSetAttribute failed\n"); grid = -1; return; }
        if (hipOccupancyMaxActiveBlocksPerMultiprocessor(&per_cu, (const void*)mega, NWAVES * 64, LDS_BYTES) != hipSuccess || per_cu < 1) { fprintf(stderr, "occupancy query: %d blocks per CU\n", per_cu); (void)hipGetLastError(); grid = -1; return; }
        (void)hipGetLastError();
        grid = cus;
    }
    if (grid < 0) return;
    (void)hipMemsetAsync((unsigned char*)d_ws + WS_CTL, 0, 1 * MiB, stream);
    Args a{};
    for (int i = 0; i < 24; ++i) a.in[i] = (const float*)d_in[i];
    a.out = (float*)d_out; a.ws = (unsigned char*)d_ws; a.ph_lo = 0; a.ph_hi = 9;
    hipLaunchKernelGGL(mega, dim3(grid), dim3(NWAVES * 64), LDS_BYTES, stream, a);
}
```

```cpp
#include <hip/hip_runtime.h>
#include <cstdio>
#include <cstdint>

typedef unsigned short bf16_t;
typedef float f32x4 __attribute__((ext_vector_type(4)));
typedef unsigned u32x4 __attribute__((ext_vector_type(4)));
typedef unsigned u32x2 __attribute__((ext_vector_type(2)));

constexpr int NB = 4, SEQ = 8192, DM = 1024, T = NB * SEQ, LP = SEQ + 128, NPAD = 112, NMETA = 16;
constexpr int INC = 1344;
constexpr float LN_EPS = 1e-5f, RMS_EPS = 1e-6f;
constexpr float ALPHA = 1.189207115002721f;
constexpr size_t MiB = 1u << 20;

constexpr size_t WS_CTL = 0;
constexpr size_t WS_HM = 1 * MiB;
constexpr size_t WS_CKVM = 1 * MiB + 128 * 1024;
constexpr size_t WS_UM = 1 * MiB + 256 * 1024;
constexpr size_t WS_KVTM = 1 * MiB + 640 * 1024;
constexpr size_t WS_SSQ = 2 * MiB;
constexpr size_t WS_EW = 4 * MiB;
constexpr size_t WS_LIST = 5 * MiB;
constexpr size_t WS_W = 16 * MiB;
constexpr size_t WS_H0 = 72 * MiB;
constexpr size_t WS_QA = 136 * MiB;
constexpr size_t WS_KA = 168 * MiB;
constexpr size_t WS_VA = 177 * MiB;
constexpr size_t WS_CQ = 186 * MiB;
constexpr size_t WS_CKV = 202 * MiB;
constexpr size_t WS_KM = 218 * MiB;
constexpr size_t WS_VM = 267 * MiB;
constexpr size_t WS_QM = 300 * MiB;
constexpr size_t WS_AO = 348 * MiB;
constexpr size_t WS_HID = 412 * MiB;
constexpr size_t WS_PRE1 = 136 * MiB;
constexpr size_t WS_H1 = 264 * MiB;
constexpr size_t WS_Y = 72 * MiB;
constexpr size_t WS_TMP = 348 * MiB;
constexpr size_t WS_AN = 412 * MiB;
constexpr size_t WS_END = 512 * MiB;
constexpr int CW_CNT = 1024;

__constant__ float c_inv_freq[32] = {1.000000000e+00f, 7.498942614e-01f, 5.623413324e-01f, 4.216965139e-01f, 3.162277639e-01f, 2.371373773e-01f, 1.778279394e-01f, 1.333521307e-01f, 1.000000015e-01f, 7.498941571e-02f, 5.623413250e-02f, 4.216965288e-02f, 3.162277490e-02f, 2.371373773e-02f, 1.778279431e-02f, 1.333521493e-02f, 9.999999776e-03f, 7.498941850e-03f, 5.623413250e-03f, 4.216964822e-03f, 3.162277630e-03f, 2.371373586e-03f, 1.778279431e-03f, 1.333521446e-03f, 1.000000047e-03f, 7.498942432e-04f, 5.623413017e-04f, 4.216965172e-04f, 3.162277571e-04f, 2.371373703e-04f, 1.778279402e-04f, 1.333521504e-04f};

#ifndef ST_NT
#define ST_NT 0
#endif
#if ST_NT
#define ST16(p, v) __builtin_nontemporal_store((v), (u32x4*)(p))
#define ST16F(p, v) __builtin_nontemporal_store((v), (f32x4*)(p))
#else
#define ST16(p, v) (*(u32x4*)(p) = (v))
#define ST16F(p, v) (*(f32x4*)(p) = (v))
#endif
__device__ __forceinline__ float bf2f(bf16_t v) { return __uint_as_float((unsigned)v << 16); }
__device__ __forceinline__ unsigned f2bf(float f) { unsigned u = __float_as_uint(f); return (u + 0x7fffu + ((u >> 16) & 1u)) >> 16; }
__device__ __forceinline__ unsigned pk2(float lo, float hi) { return f2bf(lo) | (f2bf(hi) << 16); }
__device__ __forceinline__ int lane_id() { return (int)__builtin_amdgcn_mbcnt_hi(~0u, __builtin_amdgcn_mbcnt_lo(~0u, 0u)); }
__device__ __forceinline__ float wave_sum(float v) {
#pragma unroll
    for (int o = 1; o < 64; o <<= 1) v += __shfl_xor(v, o);
    return v;
}
__device__ __forceinline__ float wave_max(float v) {
#pragma unroll
    for (int o = 1; o < 64; o <<= 1) v = fmaxf(v, __shfl_xor(v, o));
    return v;
}
__device__ __forceinline__ void rope_cs(int pos, int i, float& c, float& s) {
    const double ang = (double)pos * (double)c_inv_freq[i];
    const double rev = ang * 0.15915494309189535;
    const float fr = (float)(rev - __builtin_rint(rev));
    s = __builtin_amdgcn_sinf(fr); c = __builtin_amdgcn_cosf(fr);
}


#define LAS __attribute__((address_space(3)))
#define GAS __attribute__((address_space(1)))
typedef short bf16x8 __attribute__((ext_vector_type(8)));
typedef float f32x2 __attribute__((ext_vector_type(2)));

constexpr size_t WS_CQS = 9 * MiB;
constexpr size_t WS_CKVS = 10 * MiB;
constexpr size_t WS_COS = 11 * MiB;
constexpr size_t WS_SIN = 13 * MiB;
constexpr size_t WS_WIN = 16 * MiB;
constexpr size_t WS_WUQ = 19 * MiB;
constexpr size_t WS_WUKV = 19 * MiB + 512 * 1024;
constexpr size_t WS_WO = 20 * MiB;
constexpr size_t WS_WGU = 22 * MiB;
constexpr size_t WS_WDN = 54 * MiB;
constexpr int NPOS = SEQ + NMETA;

namespace pg8 {
constexpr int BM = 256, BK = 64, HALF = 128, HTB = HALF * BK * 2, STAGE_BYTES = 8 * HTB, NXCD = 8, WGM = 8;
__host__ __device__ __forceinline__ int lds_byte(int r, int c) { const int st = (r >> 4) * 2 + (c >> 5), rr = r & 15, cc = c & 31, ob = rr * 64 + cc * 2; return st * 1024 + (ob ^ (((ob >> 9) & 1) << 5)); }
__host__ __device__ __forceinline__ void stage_rc(int b, int& R, int& C) { const int st = b / 1024, sb = b % 1024, swz = sb ^ (((sb >> 9) & 1) << 5); R = (st >> 1) * 16 + swz / 64; C = (st & 1) * 32 + (swz % 64) / 2; }
__host__ __device__ __forceinline__ int perm32(int rho) { const int n = rho >> 4, i = rho & 15; return 8 * (i >> 2) + 4 * n + (i & 3); }
struct Unit { int pm, pn, e, r0, n; };
typedef float f32x2_t __attribute__((ext_vector_type(2))); typedef __bf16 bf16x2_t __attribute__((ext_vector_type(2)));
__device__ __forceinline__ unsigned cvt_pk_bf16(float lo, float hi) { const f32x2_t v = {lo, hi}; const bf16x2_t b = __builtin_convertvector(v, bf16x2_t); return __builtin_bit_cast(unsigned, b); }
__device__ __forceinline__ u32x4 pack8(const f32x4 a, const f32x4 b) { u32x4 w; w.x = cvt_pk_bf16(a[0], a[1]); w.y = cvt_pk_bf16(a[2], a[3]); w.z = cvt_pk_bf16(b[0], b[1]); w.w = cvt_pk_bf16(b[2], b[3]); return w; }

template <class Epi, class Sched, bool ALIGN_EPI>
__device__ __forceinline__ void gemm_phase(LAS unsigned char* lds, const int K, const Sched& S, const Epi& E) {
    const int tid = threadIdx.x, wid = __builtin_amdgcn_readfirstlane(tid >> 6), lane = tid & 63, wr = wid >> 2, wc = wid & 3, fr = lane & 15, fq = lane >> 4;
    const int nt = K / BK;
    int Rr[2]; unsigned cof[2], voffB[2];
#pragma unroll
    for (int i = 0; i < 2; ++i) { int R, C; stage_rc(tid * 16 + i * 8192, R, C); Rr[i] = R; cof[i] = (unsigned)C * 2u; const int Rb = Epi::PERM ? ((R & ~31) + perm32(R & 31)) : R; voffB[i] = (unsigned)(Rb * K + C) * 2u; }
    const size_t kstep = (size_t)(BK * 2);
    const size_t hstepB = (size_t)HALF * K * 2;
    const unsigned ldsw = (unsigned)wid * 1024u;
    const int aoff = lds_byte(wr * 64 + fr, fq * 8), boff = lds_byte(wc * 32 + fr, fq * 8);
#define PG8_SA(b, h) (((b) * 2 + (h)) * HTB)
#define PG8_SB(b, h) ((4 + (b) * 2 + (h)) * HTB)
#define PG8_STAGE(bufoff, gbase, voff) do { _Pragma("unroll") for (int _i = 0; _i < 2; ++_i) \
        __builtin_amdgcn_global_load_lds((const unsigned*)((const char*)(gbase) + (voff)[_i]), (LAS unsigned*)(lds + (bufoff) + ldsw + _i * 8192), 16, 0, 0); } while (0)
#define PG8_LDA(dst, b, h) do { _Pragma("unroll") for (int m = 0; m < 4; ++m) _Pragma("unroll") for (int k = 0; k < 2; ++k) dst[m][k] = *(const LAS bf16x8*)(lds + PG8_SA(b, h) + aoff + m * 2048 + k * 1024); } while (0)
#define PG8_LDB(dst, b, h) do { _Pragma("unroll") for (int n = 0; n < 2; ++n) _Pragma("unroll") for (int k = 0; k < 2; ++k) dst[n][k] = *(const LAS bf16x8*)(lds + PG8_SB(b, h) + boff + n * 2048 + k * 1024); } while (0)
#define PG8_MMA(ai, bj, At, Bt) do { __builtin_amdgcn_s_setprio(1); _Pragma("unroll") for (int m = 0; m < 4; ++m) _Pragma("unroll") for (int n = 0; n < 2; ++n) _Pragma("unroll") for (int k = 0; k < 2; ++k) \
        acc[ai][bj][m][n] = __builtin_amdgcn_mfma_f32_16x16x32_bf16(Bt[n][k], At[m][k], acc[ai][bj][m][n], 0, 0, 0); __builtin_amdgcn_s_setprio(0); } while (0)
#define PG8_WAIT_V(n) asm volatile("s_waitcnt vmcnt(" #n ")" ::: "memory")
#define PG8_WAIT_L(n) asm volatile("s_waitcnt lgkmcnt(" #n ")" ::: "memory")
#define PG8_BAR __builtin_amdgcn_s_barrier()
#define PG8_SCHED __builtin_amdgcn_sched_barrier(0)
    Unit cur, nxt; int ui = 0;
    if (!S.next(0, cur)) return;
    f32x4 acc[2][2][4][2];
#pragma unroll
    for (int a = 0; a < 2; ++a)
#pragma unroll
        for (int b = 0; b < 2; ++b)
#pragma unroll
            for (int m = 0; m < 4; ++m)
#pragma unroll
                for (int n = 0; n < 2; ++n) acc[a][b][m][n] = (f32x4){0.f, 0.f, 0.f, 0.f};
    bf16x8 At[4][2], B0[2][2], B1[2][2];
    unsigned vA0[2], vA1[2], vN0[2], vN1[2];
#pragma unroll
    for (int i = 0; i < 2; ++i) { vA0[i] = S.arow_off(cur, Rr[i]) + cof[i]; vA1[i] = S.arow_off(cur, Rr[i] + HALF) + cof[i]; }
    const char* cA = S.abase(cur); const char* cB = S.bbase(cur);
    PG8_STAGE(PG8_SB(0, 0), cB, voffB); PG8_STAGE(PG8_SB(0, 1), cB + hstepB, voffB); PG8_STAGE(PG8_SA(0, 0), cA, vA0); PG8_STAGE(PG8_SA(0, 1), cA, vA1);
    if (wr == 1) PG8_BAR;
    PG8_WAIT_V(2); PG8_BAR;
    PG8_STAGE(PG8_SB(1, 0), cB + kstep, voffB); PG8_STAGE(PG8_SA(1, 0), cA + kstep, vA0); PG8_STAGE(PG8_SB(1, 1), cB + hstepB + kstep, voffB);
    PG8_WAIT_V(6); PG8_BAR;
    for (;;) {
        const bool has_next = S.next(ui + 1, nxt);
        const char* nA = has_next ? S.abase(nxt) : cA; const char* nB = has_next ? S.bbase(nxt) : cB;
#pragma unroll
        for (int i = 0; i < 2; ++i) { vN0[i] = has_next ? S.arow_off(nxt, Rr[i]) + cof[i] : vA0[i]; vN1[i] = has_next ? S.arow_off(nxt, Rr[i] + HALF) + cof[i] : vA1[i]; }
#pragma unroll 1
        for (int t = 0; t < nt; t += 2) {
            const bool last = (t == nt - 2);
            const char* a1 = cA + (size_t)(t + 1) * kstep;
            const char* a2 = last ? nA : cA + (size_t)(t + 2) * kstep; const char* b2 = last ? nB : cB + (size_t)(t + 2) * kstep;
            const char* a3 = a2 + kstep; const char* b3 = b2 + kstep;
            unsigned w0[2], w1[2];
#pragma unroll
            for (int i = 0; i < 2; ++i) { w0[i] = last ? vN0[i] : vA0[i]; w1[i] = last ? vN1[i] : vA1[i]; }
            PG8_LDB(B0, 0, 0); PG8_LDB(B1, 0, 1); PG8_SCHED; PG8_LDA(At, 0, 0); PG8_STAGE(PG8_SA(1, 1), a1, vA1);
            PG8_WAIT_V(8); PG8_WAIT_L(0); PG8_BAR; PG8_MMA(0, 0, At, B0); PG8_MMA(0, 1, At, B1); PG8_BAR; PG8_SCHED;
            PG8_LDA(At, 0, 1); PG8_STAGE(PG8_SB(0, 0), b2, voffB); PG8_STAGE(PG8_SB(0, 1), b2 + hstepB, voffB); PG8_STAGE(PG8_SA(0, 0), a2, w0);
            PG8_WAIT_V(8); PG8_WAIT_L(0); PG8_BAR; PG8_MMA(1, 0, At, B0); PG8_MMA(1, 1, At, B1); PG8_BAR; PG8_SCHED;
            PG8_LDB(B0, 1, 0); PG8_LDB(B1, 1, 1); PG8_SCHED; PG8_LDA(At, 1, 0); PG8_STAGE(PG8_SA(0, 1), a2, w1);
            PG8_WAIT_V(8); PG8_WAIT_L(0); PG8_BAR; PG8_MMA(0, 0, At, B0); PG8_MMA(0, 1, At, B1); PG8_BAR; PG8_SCHED;
            PG8_LDA(At, 1, 1); PG8_STAGE(PG8_SB(1, 0), b3, voffB); PG8_STAGE(PG8_SB(1, 1), b3 + hstepB, voffB); PG8_STAGE(PG8_SA(1, 0), a3, w0);
            PG8_WAIT_V(8); PG8_WAIT_L(0); PG8_BAR; PG8_MMA(1, 0, At, B0); PG8_MMA(1, 1, At, B1); PG8_BAR; PG8_SCHED;
            if constexpr (Epi::MIDK) { if (t + 2 == nt / 2) E.midk(acc, cur, wr, wc, fr, fq); }
        }
        if constexpr (ALIGN_EPI) { if (wr == 0) PG8_BAR; }
        E(acc, cur, wr, wc, fr, fq);
        if (!has_next) break;
#pragma unroll
        for (int a = 0; a < 2; ++a)
#pragma unroll
            for (int b = 0; b < 2; ++b)
#pragma unroll
                for (int m = 0; m < 4; ++m)
#pragma unroll
                    for (int n = 0; n < 2; ++n) acc[a][b][m][n] = (f32x4){0.f, 0.f, 0.f, 0.f};
        cur = nxt; cA = nA; cB = nB; ++ui;
#pragma unroll
        for (int i = 0; i < 2; ++i) { vA0[i] = vN0[i]; vA1[i] = vN1[i]; }
        if constexpr (ALIGN_EPI) { if (wr == 1) PG8_BAR; }
    }
    PG8_WAIT_V(0);
    if constexpr (!ALIGN_EPI) { if (wr == 0) PG8_BAR; }
    PG8_BAR;
#undef PG8_SA
#undef PG8_SB
#undef PG8_STAGE
#undef PG8_LDA
#undef PG8_LDB
#undef PG8_MMA
#undef PG8_WAIT_V
#undef PG8_WAIT_L
#undef PG8_BAR
#undef PG8_SCHED
}

struct StaticOrder {
    const char* A; const char* Bt; int K;
    int nM, nN, nwg, G, c;
    __device__ void init(const void* A_, const void* Bt_, int M, int N, int K_, int G_, int c_) { A = (const char*)A_; Bt = (const char*)Bt_; K = K_; nM = M / BM; nN = N / BM; nwg = nM * nN; G = G_; c = c_; }
    __device__ bool next(int i, Unit& u) const {
        const long L = (long)i * G + c; if (L >= nwg) return false;
        int wgid = (int)L; { const int q = nwg / NXCD, r = nwg % NXCD, xcd = wgid % NXCD, off = wgid / NXCD; wgid = (xcd < r ? xcd * (q + 1) : r * (q + 1) + (xcd - r) * q) + off; }
        const int nig = WGM * nN, gid = wgid / nig, fm = gid * WGM, gsz = (nM - fm) < WGM ? (nM - fm) : WGM;
        u.pm = fm + ((wgid % nig) % gsz); u.pn = (wgid % nig) / gsz; return true;
    }
    __device__ __forceinline__ const char* abase(const Unit& u) const { return A + (size_t)u.pm * BM * K * 2; }
    __device__ __forceinline__ const char* bbase(const Unit& u) const { return Bt + (size_t)u.pn * BM * K * 2; }
    __device__ __forceinline__ unsigned arow_off(const Unit&, int R) const { return (unsigned)(R * K) * 2u; }
};
}

#define XB_TMO      128
#define XB_XCNT(j)  (256  + 64 * (j))
#define XB_XSUB(j)  (1280 + 64 * (j))
#define XB_XGEN(j)  (2304 + 64 * (j))
#define XB_TOP      3328
#define XB_TOPGEN   3392
#define XCD_BAR_WORDS 3456
#define XB_SPIN_CAP (1u << 18)
__device__ __forceinline__ unsigned xb_ld(unsigned* p)              { return __hip_atomic_load(p, __ATOMIC_RELAXED, __HIP_MEMORY_SCOPE_AGENT); }
__device__ __forceinline__ unsigned xb_add(unsigned* p, unsigned v) { return __hip_atomic_fetch_add(p, v, __ATOMIC_RELAXED, __HIP_MEMORY_SCOPE_AGENT); }
__device__ __forceinline__ unsigned xb_xcc_id() { return (unsigned)__builtin_amdgcn_s_getreg((3 << 11) | 20) & 0xFu; }
#define XB_SPIN(cond, bar) do { unsigned _sp = 0; while (cond) { __builtin_amdgcn_s_sleep(1); \
    if ((++_sp & 255u) == 0u) { if (xb_ld(&(bar)[XB_TMO])) break; if (_sp > XB_SPIN_CAP) { atomicAdd(&(bar)[XB_TMO], 1u); break; } } } } while (0)
struct XcdBarrier { unsigned* bar; unsigned x; volatile LAS unsigned* st; };
__device__ __forceinline__ XcdBarrier xcd_barrier_post(unsigned* bar, volatile LAS unsigned* st) {
    XcdBarrier b; b.bar = bar; b.x = xb_xcc_id(); b.st = st;
    if (threadIdx.x == 0) (void)xb_add(&bar[XB_XCNT(b.x)], 1u);
    return b;
}
__device__ __forceinline__ void xcd_barrier_complete(unsigned* bar, unsigned x, unsigned& nloc, unsigned& nx) {
    const unsigned G = gridDim.x * gridDim.y * gridDim.z;
    unsigned sum, cnt, mine, sp = 0u;
    for (;;) {
        sum = 0u; cnt = 0u; mine = 0u;
#pragma unroll
        for (unsigned j = 0; j < 16; ++j) { const unsigned c = xb_ld(&bar[XB_XCNT(j)]); sum += c; cnt += (c > 0u) ? 1u : 0u; mine = (j == x) ? c : mine; }
        if (sum == G) break;
        __builtin_amdgcn_s_sleep(1);
        if ((++sp & 255u) == 0u) { if (xb_ld(&bar[XB_TMO])) break; if (sp > XB_SPIN_CAP) { atomicAdd(&bar[XB_TMO], 1u); break; } }
    }
    nloc = mine > 0u ? mine : 1u; nx = cnt > 0u ? cnt : 1u;
}
__device__ __forceinline__ void xcd_barrier(const XcdBarrier& b) {
    asm volatile("s_waitcnt vmcnt(0)" ::: "memory");
    __syncthreads();
    if (threadIdx.x == 0) {
        unsigned* bar = b.bar;
        __builtin_amdgcn_s_waitcnt(0);
        unsigned nloc = b.st[0], nx = b.st[1];
        if (nloc == 0u) { xcd_barrier_complete(bar, b.x, nloc, nx); b.st[0] = nloc; b.st[1] = nx; }
        const unsigned old = xb_add(&bar[XB_XSUB(b.x)], 1u);
        const unsigned gen = old / nloc;
        if (old + 1u == (gen + 1u) * nloc) {
            __builtin_amdgcn_fence(__ATOMIC_RELEASE, "agent");
            asm volatile("s_waitcnt vmcnt(0)" ::: "memory");
            const unsigned og = xb_add(&bar[XB_TOP], 1u);
            const unsigned tg = og / nx;
            if (og + 1u == (tg + 1u) * nx) xb_add(&bar[XB_TOPGEN], 1u);
            else XB_SPIN(xb_ld(&bar[XB_TOPGEN]) == tg, bar);
            __builtin_amdgcn_fence(__ATOMIC_ACQUIRE, "agent");
            xb_add(&bar[XB_XGEN(b.x)], 1u);
            asm volatile("s_waitcnt vmcnt(0)" ::: "memory");
        } else {
            XB_SPIN(xb_ld(&bar[XB_XGEN(b.x)]) == gen, bar);
            __builtin_amdgcn_fence(__ATOMIC_ACQUIRE, "agent");
            asm volatile("s_waitcnt vmcnt(0)" ::: "memory");
        }
    }
    __syncthreads();
}

constexpr int NWAVES = 8;
constexpr int RING_BYTES = 135168, LDSCTL_OFF = RING_BYTES, MISC_OFF = LDSCTL_OFF + 320, LDS_BYTES = 147456;
constexpr int CW_BAR = 4096;
#define LDS_WAIT() asm volatile("s_waitcnt lgkmcnt(0)" ::: "memory")
#define VM_WAIT() asm volatile("s_waitcnt vmcnt(0)" ::: "memory")

struct Args {
    const float* in[24]; float* out; unsigned char* ws; int ph_lo, ph_hi;
};
struct Frame {
    LAS unsigned char* lds; unsigned char* ws; unsigned* ctl;
    int tid, lane, wave, G, bx;
};

__device__ __forceinline__ void p0_tr_item(const float* __restrict__ W, int ldn, int c0, int k0, bf16_t* dst, int K, const float* __restrict__ sc0, const float* __restrict__ sc1, LAS float* scr, int lane) {
    if (c0 >= 0) {
        f32x4 v[8];
#pragma unroll
        for (int i = 0; i < 8; ++i) v[i] = *(const f32x4*)(W + (size_t)(k0 + 8 * i + (lane >> 3)) * ldn + c0 + (lane & 7) * 4);
#pragma unroll
        for (int i = 0; i < 8; ++i) { const int kk = 8 * i + (lane >> 3), k = k0 + kk; f32x4 x = v[i];
            if (sc0) x *= (k < 512 || !sc1) ? sc0[k] : sc1[k - 512];
            LAS float* s = scr + kk * 33 + (lane & 7) * 4; s[0] = x.x; s[1] = x.y; s[2] = x.z; s[3] = x.w; }
    } else {
#pragma unroll 8
        for (int i = 0; i < 32; ++i) { const int kk = 2 * i + (lane >> 5); scr[kk * 33 + (lane & 31)] = 0.f; }
    }
    LDS_WAIT(); asm volatile("" ::: "memory");
    const int c = lane & 7;
#pragma unroll
    for (int j = 0; j < 4; ++j) { const int n = (lane >> 3) + 8 * j; const LAS float* s = scr + (8 * c) * 33 + n;
        u32x4 o; o.x = pk2(s[0 * 33], s[1 * 33]); o.y = pk2(s[2 * 33], s[3 * 33]); o.z = pk2(s[4 * 33], s[5 * 33]); o.w = pk2(s[6 * 33], s[7 * 33]);
        ST16((dst + (size_t)n * K + k0 + 8 * c), o); }
    LDS_WAIT(); asm volatile("" ::: "memory");
}
__device__ __forceinline__ int win_src_col(int tile, int q) {
    if (tile <= 1) return 256 * tile + 64 * (q & 3) + ((q >> 2) ? 32 : 0);
    if (tile == 2) { const int tb[8] = {512, 576, 640, 672, 544, 608, 704, 736}; int r = tb[0];
#pragma unroll
        for (int i = 1; i < 8; ++i) r = (q == i) ? tb[i] : r; return r; }
    if (tile == 3) return 768 + 32 * q;
    if (tile == 4) return 1024 + 32 * q;
    return q == 0 ? 1280 : (q == 4 ? 1312 : -1);
}
__device__ __forceinline__ int wuq_src_col(int tile, int q) {
    if (tile <= 1) return (2 * tile + (q >> 2)) * 192 + 32 * (q & 3);
    return (q & 3) * 192 + 128 + ((q >> 2) ? 32 : 0);
}

__device__ __forceinline__ void ln_row_bf16(const float* __restrict__ src, const float* __restrict__ g, const float* __restrict__ b, bf16_t* dst, int lane) {
    f32x4 v[4]; float s = 0.f;
#pragma unroll
    for (int j = 0; j < 4; ++j) { v[j] = *(const f32x4*)(src + j * 256 + lane * 4); s += (v[j].x + v[j].y) + (v[j].z + v[j].w); }
    const float mean = wave_sum(s) * (1.f / DM); float s2 = 0.f;
#pragma unroll
    for (int j = 0; j < 4; ++j) { v[j] = v[j] - mean; s2 += (v[j].x * v[j].x + v[j].y * v[j].y) + (v[j].z * v[j].z + v[j].w * v[j].w); }
    const float rstd = 1.f / sqrtf(wave_sum(s2) * (1.f / DM) + LN_EPS);
#pragma unroll
    for (int j = 0; j < 4; ++j) { const int c = j * 256 + lane * 4; const f32x4 gg = *(const f32x4*)(g + c), bb = *(const f32x4*)(b + c);
        const f32x4 o = v[j] * rstd * gg + bb; u32x2 w; w.x = pk2(o.x, o.y); w.y = pk2(o.z, o.w); *(u32x2*)(dst + c) = w; }
}

__device__ __forceinline__ bf16x8 ld_bcol8(const float* __restrict__ W, int ldn, int k0, int col) {
    float x[8];
#pragma unroll
    for (int j = 0; j < 8; ++j) x[j] = W[(size_t)(k0 + j) * ldn + col];
    u32x4 w; w.x = pk2(x[0], x[1]); w.y = pk2(x[2], x[3]); w.z = pk2(x[4], x[5]); w.w = pk2(x[6], x[7]);
    return __builtin_bit_cast(bf16x8, w);
}
__device__ __forceinline__ void p0_meta_block(const Frame& F, const Args& a, const int blk) {
    constexpr int RSH = 1032;
    LAS bf16_t* hm = (LAS bf16_t*)(F.lds);
    LAS float* pc = (LAS float*)(F.lds + 33280);
    const int lane = F.lane, w = F.wave, fr = lane & 15, fq = lane >> 4;
    const float* meta = a.in[1]; const float* g = a.in[2]; const float* b = a.in[3]; const float* w_in = a.in[4];
    float* UM = (float*)(F.ws + WS_UM);
#pragma unroll 1
    for (int rr = 0; rr < 2; ++rr) { const int row = 2 * w + rr; const float* src = meta + (size_t)row * DM;
        f32x4 v[4]; float s = 0.f;
#pragma unroll
        for (int j = 0; j < 4; ++j) { v[j] = *(const f32x4*)(src + j * 256 + lane * 4); s += (v[j].x + v[j].y) + (v[j].z + v[j].w); }
        const float mean = wave_sum(s) * (1.f / DM); float s2 = 0.f;
#pragma unroll
        for (int j = 0; j < 4; ++j) { v[j] = v[j] - mean; s2 += (v[j].x * v[j].x + v[j].y * v[j].y) + (v[j].z * v[j].z + v[j].w * v[j].w); }
        const float rstd = 1.f / sqrtf(wave_sum(s2) * (1.f / DM) + LN_EPS);
#pragma unroll
        for (int j = 0; j < 4; ++j) { const int c = j * 256 + lane * 4; const f32x4 gg = *(const f32x4*)(g + c), bb = *(const f32x4*)(b + c); const f32x4 o = v[j] * rstd * gg + bb;
            u32x2 pw; pw.x = pk2(o.x, o.y); pw.y = pk2(o.z, o.w); *(LAS u32x2*)(hm + row * RSH + c) = pw; } }
    __syncthreads();
    const int col = (blk < 16 ? 512 + 16 * blk : (blk < 32 ? 1024 + 16 * (blk - 16) : 1280 + 16 * (blk - 32))) + fr;
    bf16x8 bv[4];
#pragma unroll
    for (int s = 0; s < 4; ++s) bv[s] = ld_bcol8(w_in, INC, 32 * (4 * w + s) + 8 * fq, col);
    f32x4 c = {0.f, 0.f, 0.f, 0.f};
#pragma unroll
    for (int s = 0; s < 4; ++s) { const bf16x8 av = *(const LAS bf16x8*)(hm + fr * RSH + 32 * (4 * w + s) + 8 * fq); c = __builtin_amdgcn_mfma_f32_16x16x32_bf16(av, bv[s], c, 0, 0, 0); }
#pragma unroll
    for (int j = 0; j < 4; ++j) pc[w * 256 + (fq * 4 + j) * 16 + fr] = c[j];
    __syncthreads();
    if (F.tid < 256) { float sum = 0.f;
#pragma unroll
        for (int q = 0; q < 8; ++q) sum += pc[q * 256 + F.tid];
        const int oc = (blk < 16 ? 16 * blk : (blk < 32 ? 256 + 16 * (blk - 16) : 512 + 16 * (blk - 32))) + (F.tid & 15);
        UM[(F.tid >> 4) * 576 + oc] = sum; }
    __syncthreads();
}
__device__ __forceinline__ void p2_meta(const Frame& F, const Args& a, const int q) {
    const int lane = F.lane, w = F.wave, fr = lane & 15, fq = lane >> 4;
    const float* UM = (const float*)(F.ws + WS_UM); const float* gkv = a.in[8]; const float* w_ukv = a.in[9];
    bf16_t* KA = (bf16_t*)(F.ws + WS_KA); bf16_t* VA = (bf16_t*)(F.ws + WS_VA); bf16_t* KM = (bf16_t*)(F.ws + WS_KM); bf16_t* VM = (bf16_t*)(F.ws + WS_VM);
    if (q < 64) {
        LAS float* rs = (LAS float*)(F.lds); LAS float* pc = (LAS float*)(F.lds + 256);
#pragma unroll 1
        for (int rr = 0; rr < 2; ++rr) { const int row = 2 * w + rr; float ss = 0.f;
#pragma unroll
            for (int j = 0; j < 4; ++j) { const float v = UM[row * 576 + 256 + 64 * j + lane]; ss += v * v; }
            ss = wave_sum(ss); if (lane == 0) rs[row] = 1.f / sqrtf(ss * (1.f / 256.f) + RMS_EPS); }
        const bf16x8 bv = ld_bcol8(w_ukv, 1024, 32 * w + 8 * fq, 16 * q + fr);
        __syncthreads();
        float x[8]; const float r_ = rs[fr];
#pragma unroll
        for (int j = 0; j < 8; ++j) { const int k = 32 * w + 8 * fq + j; x[j] = UM[fr * 576 + 256 + k] * r_ * gkv[k]; }
        u32x4 aw; aw.x = pk2(x[0], x[1]); aw.y = pk2(x[2], x[3]); aw.z = pk2(x[4], x[5]); aw.w = pk2(x[6], x[7]);
        f32x4 c = {0.f, 0.f, 0.f, 0.f};
        c = __builtin_amdgcn_mfma_f32_16x16x32_bf16(__builtin_bit_cast(bf16x8, aw), bv, c, 0, 0, 0);
#pragma unroll
        for (int j = 0; j < 4; ++j) pc[w * 256 + (fq * 4 + j) * 16 + fr] = c[j];
        __syncthreads();
        if (F.tid < 256) { float sum = 0.f;
#pragma unroll
            for (int p = 0; p < 8; ++p) sum += pc[p * 256 + F.tid];
            const int r = F.tid >> 4, col = 16 * q + (F.tid & 15), h = col >> 8, cc = col & 255; const bf16_t hv = (bf16_t)f2bf(sum);
            for (int b2 = 0; b2 < NB; ++b2) { const size_t prow = (size_t)b2 * LP + NPAD + r;
                if (cc < 128) KM[prow * 768 + h * 192 + cc] = hv; else VM[prow * 512 + h * 128 + (cc - 128)] = hv; } }
        __syncthreads();
    } else {
        const int idx = (q - 64) * 256 + F.tid;
        if (F.tid < 256 && idx < 16 * 320) { const int r = idx / 320, c = idx % 320;
            const int oc = c < 256 ? c : c + 256; float v = UM[r * 576 + oc];
            if (c < 128 || c >= 256) { const float p = UM[r * 576 + (oc ^ 32)]; float cs, sn; rope_cs(r, c & 31, cs, sn); v = (c & 32) ? v * cs + p * sn : v * cs - p * sn; }
            const bf16_t hv = (bf16_t)f2bf(v);
            for (int b2 = 0; b2 < NB; ++b2) { const size_t prow = (size_t)b2 * LP + NPAD + r;
                if (c < 128) KA[prow * 128 + c] = hv; else if (c < 256) VA[prow * 128 + (c - 128)] = hv;
                else { const int cc = c - 256; KM[prow * 768 + 128 + cc] = hv; KM[prow * 768 + 192 + 128 + cc] = hv; KM[prow * 768 + 384 + 128 + cc] = hv; KM[prow * 768 + 576 + 128 + cc] = hv; } } }
    }
}

__device__ __forceinline__ void p0_prologue(const Frame& F, const Args& a) {
    for (int blk = F.bx; blk < 36; blk += F.G) p0_meta_block(F, a, blk);
    LAS float* scr = (LAS float*)(F.lds + F.wave * 16384);
    const int gw = F.bx * NWAVES + F.wave, NGW = F.G * NWAVES, lane = F.lane;
    unsigned char* ws = F.ws;
    constexpr int I_IN = 16 * 48, I_UQ = 4 * 24, I_UKV = 4 * 32, I_O = 16 * 32, I_GU = 32 * 16 * 16, I_DN = 32 * 4 * 32;
    constexpr int NITEMS = I_IN + I_UQ + I_UKV + I_O + I_GU + I_DN;
    for (int it = gw; it < NITEMS; it += NGW) {
        int r = it;
        if (r < I_IN) { const int kb = r / 48, nb = r % 48; p0_tr_item(a.in[4], INC, win_src_col(nb >> 3, nb & 7), 64 * kb, (bf16_t*)(ws + WS_WIN) + (size_t)(32 * nb) * DM, DM, nullptr, nullptr, scr, lane); continue; } r -= I_IN;
        if (r < I_UQ) { const int kb = r / 24, nb = r % 24; p0_tr_item(a.in[7], 768, wuq_src_col(nb >> 3, nb & 7), 64 * kb, (bf16_t*)(ws + WS_WUQ) + (size_t)(32 * nb) * 256, 256, a.in[6], nullptr, scr, lane); continue; } r -= I_UQ;
        if (r < I_UKV) { const int kb = r / 32, nb = r % 32; p0_tr_item(a.in[9], 1024, 32 * nb, 64 * kb, (bf16_t*)(ws + WS_WUKV) + (size_t)(32 * nb) * 256, 256, a.in[8], nullptr, scr, lane); continue; } r -= I_UKV;
        if (r < I_O) { const int kb = r / 32, nb = r % 32; p0_tr_item(a.in[12], DM, 32 * nb, 64 * kb, (bf16_t*)(ws + WS_WO) + (size_t)(32 * nb) * DM, DM, a.in[10], a.in[11], scr, lane); continue; } r -= I_O;
        if (r < I_GU) { const int e = r / 256, r2 = r % 256, kb = r2 / 16, nb = r2 % 16; const int tile = nb >> 3, q = nb & 7;
            const float* src = (q < 4 ? a.in[19] : a.in[20]) + (size_t)e * DM * 256;
            p0_tr_item(src, 256, 128 * tile + 32 * (q & 3), 64 * kb, (bf16_t*)(ws + WS_WGU) + ((size_t)e * 512 + 32 * nb) * DM, DM, nullptr, nullptr, scr, lane); continue; } r -= I_GU;
        { const int e = r / 128, r2 = r % 128, kb = r2 / 32, nb = r2 % 32;
            p0_tr_item(a.in[21] + (size_t)e * 256 * DM, DM, 32 * nb, 64 * kb, (bf16_t*)(ws + WS_WDN) + ((size_t)e * 1024 + 32 * nb) * 256, 256, nullptr, nullptr, scr, lane); }
    }
    { float* COS = (float*)(ws + WS_COS); float* SIN = (float*)(ws + WS_SIN);
      for (int it = gw; it < NPOS * 32 / 64; it += NGW) { const int idx = it * 64 + lane; float c, s; rope_cs(idx >> 5, idx & 31, c, s); COS[idx] = c; SIN[idx] = s; } }
    for (int it = gw; it < NB * NPAD; it += NGW) { const size_t prow = (size_t)(it / NPAD) * LP + (it % NPAD);
        const u32x4 z = {0u, 0u, 0u, 0u};
        for (int o = lane * 16; o < 3072; o += 1024) {
            unsigned char* p;
            if (o < 256) p = ws + WS_KA + prow * 256 + o; else if (o < 512) p = ws + WS_VA + prow * 256 + (o - 512 + 256);
            else if (o < 2048) p = ws + WS_KM + prow * 1536 + (o - 512); else p = ws + WS_VM + prow * 1024 + (o - 2048);
            ST16(p, z); } }
    { const float* x = a.in[0]; const float* g = a.in[2]; const float* b = a.in[3]; bf16_t* H0 = (bf16_t*)(ws + WS_H0);
      for (int m = gw; m < T; m += 2 * NGW) {
        const int m2 = m + NGW; const bool two = m2 < T;
        f32x4 v[2][4]; float s[2] = {0.f, 0.f};
#pragma unroll
        for (int j = 0; j < 4; ++j) { v[0][j] = *(const f32x4*)(x + (size_t)m * DM + j * 256 + lane * 4); v[1][j] = two ? *(const f32x4*)(x + (size_t)m2 * DM + j * 256 + lane * 4) : (f32x4){0.f, 0.f, 0.f, 0.f}; }
#pragma unroll
        for (int q = 0; q < 2; ++q)
#pragma unroll
            for (int j = 0; j < 4; ++j) s[q] += (v[q][j].x + v[q][j].y) + (v[q][j].z + v[q][j].w);
#pragma unroll
        for (int q = 0; q < 2; ++q) { if (q == 1 && !two) break;
            const float mean = wave_sum(s[q]) * (1.f / DM); float s2 = 0.f;
#pragma unroll
            for (int j = 0; j < 4; ++j) { v[q][j] = v[q][j] - mean; s2 += (v[q][j].x * v[q][j].x + v[q][j].y * v[q][j].y) + (v[q][j].z * v[q][j].z + v[q][j].w * v[q][j].w); }
            const float rstd = 1.f / sqrtf(wave_sum(s2) * (1.f / DM) + LN_EPS);
            bf16_t* dstp = H0 + (size_t)(q ? m2 : m) * DM;
#pragma unroll
            for (int j = 0; j < 4; ++j) { const int c = j * 256 + lane * 4; const f32x4 gg = *(const f32x4*)(g + c), bb = *(const f32x4*)(b + c);
                const f32x4 o = v[q][j] * rstd * gg + bb; u32x2 w2; w2.x = pk2(o.x, o.y); w2.y = pk2(o.z, o.w); *(u32x2*)(dstp + c) = w2; } }
      } }
}

__device__ __forceinline__ void rope8(const f32x4 lo0, const f32x4 lo1, const f32x4 hi0, const f32x4 hi1, const float* __restrict__ cosr, const float* __restrict__ sinr, u32x4& olo, u32x4& ohi, float scale) {
    const f32x4 c0 = *(const f32x4*)cosr, c1 = *(const f32x4*)(cosr + 4), s0 = *(const f32x4*)sinr, s1 = *(const f32x4*)(sinr + 4);
    olo = pg8::pack8((lo0 * c0 - hi0 * s0) * scale, (lo1 * c1 - hi1 * s1) * scale);
    ohi = pg8::pack8((hi0 * c0 + lo0 * s0) * scale, (hi1 * c1 + lo1 * s1) * scale);
}
struct EpiInProj {
    static constexpr bool PERM = true, MIDK = false;
    unsigned char* ws;
    __device__ __forceinline__ void operator()(const f32x4 (&acc)[2][2][4][2], const pg8::Unit& u, int wr, int wc, int fr, int fq) const {
        const int pn = u.pn, bb = u.pm >> 5, t0 = (u.pm & 31) * 256 + wr * 64 + fr;
        const float* COS = (const float*)(ws + WS_COS); const float* SIN = (const float*)(ws + WS_SIN);
        const int j0 = 8 * fq;
#pragma unroll
        for (int ai = 0; ai < 2; ++ai)
#pragma unroll
            for (int m = 0; m < 4; ++m) {
                const int t = t0 + ai * 128 + m * 16; const size_t mrow = (size_t)bb * SEQ + t; const size_t prow = (size_t)bb * LP + 128 + t; const int pos = t + NMETA;
                const f32x4 a00 = acc[ai][0][m][0], a01 = acc[ai][0][m][1], a10 = acc[ai][1][m][0], a11 = acc[ai][1][m][1];
                if (pn <= 1) { u32x4 lo, hi; rope8(a00, a01, a10, a11, COS + pos * 32 + j0, SIN + pos * 32 + j0, lo, hi, 1.f);
                    bf16_t* q = (bf16_t*)(ws + WS_QA) + mrow * 512 + (4 * pn + wc) * 64 + j0; ST16(q, lo); ST16((q + 32), hi); }
                else if (pn == 2) {
                    if (wc < 2) { u32x4 lo, hi; rope8(a00, a01, a10, a11, COS + pos * 32 + j0, SIN + pos * 32 + j0, lo, hi, 1.f);
                        bf16_t* k = (bf16_t*)(ws + WS_KA) + prow * 128 + wc * 64 + j0; ST16(k, lo); ST16((k + 32), hi); }
                    else { bf16_t* v = (bf16_t*)(ws + WS_VA) + prow * 128 + 32 * (wc - 2) + j0; ST16(v, pg8::pack8(a00, a01)); ST16((v + 64), pg8::pack8(a10, a11)); } }
                else if (pn <= 4) {
                    bf16_t* c = (bf16_t*)(ws + (pn == 3 ? WS_CQ : WS_CKV)) + mrow * 256 + 32 * wc + j0; ST16(c, pg8::pack8(a00, a01)); ST16((c + 128), pg8::pack8(a10, a11));
                    const f32x4 q = a00 * a00 + a01 * a01 + a10 * a10 + a11 * a11; float s = (q[0] + q[1]) + (q[2] + q[3]);
                    s += __shfl_xor(s, 16); s += __shfl_xor(s, 32);
                    if (fq == 0) ((float*)(ws + (pn == 3 ? WS_CQS : WS_CKVS)))[mrow * 4 + wc] = s; }
                else { if (wc == 0) { u32x4 lo, hi; rope8(a00, a01, a10, a11, COS + pos * 32 + j0, SIN + pos * 32 + j0, lo, hi, 1.f);
                        bf16_t* k = (bf16_t*)(ws + WS_KM) + prow * 768 + 128 + j0;
#pragma unroll
                        for (int h = 0; h < 4; ++h) { ST16((k + h * 192), lo); ST16((k + h * 192 + 32), hi); } } }
            }
    }
};

struct UpOrder {
    const char* CQ; const char* CKV; const char* Wq; const char* Wkv; int G, c;
    __device__ bool next(int i, pg8::Unit& u) const {
        if (G % 8 == 0) { const int x = c & 7, slot = c >> 3, ns = G >> 3; const int j = i * ns + slot;
            if (j >= 112) return false;
            if (j < 48) { u.pm = x + 8 * (j / 3); u.pn = j % 3; } else { const int j2 = j - 48; u.pm = x + 8 * (j2 >> 2); u.pn = 3 + (j2 & 3); }
            return true; }
        int L = i * G + c; if (L >= 896) return false;
        if (L < 384) { u.pm = L / 3; u.pn = L % 3; } else { L -= 384; u.pm = L >> 2; u.pn = 3 + (L & 3); }
        return true;
    }
    __device__ __forceinline__ const char* abase(const pg8::Unit& u) const { return (u.pn < 3 ? CQ : CKV) + (size_t)u.pm * 256 * 256 * 2; }
    __device__ __forceinline__ const char* bbase(const pg8::Unit& u) const { return u.pn < 3 ? Wq + (size_t)u.pn * 256 * 256 * 2 : Wkv + (size_t)(u.pn - 3) * 256 * 256 * 2; }
    __device__ __forceinline__ unsigned arow_off(const pg8::Unit&, int R) const { return (unsigned)(R * 256) * 2u; }
};
struct EpiUp {
    static constexpr bool PERM = true, MIDK = false;
    unsigned char* ws;
    __device__ __forceinline__ void operator()(const f32x4 (&acc)[2][2][4][2], const pg8::Unit& u, int wr, int wc, int fr, int fq) const {
        const int pn = u.pn, bb = u.pm >> 5, tb = (u.pm & 31) * 256;
        const size_t m0 = (size_t)bb * SEQ + tb, p0 = (size_t)bb * LP + 128 + tb;
        const char* COSb = (const char*)(ws + WS_COS) + (size_t)(tb + NMETA) * 128; const char* SINb = (const char*)(ws + WS_SIN) + (size_t)(tb + NMETA) * 128;
        const char* SSb = (const char*)(ws + (pn < 3 ? WS_CQS : WS_CKVS)) + m0 * 16;
        char* QMb = (char*)(ws + WS_QM) + m0 * 1536; char* KMb = (char*)(ws + WS_KM) + p0 * 1536; char* VMb = (char*)(ws + WS_VM) + p0 * 1024;
        int rl = wr * 64 + fr; asm volatile("" : "+v"(rl));
        const int j0 = 8 * fq;
        f32x4 sv[8];
#pragma unroll
        for (int q = 0; q < 8; ++q) sv[q] = *(const f32x4*)(SSb + (size_t)((unsigned)(rl + (q >> 2) * 128 + (q & 3) * 16) * 16u));
#pragma unroll
        for (int ai = 0; ai < 2; ++ai)
#pragma unroll
            for (int m = 0; m < 4; ++m) {
                const unsigned r = (unsigned)(rl + ai * 128 + m * 16); const f32x4 s4 = sv[ai * 4 + m];
                const float rstd = 1.f / sqrtf(((s4[0] + s4[1]) + (s4[2] + s4[3])) * (1.f / 256.f) + RMS_EPS);
                const f32x4 a00 = acc[ai][0][m][0] * rstd, a01 = acc[ai][0][m][1] * rstd, a10 = acc[ai][1][m][0] * rstd, a11 = acc[ai][1][m][1] * rstd;
                if (pn < 2) { char* q = QMb + (size_t)(r * 1536u + (unsigned)(((2 * pn) * 192 + 32 * wc + j0) * 2)); ST16(q, pg8::pack8(a00, a01)); ST16((q + 384), pg8::pack8(a10, a11)); }
                else if (pn == 2) { u32x4 lo, hi; const unsigned co = r * 128u + (unsigned)(j0 * 4); rope8(a00, a01, a10, a11, (const float*)(COSb + (size_t)co), (const float*)(SINb + (size_t)co), lo, hi, 1.f);
                    char* q = QMb + (size_t)(r * 1536u + (unsigned)((wc * 192 + 128 + j0) * 2)); ST16(q, lo); ST16((q + 64), hi); }
                else { const int h = pn - 3;
                    ST16(KMb + (size_t)(r * 1536u + (unsigned)((h * 192 + 32 * wc + j0) * 2)), pg8::pack8(a00, a01));
                    ST16(VMb + (size_t)(r * 1024u + (unsigned)((h * 128 + 32 * wc + j0) * 2)), pg8::pack8(a10, a11)); }
            }
    }
};

#ifndef ATT_PIPE
#define ATT_PIPE 0
#endif
#ifndef ATT_QKT_PF
#define ATT_QKT_PF 3
#endif
#ifndef ATT_QKT_GROUP
#define ATT_QKT_GROUP 0
#endif
#ifndef ATT_PF0
#define ATT_PF0 4
#endif
#ifndef ATT_HALF
#define ATT_HALF 0
#endif
#ifndef ATT_SKEW
#define ATT_SKEW 1
#endif
namespace att {
typedef short s16x4 __attribute__((ext_vector_type(4)));
typedef float f32x16 __attribute__((ext_vector_type(16)));
constexpr int NW = 8, QBLK = 32, KVBLK = 64, QB = NW * QBLK;
#define SBAR() __builtin_amdgcn_sched_barrier(0)
__device__ __forceinline__ int crow(int r, int hi) { return (r & 3) + 8 * (r >> 2) + 4 * hi; }
typedef float f32x2_t __attribute__((ext_vector_type(2))); typedef __bf16 bf16x2_t __attribute__((ext_vector_type(2)));
__device__ __forceinline__ unsigned cvtpk(float lo, float hi) { const f32x2_t v = {lo, hi}; const bf16x2_t b = __builtin_convertvector(v, bf16x2_t); return __builtin_bit_cast(unsigned, b); }
__device__ __forceinline__ int v_rd_base(int lane) { return ((lane & 3) << 3) | (((lane >> 2) & 3) << 6) | (((lane >> 4) & 1) << 5) | (((lane >> 5) & 1) << 8); }

template <int DQK_, int DV_, int LDQ_, int LDK_, int LDV_, int W_, bool SK_, int NPARK_>
struct Cfg {
    static constexpr int DQK = DQK_, DV = DV_, LDQ = LDQ_, LDK = LDK_, LDV = LDV_, W = W_; static constexpr bool SK = SK_;
    static constexpr int ROWB = DQK * 2, SHM_K = KVBLK * ROWB, SHM_V = KVBLK * DV * 2;
    static constexpr int KCPR = DQK / 8, VCPR = DV / 8, NKC = KVBLK * KCPR / 512, NVC = KVBLK * VCPR / 512, KG = (DV / 32) * 512, NQF = DQK / 16, NOF = DV / 32;
    static constexpr int NPARK = NPARK_, NQR = DQK_ / 16 - NPARK_;
    static constexpr int WS_OFF = 2 * SHM_V + 2 * SHM_K, PARK_OFF = WS_OFF + NW * 64 * 4, LDS_BYTES = PARK_OFF + NW * NPARK_ * 1024;
};
template <class C> struct BlockRef { const bf16_t* Q; const bf16_t* K; const bf16_t* V; bf16_t* O; float* SSQ; int P0; float m0, l0, c2; };
template <class C> struct Seam { bf16x8 qr[C::NQR]; bf16x8 st_k[C::NKC]; bf16x8 st_v[C::NVC]; };

__device__ __forceinline__ void mask_tile(f32x16& p0, f32x16& p1, int dq, unsigned W, int klim) {
    const float NEG = -__builtin_inff();
#pragma unroll
    for (int r = 0; r < 16; ++r) {
        const int c = (r & 3) + 8 * (r >> 2);
        if ((unsigned)(dq - c) >= W || c < klim) p0[r] = NEG;
        if ((unsigned)(dq - c - 32) >= W || c + 32 < klim) p1[r] = NEG;
    }
}
__device__ __forceinline__ void partialSM(f32x16& p0, f32x16& p1, float& m_reg, float& mn, float& alpha, float c2, float thr) {
    float pmax = p0[0];
#pragma unroll
    for (int r = 1; r < 16; ++r) pmax = fmaxf(pmax, p0[r]);
#pragma unroll
    for (int r = 0; r < 16; ++r) pmax = fmaxf(pmax, p1[r]);
    { auto rr = __builtin_amdgcn_permlane32_swap(__float_as_uint(pmax), __float_as_uint(pmax), false, false);
      pmax = fmaxf(__uint_as_float(rr[0]), __uint_as_float(rr[1])); }
    if (__builtin_expect(__all((pmax - m_reg) <= thr), 1)) { mn = m_reg; alpha = 1.f; }
    else { mn = fmaxf(m_reg, pmax); alpha = __builtin_amdgcn_exp2f((m_reg - mn) * c2); m_reg = mn; }
    const float mnL = -mn * c2;
#pragma unroll
    for (int r = 0; r < 16; ++r) p0[r] = fmaf(p0[r], c2, mnL);
#pragma unroll
    for (int r = 0; r < 16; ++r) p1[r] = fmaf(p1[r], c2, mnL);
#pragma unroll
    for (int r = 0; r < 16; ++r) p0[r] = __builtin_amdgcn_exp2f(p0[r]);
}
__device__ __forceinline__ void finishSM(f32x16& p0, f32x16& p1, float alpha, float& l_reg, bf16x8& pa0, bf16x8& pa1, bf16x8& pa2, bf16x8& pa3) {
#pragma unroll
    for (int r = 0; r < 16; ++r) p1[r] = __builtin_amdgcn_exp2f(p1[r]);
    float ps = 0;
#pragma unroll
    for (int r = 0; r < 16; ++r) ps += p0[r];
#pragma unroll
    for (int r = 0; r < 16; ++r) ps += p1[r];
    { auto rr = __builtin_amdgcn_permlane32_swap(__float_as_uint(ps), __float_as_uint(ps), false, false);
      ps = __uint_as_float(rr[0]) + __uint_as_float(rr[1]); }
    l_reg = l_reg * alpha + ps;
#define PK4(P, B_, OUT) do { unsigned a0 = cvtpk(P[B_+0], P[B_+1]), a1 = cvtpk(P[B_+2], P[B_+3]);                          \
        unsigned b0 = cvtpk(P[B_+4], P[B_+5]), b1 = cvtpk(P[B_+6], P[B_+7]);                                             \
        auto r0 = __builtin_amdgcn_permlane32_swap(a0, b0, false, false); auto r1 = __builtin_amdgcn_permlane32_swap(a1, b1, false, false); \
        u32x4 w = {r0[0], r1[0], r0[1], r1[1]}; OUT = *reinterpret_cast<bf16x8*>(&w); } while (0)
    PK4(p0, 0, pa0); PK4(p0, 8, pa1); PK4(p1, 0, pa2); PK4(p1, 8, pa3);
#undef PK4
}
template <class C, int D0, int PF> struct QktSched { static __device__ __forceinline__ void run() {
    __builtin_amdgcn_sched_group_barrier(0x008, 2, 0);
    if constexpr (D0 + PF < C::NQF) __builtin_amdgcn_sched_group_barrier(0x100, 2 + ((D0 + PF >= C::NQR) ? 1 : 0), 0);
    if constexpr (D0 + 1 < C::NQF) QktSched<C, D0 + 1, PF>::run(); } };
template <class C, int KB>
__device__ __forceinline__ void qkt(f32x16& p0, f32x16& p1, const char* K_lds, int r32, int hi, const bf16x8* qr, const char* qpark, bool act) {
    if (C::SK && !act) { const float NEG = -__builtin_inff();
#pragma unroll
        for (int r = 0; r < 16; ++r) { p0[r] = NEG; p1[r] = NEG; } return; }
    p0 = f32x16{}; p1 = f32x16{};
    const char* kb[4];
#pragma unroll
    for (int dd = 0; dd < 4; ++dd) kb[dd] = K_lds + KB * C::SHM_K + r32 * C::ROWB + (((dd * 16 + hi * 8) * 2) ^ (((r32 >> 1) & 7) << 4));
#pragma unroll
    for (int d0 = 0; d0 < C::NQF; ++d0) { const char* a = kb[d0 & 3] + (d0 >> 2) * 128;
        bf16x8 b0 = *reinterpret_cast<const bf16x8*>(a);
        bf16x8 b1 = *reinterpret_cast<const bf16x8*>(a + 32 * C::ROWB);
        bf16x8 qf; if (d0 < C::NQR) qf = qr[d0 < C::NQR ? d0 : 0]; else qf = *reinterpret_cast<const bf16x8*>(qpark + (d0 - C::NQR) * 1024);
        p0 = __builtin_amdgcn_mfma_f32_32x32x16_bf16(b0, qf, p0, 0, 0, 0);
        p1 = __builtin_amdgcn_mfma_f32_32x32x16_bf16(b1, qf, p1, 0, 0, 0);
        if (ATT_QKT_GROUP && C::NQF > 8 && (d0 & 3) == 3) SBAR(); }
#if ATT_QKT_PF > 0
    { constexpr int PF = ATT_QKT_PF < C::NQF ? ATT_QKT_PF : C::NQF;
      __builtin_amdgcn_sched_group_barrier(0x100, 2 * PF + ((PF > C::NQR) ? (PF - C::NQR) : 0), 0);
      QktSched<C, 0, PF>::run(); }
#endif
}
template <class C, int D0, int PF> struct QktSchedD { static __device__ __forceinline__ void run() {
    __builtin_amdgcn_sched_group_barrier(0x008, 1, 0); __builtin_amdgcn_sched_group_barrier(0x400, 2, 0); __builtin_amdgcn_sched_group_barrier(0x002, 3, 0);
    __builtin_amdgcn_sched_group_barrier(0x008, 1, 0); __builtin_amdgcn_sched_group_barrier(0x400, 1, 0); __builtin_amdgcn_sched_group_barrier(0x002, 3, 0);
    if constexpr (D0 + PF < C::NQF) __builtin_amdgcn_sched_group_barrier(0x100, 2 + ((D0 + PF >= C::NQR) ? 1 : 0), 0);
    if constexpr (D0 + 1 < C::NQF) QktSchedD<C, D0 + 1, PF>::run(); } };
template <class C, int KB>
__device__ __forceinline__ void qkt_dummy(f32x16& p0, f32x16& p1, const char* K_lds, int r32, int hi, const bf16x8* qr, const char* qpark, f32x4& dmy) {
    p0 = f32x16{}; p1 = f32x16{};
    const char* kb[4];
#pragma unroll
    for (int dd = 0; dd < 4; ++dd) kb[dd] = K_lds + KB * C::SHM_K + r32 * C::ROWB + (((dd * 16 + hi * 8) * 2) ^ (((r32 >> 1) & 7) << 4));
    f32x4 d2 = dmy;
#pragma unroll
    for (int d0 = 0; d0 < C::NQF; ++d0) { const char* a = kb[d0 & 3] + (d0 >> 2) * 128;
        bf16x8 b0 = *reinterpret_cast<const bf16x8*>(a);
        bf16x8 b1 = *reinterpret_cast<const bf16x8*>(a + 32 * C::ROWB);
        bf16x8 qf; if (d0 < C::NQR) qf = qr[d0 < C::NQR ? d0 : 0]; else qf = *reinterpret_cast<const bf16x8*>(qpark + (d0 - C::NQR) * 1024);
        p0 = __builtin_amdgcn_mfma_f32_32x32x16_bf16(b0, qf, p0, 0, 0, 0);
        p1 = __builtin_amdgcn_mfma_f32_32x32x16_bf16(b1, qf, p1, 0, 0, 0);
#pragma unroll
        for (int e = 0; e < 3; ++e) { const int i = (d0 * 3 + e) & 3; d2[i] = __builtin_amdgcn_exp2f(d2[i]); d2[(i + 1) & 3] = fmaf(d2[(i + 1) & 3], 1.0001f, d2[i]); d2[(i + 2) & 3] = fmaf(d2[(i + 2) & 3], 0.9999f, d2[i]); }
    }
    dmy = d2;
    { __builtin_amdgcn_sched_group_barrier(0x100, 6 + ((3 > C::NQR) ? (3 - C::NQR) : 0), 0);
      QktSchedD<C, 0, 3>::run(); }
}
template <class C, int VB>
__device__ __forceinline__ void pv_tile(f32x16* o, int vb0, bf16x8 pa0, bf16x8 pa1, bf16x8 pa2, bf16x8 pa3, bool act) {
    if (C::SK && !act) return;
#define TRRD(dst, off) asm volatile("ds_read_b64_tr_b16 %0, %1 offset:%2" : "=&v"(dst) : "v"(vb0), "i"(off) : "memory")
#define PV_RD(S_, d0) do { constexpr int b_ = VB * C::SHM_V + (d0) * 512; constexpr int KG_ = C::KG;   \
        TRRD(l0##S_, b_); TRRD(h0##S_, b_ + KG_); TRRD(l1##S_, b_ + 2 * KG_); TRRD(h1##S_, b_ + 3 * KG_); TRRD(l2##S_, b_ + 4 * KG_); TRRD(h2##S_, b_ + 5 * KG_); TRRD(l3##S_, b_ + 6 * KG_); TRRD(h3##S_, b_ + 7 * KG_); } while (0)
#define PV_MM(S_, d0) do {   \
        o[d0] = __builtin_amdgcn_mfma_f32_32x32x16_bf16(pa0, (bf16x8){l0##S_[0], l0##S_[1], l0##S_[2], l0##S_[3], h0##S_[0], h0##S_[1], h0##S_[2], h0##S_[3]}, o[d0], 0, 0, 0);   \
        o[d0] = __builtin_amdgcn_mfma_f32_32x32x16_bf16(pa1, (bf16x8){l1##S_[0], l1##S_[1], l1##S_[2], l1##S_[3], h1##S_[0], h1##S_[1], h1##S_[2], h1##S_[3]}, o[d0], 0, 0, 0);   \
        o[d0] = __builtin_amdgcn_mfma_f32_32x32x16_bf16(pa2, (bf16x8){l2##S_[0], l2##S_[1], l2##S_[2], l2##S_[3], h2##S_[0], h2##S_[1], h2##S_[2], h2##S_[3]}, o[d0], 0, 0, 0);   \
        o[d0] = __builtin_amdgcn_mfma_f32_32x32x16_bf16(pa3, (bf16x8){l3##S_[0], l3##S_[1], l3##S_[2], l3##S_[3], h3##S_[0], h3##S_[1], h3##S_[2], h3##S_[3]}, o[d0], 0, 0, 0); } while (0)
#define PV_W8() do { asm volatile("s_waitcnt lgkmcnt(8)" ::: "memory"); SBAR(); } while (0)
#define PV_W0() do { asm volatile("s_waitcnt lgkmcnt(0)" ::: "memory"); SBAR(); } while (0)
    s16x4 l0A, l1A, l2A, l3A, h0A, h1A, h2A, h3A, l0B, l1B, l2B, l3B, h0B, h1B, h2B, h3B;
    SBAR(); asm volatile("s_waitcnt lgkmcnt(0)" ::: "memory");
    PV_RD(A, 0); PV_RD(B, 1); PV_W8(); PV_MM(A, 0); SBAR();
    if constexpr (C::NOF == 4) { PV_RD(A, 2); PV_W8(); PV_MM(B, 1); SBAR(); PV_RD(B, 3); PV_W8(); PV_MM(A, 2); SBAR(); PV_W0(); PV_MM(B, 3); }
    else { PV_W0(); PV_MM(B, 1); }
    SBAR();
#undef PV_RD
#undef PV_MM
#undef PV_W8
#undef PV_W0
#undef TRRD
}
template <class C> __device__ __forceinline__ int jlo(int P0) { const int lowk = P0 - C::W + 1; int j = lowk > 0 ? lowk / KVBLK : 0; const int jm = NPAD / KVBLK; return j < jm ? jm : j; }

#define AT_RSRC(p) __builtin_amdgcn_make_buffer_rsrc((void*)(p), 0, 0x7fffffff, 0x00020000)
#define AT_BLD(rs, vo, so) __builtin_bit_cast(bf16x8, __builtin_amdgcn_raw_buffer_load_b128((rs), (int)(vo), (int)(so), 0))
#define AT_SLOAD(Kp, Vp, k0) do { const __amdgpu_buffer_rsrc_t kr__ = AT_RSRC(Kp), vr__ = AT_RSRC(Vp); const int ks__ = (k0) * (C::LDK * 2), vs__ = (k0) * (C::LDV * 2); \
    _Pragma("unroll") for (int i_ = 0; i_ < C::NVC; ++i_) S.st_v[i_] = AT_BLD(vr__, vgo + (unsigned)(i_ * 128), vs__); \
    _Pragma("unroll") for (int i_ = 0; i_ < C::NKC; ++i_) S.st_k[i_] = AT_BLD(kr__, kgo + (unsigned)(i_ * 128), ks__); } while (0)
#define AT_LOAD_K(Kp, k0) do { const __amdgpu_buffer_rsrc_t kr__ = AT_RSRC(Kp); const int ks__ = (k0) * (C::LDK * 2); \
    _Pragma("unroll") for (int i_ = 0; i_ < C::NKC; ++i_) S.st_k[i_] = AT_BLD(kr__, kgo + (unsigned)(i_ * 128), ks__); } while (0)
#define AT_LOAD_V(Vp, k0) do { const __amdgpu_buffer_rsrc_t vr__ = AT_RSRC(Vp); const int vs__ = (k0) * (C::LDV * 2); \
    _Pragma("unroll") for (int i_ = 0; i_ < C::NVC; ++i_) S.st_v[i_] = AT_BLD(vr__, vgo + (unsigned)(i_ * 128), vs__); } while (0)
#define AT_SWRITE_K(bf) do { _Pragma("unroll") for (int i_ = 0; i_ < C::NKC; ++i_) *(bf16x8*)(K_lds + (bf) * C::SHM_K + klo + i_ * 128) = S.st_k[i_]; } while (0)
#define AT_SWRITE_V(bf) do { _Pragma("unroll") for (int i_ = 0; i_ < C::NVC; ++i_) *(bf16x8*)(V_lds + (bf) * C::SHM_V + vlo + i_ * 1024) = S.st_v[i_]; } while (0)
#define AT_STAGE_OFFS() \
    const int srow_ = tid >> 3, scc_ = tid & 7; \
    const unsigned kgo = (unsigned)(srow_ * C::LDK + scc_ * 8) * 2u, vgo = (unsigned)(srow_ * C::LDV + scc_ * 8) * 2u; \
    const int klo = srow_ * C::ROWB + ((scc_ * 16) ^ (((srow_ >> 1) & 7) << 4)); \
    const int skk_ = (srow_ & ~0xC) | ((srow_ & 4) << 1) | ((srow_ & 8) >> 1); \
    const int vlo = ((skk_ >> 3) * C::NOF + (scc_ >> 2)) * 512 + ((skk_ & 7) * 32 + (scc_ & 3) * 8) * 2;
#define AT_VMW() asm volatile("s_waitcnt vmcnt(0)" ::: "memory")
#define AT_VMWN(n) asm volatile("s_waitcnt vmcnt(%0)" :: "i"(n) : "memory")

#define AT_QLOAD(Qp) do { bf16x8 qp_[C::NPARK > 0 ? C::NPARK : 1]; \
    const __amdgpu_buffer_rsrc_t qr__ = AT_RSRC(Qp); const int qs__ = wid * (QBLK * C::LDQ * 2); const unsigned qo__ = (unsigned)(r32 * C::LDQ + hi * 8) * 2u; \
    _Pragma("unroll") for (int d0 = 0; d0 < C::NPARK; ++d0) qp_[d0] = AT_BLD(qr__, qo__ + (unsigned)((C::NQR + d0) * 32), qs__); \
    _Pragma("unroll") for (int d0 = 0; d0 < C::NQR; ++d0) S.qr[d0] = AT_BLD(qr__, qo__ + (unsigned)(d0 * 32), qs__); \
    SBAR(); AT_VMWN(C::NQR); \
    _Pragma("unroll") for (int d0 = 0; d0 < C::NPARK; ++d0) *(bf16x8*)(qpark + d0 * 1024) = qp_[d0]; } while (0)
template <class C>
__device__ __forceinline__ void prime(const BlockRef<C>& cur, char* lds, Seam<C>& S, const int tid) {
    const int wid = __builtin_amdgcn_readfirstlane(tid >> 6), lane = tid & 63, r32 = lane & 31, hi = lane >> 5;
    char* K_lds = lds + 2 * C::SHM_V;
    AT_STAGE_OFFS()
    const int kb0 = jlo<C>(cur.P0) * KVBLK;
    char* qpark = lds + C::PARK_OFF + wid * (C::NPARK * 1024) + lane * 16;
    AT_SLOAD(cur.K, cur.V, kb0); SBAR(); AT_QLOAD(cur.Q); AT_VMW(); AT_SWRITE_K(0);
    __syncthreads();
}
template <class C>
__device__ __forceinline__ void block(const BlockRef<C>& cur, const BlockRef<C>& nxt, char* lds, Seam<C>& S, int ssq_slot, const int tid) {
    constexpr bool SK = C::SK; constexpr int W = C::W;
    const int wid = __builtin_amdgcn_readfirstlane(tid >> 6), lane = tid & 63, r32 = lane & 31, hi = lane >> 5;
    const int j_lo = jlo<C>(cur.P0);
    const int j_hi = (cur.P0 + QB - 1) / KVBLK + 1;
    const int NT = j_hi - j_lo;
    const int kbn = jlo<C>(nxt.P0) * KVBLK;
    const int qlo = cur.P0 + wid * QBLK, qm = qlo + r32 - 4 * hi;
    char* V_lds = lds; char* K_lds = lds + 2 * C::SHM_V;
    AT_STAGE_OFFS()
    float* ws = (float*)(lds + C::WS_OFF) + wid * 64; float* li_l = ws, * al_l = ws + 32;
    char* qpark = lds + C::PARK_OFF + wid * (C::NPARK * 1024) + lane * 16;
    float m_reg = cur.m0, l_reg = cur.l0; const float c2 = cur.c2, thr = 8.f * 1.4426950408889634f / c2;
    f32x16 o[C::NOF];
#pragma unroll
    for (int d_ = 0; d_ < C::NOF; ++d_) o[d_] = f32x16{};
    const int vb0 = (int)(uintptr_t)V_lds + v_rd_base(lane);
    const bf16_t* Kh = cur.K; const bf16_t* Vh = cur.V;
#define RESC(a) do { if (__any((a) < 1.f)) { if (hi == 0) al_l[r32] = (a); asm volatile("s_waitcnt lgkmcnt(0)" ::: "memory");              \
                     _Pragma("unroll") for (int d_ = 0; d_ < C::NOF; ++d_) _Pragma("unroll") for (int r = 0; r < 16; ++r) o[d_][r] *= al_l[crow(r, hi)]; } } while (0)
#define KBASE(t) ((j_lo + (t)) * KVBLK)
#define ACT(t) (KBASE(t) <= qlo + QBLK - 1 && KBASE(t) + KVBLK - 1 >= qlo - W + 1)
#define MASKT(P0_, P1_, t) do { const int kb_ = KBASE(t); if ((!SK || ACT(t)) && (kb_ + KVBLK - 1 > qlo || kb_ <= qlo + QBLK - 1 - W || kb_ < NPAD)) mask_tile(P0_, P1_, qm - kb_, (unsigned)W, NPAD - kb_ - 4 * hi); } while (0)
#if ATT_PIPE
    f32x16 pA0, pA1, pB0, pB1; float mnA, mnB, alA, alB; bf16x8 pa0, pa1, pa2, pa3;
    AT_SWRITE_V(0); SBAR();
    if (NT > 1) { AT_SLOAD(Kh, Vh, KBASE(1)); }
    SBAR(); qkt<C, 0>(pA0, pA1, K_lds, r32, hi, S.qr, qpark, ACT(0));
    MASKT(pA0, pA1, 0); partialSM(pA0, pA1, m_reg, mnA, alA, c2, thr);
    if (NT > 1) { AT_VMW(); AT_SWRITE_V(1); AT_SWRITE_K(1); }
    __syncthreads();
#define HALF_STEP(PX0, PX1, mnX, alX, PY0, PY1, alY, t, KB, VB, SB) do {                                                      \
        SBAR(); qkt<C, KB>(PX0, PX1, K_lds, r32, hi, S.qr, qpark, ACT(t));                                                  \
        finishSM(PY0, PY1, alY, l_reg, pa0, pa1, pa2, pa3); SBAR();                                                           \
        if ((t) + 1 < NT) { AT_SLOAD(Kh, Vh, KBASE((t) + 1)); SBAR(); }                                               \
        pv_tile<C, VB>(o, vb0, pa0, pa1, pa2, pa3, ACT((t) - 1)); MASKT(PX0, PX1, (t)); partialSM(PX0, PX1, m_reg, mnX, alX, c2, thr);       \
        __syncthreads();                                                                                                      \
        if ((t) + 1 < NT) { AT_VMW(); if (SB) { AT_SWRITE_V(1); AT_SWRITE_K(1); } else { AT_SWRITE_V(0); AT_SWRITE_K(0); } }                                                                          \
        RESC(alX); __syncthreads(); } while (0)
    for (int t = 1; t + 1 < NT; t += 2) {
        HALF_STEP(pB0, pB1, mnB, alB, pA0, pA1, alA, t, 1, 0, 0);
        HALF_STEP(pA0, pA1, mnA, alA, pB0, pB1, alB, t + 1, 0, 1, 1);
    }
#undef HALF_STEP
    const bool even = (NT & 1) == 0;
    if (even) { SBAR(); qkt<C, 1>(pB0, pB1, K_lds, r32, hi, S.qr, qpark, ACT(NT - 1)); SBAR(); }
    AT_SLOAD(nxt.K, nxt.V, kbn); SBAR();
    finishSM(pA0, pA1, alA, l_reg, pa0, pa1, pa2, pa3); SBAR();
    pv_tile<C, 0>(o, vb0, pa0, pa1, pa2, pa3, ACT(even ? NT - 2 : NT - 1));
    if (even) { MASKT(pB0, pB1, NT - 1); partialSM(pB0, pB1, m_reg, mnB, alB, c2, thr); __syncthreads(); RESC(alB);
        finishSM(pB0, pB1, alB, l_reg, pa0, pa1, pa2, pa3); SBAR(); pv_tile<C, 1>(o, vb0, pa0, pa1, pa2, pa3, ACT(NT - 1)); }
    SBAR();
    AT_QLOAD(nxt.Q);
    AT_SWRITE_K(0); SBAR();
#else
    f32x16 P0, P1; float mn, al; bf16x8 pa0, pa1, pa2, pa3;
    AT_SWRITE_V(0); __syncthreads();
#define STEP(t, B_, NB_) do { const bool more_ = (t) + 1 < NT;                                                              \
        SBAR(); if (more_) { AT_SLOAD(Kh, Vh, KBASE((t) + 1)); } else { AT_SLOAD(nxt.K, nxt.V, kbn); } SBAR();              \
        qkt<C, B_>(P0, P1, K_lds, r32, hi, S.qr, qpark, ACT(t)); SBAR();                                                   \
        MASKT(P0, P1, (t)); partialSM(P0, P1, m_reg, mn, al, c2, thr); RESC(al);                                            \
        finishSM(P0, P1, al, l_reg, pa0, pa1, pa2, pa3); SBAR();                                                             \
        pv_tile<C, B_>(o, vb0, pa0, pa1, pa2, pa3, ACT(t)); SBAR();                                                        \
        if (more_) { AT_VMW(); AT_SWRITE_V(NB_); AT_SWRITE_K(NB_); }                                                        \
        __syncthreads(); } while (0)
    int t = 0;
    for (; t + 1 < NT; t += 2) { STEP(t, 0, 1); STEP(t + 1, 1, 0); }
    if (t < NT) { STEP(t, 0, 1); }
#undef STEP
    AT_QLOAD(nxt.Q);
    AT_SWRITE_K(0); SBAR();
#endif
    if (hi == 0) li_l[r32] = l_reg; asm volatile("s_waitcnt lgkmcnt(0)" ::: "memory");
    float rli[16], sq[16];
#pragma unroll
    for (int r = 0; r < 16; ++r) { rli[r] = __builtin_amdgcn_rcpf(li_l[crow(r, hi)]); sq[r] = 0.f; }
    char* Ow = (char*)(cur.O + (size_t)(wid * QBLK) * 1024); const unsigned oo = (unsigned)(4 * hi * 1024 + r32) * 2u;
#pragma unroll
    for (int r = 0; r < 16; ++r) {
#pragma unroll
        for (int d0 = 0; d0 < C::NOF; ++d0) { const float v = o[d0][r] * rli[r]; sq[r] += v * v;
            const float vn = __shfl_xor(v, 1);
            if ((r32 & 1) == 0) *(unsigned*)(Ow + (size_t)(oo + (unsigned)((((r & 3) + 8 * (r >> 2)) * 1024 + d0 * 32) * 2))) = cvtpk(v, vn); } }
    float sel = 0.f; int r32e = r32, hie = hi; asm volatile("" : "+v"(r32e), "+v"(hie));
#pragma unroll
    for (int r = 0; r < 16; ++r) { float s = sq[r]; s += __shfl_xor(s, 1); s += __shfl_xor(s, 2); s += __shfl_xor(s, 4); s += __shfl_xor(s, 8); s += __shfl_xor(s, 16); sel = (r32e == r) ? s : sel; }
    if (r32e < 16) *(float*)((char*)(cur.SSQ + (size_t)(wid * QBLK) * 12 + ssq_slot) + (size_t)((unsigned)crow(r32e, hie) * 48u)) = sel;
    __syncthreads();
#undef RESC
#undef KBASE
#undef ACT
#undef MASKT
}

template <class C, int XP = 0>
__device__ __forceinline__ void block2(const BlockRef<C>& cur, char* lds, Seam<C>& S, int ssq_slot, const int tid) {
    constexpr bool SK = C::SK; constexpr int W = C::W;
    const int wid = __builtin_amdgcn_readfirstlane(tid >> 6), lane = tid & 63, r32 = lane & 31, hi = lane >> 5, g = wid >> 2;
    const int j_lo = jlo<C>(cur.P0);
    const int j_hi = (cur.P0 + QB - 1) / KVBLK + 1;
    const int NT = j_hi - j_lo;
    const int qlo = cur.P0 + wid * QBLK, qm = qlo + r32 - 4 * hi;
    char* V_lds = lds; char* K_lds = lds + 2 * C::SHM_V;
    AT_STAGE_OFFS()
    float* ws = (float*)(lds + C::WS_OFF) + wid * 64; float* li_l = ws, * al_l = ws + 32;
    char* qpark = lds + C::PARK_OFF + wid * (C::NPARK * 1024) + lane * 16;
    float m_reg = cur.m0, l_reg = cur.l0; const float c2 = cur.c2, thr = 8.f * 1.4426950408889634f / c2;
    f32x16 o[C::NOF];
#pragma unroll
    for (int d_ = 0; d_ < C::NOF; ++d_) o[d_] = f32x16{};
    const int vb0 = (int)(uintptr_t)V_lds + v_rd_base(lane);
    const bf16_t* Kh = cur.K; const bf16_t* Vh = cur.V;
#define RESC(a) do { if (__any((a) < 1.f)) { if (hi == 0) al_l[r32] = (a); asm volatile("s_waitcnt lgkmcnt(0)" ::: "memory");              \
                     _Pragma("unroll") for (int d_ = 0; d_ < C::NOF; ++d_) _Pragma("unroll") for (int r = 0; r < 16; ++r) o[d_][r] *= al_l[crow(r, hi)]; } } while (0)
#define KBASE(t) ((j_lo + (t)) * KVBLK)
#define ACT(t) (KBASE(t) <= qlo + QBLK - 1 && KBASE(t) + KVBLK - 1 >= qlo - W + 1)
#define MASKT(P0_, P1_, t) do { const int kb_ = KBASE(t); if ((!SK || ACT(t)) && (kb_ + KVBLK - 1 > qlo || kb_ <= qlo + QBLK - 1 - W || kb_ < NPAD)) mask_tile(P0_, P1_, qm - kb_, (unsigned)W, NPAD - kb_ - 4 * hi); } while (0)
#define BAR2() asm volatile("s_waitcnt lgkmcnt(0)\n\ts_barrier" ::: "memory")
#define LOADPAIR(tau) do { const int tau_ = (tau); if (tau_ < NT) { AT_LOAD_V(Vh, KBASE(tau_)); } if (tau_ + 1 < NT) { AT_LOAD_K(Kh, KBASE(tau_ + 1)); } } while (0)
#define WRITEPAIR(tau) do { const int tau_ = (tau); if (tau_ < NT) { AT_VMW(); AT_SWRITE_V(tau_ & 1); if (tau_ + 1 < NT) { AT_SWRITE_K((tau_ + 1) & 1); } } } while (0)
    AT_QLOAD(cur.Q);
    AT_LOAD_K(Kh, KBASE(0)); AT_VMW(); AT_SWRITE_K(0);
    if (g == 1) { AT_LOAD_V(Vh, KBASE(0)); AT_LOAD_K(Kh, KBASE(1)); AT_VMW(); AT_SWRITE_V(0); AT_SWRITE_K(1); }
    LOADPAIR(g);
    BAR2();
    if (g == 1) BAR2();
    f32x4 dmy = {0.f, 0.f, 0.f, 0.f}; asm volatile("" : "+v"(dmy));
    f32x16 P0 = f32x16{}, P1 = f32x16{}; float mn, al = 1.f; bf16x8 pa0 = bf16x8{}, pa1 = bf16x8{}, pa2 = bf16x8{}, pa3 = bf16x8{};
    qkt<C, 0>(P0, P1, K_lds, r32, hi, S.qr, qpark, ACT(0)); BAR2();
#define SSTAGE(t) do { if (XP != 1 && XP != 4) { MASKT(P0, P1, (t)); partialSM(P0, P1, m_reg, mn, al, c2, thr); RESC(al); finishSM(P0, P1, al, l_reg, pa0, pa1, pa2, pa3); } SBAR();   \
        if (XP != 2) { WRITEPAIR((t) + g); LOADPAIR((t) + g + 1); } BAR2(); } while (0)
#define MSTAGE(t, VB_, KB_) do { if (XP != 3) { pv_tile<C, VB_>(o, vb0, pa0, pa1, pa2, pa3, ACT(t)); SBAR();                                  \
        if ((t) + 1 < NT) { if (XP == 4) { qkt_dummy<C, KB_>(P0, P1, K_lds, r32, hi, S.qr, qpark, dmy); } else { qkt<C, KB_>(P0, P1, K_lds, r32, hi, S.qr, qpark, ACT((t) + 1)); } } } BAR2(); } while (0)
    int t = 0;
    for (; t + 1 < NT; t += 2) { SSTAGE(t); MSTAGE(t, 0, 1); SSTAGE(t + 1); MSTAGE(t + 1, 1, 0); }
    if (t < NT) { SSTAGE(t); MSTAGE(t, 0, 1); }
#undef SSTAGE
#undef MSTAGE
#undef LOADPAIR
#undef WRITEPAIR
    if (hi == 0) li_l[r32] = l_reg; asm volatile("s_waitcnt lgkmcnt(0)" ::: "memory");
    float rli[16], sq[16];
#pragma unroll
    for (int r = 0; r < 16; ++r) { rli[r] = __builtin_amdgcn_rcpf(li_l[crow(r, hi)]); sq[r] = 0.f; }
    char* Ow = (char*)(cur.O + (size_t)(wid * QBLK) * 1024); const unsigned oo = (unsigned)(4 * hi * 1024 + r32) * 2u;
#pragma unroll
    for (int r = 0; r < 16; ++r) {
#pragma unroll
        for (int d0 = 0; d0 < C::NOF; ++d0) { const float v = o[d0][r] * rli[r]; sq[r] += v * v;
            const float vn = __shfl_xor(v, 1);
            if (XP == 0 && (r32 & 1) == 0) *(unsigned*)(Ow + (size_t)(oo + (unsigned)((((r & 3) + 8 * (r >> 2)) * 1024 + d0 * 32) * 2))) = cvtpk(v, vn);
            if (XP != 0) asm volatile("" :: "v"(v)); } }
    float sel = 0.f; int r32e = r32, hie = hi; asm volatile("" : "+v"(r32e), "+v"(hie));
#pragma unroll
    for (int r = 0; r < 16; ++r) { float s = sq[r]; s += __shfl_xor(s, 1); s += __shfl_xor(s, 2); s += __shfl_xor(s, 4); s += __shfl_xor(s, 8); s += __shfl_xor(s, 16); sel = (r32e == r) ? s : sel; }
    if (XP == 0 && r32e < 16) *(float*)((char*)(cur.SSQ + (size_t)(wid * QBLK) * 12 + ssq_slot) + (size_t)((unsigned)crow(r32e, hie) * 48u)) = sel;
    if (XP != 0) asm volatile("" :: "v"(sel), "v"(dmy));
    if (g == 0) BAR2();
    BAR2();
#undef BAR2
#undef RESC
#undef KBASE
#undef ACT
#undef MASKT
}

typedef __attribute__((address_space(3))) const char* lds_cptr;
typedef short v4i16_t __attribute__((ext_vector_type(4)));
__device__ __forceinline__ s16x4 vtr(lds_cptr p) { return __builtin_bit_cast(s16x4, __builtin_amdgcn_ds_read_tr16_b64_v4i16((__attribute__((address_space(3))) v4i16_t*)p)); }
__device__ __forceinline__ void mask_half(f32x16& p, int dq, unsigned W, int klim) {
    const float NEG = -__builtin_inff();
#pragma unroll
    for (int r = 0; r < 16; ++r) { const int c = (r & 3) + 8 * (r >> 2); if ((unsigned)(dq - c) >= W || c < klim) p[r] = NEG; }
}
template <int NDS> struct StepSched { static __device__ __forceinline__ void run() {
    __builtin_amdgcn_sched_group_barrier(0x100, ATT_PF0, 0);
#define G_(n) __builtin_amdgcn_sched_group_barrier(0x008, 1, 0); if constexpr (ATT_PF0 + 2 * (n) < NDS) __builtin_amdgcn_sched_group_barrier(0x100, (NDS - ATT_PF0 - 2 * (n)) >= 2 ? 2 : 1, 0); \
              __builtin_amdgcn_sched_group_barrier(0x002, 4, 0); __builtin_amdgcn_sched_group_barrier(0x400, 1, 0);
    G_(0) G_(1) G_(2) G_(3) G_(4) G_(5) G_(6) G_(7) G_(8) G_(9) G_(10) G_(11) G_(12) G_(13) G_(14) G_(15) G_(16) G_(17) G_(18) G_(19)
#undef G_
} };
template <class C, int XP = 0>
__device__ __forceinline__ void block3(const BlockRef<C>& cur, char* lds, Seam<C>& S, int ssq_slot, const int tid) {
    static_assert(!C::SK && C::NOF == 4, "block3: causal, DV = 128");
    constexpr int W = C::W;
    const int wid = __builtin_amdgcn_readfirstlane(tid >> 6), lane = tid & 63, r32 = lane & 31, hi = lane >> 5;
    const int j_lo = jlo<C>(cur.P0);
    const int j_hi = (cur.P0 + QB - 1) / KVBLK + 1;
    const int NT = j_hi - j_lo;
    const int qlo = cur.P0 + wid * QBLK, qm = qlo + r32 - 4 * hi;
    char* V_lds = lds; char* K_lds = lds + 2 * C::SHM_V;
    AT_STAGE_OFFS()
    float* ws = (float*)(lds + C::WS_OFF) + wid * 64; float* li_l = ws, * al_l = ws + 32;
    char* qpark = lds + C::PARK_OFF + wid * (C::NPARK * 1024) + lane * 16;
    const lds_cptr qpl = (lds_cptr)qpark;
    const lds_cptr vp = (lds_cptr)V_lds + v_rd_base(lane);
    lds_cptr kp[4];
#pragma unroll
    for (int dd = 0; dd < 4; ++dd) kp[dd] = (lds_cptr)K_lds + r32 * C::ROWB + (((dd * 16 + hi * 8) * 2) ^ (((r32 >> 1) & 7) << 4));
    float m_reg = cur.m0, l_reg = cur.l0; const float c2 = cur.c2, thr = 8.f * 1.4426950408889634f / c2;
    f32x16 o[4];
#pragma unroll
    for (int d_ = 0; d_ < 4; ++d_) o[d_] = f32x16{};
    const bf16_t* Kh = cur.K; const bf16_t* Vh = cur.V;
#define KBASE(t) ((j_lo + (t)) * KVBLK)
#define BAR2() asm volatile("s_waitcnt lgkmcnt(0)\n\ts_barrier" ::: "memory")
#define RESC(a) do { if (__any((a) < 1.f)) { if (hi == 0) al_l[r32] = (a); asm volatile("s_waitcnt lgkmcnt(0)" ::: "memory");              \
                     _Pragma("unroll") for (int d_ = 0; d_ < 4; ++d_) _Pragma("unroll") for (int r = 0; r < 16; ++r) o[d_][r] *= al_l[crow(r, hi)]; } } while (0)
#define QPART(PN, KB_, HQ_) do { PN = f32x16{};                                                                                           \
        _Pragma("unroll") for (int d0 = 0; d0 < C::NQF; ++d0) { const bf16x8 kf = *(const __attribute__((address_space(3))) bf16x8*)(kp[d0 & 3] + ((KB_) * C::SHM_K + (HQ_) * 32 * C::ROWB + (d0 >> 2) * 128)); \
            bf16x8 qf; if (d0 < C::NQR) qf = S.qr[d0 < C::NQR ? d0 : 0]; else qf = *(const __attribute__((address_space(3))) bf16x8*)(qpl + (d0 - C::NQR) * 1024);                      \
            PN = __builtin_amdgcn_mfma_f32_32x32x16_bf16(kf, qf, PN, 0, 0, 0); } } while (0)
#define VPART(A_, B_, VB_, HV_) do {                                                                                                      \
        _Pragma("unroll") for (int d0 = 0; d0 < 4; ++d0) { const lds_cptr b_ = vp + ((VB_) * C::SHM_V + d0 * 512 + 4 * (HV_) * C::KG);     \
            const s16x4 la = vtr(b_), ha = vtr(b_ + C::KG), lb = vtr(b_ + 2 * C::KG), hb = vtr(b_ + 3 * C::KG);                            \
            o[d0] = __builtin_amdgcn_mfma_f32_32x32x16_bf16(A_, (bf16x8){la[0], la[1], la[2], la[3], ha[0], ha[1], ha[2], ha[3]}, o[d0], 0, 0, 0);   \
            o[d0] = __builtin_amdgcn_mfma_f32_32x32x16_bf16(B_, (bf16x8){lb[0], lb[1], lb[2], lb[3], hb[0], hb[1], hb[2], hb[3]}, o[d0], 0, 0, 0); } } while (0)
#define SMAX(PC, PM_) do {                                                                                                                \
        float pm_ = fmaxf(fmaxf(PC[0], PC[1]), fmaxf(PC[2], PC[3]));                                                                    \
        _Pragma("unroll") for (int r = 4; r < 16; r += 4) pm_ = fmaxf(pm_, fmaxf(fmaxf(PC[r], PC[r + 1]), fmaxf(PC[r + 2], PC[r + 3])));  \
        { auto rr = __builtin_amdgcn_permlane32_swap(__float_as_uint(pm_), __float_as_uint(pm_), false, false); pm_ = fmaxf(__uint_as_float(rr[0]), __uint_as_float(rr[1])); } \
        PM_ = pm_; } while (0)
#define SEXP(PC, PM_, NA_, NB_) do {                                                                                                      \
        const bool grow_ = ((PM_) - m_reg) > thr; const float mn_ = grow_ ? fmaxf(m_reg, (PM_)) : m_reg;                               \
        al = grow_ ? __builtin_amdgcn_exp2f((m_reg - mn_) * c2) : 1.f; m_reg = mn_; const float mnL_ = -mn_ * c2;                       \
        _Pragma("unroll") for (int r = 0; r < 16; ++r) PC[r] = __builtin_amdgcn_exp2f(fmaf(PC[r], c2, mnL_));                             \
        float ps_ = 0.f; _Pragma("unroll") for (int r = 0; r < 16; ++r) ps_ += PC[r];                                                     \
        { auto rr = __builtin_amdgcn_permlane32_swap(__float_as_uint(ps_), __float_as_uint(ps_), false, false); ps_ = __uint_as_float(rr[0]) + __uint_as_float(rr[1]); } \
        l_reg = l_reg * al + ps_;                                                                                                         \
        { unsigned a0 = cvtpk(PC[0], PC[1]), a1 = cvtpk(PC[2], PC[3]), b0 = cvtpk(PC[4], PC[5]), b1 = cvtpk(PC[6], PC[7]);               \
          auto r0 = __builtin_amdgcn_permlane32_swap(a0, b0, false, false); auto r1 = __builtin_amdgcn_permlane32_swap(a1, b1, false, false); \
          u32x4 w_ = {r0[0], r1[0], r0[1], r1[1]}; NA_ = __builtin_bit_cast(bf16x8, w_); }                                                \
        { unsigned a0 = cvtpk(PC[8], PC[9]), a1 = cvtpk(PC[10], PC[11]), b0 = cvtpk(PC[12], PC[13]), b1 = cvtpk(PC[14], PC[15]);         \
          auto r0 = __builtin_amdgcn_permlane32_swap(a0, b0, false, false); auto r1 = __builtin_amdgcn_permlane32_swap(a1, b1, false, false); \
          u32x4 w_ = {r0[0], r1[0], r0[1], r1[1]}; NB_ = __builtin_bit_cast(bf16x8, w_); } } while (0)
#define MASKH(PC, h) do { const int kbh_ = KBASE((h) >> 1) + 32 * ((h) & 1); if (kbh_ + 31 > qlo || kbh_ < NPAD) mask_half(PC, qm - kbh_, (unsigned)W, NPAD - kbh_ - 4 * hi); } while (0)
    AT_QLOAD(cur.Q);
    AT_LOAD_K(Kh, KBASE(0)); AT_LOAD_V(Vh, KBASE(0)); AT_VMW(); AT_SWRITE_K(0); AT_SWRITE_V(0);
    AT_LOAD_K(Kh, KBASE(1));
    BAR2();
    f32x16 PA, PB; float al = 1.f, pmA, pmB; bf16x8 fa = bf16x8{}, fb = bf16x8{}, ga, gb;
    QPART(PA, 0, 0); SBAR(); MASKH(PA, 0); SMAX(PA, pmA); SBAR();
    AT_LOAD_V(Vh, KBASE(1)); SBAR();
    QPART(PB, 0, 1); SEXP(PA, pmA, fa, fb); SBAR();
    MASKH(PB, 1); SMAX(PB, pmB); RESC(al); AT_VMWN(C::NVC); AT_SWRITE_K(1); BAR2();
#define FULL(h, PC, PMC, PN, PMN, A_, B_, NA_, NB_, VB_, HV_, KB_, HQ_, EVEN_) do { const int t_ = (h) >> 1;                              \
        if (EVEN_) { if (t_ + 1 < NT) { AT_LOAD_V(Vh, KBASE(t_ + 1)); } } else { if (t_ + 2 < NT) { AT_LOAD_K(Kh, KBASE(t_ + 2)); } } SBAR();  \
        VPART(A_, B_, VB_, HV_); QPART(PN, KB_, HQ_); SEXP(PC, PMC, NA_, NB_); StepSched<32 + C::NPARK>::run(); SBAR();                   \
        MASKH(PN, (h) + 1); SMAX(PN, PMN); RESC(al);                                                                                    \
        if (EVEN_) { if (t_ + 1 < NT) { AT_VMWN(C::NVC); AT_SWRITE_K((t_ + 1) & 1); } } else { if (t_ + 1 < NT) { if (t_ + 2 < NT) { AT_VMWN(C::NKC); } else { AT_VMW(); } AT_SWRITE_V((t_ + 1) & 1); } }  \
        BAR2(); } while (0)
    int h = 1;
    for (; h + 3 <= 2 * NT - 2; h += 4) {
        FULL(h,     PB, pmB, PA, pmA, fa, fb, ga, gb, 0, 0, 1, 0, false);
        FULL(h + 1, PA, pmA, PB, pmB, ga, gb, fa, fb, 0, 1, 1, 1, true);
        FULL(h + 2, PB, pmB, PA, pmA, fa, fb, ga, gb, 1, 0, 0, 0, false);
        FULL(h + 3, PA, pmA, PB, pmB, ga, gb, fa, fb, 1, 1, 0, 1, true);
    }
#undef FULL
    VPART(fa, fb, 0, 0); SEXP(PB, pmB, ga, gb); SBAR();
    RESC(al);
    VPART(ga, gb, 0, 1); SBAR();
#undef QPART
#undef VPART
#undef SMAX
#undef SEXP
#undef MASKH
    if (hi == 0) li_l[r32] = l_reg; asm volatile("s_waitcnt lgkmcnt(0)" ::: "memory");
    float rli[16], sq[16];
#pragma unroll
    for (int r = 0; r < 16; ++r) { rli[r] = __builtin_amdgcn_rcpf(li_l[crow(r, hi)]); sq[r] = 0.f; }
    char* Ow = (char*)(cur.O + (size_t)(wid * QBLK) * 1024); const unsigned oo = (unsigned)(4 * hi * 1024 + r32) * 2u;
#pragma unroll
    for (int r = 0; r < 16; ++r) {
#pragma unroll
        for (int d0 = 0; d0 < 4; ++d0) { const float v = o[d0][r] * rli[r]; sq[r] += v * v;
            const float vn = __shfl_xor(v, 1);
            if (XP == 0 && (r32 & 1) == 0) *(unsigned*)(Ow + (size_t)(oo + (unsigned)((((r & 3) + 8 * (r >> 2)) * 1024 + d0 * 32) * 2))) = cvtpk(v, vn);
            if (XP != 0) asm volatile("" :: "v"(v)); } }
    float sel = 0.f; int r32e = r32, hie = hi; asm volatile("" : "+v"(r32e), "+v"(hie));
#pragma unroll
    for (int r = 0; r < 16; ++r) { float s = sq[r]; s += __shfl_xor(s, 1); s += __shfl_xor(s, 2); s += __shfl_xor(s, 4); s += __shfl_xor(s, 8); s += __shfl_xor(s, 16); sel = (r32e == r) ? s : sel; }
    if (XP == 0 && r32e < 16) *(float*)((char*)(cur.SSQ + (size_t)(wid * QBLK) * 12 + ssq_slot) + (size_t)((unsigned)crow(r32e, hie) * 48u)) = sel;
    if (XP != 0) asm volatile("" :: "v"(sel));
    BAR2();
#undef BAR2
#undef RESC
#undef KBASE
}
#undef AT_STAGE_OFFS
#undef AT_LOAD_K
#undef AT_LOAD_V
#undef AT_SLOAD
#undef AT_SWRITE_K
#undef AT_SWRITE_V
#undef AT_VMW
#undef AT_VMWN
#undef AT_QLOAD
#undef AT_RSRC
#undef AT_BLD
#undef SBAR

typedef Cfg<192, 128, 768, 768, 512, LP, false, 6> CfgMLA;
typedef Cfg<64, 64, 512, 128, 128, 128, true, 0> CfgSWA;
constexpr float C2_MLA = 1.4426950408889634f * 0.07216878364870322f, C2_SWA = 1.4426950408889634f * 0.125f;
static_assert(CfgMLA::LDS_BYTES <= RING_BYTES && CfgSWA::LDS_BYTES <= RING_BYTES, "attention LDS");

__device__ __forceinline__ BlockRef<CfgMLA> mla_ref(unsigned char* ws, int bh, int qb) {
    const int b = bh >> 2, h = bh & 3; BlockRef<CfgMLA> r; const size_t m0 = (size_t)b * SEQ + (size_t)qb * QB;
    r.Q = (const bf16_t*)(ws + WS_QM) + m0 * 768 + h * 192; r.K = (const bf16_t*)(ws + WS_KM) + (size_t)b * LP * 768 + h * 192;
    r.V = (const bf16_t*)(ws + WS_VM) + (size_t)b * LP * 512 + h * 128; r.O = (bf16_t*)(ws + WS_AO) + m0 * 1024 + 512 + h * 128;
    r.SSQ = (float*)(ws + WS_SSQ) + m0 * 12; r.P0 = 128 + qb * QB; r.m0 = -1e30f; r.l0 = 0.f; r.c2 = C2_MLA; return r;
}
__device__ __forceinline__ BlockRef<CfgSWA> swa_ref(unsigned char* ws, const float* sinks, int bh, int qb) {
    const int b = bh >> 3, h = bh & 7, kvh = h >> 2; BlockRef<CfgSWA> r; const size_t m0 = (size_t)b * SEQ + (size_t)qb * QB;
    r.Q = (const bf16_t*)(ws + WS_QA) + m0 * 512 + h * 64; r.K = (const bf16_t*)(ws + WS_KA) + (size_t)b * LP * 128 + kvh * 64;
    r.V = (const bf16_t*)(ws + WS_VA) + (size_t)b * LP * 128 + kvh * 64; r.O = (bf16_t*)(ws + WS_AO) + m0 * 1024 + h * 64;
    r.SSQ = (float*)(ws + WS_SSQ) + m0 * 12; r.P0 = 128 + qb * QB; r.m0 = sinks[h] * 8.f; r.l0 = 1.f; r.c2 = C2_SWA; return r;
}
template <int XP = 0>
__device__ __forceinline__ void attn_phase(char* lds, unsigned char* ws, const float* sinks, int vcu, int G) {
    {
        const int nit = (256 - vcu + G - 1) / G;
        const int nblk = 2 * (nit > 0 ? nit : 0);
        if (nblk > 0) {
            Seam<CfgMLA> S; int tid = threadIdx.x; asm volatile("" : "+v"(tid));
#define MLA_REF(k) mla_ref(ws, (vcu + ((k) >> 1) * G) >> 4, ((k) & 1) ? ((vcu + ((k) >> 1) * G) & 15) : 31 - ((vcu + ((k) >> 1) * G) & 15))
            BlockRef<CfgMLA> cur = MLA_REF(0);
#if ATT_SKEW
#if ATT_HALF
            for (int k = 0; k < nblk; ++k) { cur = MLA_REF(k); block3<CfgMLA, XP>(cur, lds, S, 8 + (((vcu + (k >> 1) * G) >> 4) & 3), tid); }
#else
            for (int k = 0; k < nblk; ++k) { cur = MLA_REF(k); block2<CfgMLA, XP>(cur, lds, S, 8 + (((vcu + (k >> 1) * G) >> 4) & 3), tid); }
#endif
#else
            prime<CfgMLA>(cur, lds, S, tid);
            for (int k = 0; k < nblk; ++k) { const BlockRef<CfgMLA> nxt = (k + 1 < nblk) ? MLA_REF(k + 1) : cur; block<CfgMLA>(cur, nxt, lds, S, 8 + (((vcu + (k >> 1) * G) >> 4) & 3), tid); cur = nxt; }
#endif
#undef MLA_REF
        }
    }
    {
        const int nit = (256 - vcu + G - 1) / G;
        const int nblk = 4 * (nit > 0 ? nit : 0);
        if (nblk > 0) {
            Seam<CfgSWA> S; int tid = threadIdx.x; asm volatile("" : "+v"(tid));
#define SWA_REF(k) swa_ref(ws, sinks, (4 * (vcu + ((k) >> 2) * G) + ((k) & 3)) >> 5, (4 * (vcu + ((k) >> 2) * G) + ((k) & 3)) & 31)
            BlockRef<CfgSWA> cur = SWA_REF(0);
#if ATT_SKEW
            for (int k = 0; k < nblk; ++k) { cur = SWA_REF(k); block2<CfgSWA, XP>(cur, lds, S, ((4 * (vcu + (k >> 2) * G) + (k & 3)) >> 5) & 7, tid); }
#else
            prime<CfgSWA>(cur, lds, S, tid);
            for (int k = 0; k < nblk; ++k) { const BlockRef<CfgSWA> nxt = (k + 1 < nblk) ? SWA_REF(k + 1) : cur; block<CfgSWA>(cur, nxt, lds, S, ((4 * (vcu + (k >> 2) * G) + (k & 3)) >> 5) & 7, tid); cur = nxt; }
#endif
#undef SWA_REF
        }
    }
}
}

struct EpiOut {
    static constexpr bool PERM = true, MIDK = true;
    unsigned char* ws;
    __device__ __forceinline__ void midk(f32x4 (&acc)[2][2][4][2], const pg8::Unit& u, int wr, int wc, int fr, int fq) const {
        const char* SSQb = (const char*)(ws + WS_SSQ) + (size_t)u.pm * (256 * 48);
        unsigned lo = (unsigned)(wr * 64 + fr) * 48u; asm volatile("" : "+v"(lo));
#pragma unroll
        for (int ai = 0; ai < 2; ++ai) {
            f32x4 s0[4], s1[4], s2[4];
#pragma unroll
            for (int m = 0; m < 4; ++m) { const char* p = SSQb + (size_t)(lo + (unsigned)((ai * 128 + m * 16) * 48)); s0[m] = *(const f32x4*)p; s1[m] = *(const f32x4*)(p + 16); s2[m] = *(const f32x4*)(p + 32); }
#pragma unroll
            for (int m = 0; m < 4; ++m) {
                const float sa = ((s0[m][0] + s0[m][1]) + (s0[m][2] + s0[m][3])) + ((s1[m][0] + s1[m][1]) + (s1[m][2] + s1[m][3])), sb = (s2[m][0] + s2[m][1]) + (s2[m][2] + s2[m][3]);
                const float rho = sqrtf((sb * (1.f / 512.f) + RMS_EPS) / (sa * (1.f / 512.f) + RMS_EPS));
#pragma unroll
                for (int bj = 0; bj < 2; ++bj)
#pragma unroll
                    for (int n = 0; n < 2; ++n) acc[ai][bj][m][n] *= rho; }
            asm volatile("" ::: "memory"); }
    }
    __device__ __forceinline__ void operator()(const f32x4 (&acc)[2][2][4][2], const pg8::Unit& u, int wr, int wc, int fr, int fq) const {
        const char* SSQb = (const char*)(ws + WS_SSQ) + (size_t)u.pm * (256 * 48) + 32;
        const size_t tile = ((size_t)u.pm * 256) * DM + (size_t)u.pn * 256;
        const char* H0b = (const char*)(ws + WS_H0) + tile * 2; char* Pb = (char*)(ws + WS_PRE1) + tile * 2;
        unsigned lo = (unsigned)(wr * 64 + fr) * 48u, eo = (unsigned)((wr * 64 + fr) * DM + wc * 32 + 8 * fq) * 2u; asm volatile("" : "+v"(lo), "+v"(eo));
        f32x4 s2[8];
#pragma unroll
        for (int q = 0; q < 8; ++q) s2[q] = *(const f32x4*)(SSQb + (size_t)(lo + (unsigned)(((q >> 2) * 128 + (q & 3) * 16) * 48)));
#pragma unroll
        for (int ai = 0; ai < 2; ++ai) {
            u32x4 h[4][2];
#pragma unroll
            for (int m = 0; m < 4; ++m)
#pragma unroll
                for (int bj = 0; bj < 2; ++bj) h[m][bj] = *(const u32x4*)(H0b + (size_t)(eo + (unsigned)(((ai * 128 + m * 16) * DM + bj * 128) * 2)));
#pragma unroll
            for (int m = 0; m < 4; ++m) { const f32x4 sq = s2[ai * 4 + m];
                const float rb = 1.f / sqrtf(((sq[0] + sq[1]) + (sq[2] + sq[3])) * (1.f / 512.f) + RMS_EPS);
#pragma unroll
                for (int bj = 0; bj < 2; ++bj) { const u32x4 hv = h[m][bj]; f32x4 o0 = acc[ai][bj][m][0] * rb, o1 = acc[ai][bj][m][1] * rb;
                    o0[0] += ALPHA * __uint_as_float(hv.x << 16); o0[1] += ALPHA * __uint_as_float(hv.x & 0xffff0000u); o0[2] += ALPHA * __uint_as_float(hv.y << 16); o0[3] += ALPHA * __uint_as_float(hv.y & 0xffff0000u);
                    o1[0] += ALPHA * __uint_as_float(hv.z << 16); o1[1] += ALPHA * __uint_as_float(hv.z & 0xffff0000u); o1[2] += ALPHA * __uint_as_float(hv.w << 16); o1[3] += ALPHA * __uint_as_float(hv.w & 0xffff0000u);
                    ST16(Pb + (size_t)(eo + (unsigned)(((ai * 128 + m * 16) * DM + bj * 128) * 2)), pg8::pack8(o0, o1)); } }
            asm volatile("" ::: "memory"); }
    }
};

__device__ __forceinline__ void split_bf16x8(const f32x4 x0, const f32x4 x1, bf16x8& hi, bf16x8& lo) {
    unsigned h[8]; float r[8];
#pragma unroll
    for (int e = 0; e < 4; ++e) { h[e] = f2bf(x0[e]); r[e] = x0[e] - __uint_as_float(h[e] << 16); h[4 + e] = f2bf(x1[e]); r[4 + e] = x1[e] - __uint_as_float(h[4 + e] << 16); }
    u32x4 hw, lw;
    hw.x = h[0] | (h[1] << 16); hw.y = h[2] | (h[3] << 16); hw.z = h[4] | (h[5] << 16); hw.w = h[6] | (h[7] << 16);
    lw.x = pk2(r[0], r[1]); lw.y = pk2(r[2], r[3]); lw.z = pk2(r[4], r[5]); lw.w = pk2(r[6], r[7]);
    hi = __builtin_bit_cast(bf16x8, hw); lo = __builtin_bit_cast(bf16x8, lw);
}
__device__ __forceinline__ void p5_ln1_router(const Frame& F, const Args& a) {
    constexpr int RS = 1032;
    LAS float* hrow = (LAS float*)F.lds;
    LAS float* part = (LAS float*)(F.lds + 16 * RS * 4);
    LAS float* lg = part + 8 * 16 * 48;
    const int tid5 = threadIdx.x, lane = tid5 & 63, w = F.wave, fr = lane & 15, fq = lane >> 4;
    const bf16_t* PRE1 = (const bf16_t*)(F.ws + WS_PRE1); bf16_t* H1 = (bf16_t*)(F.ws + WS_H1);
    const float* g1 = a.in[13]; const float* b1 = a.in[14]; const float* wg = a.in[15]; const float* bg = a.in[16]; const float* wr = a.in[17]; const float* br = a.in[18];
    int* list = (int*)(F.ws + WS_LIST); float* ew = (float*)(F.ws + WS_EW);
    bf16x8 Bh[4][3], Bl[4][3];
#pragma unroll
    for (int s = 0; s < 4; ++s)
#pragma unroll
        for (int cb = 0; cb < 3; ++cb) { const int n = cb * 16 + fr; float x[8];
#pragma unroll
            for (int j = 0; j < 8; ++j) { const int k = 128 * w + 32 * s + 8 * fq + j; x[j] = n < 4 ? wg[k * 4 + n] : (n < 36 ? wr[k * 32 + (n - 4)] : 0.f); }
            split_bf16x8((f32x4){x[0], x[1], x[2], x[3]}, (f32x4){x[4], x[5], x[6], x[7]}, Bh[s][cb], Bl[s][cb]); }
    u32x2 pv[2][4];
    int it = F.bx;
    if (it < T / 16) {
#pragma unroll
        for (int rr = 0; rr < 2; ++rr)
#pragma unroll
            for (int j = 0; j < 4; ++j) pv[rr][j] = *(const u32x2*)(PRE1 + (size_t)(it * 16 + 2 * w + rr) * DM + j * 256 + lane * 4);
    }
    for (; it < T / 16; it += F.G) {
        const int R0 = it * 16;
#pragma unroll
        for (int rr = 0; rr < 2; ++rr) { const int r = 2 * w + rr;
            f32x4 v[4]; float s = 0.f;
#pragma unroll
            for (int j = 0; j < 4; ++j) { const u32x2 q2 = pv[rr][j]; v[j].x = __uint_as_float(q2.x << 16); v[j].y = __uint_as_float(q2.x & 0xffff0000u); v[j].z = __uint_as_float(q2.y << 16); v[j].w = __uint_as_float(q2.y & 0xffff0000u); s += (v[j].x + v[j].y) + (v[j].z + v[j].w); }
            const float mean = wave_sum(s) * (1.f / DM); float s2 = 0.f;
#pragma unroll
            for (int j = 0; j < 4; ++j) { v[j] = v[j] - mean; s2 += (v[j].x * v[j].x + v[j].y * v[j].y) + (v[j].z * v[j].z + v[j].w * v[j].w); }
            const float rstd = 1.f / sqrtf(wave_sum(s2) * (1.f / DM) + LN_EPS);
#pragma unroll
            for (int j = 0; j < 4; ++j) { const int c = j * 256 + lane * 4; const f32x4 gg = *(const f32x4*)(g1 + c), bb = *(const f32x4*)(b1 + c);
                const f32x4 o = v[j] * rstd * gg + bb; *(LAS f32x4*)(hrow + r * RS + c) = o;
                u32x2 pw; pw.x = pk2(o.x, o.y); pw.y = pk2(o.z, o.w); *(u32x2*)(H1 + (size_t)(R0 + r) * DM + c) = pw; } }
        __syncthreads();
        if (it + F.G < T / 16) {
#pragma unroll
            for (int rr = 0; rr < 2; ++rr)
#pragma unroll
                for (int j = 0; j < 4; ++j) pv[rr][j] = *(const u32x2*)(PRE1 + (size_t)((it + F.G) * 16 + 2 * w + rr) * DM + j * 256 + lane * 4);
        }
        f32x4 c0 = {0.f, 0.f, 0.f, 0.f}, c1 = c0, c2 = c0;
#pragma unroll
        for (int s = 0; s < 4; ++s) { const LAS float* ap = hrow + fr * RS + 128 * w + 32 * s + 8 * fq;
            bf16x8 ah, al; split_bf16x8(*(const LAS f32x4*)ap, *(const LAS f32x4*)(ap + 4), ah, al);
            c0 = __builtin_amdgcn_mfma_f32_16x16x32_bf16(ah, Bh[s][0], c0, 0, 0, 0); c0 = __builtin_amdgcn_mfma_f32_16x16x32_bf16(al, Bh[s][0], c0, 0, 0, 0); c0 = __builtin_amdgcn_mfma_f32_16x16x32_bf16(ah, Bl[s][0], c0, 0, 0, 0);
            c1 = __builtin_amdgcn_mfma_f32_16x16x32_bf16(ah, Bh[s][1], c1, 0, 0, 0); c1 = __builtin_amdgcn_mfma_f32_16x16x32_bf16(al, Bh[s][1], c1, 0, 0, 0); c1 = __builtin_amdgcn_mfma_f32_16x16x32_bf16(ah, Bl[s][1], c1, 0, 0, 0);
            c2 = __builtin_amdgcn_mfma_f32_16x16x32_bf16(ah, Bh[s][2], c2, 0, 0, 0); c2 = __builtin_amdgcn_mfma_f32_16x16x32_bf16(al, Bh[s][2], c2, 0, 0, 0); c2 = __builtin_amdgcn_mfma_f32_16x16x32_bf16(ah, Bl[s][2], c2, 0, 0, 0); }
#pragma unroll
        for (int j = 0; j < 4; ++j) { LAS float* pp = part + (w * 16 + fq * 4 + j) * 48 + fr; pp[0] = c0[j]; pp[16] = c1[j]; pp[32] = c2[j]; }
        __syncthreads();
        for (int idx = tid5; idx < 16 * 48; idx += NWAVES * 64) { float sum = 0.f;
#pragma unroll
            for (int q = 0; q < 8; ++q) sum += part[q * 768 + idx];
            lg[idx] = sum; }
        __syncthreads();
        if (tid5 < 16) { const int m = R0 + tid5; const LAS float* L = lg + tid5 * 48;
            const float l0 = L[0] + bg[0], l1 = L[1] + bg[1], l2 = L[2] + bg[2], l3 = L[3] + bg[3];
            const float mx = fmaxf(fmaxf(l0, l1), fmaxf(l2, l3));
            const float ex0 = expf(l0 - mx), ex1 = expf(l1 - mx), ex2 = expf(l2 - mx), ex3 = expf(l3 - mx);
            const float se = ((ex0 + ex1) + ex2) + ex3;
            int gi = 0; float gt = ex0 / se;
            { const float p = ex1 / se; if (p > gt) { gt = p; gi = 1; } }
            { const float p = ex2 / se; if (p > gt) { gt = p; gi = 2; } }
            { const float p = ex3 / se; if (p > gt) { gt = p; gi = 3; } }
            int e1 = 0, e2 = -1; float t1 = -INFINITY, t2 = -INFINITY;
#pragma unroll 1
            for (int i = 0; i < 8; ++i) { const float v = L[4 + gi * 8 + i] + br[gi * 8 + i];
                if (v > t1) { t2 = t1; e2 = e1; t1 = v; e1 = i; } else if (v > t2) { t2 = v; e2 = i; } }
            const float z = expf(t2 - t1), w1 = gt / (1.f + z), w2 = gt * z / (1.f + z);
            const int ea = gi * 8 + e1, eb = gi * 8 + e2;
            const unsigned pa = atomicAdd(&F.ctl[CW_CNT + 64 * ea], 1u); const unsigned pb = atomicAdd(&F.ctl[CW_CNT + 64 * eb], 1u);
            list[(size_t)ea * T + pa] = m * 2; list[(size_t)eb * T + pb] = m * 2 + 1; ew[m * 2] = w1; ew[m * 2 + 1] = w2; }
    }
}

struct MoeOrder {
    const unsigned* ctl; const int* list; const char* A; const char* Bt; int nN, G, c; bool gather;
    __device__ bool next(int i, pg8::Unit& u) const {
        if (G % 8 == 0) {
            const int x = c & 7, slot = c >> 3, ns = G >> 3; const int j = i * ns + slot; const int tlx = j / nN; int accx = 0, accg = 0; bool found = false;
            for (int e = 0; e < 32; ++e) { const int cn = (int)ctl[CW_CNT + 64 * e]; const int nt = (cn + 255) >> 8;
                if ((e & 7) == x) { if (!found && tlx < accx + nt) { u.e = e; u.r0 = (tlx - accx) * 256; u.n = cn; u.pm = accg + (tlx - accx); u.pn = j % nN; found = true; } accx += nt; }
                accg += nt; }
            return found; }
        const int L = i * G + c; const int tl = L / nN; int acc = 0;
        for (int e = 0; e < 32; ++e) { const int cn = (int)ctl[CW_CNT + 64 * e]; const int nt = (cn + 255) >> 8;
            if (tl < acc + nt) { u.e = e; u.r0 = (tl - acc) * 256; u.n = cn; u.pm = tl; u.pn = L % nN; return true; } acc += nt; }
        return false;
    }
    __device__ __forceinline__ const char* abase(const pg8::Unit& u) const { return gather ? A : A + (size_t)u.pm * 256 * 256 * 2; }
    __device__ __forceinline__ const char* bbase(const pg8::Unit& u) const { return gather ? Bt + ((size_t)u.e * 512 + u.pn * 256) * DM * 2 : Bt + ((size_t)u.e * 1024 + u.pn * 256) * 256 * 2; }
    __device__ __forceinline__ unsigned arow_off(const pg8::Unit& u, int R) const {
        if (!gather) return (unsigned)(R * 256) * 2u;
        const int idx = (u.r0 + R < u.n) ? list[(size_t)u.e * T + u.r0 + R] : 0;
        return (unsigned)(idx >> 1) * (unsigned)(DM * 2);
    }
};
struct EpiGU {
    static constexpr bool PERM = true, MIDK = false;
    unsigned char* ws;
    __device__ __forceinline__ void operator()(const f32x4 (&acc)[2][2][4][2], const pg8::Unit& u, int wr, int wc, int fr, int fq) const {
        const char* listb = (const char*)(ws + WS_LIST) + ((size_t)u.e * T + u.r0) * 4; const char* ewb = (const char*)(ws + WS_EW);
        char* Hb = (char*)(ws + WS_HID) + (((size_t)u.pm * 256) * 256 + u.pn * 128) * 2;
        int Rl = wr * 64 + fr; const int nrem = u.n - u.r0; asm volatile("" : "+v"(Rl));
        const unsigned ho = (unsigned)(Rl * 256 + wc * 32 + 8 * fq) * 2u;
        unsigned idx[8]; float wgt[8];
#pragma unroll
        for (int q = 0; q < 8; ++q) { const int R = Rl + (q >> 2) * 128 + (q & 3) * 16; idx[q] = (R < nrem) ? *(const unsigned*)(listb + (size_t)((unsigned)R * 4u)) : 0xffffffffu; }
#pragma unroll
        for (int q = 0; q < 8; ++q) wgt[q] = (idx[q] != 0xffffffffu) ? *(const float*)(ewb + (size_t)(idx[q] * 4u)) : 0.f;
#pragma unroll
        for (int ai = 0; ai < 2; ++ai)
#pragma unroll
            for (int m = 0; m < 4; ++m) { const float wg_ = wgt[ai * 4 + m];
                f32x4 o[2];
#pragma unroll
                for (int n = 0; n < 2; ++n) { const f32x4 gv = acc[ai][0][m][n], uv = acc[ai][1][m][n];
#pragma unroll
                    for (int e = 0; e < 4; ++e) o[n][e] = gv[e] * __builtin_amdgcn_rcpf(1.f + __builtin_amdgcn_exp2f(-1.4426950408889634f * gv[e])) * uv[e] * wg_; }
                ST16(Hb + (size_t)(ho + (unsigned)((ai * 128 + m * 16) * 512)), pg8::pack8(o[0], o[1])); }
    }
};
struct EpiDown {
    static constexpr bool PERM = true, MIDK = false;
    unsigned char* ws;
    __device__ __forceinline__ void operator()(const f32x4 (&acc)[2][2][4][2], const pg8::Unit& u, int wr, int wc, int fr, int fq) const {
        const char* listb = (const char*)(ws + WS_LIST) + ((size_t)u.e * T + u.r0) * 4; char* Yb = (char*)(ws + WS_Y) + (size_t)(u.pn * 256) * 2;
        int Rl = wr * 64 + fr; const int nrem = u.n - u.r0; asm volatile("" : "+v"(Rl));
        const unsigned yo = (unsigned)(wc * 32 + 8 * fq) * 2u;
        unsigned idx[8];
#pragma unroll
        for (int q = 0; q < 8; ++q) { const int R = Rl + (q >> 2) * 128 + (q & 3) * 16; idx[q] = (R < nrem) ? *(const unsigned*)(listb + (size_t)((unsigned)R * 4u)) : 0xffffffffu; }
#pragma unroll
        for (int ai = 0; ai < 2; ++ai)
#pragma unroll
            for (int m = 0; m < 4; ++m) { const unsigned ix = idx[ai * 4 + m];
                if (ix != 0xffffffffu) { char* y = Yb + (size_t)ix * (DM * 2) + yo;
                    ST16(y, pg8::pack8(acc[ai][0][m][0], acc[ai][0][m][1])); ST16((y + 256), pg8::pack8(acc[ai][1][m][0], acc[ai][1][m][1])); } }
    }
};

__device__ __forceinline__ void p8_ln2(const Frame& F, const Args& a) {
    const bf16_t* H1 = (const bf16_t*)(F.ws + WS_H1); const bf16_t* Y = (const bf16_t*)(F.ws + WS_Y); const float* g = a.in[22]; const float* b = a.in[23]; float* out = a.out;
    const int lane = threadIdx.x & 63;
    for (int m = F.bx * NWAVES + F.wave; m < T; m += F.G * NWAVES) {
        f32x4 v[4]; float s = 0.f;
#pragma unroll
        for (int j = 0; j < 4; ++j) { const int c = j * 256 + lane * 4;
            const u32x2 h = *(const u32x2*)(H1 + (size_t)m * DM + c), y0 = *(const u32x2*)(Y + (size_t)(2 * m) * DM + c), y1 = *(const u32x2*)(Y + (size_t)(2 * m + 1) * DM + c);
            v[j].x = ALPHA * __uint_as_float(h.x << 16) + __uint_as_float(y0.x << 16) + __uint_as_float(y1.x << 16);
            v[j].y = ALPHA * __uint_as_float(h.x & 0xffff0000u) + __uint_as_float(y0.x & 0xffff0000u) + __uint_as_float(y1.x & 0xffff0000u);
            v[j].z = ALPHA * __uint_as_float(h.y << 16) + __uint_as_float(y0.y << 16) + __uint_as_float(y1.y << 16);
            v[j].w = ALPHA * __uint_as_float(h.y & 0xffff0000u) + __uint_as_float(y0.y & 0xffff0000u) + __uint_as_float(y1.y & 0xffff0000u);
            s += (v[j].x + v[j].y) + (v[j].z + v[j].w); }
        const float mean = wave_sum(s) * (1.f / DM); float s2 = 0.f;
#pragma unroll
        for (int j = 0; j < 4; ++j) { v[j] = v[j] - mean; s2 += (v[j].x * v[j].x + v[j].y * v[j].y) + (v[j].z * v[j].z + v[j].w * v[j].w); }
        const float rstd = 1.f / sqrtf(wave_sum(s2) * (1.f / DM) + LN_EPS);
#pragma unroll
        for (int j = 0; j < 4; ++j) { const int c = j * 256 + lane * 4; const f32x4 gg = *(const f32x4*)(g + c), bb = *(const f32x4*)(b + c);
            *(f32x4*)(out + (size_t)m * DM + c) = v[j] * rstd * gg + bb; }
    }
}

__global__ void __launch_bounds__(NWAVES * 64, 2) mega(Args args) {
    extern __shared__ __attribute__((aligned(16))) unsigned char lds_raw[];
    Frame F;
    F.lds = (LAS unsigned char*)lds_raw; F.ws = args.ws; F.ctl = (unsigned*)(args.ws + WS_CTL);
    F.tid = threadIdx.x; F.lane = F.tid & 63; F.wave = __builtin_amdgcn_readfirstlane(F.tid >> 6); F.G = gridDim.x; F.bx = blockIdx.x;
    volatile LAS unsigned* MISC = (volatile LAS unsigned*)(F.lds + MISC_OFF);
    for (int u = F.tid; u < (LDS_BYTES - LDSCTL_OFF) / 4; u += NWAVES * 64) ((LAS unsigned*)(F.lds + LDSCTL_OFF))[u] = 0u;
    __syncthreads();
    XcdBarrier bar = xcd_barrier_post(F.ctl + CW_BAR, MISC + 8);
    const int lo = args.ph_lo, hi = args.ph_hi;
#define IN(k) (lo <= (k) && (k) < hi)
#define BOTH(k) (IN(k) && IN((k) + 1))
    if (IN(0)) { p0_prologue(F, args); if (BOTH(0)) xcd_barrier(bar); }
    if (IN(1)) {
        pg8::StaticOrder S; S.init(args.ws + WS_H0, args.ws + WS_WIN, T, 1536, DM, F.G, F.bx);
        EpiInProj E{args.ws};
        pg8::gemm_phase<EpiInProj, pg8::StaticOrder, true>(F.lds, DM, S, E);
        if (BOTH(1)) xcd_barrier(bar);
    }
    if (IN(2)) {
        { int q = F.bx;
          if (F.G % 8 == 0 && F.G >= 224) { const int slot = F.bx >> 3; q = slot >= 16 ? (slot - 16) * 8 + (F.bx & 7) : 1 << 20; }
          for (; q < 84; q += F.G) p2_meta(F, args, q); }
        UpOrder S{(const char*)(args.ws + WS_CQ), (const char*)(args.ws + WS_CKV), (const char*)(args.ws + WS_WUQ), (const char*)(args.ws + WS_WUKV), F.G, F.bx};
        EpiUp E{args.ws};
        pg8::gemm_phase<EpiUp, UpOrder, true>(F.lds, 256, S, E);
        if (BOTH(2)) xcd_barrier(bar);
    }
    if (IN(3)) {
        const int vcu = (F.G % 8 == 0) ? (F.bx % 8) * (F.G / 8) + F.bx / 8 : F.bx;
        att::attn_phase<0>((char*)lds_raw, args.ws, args.in[5], vcu, F.G);
        if (BOTH(3)) xcd_barrier(bar);
    }
    if (IN(4)) {
        pg8::StaticOrder S; S.init(args.ws + WS_AO, args.ws + WS_WO, T, DM, DM, F.G, F.bx);
        EpiOut E{args.ws};
        pg8::gemm_phase<EpiOut, pg8::StaticOrder, true>(F.lds, DM, S, E);
        if (BOTH(4)) xcd_barrier(bar);
    }
    if (IN(5)) { p5_ln1_router(F, args); if (BOTH(5)) xcd_barrier(bar); }
    if (IN(6)) {
        MoeOrder S{F.ctl, (const int*)(args.ws + WS_LIST), (const char*)(args.ws + WS_H1), (const char*)(args.ws + WS_WGU), 2, F.G, F.bx, true};
        EpiGU E{args.ws};
        pg8::gemm_phase<EpiGU, MoeOrder, true>(F.lds, DM, S, E);
        if (BOTH(6)) xcd_barrier(bar);
    }
    if (IN(7)) {
        MoeOrder S{F.ctl, (const int*)(args.ws + WS_LIST), (const char*)(args.ws + WS_HID), (const char*)(args.ws + WS_WDN), 4, F.G, F.bx, false};
        EpiDown E{args.ws};
        pg8::gemm_phase<EpiDown, MoeOrder, true>(F.lds, 256, S, E);
        if (BOTH(7)) xcd_barrier(bar);
    }
    if (IN(8)) { p8_ln2(F, args); }
#undef IN
#undef BOTH
}

extern "C" void kernel_launch(void* const* d_in, const int* in_sizes, int n_in, void* d_out, int out_size, void* d_ws, size_t ws_size, hipStream_t stream) {
    static int grid = 0;
    if (grid == 0) {
        if (n_in != 24 || ws_size < WS_END || out_size != T * DM) { fprintf(stderr, "kernel_launch: unexpected shapes n_in=%d ws=%zu out=%d\n", n_in, ws_size, out_size); grid = -1; return; }
        int dev = 0, cus = 0, per_cu = 0;
        if (hipGetDevice(&dev) != hipSuccess || hipDeviceGetAttribute(&cus, hipDeviceAttributeMultiprocessorCount, dev) != hipSuccess) { grid = -1; return; }
        if (hipFuncSetAttribute((const void*)mega, hipFuncAttributeMaxDynamicSharedMemorySize, LDS_BYTES) != hipSuccess) { fprintf(stderr, "hipFuncSetAttribute failed\n"); grid = -1; return; }
        if (hipOccupancyMaxActiveBlocksPerMultiprocessor(&per_cu, (const void*)mega, NWAVES * 64, LDS_BYTES) != hipSuccess || per_cu < 1) { fprintf(stderr, "occupancy query: %d blocks per CU\n", per_cu); (void)hipGetLastError(); grid = -1; return; }
        (void)hipGetLastError();
        grid = cus;
    }
    if (grid < 0) return;
    (void)hipMemsetAsync((unsigned char*)d_ws + WS_CTL, 0, 1 * MiB, stream);
    Args a{};
    for (int i = 0; i < 24; ++i) a.in[i] = (const float*)d_in[i];
    a.out = (float*)d_out; a.ws = (unsigned char*)d_ws; a.ph_lo = 0; a.ph_hi = 9;
    hipLaunchKernelGGL(mega, dim3(grid), dim3(NWAVES * 64), LDS_BYTES, stream, a);
}
```

```cpp
#include <hip/hip_runtime.h>
#include <cstdio>
#include <cstdint>

typedef unsigned short bf16_t;
typedef float f32x4 __attribute__((ext_vector_type(4)));
typedef unsigned u32x4 __attribute__((ext_vector_type(4)));
typedef unsigned u32x2 __attribute__((ext_vector_type(2)));

constexpr int NB = 4, SEQ = 8192, DM = 1024, T = NB * SEQ, LP = SEQ + 128, NPAD = 112, NMETA = 16;
constexpr int INC = 1344;
constexpr float LN_EPS = 1e-5f, RMS_EPS = 1e-6f;
constexpr float ALPHA = 1.189207115002721f;
constexpr size_t MiB = 1u << 20;

constexpr size_t WS_CTL = 0;
constexpr size_t WS_HM = 1 * MiB;
constexpr size_t WS_CKVM = 1 * MiB + 128 * 1024;
constexpr size_t WS_UM = 1 * MiB + 256 * 1024;
constexpr size_t WS_KVTM = 1 * MiB + 640 * 1024;
constexpr size_t WS_SSQ = 2 * MiB;
constexpr size_t WS_EW = 4 * MiB;
constexpr size_t WS_LIST = 5 * MiB;
constexpr size_t WS_W = 16 * MiB;
constexpr size_t WS_H0 = 72 * MiB;
constexpr size_t WS_QA = 136 * MiB;
constexpr size_t WS_KA = 168 * MiB;
constexpr size_t WS_VA = 177 * MiB;
constexpr size_t WS_CQ = 186 * MiB;
constexpr size_t WS_CKV = 202 * MiB;
constexpr size_t WS_KM = 218 * MiB;
constexpr size_t WS_VM = 267 * MiB;
constexpr size_t WS_QM = 300 * MiB;
constexpr size_t WS_AO = 348 * MiB;
constexpr size_t WS_HID = 412 * MiB;
constexpr size_t WS_PRE1 = 136 * MiB;
constexpr size_t WS_H1 = 264 * MiB;
constexpr size_t WS_Y = 72 * MiB;
constexpr size_t WS_TMP = 348 * MiB;
constexpr size_t WS_AN = 412 * MiB;
constexpr size_t WS_END = 512 * MiB;
constexpr int CW_CNT = 1024;

__constant__ float c_inv_freq[32] = {1.000000000e+00f, 7.498942614e-01f, 5.623413324e-01f, 4.216965139e-01f, 3.162277639e-01f, 2.371373773e-01f, 1.778279394e-01f, 1.333521307e-01f, 1.000000015e-01f, 7.498941571e-02f, 5.623413250e-02f, 4.216965288e-02f, 3.162277490e-02f, 2.371373773e-02f, 1.778279431e-02f, 1.333521493e-02f, 9.999999776e-03f, 7.498941850e-03f, 5.623413250e-03f, 4.216964822e-03f, 3.162277630e-03f, 2.371373586e-03f, 1.778279431e-03f, 1.333521446e-03f, 1.000000047e-03f, 7.498942432e-04f, 5.623413017e-04f, 4.216965172e-04f, 3.162277571e-04f, 2.371373703e-04f, 1.778279402e-04f, 1.333521504e-04f};

#ifndef ST_NT
#define ST_NT 0
#endif
#if ST_NT
#define ST16(p, v) __builtin_nontemporal_store((v), (u32x4*)(p))
#define ST16F(p, v) __builtin_nontemporal_store((v), (f32x4*)(p))
#else
#define ST16(p, v) (*(u32x4*)(p) = (v))
#define ST16F(p, v) (*(f32x4*)(p) = (v))
#endif
__device__ __forceinline__ float bf2f(bf16_t v) { return __uint_as_float((unsigned)v << 16); }
__device__ __forceinline__ unsigned f2bf(float f) { unsigned u = __float_as_uint(f); return (u + 0x7fffu + ((u >> 16) & 1u)) >> 16; }
__device__ __forceinline__ unsigned pk2(float lo, float hi) { return f2bf(lo) | (f2bf(hi) << 16); }
__device__ __forceinline__ int lane_id() { return (int)__builtin_amdgcn_mbcnt_hi(~0u, __builtin_amdgcn_mbcnt_lo(~0u, 0u)); }
__device__ __forceinline__ float wave_sum(float v) {
#pragma unroll
    for (int o = 1; o < 64; o <<= 1) v += __shfl_xor(v, o);
    return v;
}
__device__ __forceinline__ float wave_max(float v) {
#pragma unroll
    for (int o = 1; o < 64; o <<= 1) v = fmaxf(v, __shfl_xor(v, o));
    return v;
}
__device__ __forceinline__ void rope_cs(int pos, int i, float& c, float& s) {
    const double ang = (double)pos * (double)c_inv_freq[i];
    const double rev = ang * 0.15915494309189535;
    const float fr = (float)(rev - __builtin_rint(rev));
    s = __builtin_amdgcn_sinf(fr); c = __builtin_amdgcn_cosf(fr);
}


#define LAS __attribute__((address_space(3)))
#define GAS __attribute__((address_space(1)))
typedef short bf16x8 __attribute__((ext_vector_type(8)));
typedef float f32x2 __attribute__((ext_vector_type(2)));

constexpr size_t WS_CQS = 9 * MiB;
constexpr size_t WS_CKVS = 10 * MiB;
constexpr size_t WS_COS = 11 * MiB;
constexpr size_t WS_SIN = 13 * MiB;
constexpr size_t WS_WIN = 16 * MiB;
constexpr size_t WS_WUQ = 19 * MiB;
constexpr size_t WS_WUKV = 19 * MiB + 512 * 1024;
constexpr size_t WS_WO = 20 * MiB;
constexpr size_t WS_WGU = 22 * MiB;
constexpr size_t WS_WDN = 54 * MiB;
constexpr int NPOS = SEQ + NMETA;

namespace pg8 {
constexpr int BM = 256, BK = 64, HALF = 128, HTB = HALF * BK * 2, STAGE_BYTES = 8 * HTB, NXCD = 8, WGM = 8;
__host__ __device__ __forceinline__ int lds_byte(int r, int c) { const int st = (r >> 4) * 2 + (c >> 5), rr = r & 15, cc = c & 31, ob = rr * 64 + cc * 2; return st * 1024 + (ob ^ (((ob >> 9) & 1) << 5)); }
__host__ __device__ __forceinline__ void stage_rc(int b, int& R, int& C) { const int st = b / 1024, sb = b % 1024, swz = sb ^ (((sb >> 9) & 1) << 5); R = (st >> 1) * 16 + swz / 64; C = (st & 1) * 32 + (swz % 64) / 2; }
__host__ __device__ __forceinline__ int perm32(int rho) { const int n = rho >> 4, i = rho & 15; return 8 * (i >> 2) + 4 * n + (i & 3); }
struct Unit { int pm, pn, e, r0, n; };
typedef float f32x2_t __attribute__((ext_vector_type(2))); typedef __bf16 bf16x2_t __attribute__((ext_vector_type(2)));
__device__ __forceinline__ unsigned cvt_pk_bf16(float lo, float hi) { const f32x2_t v = {lo, hi}; const bf16x2_t b = __builtin_convertvector(v, bf16x2_t); return __builtin_bit_cast(unsigned, b); }
__device__ __forceinline__ u32x4 pack8(const f32x4 a, const f32x4 b) { u32x4 w; w.x = cvt_pk_bf16(a[0], a[1]); w.y = cvt_pk_bf16(a[2], a[3]); w.z = cvt_pk_bf16(b[0], b[1]); w.w = cvt_pk_bf16(b[2], b[3]); return w; }

template <class Epi, class Sched, bool ALIGN_EPI>
__device__ __forceinline__ void gemm_phase(LAS unsigned char* lds, const int K, const Sched& S, const Epi& E) {
    const int tid = threadIdx.x, wid = __builtin_amdgcn_readfirstlane(tid >> 6), lane = tid & 63, wr = wid >> 2, wc = wid & 3, fr = lane & 15, fq = lane >> 4;
    const int nt = K / BK;
    int Rr[2]; unsigned cof[2], voffB[2];
#pragma unroll
    for (int i = 0; i < 2; ++i) { int R, C; stage_rc(tid * 16 + i * 8192, R, C); Rr[i] = R; cof[i] = (unsigned)C * 2u; const int Rb = Epi::PERM ? ((R & ~31) + perm32(R & 31)) : R; voffB[i] = (unsigned)(Rb * K + C) * 2u; }
    const size_t kstep = (size_t)(BK * 2);
    const size_t hstepB = (size_t)HALF * K * 2;
    const unsigned ldsw = (unsigned)wid * 1024u;
    const int aoff = lds_byte(wr * 64 + fr, fq * 8), boff = lds_byte(wc * 32 + fr, fq * 8);
#define PG8_SA(b, h) (((b) * 2 + (h)) * HTB)
#define PG8_SB(b, h) ((4 + (b) * 2 + (h)) * HTB)
#define PG8_STAGE(bufoff, gbase, voff) do { _Pragma("unroll") for (int _i = 0; _i < 2; ++_i) \
        __builtin_amdgcn_global_load_lds((const unsigned*)((const char*)(gbase) + (voff)[_i]), (LAS unsigned*)(lds + (bufoff) + ldsw + _i * 8192), 16, 0, 0); } while (0)
#define PG8_LDA(dst, b, h) do { _Pragma("unroll") for (int m = 0; m < 4; ++m) _Pragma("unroll") for (int k = 0; k < 2; ++k) dst[m][k] = *(const LAS bf16x8*)(lds + PG8_SA(b, h) + aoff + m * 2048 + k * 1024); } while (0)
#define PG8_LDB(dst, b, h) do { _Pragma("unroll") for (int n = 0; n < 2; ++n) _Pragma("unroll") for (int k = 0; k < 2; ++k) dst[n][k] = *(const LAS bf16x8*)(lds + PG8_SB(b, h) + boff + n * 2048 + k * 1024); } while (0)
#define PG8_MMA(ai, bj, At, Bt) do { __builtin_amdgcn_s_setprio(1); _Pragma("unroll") for (int m = 0; m < 4; ++m) _Pragma("unroll") for (int n = 0; n < 2; ++n) _Pragma("unroll") for (int k = 0; k < 2; ++k) \
        acc[ai][bj][m][n] = __builtin_amdgcn_mfma_f32_16x16x32_bf16(Bt[n][k], At[m][k], acc[ai][bj][m][n], 0, 0, 0); __builtin_amdgcn_s_setprio(0); } while (0)
#define PG8_WAIT_V(n) asm volatile("s_waitcnt vmcnt(" #n ")" ::: "memory")
#define PG8_WAIT_L(n) asm volatile("s_waitcnt lgkmcnt(" #n ")" ::: "memory")
#define PG8_BAR __builtin_amdgcn_s_barrier()
#define PG8_SCHED __builtin_amdgcn_sched_barrier(0)
    Unit cur, nxt; int ui = 0;
    if (!S.next(0, cur)) return;
    f32x4 acc[2][2][4][2];
#pragma unroll
    for (int a = 0; a < 2; ++a)
#pragma unroll
        for (int b = 0; b < 2; ++b)
#pragma unroll
            for (int m = 0; m < 4; ++m)
#pragma unroll
                for (int n = 0; n < 2; ++n) acc[a][b][m][n] = (f32x4){0.f, 0.f, 0.f, 0.f};
    bf16x8 At[4][2], B0[2][2], B1[2][2];
    unsigned vA0[2], vA1[2], vN0[2], vN1[2];
#pragma unroll
    for (int i = 0; i < 2; ++i) { vA0[i] = S.arow_off(cur, Rr[i]) + cof[i]; vA1[i] = S.arow_off(cur, Rr[i] + HALF) + cof[i]; }
    const char* cA = S.abase(cur); const char* cB = S.bbase(cur);
    PG8_STAGE(PG8_SB(0, 0), cB, voffB); PG8_STAGE(PG8_SB(0, 1), cB + hstepB, voffB); PG8_STAGE(PG8_SA(0, 0), cA, vA0); PG8_STAGE(PG8_SA(0, 1), cA, vA1);
    if (wr == 1) PG8_BAR;
    PG8_WAIT_V(2); PG8_BAR;
    PG8_STAGE(PG8_SB(1, 0), cB + kstep, voffB); PG8_STAGE(PG8_SA(1, 0), cA + kstep, vA0); PG8_STAGE(PG8_SB(1, 1), cB + hstepB + kstep, voffB);
    PG8_WAIT_V(6); PG8_BAR;
    for (;;) {
        const bool has_next = S.next(ui + 1, nxt);
        const char* nA = has_next ? S.abase(nxt) : cA; const char* nB = has_next ? S.bbase(nxt) : cB;
#pragma unroll
        for (int i = 0; i < 2; ++i) { vN0[i] = has_next ? S.arow_off(nxt, Rr[i]) + cof[i] : vA0[i]; vN1[i] = has_next ? S.arow_off(nxt, Rr[i] + HALF) + cof[i] : vA1[i]; }
#pragma unroll 1
        for (int t = 0; t < nt; t += 2) {
            const bool last = (t == nt - 2);
            const char* a1 = cA + (size_t)(t + 1) * kstep;
            const char* a2 = last ? nA : cA + (size_t)(t + 2) * kstep; const char* b2 = last ? nB : cB + (size_t)(t + 2) * kstep;
            const char* a3 = a2 + kstep; const char* b3 = b2 + kstep;
            unsigned w0[2], w1[2];
#pragma unroll
            for (int i = 0; i < 2; ++i) { w0[i] = last ? vN0[i] : vA0[i]; w1[i] = last ? vN1[i] : vA1[i]; }
            PG8_LDB(B0, 0, 0); PG8_LDB(B1, 0, 1); PG8_SCHED; PG8_LDA(At, 0, 0); PG8_STAGE(PG8_SA(1, 1), a1, vA1);
            PG8_WAIT_V(8); PG8_WAIT_L(0); PG8_BAR; PG8_MMA(0, 0, At, B0); PG8_MMA(0, 1, At, B1); PG8_BAR; PG8_SCHED;
            PG8_LDA(At, 0, 1); PG8_STAGE(PG8_SB(0, 0), b2, voffB); PG8_STAGE(PG8_SB(0, 1), b2 + hstepB, voffB); PG8_STAGE(PG8_SA(0, 0), a2, w0);
            PG8_WAIT_V(8); PG8_WAIT_L(0); PG8_BAR; PG8_MMA(1, 0, At, B0); PG8_MMA(1, 1, At, B1); PG8_BAR; PG8_SCHED;
            PG8_LDB(B0, 1, 0); PG8_LDB(B1, 1, 1); PG8_SCHED; PG8_LDA(At, 1, 0); PG8_STAGE(PG8_SA(0, 1), a2, w1);
            PG8_WAIT_V(8); PG8_WAIT_L(0); PG8_BAR; PG8_MMA(0, 0, At, B0); PG8_MMA(0, 1, At, B1); PG8_BAR; PG8_SCHED;
            PG8_LDA(At, 1, 1); PG8_STAGE(PG8_SB(1, 0), b3, voffB); PG8_STAGE(PG8_SB(1, 1), b3 + hstepB, voffB); PG8_STAGE(PG8_SA(1, 0), a3, w0);
            PG8_WAIT_V(8); PG8_WAIT_L(0); PG8_BAR; PG8_MMA(1, 0, At, B0); PG8_MMA(1, 1, At, B1); PG8_BAR; PG8_SCHED;
            if constexpr (Epi::MIDK) { if (t + 2 == nt / 2) E.midk(acc, cur, wr, wc, fr, fq); }
        }
        if constexpr (ALIGN_EPI) { if (wr == 0) PG8_BAR; }
        E(acc, cur, wr, wc, fr, fq);
        if (!has_next) break;
#pragma unroll
        for (int a = 0; a < 2; ++a)
#pragma unroll
            for (int b = 0; b < 2; ++b)
#pragma unroll
                for (int m = 0; m < 4; ++m)
#pragma unroll
                    for (int n = 0; n < 2; ++n) acc[a][b][m][n] = (f32x4){0.f, 0.f, 0.f, 0.f};
        cur = nxt; cA = nA; cB = nB; ++ui;
#pragma unroll
        for (int i = 0; i < 2; ++i) { vA0[i] = vN0[i]; vA1[i] = vN1[i]; }
        if constexpr (ALIGN_EPI) { if (wr == 1) PG8_BAR; }
    }
    PG8_WAIT_V(0);
    if constexpr (!ALIGN_EPI) { if (wr == 0) PG8_BAR; }
    PG8_BAR;
#undef PG8_SA
#undef PG8_SB
#undef PG8_STAGE
#undef PG8_LDA
#undef PG8_LDB
#undef PG8_MMA
#undef PG8_WAIT_V
#undef PG8_WAIT_L
#undef PG8_BAR
#undef PG8_SCHED
}

struct StaticOrder {
    const char* A; const char* Bt; int K;
    int nM, nN, nwg, G, c;
    __device__ void init(const void* A_, const void* Bt_, int M, int N, int K_, int G_, int c_) { A = (const char*)A_; Bt = (const char*)Bt_; K = K_; nM = M / BM; nN = N / BM; nwg = nM * nN; G = G_; c = c_; }
    __device__ bool next(int i, Unit& u) const {
        const long L = (long)i * G + c; if (L >= nwg) return false;
        int wgid = (int)L; { const int q = nwg / NXCD, r = nwg % NXCD, xcd = wgid % NXCD, off = wgid / NXCD; wgid = (xcd < r ? xcd * (q + 1) : r * (q + 1) + (xcd - r) * q) + off; }
        const int nig = WGM * nN, gid = wgid / nig, fm = gid * WGM, gsz = (nM - fm) < WGM ? (nM - fm) : WGM;
        u.pm = fm + ((wgid % nig) % gsz); u.pn = (wgid % nig) / gsz; return true;
    }
    __device__ __forceinline__ const char* abase(const Unit& u) const { return A + (size_t)u.pm * BM * K * 2; }
    __device__ __forceinline__ const char* bbase(const Unit& u) const { return Bt + (size_t)u.pn * BM * K * 2; }
    __device__ __forceinline__ unsigned arow_off(const Unit&, int R) const { return (unsigned)(R * K) * 2u; }
};
}

#define XB_TMO      128
#define XB_XCNT(j)  (256  + 64 * (j))
#define XB_XSUB(j)  (1280 + 64 * (j))
#define XB_XGEN(j)  (2304 + 64 * (j))
#define XB_TOP      3328
#define XB_TOPGEN   3392
#define XCD_BAR_WORDS 3456
#define XB_SPIN_CAP (1u << 18)
__device__ __forceinline__ unsigned xb_ld(unsigned* p)              { return __hip_atomic_load(p, __ATOMIC_RELAXED, __HIP_MEMORY_SCOPE_AGENT); }
__device__ __forceinline__ unsigned xb_add(unsigned* p, unsigned v) { return __hip_atomic_fetch_add(p, v, __ATOMIC_RELAXED, __HIP_MEMORY_SCOPE_AGENT); }
__device__ __forceinline__ unsigned xb_xcc_id() { return (unsigned)__builtin_amdgcn_s_getreg((3 << 11) | 20) & 0xFu; }
#define XB_SPIN(cond, bar) do { unsigned _sp = 0; while (cond) { __builtin_amdgcn_s_sleep(1); \
    if ((++_sp & 255u) == 0u) { if (xb_ld(&(bar)[XB_TMO])) break; if (_sp > XB_SPIN_CAP) { atomicAdd(&(bar)[XB_TMO], 1u); break; } } } } while (0)
struct XcdBarrier { unsigned* bar; unsigned x; volatile LAS unsigned* st; };
__device__ __forceinline__ XcdBarrier xcd_barrier_post(unsigned* bar, volatile LAS unsigned* st) {
    XcdBarrier b; b.bar = bar; b.x = xb_xcc_id(); b.st = st;
    if (threadIdx.x == 0) (void)xb_add(&bar[XB_XCNT(b.x)], 1u);
    return b;
}
__device__ __forceinline__ void xcd_barrier_complete(unsigned* bar, unsigned x, unsigned& nloc, unsigned& nx) {
    const unsigned G = gridDim.x * gridDim.y * gridDim.z;
    unsigned sum, cnt, mine, sp = 0u;
    for (;;) {
        sum = 0u; cnt = 0u; mine = 0u;
#pragma unroll
        for (unsigned j = 0; j < 16; ++j) { const unsigned c = xb_ld(&bar[XB_XCNT(j)]); sum += c; cnt += (c > 0u) ? 1u : 0u; mine = (j == x) ? c : mine; }
        if (sum == G) break;
        __builtin_amdgcn_s_sleep(1);
        if ((++sp & 255u) == 0u) { if (xb_ld(&bar[XB_TMO])) break; if (sp > XB_SPIN_CAP) { atomicAdd(&bar[XB_TMO], 1u); break; } }
    }
    nloc = mine > 0u ? mine : 1u; nx = cnt > 0u ? cnt : 1u;
}
__device__ __forceinline__ void xcd_barrier(const XcdBarrier& b) {
    asm volatile("s_waitcnt vmcnt(0)" ::: "memory");
    __syncthreads();
    if (threadIdx.x == 0) {
        unsigned* bar = b.bar;
        __builtin_amdgcn_s_waitcnt(0);
        unsigned nloc = b.st[0], nx = b.st[1];
        if (nloc == 0u) { xcd_barrier_complete(bar, b.x, nloc, nx); b.st[0] = nloc; b.st[1] = nx; }
        const unsigned old = xb_add(&bar[XB_XSUB(b.x)], 1u);
        const unsigned gen = old / nloc;
        if (old + 1u == (gen + 1u) * nloc) {
            __builtin_amdgcn_fence(__ATOMIC_RELEASE, "agent");
            asm volatile("s_waitcnt vmcnt(0)" ::: "memory");
            const unsigned og = xb_add(&bar[XB_TOP], 1u);
            const unsigned tg = og / nx;
            if (og + 1u == (tg + 1u) * nx) xb_add(&bar[XB_TOPGEN], 1u);
            else XB_SPIN(xb_ld(&bar[XB_TOPGEN]) == tg, bar);
            __builtin_amdgcn_fence(__ATOMIC_ACQUIRE, "agent");
            xb_add(&bar[XB_XGEN(b.x)], 1u);
            asm volatile("s_waitcnt vmcnt(0)" ::: "memory");
        } else {
            XB_SPIN(xb_ld(&bar[XB_XGEN(b.x)]) == gen, bar);
            __builtin_amdgcn_fence(__ATOMIC_ACQUIRE, "agent");
            asm volatile("s_waitcnt vmcnt(0)" ::: "memory");
        }
    }
    __syncthreads();
}

constexpr int NWAVES = 8;
constexpr int RING_BYTES = 135168, LDSCTL_OFF = RING_BYTES, MISC_OFF = LDSCTL_OFF + 320, LDS_BYTES = 147456;
constexpr int CW_BAR = 4096;
#define LDS_WAIT() asm volatile("s_waitcnt lgkmcnt(0)" ::: "memory")
#define VM_WAIT() asm volatile("s_waitcnt vmcnt(0)" ::: "memory")

struct Args {
    const float* in[24]; float* out; unsigned char* ws; int ph_lo, ph_hi;
};
struct Frame {
    LAS unsigned char* lds; unsigned char* ws; unsigned* ctl;
    int tid, lane, wave, G, bx;
};

__device__ __forceinline__ void p0_tr_item(const float* __restrict__ W, int ldn, int c0, int k0, bf16_t* dst, int K, const float* __restrict__ sc0, const float* __restrict__ sc1, LAS float* scr, int lane) {
    if (c0 >= 0) {
        f32x4 v[8];
#pragma unroll
        for (int i = 0; i < 8; ++i) v[i] = *(const f32x4*)(W + (size_t)(k0 + 8 * i + (lane >> 3)) * ldn + c0 + (lane & 7) * 4);
#pragma unroll
        for (int i = 0; i < 8; ++i) { const int kk = 8 * i + (lane >> 3), k = k0 + kk; f32x4 x = v[i];
            if (sc0) x *= (k < 512 || !sc1) ? sc0[k] : sc1[k - 512];
            LAS float* s = scr + kk * 33 + (lane & 7) * 4; s[0] = x.x; s[1] = x.y; s[2] = x.z; s[3] = x.w; }
    } else {
#pragma unroll 8
        for (int i = 0; i < 32; ++i) { const int kk = 2 * i + (lane >> 5); scr[kk * 33 + (lane & 31)] = 0.f; }
    }
    LDS_WAIT(); asm volatile("" ::: "memory");
    const int c = lane & 7;
#pragma unroll
    for (int j = 0; j < 4; ++j) { const int n = (lane >> 3) + 8 * j; const LAS float* s = scr + (8 * c) * 33 + n;
        u32x4 o; o.x = pk2(s[0 * 33], s[1 * 33]); o.y = pk2(s[2 * 33], s[3 * 33]); o.z = pk2(s[4 * 33], s[5 * 33]); o.w = pk2(s[6 * 33], s[7 * 33]);
        ST16((dst + (size_t)n * K + k0 + 8 * c), o); }
    LDS_WAIT(); asm volatile("" ::: "memory");
}
__device__ __forceinline__ int win_src_col(int tile, int q) {
    if (tile <= 1) return 256 * tile + 64 * (q & 3) + ((q >> 2) ? 32 : 0);
    if (tile == 2) { const int tb[8] = {512, 576, 640, 672, 544, 608, 704, 736}; int r = tb[0];
#pragma unroll
        for (int i = 1; i < 8; ++i) r = (q == i) ? tb[i] : r; return r; }
    if (tile == 3) return 768 + 32 * q;
    if (tile == 4) return 1024 + 32 * q;
    return q == 0 ? 1280 : (q == 4 ? 1312 : -1);
}
__device__ __forceinline__ int wuq_src_col(int tile, int q) {
    if (tile <= 1) return (2 * tile + (q >> 2)) * 192 + 32 * (q & 3);
    return (q & 3) * 192 + 128 + ((q >> 2) ? 32 : 0);
}

__device__ __forceinline__ void ln_row_bf16(const float* __restrict__ src, const float* __restrict__ g, const float* __restrict__ b, bf16_t* dst, int lane) {
    f32x4 v[4]; float s = 0.f;
#pragma unroll
    for (int j = 0; j < 4; ++j) { v[j] = *(const f32x4*)(src + j * 256 + lane * 4); s += (v[j].x + v[j].y) + (v[j].z + v[j].w); }
    const float mean = wave_sum(s) * (1.f / DM); float s2 = 0.f;
#pragma unroll
    for (int j = 0; j < 4; ++j) { v[j] = v[j] - mean; s2 += (v[j].x * v[j].x + v[j].y * v[j].y) + (v[j].z * v[j].z + v[j].w * v[j].w); }
    const float rstd = 1.f / sqrtf(wave_sum(s2) * (1.f / DM) + LN_EPS);
#pragma unroll
    for (int j = 0; j < 4; ++j) { const int c = j * 256 + lane * 4; const f32x4 gg = *(const f32x4*)(g + c), bb = *(const f32x4*)(b + c);
        const f32x4 o = v[j] * rstd * gg + bb; u32x2 w; w.x = pk2(o.x, o.y); w.y = pk2(o.z, o.w); *(u32x2*)(dst + c) = w; }
}

__device__ __forceinline__ bf16x8 ld_bcol8(const float* __restrict__ W, int ldn, int k0, int col) {
    float x[8];
#pragma unroll
    for (int j = 0; j < 8; ++j) x[j] = W[(size_t)(k0 + j) * ldn + col];
    u32x4 w; w.x = pk2(x[0], x[1]); w.y = pk2(x[2], x[3]); w.z = pk2(x[4], x[5]); w.w = pk2(x[6], x[7]);
    return __builtin_bit_cast(bf16x8, w);
}
__device__ __forceinline__ void p0_meta_block(const Frame& F, const Args& a, const int blk) {
    constexpr int RSH = 1032;
    LAS bf16_t* hm = (LAS bf16_t*)(F.lds);
    LAS float* pc = (LAS float*)(F.lds + 33280);
    const int lane = F.lane, w = F.wave, fr = lane & 15, fq = lane >> 4;
    const float* meta = a.in[1]; const float* g = a.in[2]; const float* b = a.in[3]; const float* w_in = a.in[4];
    float* UM = (float*)(F.ws + WS_UM);
#pragma unroll 1
    for (int rr = 0; rr < 2; ++rr) { const int row = 2 * w + rr; const float* src = meta + (size_t)row * DM;
        f32x4 v[4]; float s = 0.f;
#pragma unroll
        for (int j = 0; j < 4; ++j) { v[j] = *(const f32x4*)(src + j * 256 + lane * 4); s += (v[j].x + v[j].y) + (v[j].z + v[j].w); }
        const float mean = wave_sum(s) * (1.f / DM); float s2 = 0.f;
#pragma unroll
        for (int j = 0; j < 4; ++j) { v[j] = v[j] - mean; s2 += (v[j].x * v[j].x + v[j].y * v[j].y) + (v[j].z * v[j].z + v[j].w * v[j].w); }
        const float rstd = 1.f / sqrtf(wave_sum(s2) * (1.f / DM) + LN_EPS);
#pragma unroll
        for (int j = 0; j < 4; ++j) { const int c = j * 256 + lane * 4; const f32x4 gg = *(const f32x4*)(g + c), bb = *(const f32x4*)(b + c); const f32x4 o = v[j] * rstd * gg + bb;
            u32x2 pw; pw.x = pk2(o.x, o.y); pw.y = pk2(o.z, o.w); *(LAS u32x2*)(hm + row * RSH + c) = pw; } }
    __syncthreads();
    const int col = (blk < 16 ? 512 + 16 * blk : (blk < 32 ? 1024 + 16 * (blk - 16) : 1280 + 16 * (blk - 32))) + fr;
    bf16x8 bv[4];
#pragma unroll
    for (int s = 0; s < 4; ++s) bv[s] = ld_bcol8(w_in, INC, 32 * (4 * w + s) + 8 * fq, col);
    f32x4 c = {0.f, 0.f, 0.f, 0.f};
#pragma unroll
    for (int s = 0; s < 4; ++s) { const bf16x8 av = *(const LAS bf16x8*)(hm + fr * RSH + 32 * (4 * w + s) + 8 * fq); c = __builtin_amdgcn_mfma_f32_16x16x32_bf16(av, bv[s], c, 0, 0, 0); }
#pragma unroll
    for (int j = 0; j < 4; ++j) pc[w * 256 + (fq * 4 + j) * 16 + fr] = c[j];
    __syncthreads();
    if (F.tid < 256) { float sum = 0.f;
#pragma unroll
        for (int q = 0; q < 8; ++q) sum += pc[q * 256 + F.tid];
        const int oc = (blk < 16 ? 16 * blk : (blk < 32 ? 256 + 16 * (blk - 16) : 512 + 16 * (blk - 32))) + (F.tid & 15);
        UM[(F.tid >> 4) * 576 + oc] = sum; }
    __syncthreads();
}
__device__ __forceinline__ void p2_meta(const Frame& F, const Args& a, const int q) {
    const int lane = F.lane, w = F.wave, fr = lane & 15, fq = lane >> 4;
    const float* UM = (const float*)(F.ws + WS_UM); const float* gkv = a.in[8]; const float* w_ukv = a.in[9];
    bf16_t* KA = (bf16_t*)(F.ws + WS_KA); bf16_t* VA = (bf16_t*)(F.ws + WS_VA); bf16_t* KM = (bf16_t*)(F.ws + WS_KM); bf16_t* VM = (bf16_t*)(F.ws + WS_VM);
    if (q < 64) {
        LAS float* rs = (LAS float*)(F.lds); LAS float* pc = (LAS float*)(F.lds + 256);
#pragma unroll 1
        for (int rr = 0; rr < 2; ++rr) { const int row = 2 * w + rr; float ss = 0.f;
#pragma unroll
            for (int j = 0; j < 4; ++j) { const float v = UM[row * 576 + 256 + 64 * j + lane]; ss += v * v; }
            ss = wave_sum(ss); if (lane == 0) rs[row] = 1.f / sqrtf(ss * (1.f / 256.f) + RMS_EPS); }
        const bf16x8 bv = ld_bcol8(w_ukv, 1024, 32 * w + 8 * fq, 16 * q + fr);
        __syncthreads();
        float x[8]; const float r_ = rs[fr];
#pragma unroll
        for (int j = 0; j < 8; ++j) { const int k = 32 * w + 8 * fq + j; x[j] = UM[fr * 576 + 256 + k] * r_ * gkv[k]; }
        u32x4 aw; aw.x = pk2(x[0], x[1]); aw.y = pk2(x[2], x[3]); aw.z = pk2(x[4], x[5]); aw.w = pk2(x[6], x[7]);
        f32x4 c = {0.f, 0.f, 0.f, 0.f};
        c = __builtin_amdgcn_mfma_f32_16x16x32_bf16(__builtin_bit_cast(bf16x8, aw), bv, c, 0, 0, 0);
#pragma unroll
        for (int j = 0; j < 4; ++j) pc[w * 256 + (fq * 4 + j) * 16 + fr] = c[j];
        __syncthreads();
        if (F.tid < 256) { float sum = 0.f;
#pragma unroll
            for (int p = 0; p < 8; ++p) sum += pc[p * 256 + F.tid];
            const int r = F.tid >> 4, col = 16 * q + (F.tid & 15), h = col >> 8, cc = col & 255; const bf16_t hv = (bf16_t)f2bf(sum);
            for (int b2 = 0; b2 < NB; ++b2) { const size_t prow = (size_t)b2 * LP + NPAD + r;
                if (cc < 128) KM[prow * 768 + h * 192 + cc] = hv; else VM[prow * 512 + h * 128 + (cc - 128)] = hv; } }
        __syncthreads();
    } else {
        const int idx = (q - 64) * 256 + F.tid;
        if (F.tid < 256 && idx < 16 * 320) { const int r = idx / 320, c = idx % 320;
            const int oc = c < 256 ? c : c + 256; float v = UM[r * 576 + oc];
            if (c < 128 || c >= 256) { const float p = UM[r * 576 + (oc ^ 32)]; float cs, sn; rope_cs(r, c & 31, cs, sn); v = (c & 32) ? v * cs + p * sn : v * cs - p * sn; }
            const bf16_t hv = (bf16_t)f2bf(v);
            for (int b2 = 0; b2 < NB; ++b2) { const size_t prow = (size_t)b2 * LP + NPAD + r;
                if (c < 128) KA[prow * 128 + c] = hv; else if (c < 256) VA[prow * 128 + (c - 128)] = hv;
                else { const int cc = c - 256; KM[prow * 768 + 128 + cc] = hv; KM[prow * 768 + 192 + 128 + cc] = hv; KM[prow * 768 + 384 + 128 + cc] = hv; KM[prow * 768 + 576 + 128 + cc] = hv; } } }
    }
}

__device__ __forceinline__ void p0_prologue(const Frame& F, const Args& a) {
    for (int blk = F.bx; blk < 36; blk += F.G) p0_meta_block(F, a, blk);
    LAS float* scr = (LAS float*)(F.lds + F.wave * 16384);
    const int gw = F.bx * NWAVES + F.wave, NGW = F.G * NWAVES, lane = F.lane;
    unsigned char* ws = F.ws;
    constexpr int I_IN = 16 * 48, I_UQ = 4 * 24, I_UKV = 4 * 32, I_O = 16 * 32, I_GU = 32 * 16 * 16, I_DN = 32 * 4 * 32;
    constexpr int NITEMS = I_IN + I_UQ + I_UKV + I_O + I_GU + I_DN;
    for (int it = gw; it < NITEMS; it += NGW) {
        int r = it;
        if (r < I_IN) { const int kb = r / 48, nb = r % 48; p0_tr_item(a.in[4], INC, win_src_col(nb >> 3, nb & 7), 64 * kb, (bf16_t*)(ws + WS_WIN) + (size_t)(32 * nb) * DM, DM, nullptr, nullptr, scr, lane); continue; } r -= I_IN;
        if (r < I_UQ) { const int kb = r / 24, nb = r % 24; p0_tr_item(a.in[7], 768, wuq_src_col(nb >> 3, nb & 7), 64 * kb, (bf16_t*)(ws + WS_WUQ) + (size_t)(32 * nb) * 256, 256, a.in[6], nullptr, scr, lane); continue; } r -= I_UQ;
        if (r < I_UKV) { const int kb = r / 32, nb = r % 32; p0_tr_item(a.in[9], 1024, 32 * nb, 64 * kb, (bf16_t*)(ws + WS_WUKV) + (size_t)(32 * nb) * 256, 256, a.in[8], nullptr, scr, lane); continue; } r -= I_UKV;
        if (r < I_O) { const int kb = r / 32, nb = r % 32; p0_tr_item(a.in[12], DM, 32 * nb, 64 * kb, (bf16_t*)(ws + WS_WO) + (size_t)(32 * nb) * DM, DM, a.in[10], a.in[11], scr, lane); continue; } r -= I_O;
        if (r < I_GU) { const int e = r / 256, r2 = r % 256, kb = r2 / 16, nb = r2 % 16; const int tile = nb >> 3, q = nb & 7;
            const float* src = (q < 4 ? a.in[19] : a.in[20]) + (size_t)e * DM * 256;
            p0_tr_item(src, 256, 128 * tile + 32 * (q & 3), 64 * kb, (bf16_t*)(ws + WS_WGU) + ((size_t)e * 512 + 32 * nb) * DM, DM, nullptr, nullptr, scr, lane); continue; } r -= I_GU;
        { const int e = r / 128, r2 = r % 128, kb = r2 / 32, nb = r2 % 32;
            p0_tr_item(a.in[21] + (size_t)e * 256 * DM, DM, 32 * nb, 64 * kb, (bf16_t*)(ws + WS_WDN) + ((size_t)e * 1024 + 32 * nb) * 256, 256, nullptr, nullptr, scr, lane); }
    }
    { float* COS = (float*)(ws + WS_COS); float* SIN = (float*)(ws + WS_SIN);
      for (int it = gw; it < NPOS * 32 / 64; it += NGW) { const int idx = it * 64 + lane; float c, s; rope_cs(idx >> 5, idx & 31, c, s); COS[idx] = c; SIN[idx] = s; } }
    for (int it = gw; it < NB * NPAD; it += NGW) { const size_t prow = (size_t)(it / NPAD) * LP + (it % NPAD);
        const u32x4 z = {0u, 0u, 0u, 0u};
        for (int o = lane * 16; o < 3072; o += 1024) {
            unsigned char* p;
            if (o < 256) p = ws + WS_KA + prow * 256 + o; else if (o < 512) p = ws + WS_VA + prow * 256 + (o - 512 + 256);
            else if (o < 2048) p = ws + WS_KM + prow * 1536 + (o - 512); else p = ws + WS_VM + prow * 1024 + (o - 2048);
            ST16(p, z); } }
    { const float* x = a.in[0]; const float* g = a.in[2]; const float* b = a.in[3]; bf16_t* H0 = (bf16_t*)(ws + WS_H0);
      for (int m = gw; m < T; m += 2 * NGW) {
        const int m2 = m + NGW; const bool two = m2 < T;
        f32x4 v[2][4]; float s[2] = {0.f, 0.f};
#pragma unroll
        for (int j = 0; j < 4; ++j) { v[0][j] = *(const f32x4*)(x + (size_t)m * DM + j * 256 + lane * 4); v[1][j] = two ? *(const f32x4*)(x + (size_t)m2 * DM + j * 256 + lane * 4) : (f32x4){0.f, 0.f, 0.f, 0.f}; }
#pragma unroll
        for (int q = 0; q < 2; ++q)
#pragma unroll
            for (int j = 0; j < 4; ++j) s[q] += (v[q][j].x + v[q][j].y) + (v[q][j].z + v[q][j].w);
#pragma unroll
        for (int q = 0; q < 2; ++q) { if (q == 1 && !two) break;
            const float mean = wave_sum(s[q]) * (1.f / DM); float s2 = 0.f;
#pragma unroll
            for (int j = 0; j < 4; ++j) { v[q][j] = v[q][j] - mean; s2 += (v[q][j].x * v[q][j].x + v[q][j].y * v[q][j].y) + (v[q][j].z * v[q][j].z + v[q][j].w * v[q][j].w); }
            const float rstd = 1.f / sqrtf(wave_sum(s2) * (1.f / DM) + LN_EPS);
            bf16_t* dstp = H0 + (size_t)(q ? m2 : m) * DM;
#pragma unroll
            for (int j = 0; j < 4; ++j) { const int c = j * 256 + lane * 4; const f32x4 gg = *(const f32x4*)(g + c), bb = *(const f32x4*)(b + c);
                const f32x4 o = v[q][j] * rstd * gg + bb; u32x2 w2; w2.x = pk2(o.x, o.y); w2.y = pk2(o.z, o.w); *(u32x2*)(dstp + c) = w2; } }
      } }
}

__device__ __forceinline__ void rope8(const f32x4 lo0, const f32x4 lo1, const f32x4 hi0, const f32x4 hi1, const float* __restrict__ cosr, const float* __restrict__ sinr, u32x4& olo, u32x4& ohi, float scale) {
    const f32x4 c0 = *(const f32x4*)cosr, c1 = *(const f32x4*)(cosr + 4), s0 = *(const f32x4*)sinr, s1 = *(const f32x4*)(sinr + 4);
    olo = pg8::pack8((lo0 * c0 - hi0 * s0) * scale, (lo1 * c1 - hi1 * s1) * scale);
    ohi = pg8::pack8((hi0 * c0 + lo0 * s0) * scale, (hi1 * c1 + lo1 * s1) * scale);
}
struct EpiInProj {
    static constexpr bool PERM = true, MIDK = false;
    unsigned char* ws;
    __device__ __forceinline__ void operator()(const f32x4 (&acc)[2][2][4][2], const pg8::Unit& u, int wr, int wc, int fr, int fq) const {
        const int pn = u.pn, bb = u.pm >> 5, t0 = (u.pm & 31) * 256 + wr * 64 + fr;
        const float* COS = (const float*)(ws + WS_COS); const float* SIN = (const float*)(ws + WS_SIN);
        const int j0 = 8 * fq;
#pragma unroll
        for (int ai = 0; ai < 2; ++ai)
#pragma unroll
            for (int m = 0; m < 4; ++m) {
                const int t = t0 + ai * 128 + m * 16; const size_t mrow = (size_t)bb * SEQ + t; const size_t prow = (size_t)bb * LP + 128 + t; const int pos = t + NMETA;
                const f32x4 a00 = acc[ai][0][m][0], a01 = acc[ai][0][m][1], a10 = acc[ai][1][m][0], a11 = acc[ai][1][m][1];
                if (pn <= 1) { u32x4 lo, hi; rope8(a00, a01, a10, a11, COS + pos * 32 + j0, SIN + pos * 32 + j0, lo, hi, 1.f);
                    bf16_t* q = (bf16_t*)(ws + WS_QA) + mrow * 512 + (4 * pn + wc) * 64 + j0; ST16(q, lo); ST16((q + 32), hi); }
                else if (pn == 2) {
                    if (wc < 2) { u32x4 lo, hi; rope8(a00, a01, a10, a11, COS + pos * 32 + j0, SIN + pos * 32 + j0, lo, hi, 1.f);
                        bf16_t* k = (bf16_t*)(ws + WS_KA) + prow * 128 + wc * 64 + j0; ST16(k, lo); ST16((k + 32), hi); }
                    else { bf16_t* v = (bf16_t*)(ws + WS_VA) + prow * 128 + 32 * (wc - 2) + j0; ST16(v, pg8::pack8(a00, a01)); ST16((v + 64), pg8::pack8(a10, a11)); } }
                else if (pn <= 4) {
                    bf16_t* c = (bf16_t*)(ws + (pn == 3 ? WS_CQ : WS_CKV)) + mrow * 256 + 32 * wc + j0; ST16(c, pg8::pack8(a00, a01)); ST16((c + 128), pg8::pack8(a10, a11));
                    const f32x4 q = a00 * a00 + a01 * a01 + a10 * a10 + a11 * a11; float s = (q[0] + q[1]) + (q[2] + q[3]);
                    s += __shfl_xor(s, 16); s += __shfl_xor(s, 32);
                    if (fq == 0) ((float*)(ws + (pn == 3 ? WS_CQS : WS_CKVS)))[mrow * 4 + wc] = s; }
                else { if (wc == 0) { u32x4 lo, hi; rope8(a00, a01, a10, a11, COS + pos * 32 + j0, SIN + pos * 32 + j0, lo, hi, 1.f);
                        bf16_t* k = (bf16_t*)(ws + WS_KM) + prow * 768 + 128 + j0;
#pragma unroll
                        for (int h = 0; h < 4; ++h) { ST16((k + h * 192), lo); ST16((k + h * 192 + 32), hi); } } }
            }
    }
};

struct UpOrder {
    const char* CQ; const char* CKV; const char* Wq; const char* Wkv; int G, c;
    __device__ bool next(int i, pg8::Unit& u) const {
        if (G % 8 == 0) { const int x = c & 7, slot = c >> 3, ns = G >> 3; const int j = i * ns + slot;
            if (j >= 112) return false;
            if (j < 48) { u.pm = x + 8 * (j / 3); u.pn = j % 3; } else { const int j2 = j - 48; u.pm = x + 8 * (j2 >> 2); u.pn = 3 + (j2 & 3); }
            return true; }
        int L = i * G + c; if (L >= 896) return false;
        if (L < 384) { u.pm = L / 3; u.pn = L % 3; } else { L -= 384; u.pm = L >> 2; u.pn = 3 + (L & 3); }
        return true;
    }
    __device__ __forceinline__ const char* abase(const pg8::Unit& u) const { return (u.pn < 3 ? CQ : CKV) + (size_t)u.pm * 256 * 256 * 2; }
    __device__ __forceinline__ const char* bbase(const pg8::Unit& u) const { return u.pn < 3 ? Wq + (size_t)u.pn * 256 * 256 * 2 : Wkv + (size_t)(u.pn - 3) * 256 * 256 * 2; }
    __device__ __forceinline__ unsigned arow_off(const pg8::Unit&, int R) const { return (unsigned)(R * 256) * 2u; }
};
struct EpiUp {
    static constexpr bool PERM = true, MIDK = false;
    unsigned char* ws;
    __device__ __forceinline__ void operator()(const f32x4 (&acc)[2][2][4][2], const pg8::Unit& u, int wr, int wc, int fr, int fq) const {
        const int pn = u.pn, bb = u.pm >> 5, tb = (u.pm & 31) * 256;
        const size_t m0 = (size_t)bb * SEQ + tb, p0 = (size_t)bb * LP + 128 + tb;
        const char* COSb = (const char*)(ws + WS_COS) + (size_t)(tb + NMETA) * 128; const char* SINb = (const char*)(ws + WS_SIN) + (size_t)(tb + NMETA) * 128;
        const char* SSb = (const char*)(ws + (pn < 3 ? WS_CQS : WS_CKVS)) + m0 * 16;
        char* QMb = (char*)(ws + WS_QM) + m0 * 1536; char* KMb = (char*)(ws + WS_KM) + p0 * 1536; char* VMb = (char*)(ws + WS_VM) + p0 * 1024;
        int rl = wr * 64 + fr; asm volatile("" : "+v"(rl));
        const int j0 = 8 * fq;
        f32x4 sv[8];
#pragma unroll
        for (int q = 0; q < 8; ++q) sv[q] = *(const f32x4*)(SSb + (size_t)((unsigned)(rl + (q >> 2) * 128 + (q & 3) * 16) * 16u));
#pragma unroll
        for (int ai = 0; ai < 2; ++ai)
#pragma unroll
            for (int m = 0; m < 4; ++m) {
                const unsigned r = (unsigned)(rl + ai * 128 + m * 16); const f32x4 s4 = sv[ai * 4 + m];
                const float rstd = 1.f / sqrtf(((s4[0] + s4[1]) + (s4[2] + s4[3])) * (1.f / 256.f) + RMS_EPS);
                const f32x4 a00 = acc[ai][0][m][0] * rstd, a01 = acc[ai][0][m][1] * rstd, a10 = acc[ai][1][m][0] * rstd, a11 = acc[ai][1][m][1] * rstd;
                if (pn < 2) { char* q = QMb + (size_t)(r * 1536u + (unsigned)(((2 * pn) * 192 + 32 * wc + j0) * 2)); ST16(q, pg8::pack8(a00, a01)); ST16((q + 384), pg8::pack8(a10, a11)); }
                else if (pn == 2) { u32x4 lo, hi; const unsigned co = r * 128u + (unsigned)(j0 * 4); rope8(a00, a01, a10, a11, (const float*)(COSb + (size_t)co), (const float*)(SINb + (size_t)co), lo, hi, 1.f);
                    char* q = QMb + (size_t)(r * 1536u + (unsigned)((wc * 192 + 128 + j0) * 2)); ST16(q, lo); ST16((q + 64), hi); }
                else { const int h = pn - 3;
                    ST16(KMb + (size_t)(r * 1536u + (unsigned)((h * 192 + 32 * wc + j0) * 2)), pg8::pack8(a00, a01));
                    ST16(VMb + (size_t)(r * 1024u + (unsigned)((h * 128 + 32 * wc + j0) * 2)), pg8::pack8(a10, a11)); }
            }
    }
};

#ifndef ATT_PIPE
#define ATT_PIPE 0
#endif
#ifndef ATT_QKT_PF
#define ATT_QKT_PF 3
#endif
#ifndef ATT_QKT_GROUP
#define ATT_QKT_GROUP 0
#endif
#ifndef ATT_PF0
#define ATT_PF0 4
#endif
#ifndef ATT_HALF
#define ATT_HALF 0
#endif
#ifndef ATT_SKEW_SWA
#define ATT_SKEW_SWA 0
#endif
#ifndef ATT_SKEW
#define ATT_SKEW 1
#endif
namespace att {
typedef short s16x4 __attribute__((ext_vector_type(4)));
typedef float f32x16 __attribute__((ext_vector_type(16)));
constexpr int NW = 8, QBLK = 32, KVBLK = 64, QB = NW * QBLK;
#define SBAR() __builtin_amdgcn_sched_barrier(0)
__device__ __forceinline__ int crow(int r, int hi) { return (r & 3) + 8 * (r >> 2) + 4 * hi; }
typedef float f32x2_t __attribute__((ext_vector_type(2))); typedef __bf16 bf16x2_t __attribute__((ext_vector_type(2)));
__device__ __forceinline__ unsigned cvtpk(float lo, float hi) { const f32x2_t v = {lo, hi}; const bf16x2_t b = __builtin_convertvector(v, bf16x2_t); return __builtin_bit_cast(unsigned, b); }
__device__ __forceinline__ int v_rd_base(int lane) { return ((lane & 3) << 3) | (((lane >> 2) & 3) << 6) | (((lane >> 4) & 1) << 5) | (((lane >> 5) & 1) << 8); }

template <int DQK_, int DV_, int LDQ_, int LDK_, int LDV_, int W_, bool SK_, int NPARK_>
struct Cfg {
    static constexpr int DQK = DQK_, DV = DV_, LDQ = LDQ_, LDK = LDK_, LDV = LDV_, W = W_; static constexpr bool SK = SK_;
    static constexpr int ROWB = DQK * 2, SHM_K = KVBLK * ROWB, SHM_V = KVBLK * DV * 2;
    static constexpr int KCPR = DQK / 8, VCPR = DV / 8, NKC = KVBLK * KCPR / 512, NVC = KVBLK * VCPR / 512, KG = (DV / 32) * 512, NQF = DQK / 16, NOF = DV / 32;
    static constexpr int NPARK = NPARK_, NQR = DQK_ / 16 - NPARK_;
    static constexpr int WS_OFF = 2 * SHM_V + 2 * SHM_K, PARK_OFF = WS_OFF + NW * 64 * 4, LDS_BYTES = PARK_OFF + NW * NPARK_ * 1024;
};
template <class C> struct BlockRef { const bf16_t* Q; const bf16_t* K; const bf16_t* V; bf16_t* O; float* SSQ; int P0; float m0, l0, c2; };
template <class C> struct Seam { bf16x8 qr[C::NQR]; bf16x8 st_k[C::NKC]; bf16x8 st_v[C::NVC]; };

__device__ __forceinline__ void mask_tile(f32x16& p0, f32x16& p1, int dq, unsigned W, int klim) {
    const float NEG = -__builtin_inff();
#pragma unroll
    for (int r = 0; r < 16; ++r) {
        const int c = (r & 3) + 8 * (r >> 2);
        if ((unsigned)(dq - c) >= W || c < klim) p0[r] = NEG;
        if ((unsigned)(dq - c - 32) >= W || c + 32 < klim) p1[r] = NEG;
    }
}
__device__ __forceinline__ void partialSM(f32x16& p0, f32x16& p1, float& m_reg, float& mn, float& alpha, float c2, float thr) {
    float pmax = p0[0];
#pragma unroll
    for (int r = 1; r < 16; ++r) pmax = fmaxf(pmax, p0[r]);
#pragma unroll
    for (int r = 0; r < 16; ++r) pmax = fmaxf(pmax, p1[r]);
    { auto rr = __builtin_amdgcn_permlane32_swap(__float_as_uint(pmax), __float_as_uint(pmax), false, false);
      pmax = fmaxf(__uint_as_float(rr[0]), __uint_as_float(rr[1])); }
    if (__builtin_expect(__all((pmax - m_reg) <= thr), 1)) { mn = m_reg; alpha = 1.f; }
    else { mn = fmaxf(m_reg, pmax); alpha = __builtin_amdgcn_exp2f((m_reg - mn) * c2); m_reg = mn; }
    const float mnL = -mn * c2;
#pragma unroll
    for (int r = 0; r < 16; ++r) p0[r] = fmaf(p0[r], c2, mnL);
#pragma unroll
    for (int r = 0; r < 16; ++r) p1[r] = fmaf(p1[r], c2, mnL);
#pragma unroll
    for (int r = 0; r < 16; ++r) p0[r] = __builtin_amdgcn_exp2f(p0[r]);
}
__device__ __forceinline__ void finishSM(f32x16& p0, f32x16& p1, float alpha, float& l_reg, bf16x8& pa0, bf16x8& pa1, bf16x8& pa2, bf16x8& pa3) {
#pragma unroll
    for (int r = 0; r < 16; ++r) p1[r] = __builtin_amdgcn_exp2f(p1[r]);
    float ps = 0;
#pragma unroll
    for (int r = 0; r < 16; ++r) ps += p0[r];
#pragma unroll
    for (int r = 0; r < 16; ++r) ps += p1[r];
    { auto rr = __builtin_amdgcn_permlane32_swap(__float_as_uint(ps), __float_as_uint(ps), false, false);
      ps = __uint_as_float(rr[0]) + __uint_as_float(rr[1]); }
    l_reg = l_reg * alpha + ps;
#define PK4(P, B_, OUT) do { unsigned a0 = cvtpk(P[B_+0], P[B_+1]), a1 = cvtpk(P[B_+2], P[B_+3]);                          \
        unsigned b0 = cvtpk(P[B_+4], P[B_+5]), b1 = cvtpk(P[B_+6], P[B_+7]);                                             \
        auto r0 = __builtin_amdgcn_permlane32_swap(a0, b0, false, false); auto r1 = __builtin_amdgcn_permlane32_swap(a1, b1, false, false); \
        u32x4 w = {r0[0], r1[0], r0[1], r1[1]}; OUT = *reinterpret_cast<bf16x8*>(&w); } while (0)
    PK4(p0, 0, pa0); PK4(p0, 8, pa1); PK4(p1, 0, pa2); PK4(p1, 8, pa3);
#undef PK4
}
template <class C, int D0, int PF> struct QktSched { static __device__ __forceinline__ void run() {
    __builtin_amdgcn_sched_group_barrier(0x008, 2, 0);
    if constexpr (D0 + PF < C::NQF) __builtin_amdgcn_sched_group_barrier(0x100, 2 + ((D0 + PF >= C::NQR) ? 1 : 0), 0);
    if constexpr (D0 + 1 < C::NQF) QktSched<C, D0 + 1, PF>::run(); } };
template <class C, int KB>
__device__ __forceinline__ void qkt(f32x16& p0, f32x16& p1, const char* K_lds, int r32, int hi, const bf16x8* qr, const char* qpark, bool act) {
    if (C::SK && !act) { const float NEG = -__builtin_inff();
#pragma unroll
        for (int r = 0; r < 16; ++r) { p0[r] = NEG; p1[r] = NEG; } return; }
    p0 = f32x16{}; p1 = f32x16{};
    const char* kb[4];
#pragma unroll
    for (int dd = 0; dd < 4; ++dd) kb[dd] = K_lds + KB * C::SHM_K + r32 * C::ROWB + (((dd * 16 + hi * 8) * 2) ^ (((r32 >> 1) & 7) << 4));
#pragma unroll
    for (int d0 = 0; d0 < C::NQF; ++d0) { const char* a = kb[d0 & 3] + (d0 >> 2) * 128;
        bf16x8 b0 = *reinterpret_cast<const bf16x8*>(a);
        bf16x8 b1 = *reinterpret_cast<const bf16x8*>(a + 32 * C::ROWB);
        bf16x8 qf; if (d0 < C::NQR) qf = qr[d0 < C::NQR ? d0 : 0]; else qf = *reinterpret_cast<const bf16x8*>(qpark + (d0 - C::NQR) * 1024);
        p0 = __builtin_amdgcn_mfma_f32_32x32x16_bf16(b0, qf, p0, 0, 0, 0);
        p1 = __builtin_amdgcn_mfma_f32_32x32x16_bf16(b1, qf, p1, 0, 0, 0);
        if (ATT_QKT_GROUP && C::NQF > 8 && (d0 & 3) == 3) SBAR(); }
#if ATT_QKT_PF > 0
    { constexpr int PF = ATT_QKT_PF < C::NQF ? ATT_QKT_PF : C::NQF;
      __builtin_amdgcn_sched_group_barrier(0x100, 2 * PF + ((PF > C::NQR) ? (PF - C::NQR) : 0), 0);
      QktSched<C, 0, PF>::run(); }
#endif
}
template <class C, int D0, int PF> struct QktSchedD { static __device__ __forceinline__ void run() {
    __builtin_amdgcn_sched_group_barrier(0x008, 1, 0); __builtin_amdgcn_sched_group_barrier(0x400, 2, 0); __builtin_amdgcn_sched_group_barrier(0x002, 3, 0);
    __builtin_amdgcn_sched_group_barrier(0x008, 1, 0); __builtin_amdgcn_sched_group_barrier(0x400, 1, 0); __builtin_amdgcn_sched_group_barrier(0x002, 3, 0);
    if constexpr (D0 + PF < C::NQF) __builtin_amdgcn_sched_group_barrier(0x100, 2 + ((D0 + PF >= C::NQR) ? 1 : 0), 0);
    if constexpr (D0 + 1 < C::NQF) QktSchedD<C, D0 + 1, PF>::run(); } };
template <class C, int KB>
__device__ __forceinline__ void qkt_dummy(f32x16& p0, f32x16& p1, const char* K_lds, int r32, int hi, const bf16x8* qr, const char* qpark, f32x4& dmy) {
    p0 = f32x16{}; p1 = f32x16{};
    const char* kb[4];
#pragma unroll
    for (int dd = 0; dd < 4; ++dd) kb[dd] = K_lds + KB * C::SHM_K + r32 * C::ROWB + (((dd * 16 + hi * 8) * 2) ^ (((r32 >> 1) & 7) << 4));
    f32x4 d2 = dmy;
#pragma unroll
    for (int d0 = 0; d0 < C::NQF; ++d0) { const char* a = kb[d0 & 3] + (d0 >> 2) * 128;
        bf16x8 b0 = *reinterpret_cast<const bf16x8*>(a);
        bf16x8 b1 = *reinterpret_cast<const bf16x8*>(a + 32 * C::ROWB);
        bf16x8 qf; if (d0 < C::NQR) qf = qr[d0 < C::NQR ? d0 : 0]; else qf = *reinterpret_cast<const bf16x8*>(qpark + (d0 - C::NQR) * 1024);
        p0 = __builtin_amdgcn_mfma_f32_32x32x16_bf16(b0, qf, p0, 0, 0, 0);
        p1 = __builtin_amdgcn_mfma_f32_32x32x16_bf16(b1, qf, p1, 0, 0, 0);
#pragma unroll
        for (int e = 0; e < 3; ++e) { const int i = (d0 * 3 + e) & 3; d2[i] = __builtin_amdgcn_exp2f(d2[i]); d2[(i + 1) & 3] = fmaf(d2[(i + 1) & 3], 1.0001f, d2[i]); d2[(i + 2) & 3] = fmaf(d2[(i + 2) & 3], 0.9999f, d2[i]); }
    }
    dmy = d2;
    { __builtin_amdgcn_sched_group_barrier(0x100, 6 + ((3 > C::NQR) ? (3 - C::NQR) : 0), 0);
      QktSchedD<C, 0, 3>::run(); }
}
template <class C, int VB>
__device__ __forceinline__ void pv_tile(f32x16* o, int vb0, bf16x8 pa0, bf16x8 pa1, bf16x8 pa2, bf16x8 pa3, bool act) {
    if (C::SK && !act) return;
#define TRRD(dst, off) asm volatile("ds_read_b64_tr_b16 %0, %1 offset:%2" : "=&v"(dst) : "v"(vb0), "i"(off) : "memory")
#define PV_RD(S_, d0) do { constexpr int b_ = VB * C::SHM_V + (d0) * 512; constexpr int KG_ = C::KG;   \
        TRRD(l0##S_, b_); TRRD(h0##S_, b_ + KG_); TRRD(l1##S_, b_ + 2 * KG_); TRRD(h1##S_, b_ + 3 * KG_); TRRD(l2##S_, b_ + 4 * KG_); TRRD(h2##S_, b_ + 5 * KG_); TRRD(l3##S_, b_ + 6 * KG_); TRRD(h3##S_, b_ + 7 * KG_); } while (0)
#define PV_MM(S_, d0) do {   \
        o[d0] = __builtin_amdgcn_mfma_f32_32x32x16_bf16(pa0, (bf16x8){l0##S_[0], l0##S_[1], l0##S_[2], l0##S_[3], h0##S_[0], h0##S_[1], h0##S_[2], h0##S_[3]}, o[d0], 0, 0, 0);   \
        o[d0] = __builtin_amdgcn_mfma_f32_32x32x16_bf16(pa1, (bf16x8){l1##S_[0], l1##S_[1], l1##S_[2], l1##S_[3], h1##S_[0], h1##S_[1], h1##S_[2], h1##S_[3]}, o[d0], 0, 0, 0);   \
        o[d0] = __builtin_amdgcn_mfma_f32_32x32x16_bf16(pa2, (bf16x8){l2##S_[0], l2##S_[1], l2##S_[2], l2##S_[3], h2##S_[0], h2##S_[1], h2##S_[2], h2##S_[3]}, o[d0], 0, 0, 0);   \
        o[d0] = __builtin_amdgcn_mfma_f32_32x32x16_bf16(pa3, (bf16x8){l3##S_[0], l3##S_[1], l3##S_[2], l3##S_[3], h3##S_[0], h3##S_[1], h3##S_[2], h3##S_[3]}, o[d0], 0, 0, 0); } while (0)
#define PV_W8() do { asm volatile("s_waitcnt lgkmcnt(8)" ::: "memory"); SBAR(); } while (0)
#define PV_W0() do { asm volatile("s_waitcnt lgkmcnt(0)" ::: "memory"); SBAR(); } while (0)
    s16x4 l0A, l1A, l2A, l3A, h0A, h1A, h2A, h3A, l0B, l1B, l2B, l3B, h0B, h1B, h2B, h3B;
    SBAR(); asm volatile("s_waitcnt lgkmcnt(0)" ::: "memory");
    PV_RD(A, 0); PV_RD(B, 1); PV_W8(); PV_MM(A, 0); SBAR();
    if constexpr (C::NOF == 4) { PV_RD(A, 2); PV_W8(); PV_MM(B, 1); SBAR(); PV_RD(B, 3); PV_W8(); PV_MM(A, 2); SBAR(); PV_W0(); PV_MM(B, 3); }
    else { PV_W0(); PV_MM(B, 1); }
    SBAR();
#undef PV_RD
#undef PV_MM
#undef PV_W8
#undef PV_W0
#undef TRRD
}
template <class C> __device__ __forceinline__ int jlo(int P0) { const int lowk = P0 - C::W + 1; int j = lowk > 0 ? lowk / KVBLK : 0; const int jm = NPAD / KVBLK; return j < jm ? jm : j; }

#define AT_RSRC(p) __builtin_amdgcn_make_buffer_rsrc((void*)(p), 0, 0x7fffffff, 0x00020000)
#define AT_BLD(rs, vo, so) __builtin_bit_cast(bf16x8, __builtin_amdgcn_raw_buffer_load_b128((rs), (int)(vo), (int)(so), 0))
#define AT_SLOAD(Kp, Vp, k0) do { const __amdgpu_buffer_rsrc_t kr__ = AT_RSRC(Kp), vr__ = AT_RSRC(Vp); const int ks__ = (k0) * (C::LDK * 2), vs__ = (k0) * (C::LDV * 2); \
    _Pragma("unroll") for (int i_ = 0; i_ < C::NVC; ++i_) S.st_v[i_] = AT_BLD(vr__, vgo + (unsigned)(i_ * 128), vs__); \
    _Pragma("unroll") for (int i_ = 0; i_ < C::NKC; ++i_) S.st_k[i_] = AT_BLD(kr__, kgo + (unsigned)(i_ * 128), ks__); } while (0)
#define AT_LOAD_K(Kp, k0) do { const __amdgpu_buffer_rsrc_t kr__ = AT_RSRC(Kp); const int ks__ = (k0) * (C::LDK * 2); \
    _Pragma("unroll") for (int i_ = 0; i_ < C::NKC; ++i_) S.st_k[i_] = AT_BLD(kr__, kgo + (unsigned)(i_ * 128), ks__); } while (0)
#define AT_LOAD_V(Vp, k0) do { const __amdgpu_buffer_rsrc_t vr__ = AT_RSRC(Vp); const int vs__ = (k0) * (C::LDV * 2); \
    _Pragma("unroll") for (int i_ = 0; i_ < C::NVC; ++i_) S.st_v[i_] = AT_BLD(vr__, vgo + (unsigned)(i_ * 128), vs__); } while (0)
#define AT_SWRITE_K(bf) do { _Pragma("unroll") for (int i_ = 0; i_ < C::NKC; ++i_) *(bf16x8*)(K_lds + (bf) * C::SHM_K + klo + i_ * 128) = S.st_k[i_]; } while (0)
#define AT_SWRITE_V(bf) do { _Pragma("unroll") for (int i_ = 0; i_ < C::NVC; ++i_) *(bf16x8*)(V_lds + (bf) * C::SHM_V + vlo + i_ * 1024) = S.st_v[i_]; } while (0)
#define AT_STAGE_OFFS() \
    const int srow_ = tid >> 3, scc_ = tid & 7; \
    const unsigned kgo = (unsigned)(srow_ * C::LDK + scc_ * 8) * 2u, vgo = (unsigned)(srow_ * C::LDV + scc_ * 8) * 2u; \
    const int klo = srow_ * C::ROWB + ((scc_ * 16) ^ (((srow_ >> 1) & 7) << 4)); \
    const int skk_ = (srow_ & ~0xC) | ((srow_ & 4) << 1) | ((srow_ & 8) >> 1); \
    const int vlo = ((skk_ >> 3) * C::NOF + (scc_ >> 2)) * 512 + ((skk_ & 7) * 32 + (scc_ & 3) * 8) * 2;
#define AT_VMW() asm volatile("s_waitcnt vmcnt(0)" ::: "memory")
#define AT_VMWN(n) asm volatile("s_waitcnt vmcnt(%0)" :: "i"(n) : "memory")

#define AT_QLOAD(Qp) do { bf16x8 qp_[C::NPARK > 0 ? C::NPARK : 1]; \
    const __amdgpu_buffer_rsrc_t qr__ = AT_RSRC(Qp); const int qs__ = wid * (QBLK * C::LDQ * 2); const unsigned qo__ = (unsigned)(r32 * C::LDQ + hi * 8) * 2u; \
    _Pragma("unroll") for (int d0 = 0; d0 < C::NPARK; ++d0) qp_[d0] = AT_BLD(qr__, qo__ + (unsigned)((C::NQR + d0) * 32), qs__); \
    _Pragma("unroll") for (int d0 = 0; d0 < C::NQR; ++d0) S.qr[d0] = AT_BLD(qr__, qo__ + (unsigned)(d0 * 32), qs__); \
    SBAR(); AT_VMWN(C::NQR); \
    _Pragma("unroll") for (int d0 = 0; d0 < C::NPARK; ++d0) *(bf16x8*)(qpark + d0 * 1024) = qp_[d0]; } while (0)
template <class C>
__device__ __forceinline__ void prime(const BlockRef<C>& cur, char* lds, Seam<C>& S, const int tid) {
    const int wid = __builtin_amdgcn_readfirstlane(tid >> 6), lane = tid & 63, r32 = lane & 31, hi = lane >> 5;
    char* K_lds = lds + 2 * C::SHM_V;
    AT_STAGE_OFFS()
    const int kb0 = jlo<C>(cur.P0) * KVBLK;
    char* qpark = lds + C::PARK_OFF + wid * (C::NPARK * 1024) + lane * 16;
    AT_SLOAD(cur.K, cur.V, kb0); SBAR(); AT_QLOAD(cur.Q); AT_VMW(); AT_SWRITE_K(0);
    __syncthreads();
}
template <class C>
__device__ __forceinline__ void block(const BlockRef<C>& cur, const BlockRef<C>& nxt, char* lds, Seam<C>& S, int ssq_slot, const int tid) {
    constexpr bool SK = C::SK; constexpr int W = C::W;
    const int wid = __builtin_amdgcn_readfirstlane(tid >> 6), lane = tid & 63, r32 = lane & 31, hi = lane >> 5;
    const int j_lo = jlo<C>(cur.P0);
    const int j_hi = (cur.P0 + QB - 1) / KVBLK + 1;
    const int NT = j_hi - j_lo;
    const int kbn = jlo<C>(nxt.P0) * KVBLK;
    const int qlo = cur.P0 + wid * QBLK, qm = qlo + r32 - 4 * hi;
    char* V_lds = lds; char* K_lds = lds + 2 * C::SHM_V;
    AT_STAGE_OFFS()
    float* ws = (float*)(lds + C::WS_OFF) + wid * 64; float* li_l = ws, * al_l = ws + 32;
    char* qpark = lds + C::PARK_OFF + wid * (C::NPARK * 1024) + lane * 16;
    float m_reg = cur.m0, l_reg = cur.l0; const float c2 = cur.c2, thr = 8.f * 1.4426950408889634f / c2;
    f32x16 o[C::NOF];
#pragma unroll
    for (int d_ = 0; d_ < C::NOF; ++d_) o[d_] = f32x16{};
    const int vb0 = (int)(uintptr_t)V_lds + v_rd_base(lane);
    const bf16_t* Kh = cur.K; const bf16_t* Vh = cur.V;
#define RESC(a) do { if (__any((a) < 1.f)) { if (hi == 0) al_l[r32] = (a); asm volatile("s_waitcnt lgkmcnt(0)" ::: "memory");              \
                     _Pragma("unroll") for (int d_ = 0; d_ < C::NOF; ++d_) _Pragma("unroll") for (int r = 0; r < 16; ++r) o[d_][r] *= al_l[crow(r, hi)]; } } while (0)
#define KBASE(t) ((j_lo + (t)) * KVBLK)
#define ACT(t) (KBASE(t) <= qlo + QBLK - 1 && KBASE(t) + KVBLK - 1 >= qlo - W + 1)
#define MASKT(P0_, P1_, t) do { const int kb_ = KBASE(t); if ((!SK || ACT(t)) && (kb_ + KVBLK - 1 > qlo || kb_ <= qlo + QBLK - 1 - W || kb_ < NPAD)) mask_tile(P0_, P1_, qm - kb_, (unsigned)W, NPAD - kb_ - 4 * hi); } while (0)
#if ATT_PIPE
    f32x16 pA0, pA1, pB0, pB1; float mnA, mnB, alA, alB; bf16x8 pa0, pa1, pa2, pa3;
    AT_SWRITE_V(0); SBAR();
    if (NT > 1) { AT_SLOAD(Kh, Vh, KBASE(1)); }
    SBAR(); qkt<C, 0>(pA0, pA1, K_lds, r32, hi, S.qr, qpark, ACT(0));
    MASKT(pA0, pA1, 0); partialSM(pA0, pA1, m_reg, mnA, alA, c2, thr);
    if (NT > 1) { AT_VMW(); AT_SWRITE_V(1); AT_SWRITE_K(1); }
    __syncthreads();
#define HALF_STEP(PX0, PX1, mnX, alX, PY0, PY1, alY, t, KB, VB, SB) do {                                                      \
        SBAR(); qkt<C, KB>(PX0, PX1, K_lds, r32, hi, S.qr, qpark, ACT(t));                                                  \
        finishSM(PY0, PY1, alY, l_reg, pa0, pa1, pa2, pa3); SBAR();                                                           \
        if ((t) + 1 < NT) { AT_SLOAD(Kh, Vh, KBASE((t) + 1)); SBAR(); }                                               \
        pv_tile<C, VB>(o, vb0, pa0, pa1, pa2, pa3, ACT((t) - 1)); MASKT(PX0, PX1, (t)); partialSM(PX0, PX1, m_reg, mnX, alX, c2, thr);       \
        __syncthreads();                                                                                                      \
        if ((t) + 1 < NT) { AT_VMW(); if (SB) { AT_SWRITE_V(1); AT_SWRITE_K(1); } else { AT_SWRITE_V(0); AT_SWRITE_K(0); } }                                                                          \
        RESC(alX); __syncthreads(); } while (0)
    for (int t = 1; t + 1 < NT; t += 2) {
        HALF_STEP(pB0, pB1, mnB, alB, pA0, pA1, alA, t, 1, 0, 0);
        HALF_STEP(pA0, pA1, mnA, alA, pB0, pB1, alB, t + 1, 0, 1, 1);
    }
#undef HALF_STEP
    const bool even = (NT & 1) == 0;
    if (even) { SBAR(); qkt<C, 1>(pB0, pB1, K_lds, r32, hi, S.qr, qpark, ACT(NT - 1)); SBAR(); }
    AT_SLOAD(nxt.K, nxt.V, kbn); SBAR();
    finishSM(pA0, pA1, alA, l_reg, pa0, pa1, pa2, pa3); SBAR();
    pv_tile<C, 0>(o, vb0, pa0, pa1, pa2, pa3, ACT(even ? NT - 2 : NT - 1));
    if (even) { MASKT(pB0, pB1, NT - 1); partialSM(pB0, pB1, m_reg, mnB, alB, c2, thr); __syncthreads(); RESC(alB);
        finishSM(pB0, pB1, alB, l_reg, pa0, pa1, pa2, pa3); SBAR(); pv_tile<C, 1>(o, vb0, pa0, pa1, pa2, pa3, ACT(NT - 1)); }
    SBAR();
    AT_QLOAD(nxt.Q);
    AT_SWRITE_K(0); SBAR();
#else
    f32x16 P0, P1; float mn, al; bf16x8 pa0, pa1, pa2, pa3;
    AT_SWRITE_V(0); __syncthreads();
#define STEP(t, B_, NB_) do { const bool more_ = (t) + 1 < NT;                                                              \
        SBAR(); if (more_) { AT_SLOAD(Kh, Vh, KBASE((t) + 1)); } else { AT_SLOAD(nxt.K, nxt.V, kbn); } SBAR();              \
        qkt<C, B_>(P0, P1, K_lds, r32, hi, S.qr, qpark, ACT(t)); SBAR();                                                   \
        MASKT(P0, P1, (t)); partialSM(P0, P1, m_reg, mn, al, c2, thr); RESC(al);                                            \
        finishSM(P0, P1, al, l_reg, pa0, pa1, pa2, pa3); SBAR();                                                             \
        pv_tile<C, B_>(o, vb0, pa0, pa1, pa2, pa3, ACT(t)); SBAR();                                                        \
        if (more_) { AT_VMW(); AT_SWRITE_V(NB_); AT_SWRITE_K(NB_); }                                                        \
        __syncthreads(); } while (0)
    int t = 0;
    for (; t + 1 < NT; t += 2) { STEP(t, 0, 1); STEP(t + 1, 1, 0); }
    if (t < NT) { STEP(t, 0, 1); }
#undef STEP
    AT_QLOAD(nxt.Q);
    AT_SWRITE_K(0); SBAR();
#endif
    if (hi == 0) li_l[r32] = l_reg; asm volatile("s_waitcnt lgkmcnt(0)" ::: "memory");
    float rli[16], sq[16];
#pragma unroll
    for (int r = 0; r < 16; ++r) { rli[r] = __builtin_amdgcn_rcpf(li_l[crow(r, hi)]); sq[r] = 0.f; }
    char* Ow = (char*)(cur.O + (size_t)(wid * QBLK) * 1024); const unsigned oo = (unsigned)(4 * hi * 1024 + r32) * 2u;
#pragma unroll
    for (int r = 0; r < 16; ++r) {
#pragma unroll
        for (int d0 = 0; d0 < C::NOF; ++d0) { const float v = o[d0][r] * rli[r]; sq[r] += v * v;
            const float vn = __shfl_xor(v, 1);
            if ((r32 & 1) == 0) *(unsigned*)(Ow + (size_t)(oo + (unsigned)((((r & 3) + 8 * (r >> 2)) * 1024 + d0 * 32) * 2))) = cvtpk(v, vn); } }
    float sel = 0.f; int r32e = r32, hie = hi; asm volatile("" : "+v"(r32e), "+v"(hie));
#pragma unroll
    for (int r = 0; r < 16; ++r) { float s = sq[r]; s += __shfl_xor(s, 1); s += __shfl_xor(s, 2); s += __shfl_xor(s, 4); s += __shfl_xor(s, 8); s += __shfl_xor(s, 16); sel = (r32e == r) ? s : sel; }
    if (r32e < 16) *(float*)((char*)(cur.SSQ + (size_t)(wid * QBLK) * 12 + ssq_slot) + (size_t)((unsigned)crow(r32e, hie) * 48u)) = sel;
    __syncthreads();
#undef RESC
#undef KBASE
#undef ACT
#undef MASKT
}

template <class C, int XP = 0>
__device__ __forceinline__ void block2(const BlockRef<C>& cur, char* lds, Seam<C>& S, int ssq_slot, const int tid) {
    constexpr bool SK = C::SK; constexpr int W = C::W;
    const int wid = __builtin_amdgcn_readfirstlane(tid >> 6), lane = tid & 63, r32 = lane & 31, hi = lane >> 5, g = wid >> 2;
    const int j_lo = jlo<C>(cur.P0);
    const int j_hi = (cur.P0 + QB - 1) / KVBLK + 1;
    const int NT = j_hi - j_lo;
    const int qlo = cur.P0 + wid * QBLK, qm = qlo + r32 - 4 * hi;
    char* V_lds = lds; char* K_lds = lds + 2 * C::SHM_V;
    AT_STAGE_OFFS()
    float* ws = (float*)(lds + C::WS_OFF) + wid * 64; float* li_l = ws, * al_l = ws + 32;
    char* qpark = lds + C::PARK_OFF + wid * (C::NPARK * 1024) + lane * 16;
    float m_reg = cur.m0, l_reg = cur.l0; const float c2 = cur.c2, thr = 8.f * 1.4426950408889634f / c2;
    f32x16 o[C::NOF];
#pragma unroll
    for (int d_ = 0; d_ < C::NOF; ++d_) o[d_] = f32x16{};
    const int vb0 = (int)(uintptr_t)V_lds + v_rd_base(lane);
    const bf16_t* Kh = cur.K; const bf16_t* Vh = cur.V;
#define RESC(a) do { if (__any((a) < 1.f)) { if (hi == 0) al_l[r32] = (a); asm volatile("s_waitcnt lgkmcnt(0)" ::: "memory");              \
                     _Pragma("unroll") for (int d_ = 0; d_ < C::NOF; ++d_) _Pragma("unroll") for (int r = 0; r < 16; ++r) o[d_][r] *= al_l[crow(r, hi)]; } } while (0)
#define KBASE(t) ((j_lo + (t)) * KVBLK)
#define ACT(t) (KBASE(t) <= qlo + QBLK - 1 && KBASE(t) + KVBLK - 1 >= qlo - W + 1)
#define MASKT(P0_, P1_, t) do { const int kb_ = KBASE(t); if ((!SK || ACT(t)) && (kb_ + KVBLK - 1 > qlo || kb_ <= qlo + QBLK - 1 - W || kb_ < NPAD)) mask_tile(P0_, P1_, qm - kb_, (unsigned)W, NPAD - kb_ - 4 * hi); } while (0)
#define BAR2() asm volatile("s_waitcnt lgkmcnt(0)\n\ts_barrier" ::: "memory")
#define LOADPAIR(tau) do { const int tau_ = (tau); if (tau_ < NT) { AT_LOAD_V(Vh, KBASE(tau_)); } if (tau_ + 1 < NT) { AT_LOAD_K(Kh, KBASE(tau_ + 1)); } } while (0)
#define WRITEPAIR(tau) do { const int tau_ = (tau); if (tau_ < NT) { AT_VMW(); AT_SWRITE_V(tau_ & 1); if (tau_ + 1 < NT) { AT_SWRITE_K((tau_ + 1) & 1); } } } while (0)
    AT_QLOAD(cur.Q);
    AT_LOAD_K(Kh, KBASE(0)); AT_VMW(); AT_SWRITE_K(0);
    if (g == 1) { AT_LOAD_V(Vh, KBASE(0)); AT_LOAD_K(Kh, KBASE(1)); AT_VMW(); AT_SWRITE_V(0); AT_SWRITE_K(1); }
    LOADPAIR(g);
    BAR2();
    if (g == 1) BAR2();
    f32x4 dmy = {0.f, 0.f, 0.f, 0.f}; asm volatile("" : "+v"(dmy));
    f32x16 P0 = f32x16{}, P1 = f32x16{}; float mn, al = 1.f; bf16x8 pa0 = bf16x8{}, pa1 = bf16x8{}, pa2 = bf16x8{}, pa3 = bf16x8{};
    qkt<C, 0>(P0, P1, K_lds, r32, hi, S.qr, qpark, ACT(0)); BAR2();
#define SSTAGE(t) do { if (XP != 1 && XP != 4) { MASKT(P0, P1, (t)); partialSM(P0, P1, m_reg, mn, al, c2, thr); RESC(al); finishSM(P0, P1, al, l_reg, pa0, pa1, pa2, pa3); } SBAR();   \
        if (XP != 2) { WRITEPAIR((t) + g); LOADPAIR((t) + g + 1); } BAR2(); } while (0)
#define MSTAGE(t, VB_, KB_) do { if (XP != 3) { pv_tile<C, VB_>(o, vb0, pa0, pa1, pa2, pa3, ACT(t)); SBAR();                                  \
        if ((t) + 1 < NT) { if (XP == 4) { qkt_dummy<C, KB_>(P0, P1, K_lds, r32, hi, S.qr, qpark, dmy); } else { qkt<C, KB_>(P0, P1, K_lds, r32, hi, S.qr, qpark, ACT((t) + 1)); } } } BAR2(); } while (0)
    int t = 0;
    for (; t + 1 < NT; t += 2) { SSTAGE(t); MSTAGE(t, 0, 1); SSTAGE(t + 1); MSTAGE(t + 1, 1, 0); }
    if (t < NT) { SSTAGE(t); MSTAGE(t, 0, 1); }
#undef SSTAGE
#undef MSTAGE
#undef LOADPAIR
#undef WRITEPAIR
    if (hi == 0) li_l[r32] = l_reg; asm volatile("s_waitcnt lgkmcnt(0)" ::: "memory");
    float rli[16], sq[16];
#pragma unroll
    for (int r = 0; r < 16; ++r) { rli[r] = __builtin_amdgcn_rcpf(li_l[crow(r, hi)]); sq[r] = 0.f; }
    char* Ow = (char*)(cur.O + (size_t)(wid * QBLK) * 1024); const unsigned oo = (unsigned)(4 * hi * 1024 + r32) * 2u;
#pragma unroll
    for (int r = 0; r < 16; ++r) {
#pragma unroll
        for (int d0 = 0; d0 < C::NOF; ++d0) { const float v = o[d0][r] * rli[r]; sq[r] += v * v;
            const float vn = __shfl_xor(v, 1);
            if (XP == 0 && (r32 & 1) == 0) *(unsigned*)(Ow + (size_t)(oo + (unsigned)((((r & 3) + 8 * (r >> 2)) * 1024 + d0 * 32) * 2))) = cvtpk(v, vn);
            if (XP != 0) asm volatile("" :: "v"(v)); } }
    float sel = 0.f; int r32e = r32, hie = hi; asm volatile("" : "+v"(r32e), "+v"(hie));
#pragma unroll
    for (int r = 0; r < 16; ++r) { float s = sq[r]; s += __shfl_xor(s, 1); s += __shfl_xor(s, 2); s += __shfl_xor(s, 4); s += __shfl_xor(s, 8); s += __shfl_xor(s, 16); sel = (r32e == r) ? s : sel; }
    if (XP == 0 && r32e < 16) *(float*)((char*)(cur.SSQ + (size_t)(wid * QBLK) * 12 + ssq_slot) + (size_t)((unsigned)crow(r32e, hie) * 48u)) = sel;
    if (XP != 0) asm volatile("" :: "v"(sel), "v"(dmy));
    if (g == 0) BAR2();
    BAR2();
#undef BAR2
#undef RESC
#undef KBASE
#undef ACT
#undef MASKT
}

typedef __attribute__((address_space(3))) const char* lds_cptr;
typedef short v4i16_t __attribute__((ext_vector_type(4)));
__device__ __forceinline__ s16x4 vtr(lds_cptr p) { return __builtin_bit_cast(s16x4, __builtin_amdgcn_ds_read_tr16_b64_v4i16((__attribute__((address_space(3))) v4i16_t*)p)); }
__device__ __forceinline__ void mask_half(f32x16& p, int dq, unsigned W, int klim) {
    const float NEG = -__builtin_inff();
#pragma unroll
    for (int r = 0; r < 16; ++r) { const int c = (r & 3) + 8 * (r >> 2); if ((unsigned)(dq - c) >= W || c < klim) p[r] = NEG; }
}
template <int NDS> struct StepSched { static __device__ __forceinline__ void run() {
    __builtin_amdgcn_sched_group_barrier(0x100, ATT_PF0, 0);
#define G_(n) __builtin_amdgcn_sched_group_barrier(0x008, 1, 0); if constexpr (ATT_PF0 + 2 * (n) < NDS) __builtin_amdgcn_sched_group_barrier(0x100, (NDS - ATT_PF0 - 2 * (n)) >= 2 ? 2 : 1, 0); \
              __builtin_amdgcn_sched_group_barrier(0x002, 4, 0); __builtin_amdgcn_sched_group_barrier(0x400, 1, 0);
    G_(0) G_(1) G_(2) G_(3) G_(4) G_(5) G_(6) G_(7) G_(8) G_(9) G_(10) G_(11) G_(12) G_(13) G_(14) G_(15) G_(16) G_(17) G_(18) G_(19)
#undef G_
} };
template <class C, int XP = 0>
__device__ __forceinline__ void block3(const BlockRef<C>& cur, char* lds, Seam<C>& S, int ssq_slot, const int tid) {
    static_assert(!C::SK && C::NOF == 4, "block3: causal, DV = 128");
    constexpr int W = C::W;
    const int wid = __builtin_amdgcn_readfirstlane(tid >> 6), lane = tid & 63, r32 = lane & 31, hi = lane >> 5;
    const int j_lo = jlo<C>(cur.P0);
    const int j_hi = (cur.P0 + QB - 1) / KVBLK + 1;
    const int NT = j_hi - j_lo;
    const int qlo = cur.P0 + wid * QBLK, qm = qlo + r32 - 4 * hi;
    char* V_lds = lds; char* K_lds = lds + 2 * C::SHM_V;
    AT_STAGE_OFFS()
    float* ws = (float*)(lds + C::WS_OFF) + wid * 64; float* li_l = ws, * al_l = ws + 32;
    char* qpark = lds + C::PARK_OFF + wid * (C::NPARK * 1024) + lane * 16;
    const lds_cptr qpl = (lds_cptr)qpark;
    const lds_cptr vp = (lds_cptr)V_lds + v_rd_base(lane);
    lds_cptr kp[4];
#pragma unroll
    for (int dd = 0; dd < 4; ++dd) kp[dd] = (lds_cptr)K_lds + r32 * C::ROWB + (((dd * 16 + hi * 8) * 2) ^ (((r32 >> 1) & 7) << 4));
    float m_reg = cur.m0, l_reg = cur.l0; const float c2 = cur.c2, thr = 8.f * 1.4426950408889634f / c2;
    f32x16 o[4];
#pragma unroll
    for (int d_ = 0; d_ < 4; ++d_) o[d_] = f32x16{};
    const bf16_t* Kh = cur.K; const bf16_t* Vh = cur.V;
#define KBASE(t) ((j_lo + (t)) * KVBLK)
#define BAR2() asm volatile("s_waitcnt lgkmcnt(0)\n\ts_barrier" ::: "memory")
#define RESC(a) do { if (__any((a) < 1.f)) { if (hi == 0) al_l[r32] = (a); asm volatile("s_waitcnt lgkmcnt(0)" ::: "memory");              \
                     _Pragma("unroll") for (int d_ = 0; d_ < 4; ++d_) _Pragma("unroll") for (int r = 0; r < 16; ++r) o[d_][r] *= al_l[crow(r, hi)]; } } while (0)
#define QPART(PN, KB_, HQ_) do { PN = f32x16{};                                                                                           \
        _Pragma("unroll") for (int d0 = 0; d0 < C::NQF; ++d0) { const bf16x8 kf = *(const __attribute__((address_space(3))) bf16x8*)(kp[d0 & 3] + ((KB_) * C::SHM_K + (HQ_) * 32 * C::ROWB + (d0 >> 2) * 128)); \
            bf16x8 qf; if (d0 < C::NQR) qf = S.qr[d0 < C::NQR ? d0 : 0]; else qf = *(const __attribute__((address_space(3))) bf16x8*)(qpl + (d0 - C::NQR) * 1024);                      \
            PN = __builtin_amdgcn_mfma_f32_32x32x16_bf16(kf, qf, PN, 0, 0, 0); } } while (0)
#define VPART(A_, B_, VB_, HV_) do {                                                                                                      \
        _Pragma("unroll") for (int d0 = 0; d0 < 4; ++d0) { const lds_cptr b_ = vp + ((VB_) * C::SHM_V + d0 * 512 + 4 * (HV_) * C::KG);     \
            const s16x4 la = vtr(b_), ha = vtr(b_ + C::KG), lb = vtr(b_ + 2 * C::KG), hb = vtr(b_ + 3 * C::KG);                            \
            o[d0] = __builtin_amdgcn_mfma_f32_32x32x16_bf16(A_, (bf16x8){la[0], la[1], la[2], la[3], ha[0], ha[1], ha[2], ha[3]}, o[d0], 0, 0, 0);   \
            o[d0] = __builtin_amdgcn_mfma_f32_32x32x16_bf16(B_, (bf16x8){lb[0], lb[1], lb[2], lb[3], hb[0], hb[1], hb[2], hb[3]}, o[d0], 0, 0, 0); } } while (0)
#define SMAX(PC, PM_) do {                                                                                                                \
        float pm_ = fmaxf(fmaxf(PC[0], PC[1]), fmaxf(PC[2], PC[3]));                                                                    \
        _Pragma("unroll") for (int r = 4; r < 16; r += 4) pm_ = fmaxf(pm_, fmaxf(fmaxf(PC[r], PC[r + 1]), fmaxf(PC[r + 2], PC[r + 3])));  \
        { auto rr = __builtin_amdgcn_permlane32_swap(__float_as_uint(pm_), __float_as_uint(pm_), false, false); pm_ = fmaxf(__uint_as_float(rr[0]), __uint_as_float(rr[1])); } \
        PM_ = pm_; } while (0)
#define SEXP(PC, PM_, NA_, NB_) do {                                                                                                      \
        const bool grow_ = ((PM_) - m_reg) > thr; const float mn_ = grow_ ? fmaxf(m_reg, (PM_)) : m_reg;                               \
        al = grow_ ? __builtin_amdgcn_exp2f((m_reg - mn_) * c2) : 1.f; m_reg = mn_; const float mnL_ = -mn_ * c2;                       \
        _Pragma("unroll") for (int r = 0; r < 16; ++r) PC[r] = __builtin_amdgcn_exp2f(fmaf(PC[r], c2, mnL_));                             \
        float ps_ = 0.f; _Pragma("unroll") for (int r = 0; r < 16; ++r) ps_ += PC[r];                                                     \
        { auto rr = __builtin_amdgcn_permlane32_swap(__float_as_uint(ps_), __float_as_uint(ps_), false, false); ps_ = __uint_as_float(rr[0]) + __uint_as_float(rr[1]); } \
        l_reg = l_reg * al + ps_;                                                                                                         \
        { unsigned a0 = cvtpk(PC[0], PC[1]), a1 = cvtpk(PC[2], PC[3]), b0 = cvtpk(PC[4], PC[5]), b1 = cvtpk(PC[6], PC[7]);               \
          auto r0 = __builtin_amdgcn_permlane32_swap(a0, b0, false, false); auto r1 = __builtin_amdgcn_permlane32_swap(a1, b1, false, false); \
          u32x4 w_ = {r0[0], r1[0], r0[1], r1[1]}; NA_ = __builtin_bit_cast(bf16x8, w_); }                                                \
        { unsigned a0 = cvtpk(PC[8], PC[9]), a1 = cvtpk(PC[10], PC[11]), b0 = cvtpk(PC[12], PC[13]), b1 = cvtpk(PC[14], PC[15]);         \
          auto r0 = __builtin_amdgcn_permlane32_swap(a0, b0, false, false); auto r1 = __builtin_amdgcn_permlane32_swap(a1, b1, false, false); \
          u32x4 w_ = {r0[0], r1[0], r0[1], r1[1]}; NB_ = __builtin_bit_cast(bf16x8, w_); } } while (0)
#define MASKH(PC, h) do { const int kbh_ = KBASE((h) >> 1) + 32 * ((h) & 1); if (kbh_ + 31 > qlo || kbh_ < NPAD) mask_half(PC, qm - kbh_, (unsigned)W, NPAD - kbh_ - 4 * hi); } while (0)
    AT_QLOAD(cur.Q);
    AT_LOAD_K(Kh, KBASE(0)); AT_LOAD_V(Vh, KBASE(0)); AT_VMW(); AT_SWRITE_K(0); AT_SWRITE_V(0);
    AT_LOAD_K(Kh, KBASE(1));
    BAR2();
    f32x16 PA, PB; float al = 1.f, pmA, pmB; bf16x8 fa = bf16x8{}, fb = bf16x8{}, ga, gb;
    QPART(PA, 0, 0); SBAR(); MASKH(PA, 0); SMAX(PA, pmA); SBAR();
    AT_LOAD_V(Vh, KBASE(1)); SBAR();
    QPART(PB, 0, 1); SEXP(PA, pmA, fa, fb); SBAR();
    MASKH(PB, 1); SMAX(PB, pmB); RESC(al); AT_VMWN(C::NVC); AT_SWRITE_K(1); BAR2();
#define FULL(h, PC, PMC, PN, PMN, A_, B_, NA_, NB_, VB_, HV_, KB_, HQ_, EVEN_) do { const int t_ = (h) >> 1;                              \
        if (EVEN_) { if (t_ + 1 < NT) { AT_LOAD_V(Vh, KBASE(t_ + 1)); } } else { if (t_ + 2 < NT) { AT_LOAD_K(Kh, KBASE(t_ + 2)); } } SBAR();  \
        VPART(A_, B_, VB_, HV_); QPART(PN, KB_, HQ_); SEXP(PC, PMC, NA_, NB_); StepSched<32 + C::NPARK>::run(); SBAR();                   \
        MASKH(PN, (h) + 1); SMAX(PN, PMN); RESC(al);                                                                                    \
        if (EVEN_) { if (t_ + 1 < NT) { AT_VMWN(C::NVC); AT_SWRITE_K((t_ + 1) & 1); } } else { if (t_ + 1 < NT) { if (t_ + 2 < NT) { AT_VMWN(C::NKC); } else { AT_VMW(); } AT_SWRITE_V((t_ + 1) & 1); } }  \
        BAR2(); } while (0)
    int h = 1;
    for (; h + 3 <= 2 * NT - 2; h += 4) {
        FULL(h,     PB, pmB, PA, pmA, fa, fb, ga, gb, 0, 0, 1, 0, false);
        FULL(h + 1, PA, pmA, PB, pmB, ga, gb, fa, fb, 0, 1, 1, 1, true);
        FULL(h + 2, PB, pmB, PA, pmA, fa, fb, ga, gb, 1, 0, 0, 0, false);
        FULL(h + 3, PA, pmA, PB, pmB, ga, gb, fa, fb, 1, 1, 0, 1, true);
    }
#undef FULL
    VPART(fa, fb, 0, 0); SEXP(PB, pmB, ga, gb); SBAR();
    RESC(al);
    VPART(ga, gb, 0, 1); SBAR();
#undef QPART
#undef VPART
#undef SMAX
#undef SEXP
#undef MASKH
    if (hi == 0) li_l[r32] = l_reg; asm volatile("s_waitcnt lgkmcnt(0)" ::: "memory");
    float rli[16], sq[16];
#pragma unroll
    for (int r = 0; r < 16; ++r) { rli[r] = __builtin_amdgcn_rcpf(li_l[crow(r, hi)]); sq[r] = 0.f; }
    char* Ow = (char*)(cur.O + (size_t)(wid * QBLK) * 1024); const unsigned oo = (unsigned)(4 * hi * 1024 + r32) * 2u;
#pragma unroll
    for (int r = 0; r < 16; ++r) {
#pragma unroll
        for (int d0 = 0; d0 < 4; ++d0) { const float v = o[d0][r] * rli[r]; sq[r] += v * v;
            const float vn = __shfl_xor(v, 1);
            if (XP == 0 && (r32 & 1) == 0) *(unsigned*)(Ow + (size_t)(oo + (unsigned)((((r & 3) + 8 * (r >> 2)) * 1024 + d0 * 32) * 2))) = cvtpk(v, vn);
            if (XP != 0) asm volatile("" :: "v"(v)); } }
    float sel = 0.f; int r32e = r32, hie = hi; asm volatile("" : "+v"(r32e), "+v"(hie));
#pragma unroll
    for (int r = 0; r < 16; ++r) { float s = sq[r]; s += __shfl_xor(s, 1); s += __shfl_xor(s, 2); s += __shfl_xor(s, 4); s += __shfl_xor(s, 8); s += __shfl_xor(s, 16); sel = (r32e == r) ? s : sel; }
    if (XP == 0 && r32e < 16) *(float*)((char*)(cur.SSQ + (size_t)(wid * QBLK) * 12 + ssq_slot) + (size_t)((unsigned)crow(r32e, hie) * 48u)) = sel;
    if (XP != 0) asm volatile("" :: "v"(sel));
    BAR2();
#undef BAR2
#undef RESC
#undef KBASE
}
#undef AT_STAGE_OFFS
#undef AT_LOAD_K
#undef AT_LOAD_V
#undef AT_SLOAD
#undef AT_SWRITE_K
#undef AT_SWRITE_V
#undef AT_VMW
#undef AT_VMWN
#undef AT_QLOAD
#undef AT_RSRC
#undef AT_BLD
#undef SBAR

typedef Cfg<192, 128, 768, 768, 512, LP, false, 6> CfgMLA;
typedef Cfg<64, 64, 512, 128, 128, 128, true, 0> CfgSWA;
constexpr float C2_MLA = 1.4426950408889634f * 0.07216878364870322f, C2_SWA = 1.4426950408889634f * 0.125f;
static_assert(CfgMLA::LDS_BYTES <= RING_BYTES && CfgSWA::LDS_BYTES <= RING_BYTES, "attention LDS");

__device__ __forceinline__ BlockRef<CfgMLA> mla_ref(unsigned char* ws, int bh, int qb) {
    const int b = bh >> 2, h = bh & 3; BlockRef<CfgMLA> r; const size_t m0 = (size_t)b * SEQ + (size_t)qb * QB;
    r.Q = (const bf16_t*)(ws + WS_QM) + m0 * 768 + h * 192; r.K = (const bf16_t*)(ws + WS_KM) + (size_t)b * LP * 768 + h * 192;
    r.V = (const bf16_t*)(ws + WS_VM) + (size_t)b * LP * 512 + h * 128; r.O = (bf16_t*)(ws + WS_AO) + m0 * 1024 + 512 + h * 128;
    r.SSQ = (float*)(ws + WS_SSQ) + m0 * 12; r.P0 = 128 + qb * QB; r.m0 = -1e30f; r.l0 = 0.f; r.c2 = C2_MLA; return r;
}
__device__ __forceinline__ BlockRef<CfgSWA> swa_ref(unsigned char* ws, const float* sinks, int bh, int qb) {
    const int b = bh >> 3, h = bh & 7, kvh = h >> 2; BlockRef<CfgSWA> r; const size_t m0 = (size_t)b * SEQ + (size_t)qb * QB;
    r.Q = (const bf16_t*)(ws + WS_QA) + m0 * 512 + h * 64; r.K = (const bf16_t*)(ws + WS_KA) + (size_t)b * LP * 128 + kvh * 64;
    r.V = (const bf16_t*)(ws + WS_VA) + (size_t)b * LP * 128 + kvh * 64; r.O = (bf16_t*)(ws + WS_AO) + m0 * 1024 + h * 64;
    r.SSQ = (float*)(ws + WS_SSQ) + m0 * 12; r.P0 = 128 + qb * QB; r.m0 = sinks[h] * 8.f; r.l0 = 1.f; r.c2 = C2_SWA; return r;
}
template <int XP = 0>
__device__ __forceinline__ void attn_phase(char* lds, unsigned char* ws, const float* sinks, int vcu, int G) {
    {
        const int nit = (256 - vcu + G - 1) / G;
        const int nblk = 2 * (nit > 0 ? nit : 0);
        if (nblk > 0) {
            Seam<CfgMLA> S; int tid = threadIdx.x; asm volatile("" : "+v"(tid));
#define MLA_REF(k) mla_ref(ws, (vcu + ((k) >> 1) * G) >> 4, ((k) & 1) ? ((vcu + ((k) >> 1) * G) & 15) : 31 - ((vcu + ((k) >> 1) * G) & 15))
            BlockRef<CfgMLA> cur = MLA_REF(0);
#if ATT_SKEW
#if ATT_HALF
            for (int k = 0; k < nblk; ++k) { cur = MLA_REF(k); block3<CfgMLA, XP>(cur, lds, S, 8 + (((vcu + (k >> 1) * G) >> 4) & 3), tid); }
#else
            for (int k = 0; k < nblk; ++k) { cur = MLA_REF(k); block2<CfgMLA, XP>(cur, lds, S, 8 + (((vcu + (k >> 1) * G) >> 4) & 3), tid); }
#endif
#else
            prime<CfgMLA>(cur, lds, S, tid);
            for (int k = 0; k < nblk; ++k) { const BlockRef<CfgMLA> nxt = (k + 1 < nblk) ? MLA_REF(k + 1) : cur; block<CfgMLA>(cur, nxt, lds, S, 8 + (((vcu + (k >> 1) * G) >> 4) & 3), tid); cur = nxt; }
#endif
#undef MLA_REF
        }
    }
    {
        const int nit = (256 - vcu + G - 1) / G;
        const int nblk = 4 * (nit > 0 ? nit : 0);
        if (nblk > 0) {
            Seam<CfgSWA> S; int tid = threadIdx.x; asm volatile("" : "+v"(tid));
#define SWA_REF(k) swa_ref(ws, sinks, (4 * (vcu + ((k) >> 2) * G) + ((k) & 3)) >> 5, (4 * (vcu + ((k) >> 2) * G) + ((k) & 3)) & 31)
            BlockRef<CfgSWA> cur = SWA_REF(0);
#if ATT_SKEW_SWA
            for (int k = 0; k < nblk; ++k) { cur = SWA_REF(k); block2<CfgSWA, XP>(cur, lds, S, ((4 * (vcu + (k >> 2) * G) + (k & 3)) >> 5) & 7, tid); }
#else
            prime<CfgSWA>(cur, lds, S, tid);
            for (int k = 0; k < nblk; ++k) { const BlockRef<CfgSWA> nxt = (k + 1 < nblk) ? SWA_REF(k + 1) : cur; block<CfgSWA>(cur, nxt, lds, S, ((4 * (vcu + (k >> 2) * G) + (k & 3)) >> 5) & 7, tid); cur = nxt; }
#endif
#undef SWA_REF
        }
    }
}
}

struct EpiOut {
    static constexpr bool PERM = true, MIDK = true;
    unsigned char* ws;
    __device__ __forceinline__ void midk(f32x4 (&acc)[2][2][4][2], const pg8::Unit& u, int wr, int wc, int fr, int fq) const {
        const char* SSQb = (const char*)(ws + WS_SSQ) + (size_t)u.pm * (256 * 48);
        unsigned lo = (unsigned)(wr * 64 + fr) * 48u; asm volatile("" : "+v"(lo));
#pragma unroll
        for (int ai = 0; ai < 2; ++ai) {
            f32x4 s0[4], s1[4], s2[4];
#pragma unroll
            for (int m = 0; m < 4; ++m) { const char* p = SSQb + (size_t)(lo + (unsigned)((ai * 128 + m * 16) * 48)); s0[m] = *(const f32x4*)p; s1[m] = *(const f32x4*)(p + 16); s2[m] = *(const f32x4*)(p + 32); }
#pragma unroll
            for (int m = 0; m < 4; ++m) {
                const float sa = ((s0[m][0] + s0[m][1]) + (s0[m][2] + s0[m][3])) + ((s1[m][0] + s1[m][1]) + (s1[m][2] + s1[m][3])), sb = (s2[m][0] + s2[m][1]) + (s2[m][2] + s2[m][3]);
                const float rho = sqrtf((sb * (1.f / 512.f) + RMS_EPS) / (sa * (1.f / 512.f) + RMS_EPS));
#pragma unroll
                for (int bj = 0; bj < 2; ++bj)
#pragma unroll
                    for (int n = 0; n < 2; ++n) acc[ai][bj][m][n] *= rho; }
            asm volatile("" ::: "memory"); }
    }
    __device__ __forceinline__ void operator()(const f32x4 (&acc)[2][2][4][2], const pg8::Unit& u, int wr, int wc, int fr, int fq) const {
        const char* SSQb = (const char*)(ws + WS_SSQ) + (size_t)u.pm * (256 * 48) + 32;
        const size_t tile = ((size_t)u.pm * 256) * DM + (size_t)u.pn * 256;
        const char* H0b = (const char*)(ws + WS_H0) + tile * 2; char* Pb = (char*)(ws + WS_PRE1) + tile * 2;
        unsigned lo = (unsigned)(wr * 64 + fr) * 48u, eo = (unsigned)((wr * 64 + fr) * DM + wc * 32 + 8 * fq) * 2u; asm volatile("" : "+v"(lo), "+v"(eo));
        f32x4 s2[8];
#pragma unroll
        for (int q = 0; q < 8; ++q) s2[q] = *(const f32x4*)(SSQb + (size_t)(lo + (unsigned)(((q >> 2) * 128 + (q & 3) * 16) * 48)));
#pragma unroll
        for (int ai = 0; ai < 2; ++ai) {
            u32x4 h[4][2];
#pragma unroll
            for (int m = 0; m < 4; ++m)
#pragma unroll
                for (int bj = 0; bj < 2; ++bj) h[m][bj] = *(const u32x4*)(H0b + (size_t)(eo + (unsigned)(((ai * 128 + m * 16) * DM + bj * 128) * 2)));
#pragma unroll
            for (int m = 0; m < 4; ++m) { const f32x4 sq = s2[ai * 4 + m];
                const float rb = 1.f / sqrtf(((sq[0] + sq[1]) + (sq[2] + sq[3])) * (1.f / 512.f) + RMS_EPS);
#pragma unroll
                for (int bj = 0; bj < 2; ++bj) { const u32x4 hv = h[m][bj]; f32x4 o0 = acc[ai][bj][m][0] * rb, o1 = acc[ai][bj][m][1] * rb;
                    o0[0] += ALPHA * __uint_as_float(hv.x << 16); o0[1] += ALPHA * __uint_as_float(hv.x & 0xffff0000u); o0[2] += ALPHA * __uint_as_float(hv.y << 16); o0[3] += ALPHA * __uint_as_float(hv.y & 0xffff0000u);
                    o1[0] += ALPHA * __uint_as_float(hv.z << 16); o1[1] += ALPHA * __uint_as_float(hv.z & 0xffff0000u); o1[2] += ALPHA * __uint_as_float(hv.w << 16); o1[3] += ALPHA * __uint_as_float(hv.w & 0xffff0000u);
                    ST16(Pb + (size_t)(eo + (unsigned)(((ai * 128 + m * 16) * DM + bj * 128) * 2)), pg8::pack8(o0, o1)); } }
            asm volatile("" ::: "memory"); }
    }
};

__device__ __forceinline__ void split_bf16x8(const f32x4 x0, const f32x4 x1, bf16x8& hi, bf16x8& lo) {
    unsigned h[8]; float r[8];
#pragma unroll
    for (int e = 0; e < 4; ++e) { h[e] = f2bf(x0[e]); r[e] = x0[e] - __uint_as_float(h[e] << 16); h[4 + e] = f2bf(x1[e]); r[4 + e] = x1[e] - __uint_as_float(h[4 + e] << 16); }
    u32x4 hw, lw;
    hw.x = h[0] | (h[1] << 16); hw.y = h[2] | (h[3] << 16); hw.z = h[4] | (h[5] << 16); hw.w = h[6] | (h[7] << 16);
    lw.x = pk2(r[0], r[1]); lw.y = pk2(r[2], r[3]); lw.z = pk2(r[4], r[5]); lw.w = pk2(r[6], r[7]);
    hi = __builtin_bit_cast(bf16x8, hw); lo = __builtin_bit_cast(bf16x8, lw);
}
__device__ __forceinline__ void p5_ln1_router(const Frame& F, const Args& a) {
    constexpr int RS = 1032;
    LAS float* hrow = (LAS float*)F.lds;
    LAS float* part = (LAS float*)(F.lds + 16 * RS * 4);
    LAS float* lg = part + 8 * 16 * 48;
    const int tid5 = threadIdx.x, lane = tid5 & 63, w = F.wave, fr = lane & 15, fq = lane >> 4;
    const bf16_t* PRE1 = (const bf16_t*)(F.ws + WS_PRE1); bf16_t* H1 = (bf16_t*)(F.ws + WS_H1);
    const float* g1 = a.in[13]; const float* b1 = a.in[14]; const float* wg = a.in[15]; const float* bg = a.in[16]; const float* wr = a.in[17]; const float* br = a.in[18];
    int* list = (int*)(F.ws + WS_LIST); float* ew = (float*)(F.ws + WS_EW);
    bf16x8 Bh[4][3], Bl[4][3];
#pragma unroll
    for (int s = 0; s < 4; ++s)
#pragma unroll
        for (int cb = 0; cb < 3; ++cb) { const int n = cb * 16 + fr; float x[8];
#pragma unroll
            for (int j = 0; j < 8; ++j) { const int k = 128 * w + 32 * s + 8 * fq + j; x[j] = n < 4 ? wg[k * 4 + n] : (n < 36 ? wr[k * 32 + (n - 4)] : 0.f); }
            split_bf16x8((f32x4){x[0], x[1], x[2], x[3]}, (f32x4){x[4], x[5], x[6], x[7]}, Bh[s][cb], Bl[s][cb]); }
    u32x2 pv[2][4];
    int it = F.bx;
    if (it < T / 16) {
#pragma unroll
        for (int rr = 0; rr < 2; ++rr)
#pragma unroll
            for (int j = 0; j < 4; ++j) pv[rr][j] = *(const u32x2*)(PRE1 + (size_t)(it * 16 + 2 * w + rr) * DM + j * 256 + lane * 4);
    }
    for (; it < T / 16; it += F.G) {
        const int R0 = it * 16;
#pragma unroll
        for (int rr = 0; rr < 2; ++rr) { const int r = 2 * w + rr;
            f32x4 v[4]; float s = 0.f;
#pragma unroll
            for (int j = 0; j < 4; ++j) { const u32x2 q2 = pv[rr][j]; v[j].x = __uint_as_float(q2.x << 16); v[j].y = __uint_as_float(q2.x & 0xffff0000u); v[j].z = __uint_as_float(q2.y << 16); v[j].w = __uint_as_float(q2.y & 0xffff0000u); s += (v[j].x + v[j].y) + (v[j].z + v[j].w); }
            const float mean = wave_sum(s) * (1.f / DM); float s2 = 0.f;
#pragma unroll
            for (int j = 0; j < 4; ++j) { v[j] = v[j] - mean; s2 += (v[j].x * v[j].x + v[j].y * v[j].y) + (v[j].z * v[j].z + v[j].w * v[j].w); }
            const float rstd = 1.f / sqrtf(wave_sum(s2) * (1.f / DM) + LN_EPS);
#pragma unroll
            for (int j = 0; j < 4; ++j) { const int c = j * 256 + lane * 4; const f32x4 gg = *(const f32x4*)(g1 + c), bb = *(const f32x4*)(b1 + c);
                const f32x4 o = v[j] * rstd * gg + bb; *(LAS f32x4*)(hrow + r * RS + c) = o;
                u32x2 pw; pw.x = pk2(o.x, o.y); pw.y = pk2(o.z, o.w); *(u32x2*)(H1 + (size_t)(R0 + r) * DM + c) = pw; } }
        __syncthreads();
        if (it + F.G < T / 16) {
#pragma unroll
            for (int rr = 0; rr < 2; ++rr)
#pragma unroll
                for (int j = 0; j < 4; ++j) pv[rr][j] = *(const u32x2*)(PRE1 + (size_t)((it + F.G) * 16 + 2 * w + rr) * DM + j * 256 + lane * 4);
        }
        f32x4 c0 = {0.f, 0.f, 0.f, 0.f}, c1 = c0, c2 = c0;
#pragma unroll
        for (int s = 0; s < 4; ++s) { const LAS float* ap = hrow + fr * RS + 128 * w + 32 * s + 8 * fq;
            bf16x8 ah, al; split_bf16x8(*(const LAS f32x4*)ap, *(const LAS f32x4*)(ap + 4), ah, al);
            c0 = __builtin_amdgcn_mfma_f32_16x16x32_bf16(ah, Bh[s][0], c0, 0, 0, 0); c0 = __builtin_amdgcn_mfma_f32_16x16x32_bf16(al, Bh[s][0], c0, 0, 0, 0); c0 = __builtin_amdgcn_mfma_f32_16x16x32_bf16(ah, Bl[s][0], c0, 0, 0, 0);
            c1 = __builtin_amdgcn_mfma_f32_16x16x32_bf16(ah, Bh[s][1], c1, 0, 0, 0); c1 = __builtin_amdgcn_mfma_f32_16x16x32_bf16(al, Bh[s][1], c1, 0, 0, 0); c1 = __builtin_amdgcn_mfma_f32_16x16x32_bf16(ah, Bl[s][1], c1, 0, 0, 0);
            c2 = __builtin_amdgcn_mfma_f32_16x16x32_bf16(ah, Bh[s][2], c2, 0, 0, 0); c2 = __builtin_amdgcn_mfma_f32_16x16x32_bf16(al, Bh[s][2], c2, 0, 0, 0); c2 = __builtin_amdgcn_mfma_f32_16x16x32_bf16(ah, Bl[s][2], c2, 0, 0, 0); }
#pragma unroll
        for (int j = 0; j < 4; ++j) { LAS float* pp = part + (w * 16 + fq * 4 + j) * 48 + fr; pp[0] = c0[j]; pp[16] = c1[j]; pp[32] = c2[j]; }
        __syncthreads();
        for (int idx = tid5; idx < 16 * 48; idx += NWAVES * 64) { float sum = 0.f;
#pragma unroll
            for (int q = 0; q < 8; ++q) sum += part[q * 768 + idx];
            lg[idx] = sum; }
        __syncthreads();
        if (tid5 < 16) { const int m = R0 + tid5; const LAS float* L = lg + tid5 * 48;
            const float l0 = L[0] + bg[0], l1 = L[1] + bg[1], l2 = L[2] + bg[2], l3 = L[3] + bg[3];
            const float mx = fmaxf(fmaxf(l0, l1), fmaxf(l2, l3));
            const float ex0 = expf(l0 - mx), ex1 = expf(l1 - mx), ex2 = expf(l2 - mx), ex3 = expf(l3 - mx);
            const float se = ((ex0 + ex1) + ex2) + ex3;
            int gi = 0; float gt = ex0 / se;
            { const float p = ex1 / se; if (p > gt) { gt = p; gi = 1; } }
            { const float p = ex2 / se; if (p > gt) { gt = p; gi = 2; } }
            { const float p = ex3 / se; if (p > gt) { gt = p; gi = 3; } }
            int e1 = 0, e2 = -1; float t1 = -INFINITY, t2 = -INFINITY;
#pragma unroll 1
            for (int i = 0; i < 8; ++i) { const float v = L[4 + gi * 8 + i] + br[gi * 8 + i];
                if (v > t1) { t2 = t1; e2 = e1; t1 = v; e1 = i; } else if (v > t2) { t2 = v; e2 = i; } }
            const float z = expf(t2 - t1), w1 = gt / (1.f + z), w2 = gt * z / (1.f + z);
            const int ea = gi * 8 + e1, eb = gi * 8 + e2;
            const unsigned pa = atomicAdd(&F.ctl[CW_CNT + 64 * ea], 1u); const unsigned pb = atomicAdd(&F.ctl[CW_CNT + 64 * eb], 1u);
            list[(size_t)ea * T + pa] = m * 2; list[(size_t)eb * T + pb] = m * 2 + 1; ew[m * 2] = w1; ew[m * 2 + 1] = w2; }
    }
}

struct MoeOrder {
    const unsigned* ctl; const int* list; const char* A; const char* Bt; int nN, G, c; bool gather;
    __device__ bool next(int i, pg8::Unit& u) const {
        if (G % 8 == 0) {
            const int x = c & 7, slot = c >> 3, ns = G >> 3; const int j = i * ns + slot; const int tlx = j / nN; int accx = 0, accg = 0; bool found = false;
            for (int e = 0; e < 32; ++e) { const int cn = (int)ctl[CW_CNT + 64 * e]; const int nt = (cn + 255) >> 8;
                if ((e & 7) == x) { if (!found && tlx < accx + nt) { u.e = e; u.r0 = (tlx - accx) * 256; u.n = cn; u.pm = accg + (tlx - accx); u.pn = j % nN; found = true; } accx += nt; }
                accg += nt; }
            return found; }
        const int L = i * G + c; const int tl = L / nN; int acc = 0;
        for (int e = 0; e < 32; ++e) { const int cn = (int)ctl[CW_CNT + 64 * e]; const int nt = (cn + 255) >> 8;
            if (tl < acc + nt) { u.e = e; u.r0 = (tl - acc) * 256; u.n = cn; u.pm = tl; u.pn = L % nN; return true; } acc += nt; }
        return false;
    }
    __device__ __forceinline__ const char* abase(const pg8::Unit& u) const { return gather ? A : A + (size_t)u.pm * 256 * 256 * 2; }
    __device__ __forceinline__ const char* bbase(const pg8::Unit& u) const { return gather ? Bt + ((size_t)u.e * 512 + u.pn * 256) * DM * 2 : Bt + ((size_t)u.e * 1024 + u.pn * 256) * 256 * 2; }
    __device__ __forceinline__ unsigned arow_off(const pg8::Unit& u, int R) const {
        if (!gather) return (unsigned)(R * 256) * 2u;
        const int idx = (u.r0 + R < u.n) ? list[(size_t)u.e * T + u.r0 + R] : 0;
        return (unsigned)(idx >> 1) * (unsigned)(DM * 2);
    }
};
struct EpiGU {
    static constexpr bool PERM = true, MIDK = false;
    unsigned char* ws;
    __device__ __forceinline__ void operator()(const f32x4 (&acc)[2][2][4][2], const pg8::Unit& u, int wr, int wc, int fr, int fq) const {
        const char* listb = (const char*)(ws + WS_LIST) + ((size_t)u.e * T + u.r0) * 4; const char* ewb = (const char*)(ws + WS_EW);
        char* Hb = (char*)(ws + WS_HID) + (((size_t)u.pm * 256) * 256 + u.pn * 128) * 2;
        int Rl = wr * 64 + fr; const int nrem = u.n - u.r0; asm volatile("" : "+v"(Rl));
        const unsigned ho = (unsigned)(Rl * 256 + wc * 32 + 8 * fq) * 2u;
        unsigned idx[8]; float wgt[8];
#pragma unroll
        for (int q = 0; q < 8; ++q) { const int R = Rl + (q >> 2) * 128 + (q & 3) * 16; idx[q] = (R < nrem) ? *(const unsigned*)(listb + (size_t)((unsigned)R * 4u)) : 0xffffffffu; }
#pragma unroll
        for (int q = 0; q < 8; ++q) wgt[q] = (idx[q] != 0xffffffffu) ? *(const float*)(ewb + (size_t)(idx[q] * 4u)) : 0.f;
#pragma unroll
        for (int ai = 0; ai < 2; ++ai)
#pragma unroll
            for (int m = 0; m < 4; ++m) { const float wg_ = wgt[ai * 4 + m];
                f32x4 o[2];
#pragma unroll
                for (int n = 0; n < 2; ++n) { const f32x4 gv = acc[ai][0][m][n], uv = acc[ai][1][m][n];
#pragma unroll
                    for (int e = 0; e < 4; ++e) o[n][e] = gv[e] * __builtin_amdgcn_rcpf(1.f + __builtin_amdgcn_exp2f(-1.4426950408889634f * gv[e])) * uv[e] * wg_; }
                ST16(Hb + (size_t)(ho + (unsigned)((ai * 128 + m * 16) * 512)), pg8::pack8(o[0], o[1])); }
    }
};
struct EpiDown {
    static constexpr bool PERM = true, MIDK = false;
    unsigned char* ws;
    __device__ __forceinline__ void operator()(const f32x4 (&acc)[2][2][4][2], const pg8::Unit& u, int wr, int wc, int fr, int fq) const {
        const char* listb = (const char*)(ws + WS_LIST) + ((size_t)u.e * T + u.r0) * 4; char* Yb = (char*)(ws + WS_Y) + (size_t)(u.pn * 256) * 2;
        int Rl = wr * 64 + fr; const int nrem = u.n - u.r0; asm volatile("" : "+v"(Rl));
        const unsigned yo = (unsigned)(wc * 32 + 8 * fq) * 2u;
        unsigned idx[8];
#pragma unroll
        for (int q = 0; q < 8; ++q) { const int R = Rl + (q >> 2) * 128 + (q & 3) * 16; idx[q] = (R < nrem) ? *(const unsigned*)(listb + (size_t)((unsigned)R * 4u)) : 0xffffffffu; }
#pragma unroll
        for (int ai = 0; ai < 2; ++ai)
#pragma unroll
            for (int m = 0; m < 4; ++m) { const unsigned ix = idx[ai * 4 + m];
                if (ix != 0xffffffffu) { char* y = Yb + (size_t)ix * (DM * 2) + yo;
                    ST16(y, pg8::pack8(acc[ai][0][m][0], acc[ai][0][m][1])); ST16((y + 256), pg8::pack8(acc[ai][1][m][0], acc[ai][1][m][1])); } }
    }
};

__device__ __forceinline__ void p8_ln2(const Frame& F, const Args& a) {
    const bf16_t* H1 = (const bf16_t*)(F.ws + WS_H1); const bf16_t* Y = (const bf16_t*)(F.ws + WS_Y); const float* g = a.in[22]; const float* b = a.in[23]; float* out = a.out;
    const int lane = threadIdx.x & 63; const int NGW = F.G * NWAVES;
    for (int m0 = F.bx * NWAVES + F.wave; m0 < T; m0 += 2 * NGW) {
        const int m1 = m0 + NGW; const bool two = m1 < T; const int mm[2] = {m0, two ? m1 : m0};
        u32x2 hq[2][4], y0[2][4], y1[2][4];
#pragma unroll
        for (int q = 0; q < 2; ++q)
#pragma unroll
            for (int j = 0; j < 4; ++j) { const int c = j * 256 + lane * 4; const size_t m = (size_t)mm[q];
                hq[q][j] = *(const u32x2*)(H1 + m * DM + c); y0[q][j] = *(const u32x2*)(Y + (2 * m) * DM + c); y1[q][j] = *(const u32x2*)(Y + (2 * m + 1) * DM + c); }
#pragma unroll
        for (int q = 0; q < 2; ++q) { if (q == 1 && !two) break;
            f32x4 v[4]; float s = 0.f;
#pragma unroll
            for (int j = 0; j < 4; ++j) { const u32x2 h = hq[q][j], a0 = y0[q][j], a1 = y1[q][j];
                v[j].x = ALPHA * __uint_as_float(h.x << 16) + __uint_as_float(a0.x << 16) + __uint_as_float(a1.x << 16);
                v[j].y = ALPHA * __uint_as_float(h.x & 0xffff0000u) + __uint_as_float(a0.x & 0xffff0000u) + __uint_as_float(a1.x & 0xffff0000u);
                v[j].z = ALPHA * __uint_as_float(h.y << 16) + __uint_as_float(a0.y << 16) + __uint_as_float(a1.y << 16);
                v[j].w = ALPHA * __uint_as_float(h.y & 0xffff0000u) + __uint_as_float(a0.y & 0xffff0000u) + __uint_as_float(a1.y & 0xffff0000u);
                s += (v[j].x + v[j].y) + (v[j].z + v[j].w); }
            const float mean = wave_sum(s) * (1.f / DM); float s2 = 0.f;
#pragma unroll
            for (int j = 0; j < 4; ++j) { v[j] = v[j] - mean; s2 += (v[j].x * v[j].x + v[j].y * v[j].y) + (v[j].z * v[j].z + v[j].w * v[j].w); }
            const float rstd = 1.f / sqrtf(wave_sum(s2) * (1.f / DM) + LN_EPS);
            float* orow = out + (size_t)mm[q] * DM;
#pragma unroll
            for (int j = 0; j < 4; ++j) { const int c = j * 256 + lane * 4; const f32x4 gg = *(const f32x4*)(g + c), bb = *(const f32x4*)(b + c);
                *(f32x4*)(orow + c) = v[j] * rstd * gg + bb; } }
    }
}

__global__ void __launch_bounds__(NWAVES * 64, 2) mega(Args args) {
    extern __shared__ __attribute__((aligned(16))) unsigned char lds_raw[];
    Frame F;
    F.lds = (LAS unsigned char*)lds_raw; F.ws = args.ws; F.ctl = (unsigned*)(args.ws + WS_CTL);
    F.tid = threadIdx.x; F.lane = F.tid & 63; F.wave = __builtin_amdgcn_readfirstlane(F.tid >> 6); F.G = gridDim.x; F.bx = blockIdx.x;
    volatile LAS unsigned* MISC = (volatile LAS unsigned*)(F.lds + MISC_OFF);
    for (int u = F.tid; u < (LDS_BYTES - LDSCTL_OFF) / 4; u += NWAVES * 64) ((LAS unsigned*)(F.lds + LDSCTL_OFF))[u] = 0u;
    __syncthreads();
    XcdBarrier bar = xcd_barrier_post(F.ctl + CW_BAR, MISC + 8);
    const int lo = args.ph_lo, hi = args.ph_hi;
#define IN(k) (lo <= (k) && (k) < hi)
#define BOTH(k) (IN(k) && IN((k) + 1))
    if (IN(0)) { p0_prologue(F, args); if (BOTH(0)) xcd_barrier(bar); }
    if (IN(1)) {
        pg8::StaticOrder S; S.init(args.ws + WS_H0, args.ws + WS_WIN, T, 1536, DM, F.G, F.bx);
        EpiInProj E{args.ws};
        pg8::gemm_phase<EpiInProj, pg8::StaticOrder, true>(F.lds, DM, S, E);
        if (BOTH(1)) xcd_barrier(bar);
    }
    if (IN(2)) {
        { int q = F.bx;
          if (F.G % 8 == 0 && F.G >= 224) { const int slot = F.bx >> 3; q = slot >= 16 ? (slot - 16) * 8 + (F.bx & 7) : 1 << 20; }
          for (; q < 84; q += F.G) p2_meta(F, args, q); }
        UpOrder S{(const char*)(args.ws + WS_CQ), (const char*)(args.ws + WS_CKV), (const char*)(args.ws + WS_WUQ), (const char*)(args.ws + WS_WUKV), F.G, F.bx};
        EpiUp E{args.ws};
        pg8::gemm_phase<EpiUp, UpOrder, true>(F.lds, 256, S, E);
        if (BOTH(2)) xcd_barrier(bar);
    }
    if (IN(3)) {
        const int vcu = (F.G % 8 == 0) ? (F.bx % 8) * (F.G / 8) + F.bx / 8 : F.bx;
        att::attn_phase<0>((char*)lds_raw, args.ws, args.in[5], vcu, F.G);
        if (BOTH(3)) xcd_barrier(bar);
    }
    if (IN(4)) {
        pg8::StaticOrder S; S.init(args.ws + WS_AO, args.ws + WS_WO, T, DM, DM, F.G, F.bx);
        EpiOut E{args.ws};
        pg8::gemm_phase<EpiOut, pg8::StaticOrder, true>(F.lds, DM, S, E);
        if (BOTH(4)) xcd_barrier(bar);
    }
    if (IN(5)) { p5_ln1_router(F, args); if (BOTH(5)) xcd_barrier(bar); }
    if (IN(6)) {
        MoeOrder S{F.ctl, (const int*)(args.ws + WS_LIST), (const char*)(args.ws + WS_H1), (const char*)(args.ws + WS_WGU), 2, F.G, F.bx, true};
        EpiGU E{args.ws};
        pg8::gemm_phase<EpiGU, MoeOrder, true>(F.lds, DM, S, E);
        if (BOTH(6)) xcd_barrier(bar);
    }
    if (IN(7)) {
        MoeOrder S{F.ctl, (const int*)(args.ws + WS_LIST), (const char*)(args.ws + WS_HID), (const char*)(args.ws + WS_WDN), 4, F.G, F.bx, false};
        EpiDown E{args.ws};
        pg8::gemm_phase<EpiDown, MoeOrder, true>(F.lds, 256, S, E);
        if (BOTH(7)) xcd_barrier(bar);
    }
    if (IN(8)) { p8_ln2(F, args); }
#undef IN
#undef BOTH
}

extern "C" void kernel_launch(void* const* d_in, const int* in_sizes, int n_in, void* d_out, int out_size, void* d_ws, size_t ws_size, hipStream_t stream) {
    static int grid = 0;
    if (grid == 0) {
        if (n_in != 24 || ws_size < WS_END || out_size != T * DM) { fprintf(stderr, "kernel_launch: unexpected shapes n_in=%d ws=%zu out=%d\n", n_in, ws_size, out_size); grid = -1; return; }
        int dev = 0, cus = 0, per_cu = 0;
        if (hipGetDevice(&dev) != hipSuccess || hipDeviceGetAttribute(&cus, hipDeviceAttributeMultiprocessorCount, dev) != hipSuccess) { grid = -1; return; }
        if (hipFuncSetAttribute((const void*)mega, hipFuncAttributeMaxDynamicSharedMemorySize, LDS_BYTES) != hipSuccess) { fprintf(stderr, "hipFuncSetAttribute failed\n"); grid = -1; return; }
        if (hipOccupancyMaxActiveBlocksPerMultiprocessor(&per_cu, (const void*)mega, NWAVES * 64, LDS_BYTES) != hipSuccess || per_cu < 1) { fprintf(stderr, "occupancy query: %d blocks per CU\n", per_cu); (void)hipGetLastError(); grid = -1; return; }
        (void)hipGetLastError();
        grid = cus;
    }
    if (grid < 0) return;
    static_assert((CW_BAR + XCD_BAR_WORDS) * 4 <= 32768 && (CW_CNT + 64 * 32) * 4 <= 32768, "control words inside the per-call memset");
    (void)hipMemsetAsync((unsigned char*)d_ws + WS_CTL, 0, 32768, stream);
    Args a{};
    for (int i = 0; i < 24; ++i) a.in[i] = (const float*)d_in[i];
    a.out = (float*)d_out; a.ws = (unsigned char*)d_ws; a.ph_lo = 0; a.ph_hi = 9;
    hipLaunchKernelGGL(mega, dim3(grid), dim3(NWAVES * 64), LDS_BYTES, stream, a);
}
```

```cpp
#include <hip/hip_runtime.h>
#include <cstdio>
#include <cstdint>

typedef unsigned short bf16_t;
typedef float f32x4 __attribute__((ext_vector_type(4)));
typedef unsigned u32x4 __attribute__((ext_vector_type(4)));
typedef unsigned u32x2 __attribute__((ext_vector_type(2)));

constexpr int NB = 4, SEQ = 8192, DM = 1024, T = NB * SEQ, LP = SEQ + 128, NPAD = 112, NMETA = 16;
constexpr int INC = 1344;
constexpr float LN_EPS = 1e-5f, RMS_EPS = 1e-6f;
constexpr float ALPHA = 1.189207115002721f;
constexpr size_t MiB = 1u << 20;

constexpr size_t WS_CTL = 0;
constexpr size_t WS_HM = 1 * MiB;
constexpr size_t WS_CKVM = 1 * MiB + 128 * 1024;
constexpr size_t WS_UM = 1 * MiB + 256 * 1024;
constexpr size_t WS_KVTM = 1 * MiB + 640 * 1024;
constexpr size_t WS_SSQ = 2 * MiB;
constexpr size_t WS_EW = 4 * MiB;
constexpr size_t WS_LIST = 5 * MiB;
constexpr size_t WS_W = 16 * MiB;
constexpr size_t WS_H0 = 72 * MiB;
constexpr size_t WS_QA = 136 * MiB;
constexpr size_t WS_KA = 168 * MiB;
constexpr size_t WS_VA = 177 * MiB;
constexpr size_t WS_CQ = 186 * MiB;
constexpr size_t WS_CKV = 202 * MiB;
constexpr size_t WS_KM = 218 * MiB;
constexpr size_t WS_VM = 267 * MiB;
constexpr size_t WS_QM = 300 * MiB;
constexpr size_t WS_AO = 348 * MiB;
constexpr size_t WS_HID = 412 * MiB;
constexpr size_t WS_PRE1 = 136 * MiB;
constexpr size_t WS_H1 = 264 * MiB;
constexpr size_t WS_Y = 72 * MiB;
constexpr size_t WS_TMP = 348 * MiB;
constexpr size_t WS_AN = 412 * MiB;
constexpr size_t WS_END = 512 * MiB;
constexpr int CW_CNT = 1024;

__constant__ float c_inv_freq[32] = {1.000000000e+00f, 7.498942614e-01f, 5.623413324e-01f, 4.216965139e-01f, 3.162277639e-01f, 2.371373773e-01f, 1.778279394e-01f, 1.333521307e-01f, 1.000000015e-01f, 7.498941571e-02f, 5.623413250e-02f, 4.216965288e-02f, 3.162277490e-02f, 2.371373773e-02f, 1.778279431e-02f, 1.333521493e-02f, 9.999999776e-03f, 7.498941850e-03f, 5.623413250e-03f, 4.216964822e-03f, 3.162277630e-03f, 2.371373586e-03f, 1.778279431e-03f, 1.333521446e-03f, 1.000000047e-03f, 7.498942432e-04f, 5.623413017e-04f, 4.216965172e-04f, 3.162277571e-04f, 2.371373703e-04f, 1.778279402e-04f, 1.333521504e-04f};

#ifndef ST_NT
#define ST_NT 0
#endif
#if ST_NT
#define ST16(p, v) __builtin_nontemporal_store((v), (u32x4*)(p))
#define ST16F(p, v) __builtin_nontemporal_store((v), (f32x4*)(p))
#else
#define ST16(p, v) (*(u32x4*)(p) = (v))
#define ST16F(p, v) (*(f32x4*)(p) = (v))
#endif
__device__ __forceinline__ float bf2f(bf16_t v) { return __uint_as_float((unsigned)v << 16); }
__device__ __forceinline__ unsigned f2bf(float f) { unsigned u = __float_as_uint(f); return (u + 0x7fffu + ((u >> 16) & 1u)) >> 16; }
__device__ __forceinline__ unsigned pk2(float lo, float hi) { return f2bf(lo) | (f2bf(hi) << 16); }
__device__ __forceinline__ int lane_id() { return (int)__builtin_amdgcn_mbcnt_hi(~0u, __builtin_amdgcn_mbcnt_lo(~0u, 0u)); }
__device__ __forceinline__ float wave_sum(float v) {
#pragma unroll
    for (int o = 1; o < 64; o <<= 1) v += __shfl_xor(v, o);
    return v;
}
__device__ __forceinline__ float wave_max(float v) {
#pragma unroll
    for (int o = 1; o < 64; o <<= 1) v = fmaxf(v, __shfl_xor(v, o));
    return v;
}
__device__ __forceinline__ void rope_cs(int pos, int i, float& c, float& s) {
    const double ang = (double)pos * (double)c_inv_freq[i];
    const double rev = ang * 0.15915494309189535;
    const float fr = (float)(rev - __builtin_rint(rev));
    s = __builtin_amdgcn_sinf(fr); c = __builtin_amdgcn_cosf(fr);
}


#define LAS __attribute__((address_space(3)))
#define GAS __attribute__((address_space(1)))
typedef short bf16x8 __attribute__((ext_vector_type(8)));
typedef float f32x2 __attribute__((ext_vector_type(2)));

constexpr size_t WS_CQS = 9 * MiB;
constexpr size_t WS_CKVS = 10 * MiB;
constexpr size_t WS_COS = 11 * MiB;
constexpr size_t WS_SIN = 13 * MiB;
constexpr size_t WS_WIN = 16 * MiB;
constexpr size_t WS_WUQ = 19 * MiB;
constexpr size_t WS_WUKV = 19 * MiB + 512 * 1024;
constexpr size_t WS_WO = 20 * MiB;
constexpr size_t WS_WGU = 22 * MiB;
constexpr size_t WS_WDN = 54 * MiB;
constexpr int NPOS = SEQ + NMETA;

namespace pg8 {
constexpr int BM = 256, BK = 64, HALF = 128, HTB = HALF * BK * 2, STAGE_BYTES = 8 * HTB, NXCD = 8, WGM = 8;
__host__ __device__ __forceinline__ int lds_byte(int r, int c) { const int st = (r >> 4) * 2 + (c >> 5), rr = r & 15, cc = c & 31, ob = rr * 64 + cc * 2; return st * 1024 + (ob ^ (((ob >> 9) & 1) << 5)); }
__host__ __device__ __forceinline__ void stage_rc(int b, int& R, int& C) { const int st = b / 1024, sb = b % 1024, swz = sb ^ (((sb >> 9) & 1) << 5); R = (st >> 1) * 16 + swz / 64; C = (st & 1) * 32 + (swz % 64) / 2; }
__host__ __device__ __forceinline__ int perm32(int rho) { const int n = rho >> 4, i = rho & 15; return 8 * (i >> 2) + 4 * n + (i & 3); }
struct Unit { int pm, pn, e, r0, n; };
typedef float f32x2_t __attribute__((ext_vector_type(2))); typedef __bf16 bf16x2_t __attribute__((ext_vector_type(2)));
__device__ __forceinline__ unsigned cvt_pk_bf16(float lo, float hi) { const f32x2_t v = {lo, hi}; const bf16x2_t b = __builtin_convertvector(v, bf16x2_t); return __builtin_bit_cast(unsigned, b); }
__device__ __forceinline__ u32x4 pack8(const f32x4 a, const f32x4 b) { u32x4 w; w.x = cvt_pk_bf16(a[0], a[1]); w.y = cvt_pk_bf16(a[2], a[3]); w.z = cvt_pk_bf16(b[0], b[1]); w.w = cvt_pk_bf16(b[2], b[3]); return w; }

template <class Epi, class Sched, bool ALIGN_EPI>
__device__ __forceinline__ void gemm_phase(LAS unsigned char* lds, const int K, const Sched& S, const Epi& E) {
    const int tid = threadIdx.x, wid = __builtin_amdgcn_readfirstlane(tid >> 6), lane = tid & 63, wr = wid >> 2, wc = wid & 3, fr = lane & 15, fq = lane >> 4;
    const int nt = K / BK;
    int Rr[2]; unsigned cof[2], voffB[2];
#pragma unroll
    for (int i = 0; i < 2; ++i) { int R, C; stage_rc(tid * 16 + i * 8192, R, C); Rr[i] = R; cof[i] = (unsigned)C * 2u; const int Rb = Epi::PERM ? ((R & ~31) + perm32(R & 31)) : R; voffB[i] = (unsigned)(Rb * K + C) * 2u; }
    const size_t kstep = (size_t)(BK * 2);
    const size_t hstepB = (size_t)HALF * K * 2;
    const unsigned ldsw = (unsigned)wid * 1024u;
    const int aoff = lds_byte(wr * 64 + fr, fq * 8), boff = lds_byte(wc * 32 + fr, fq * 8);
#define PG8_SA(b, h) (((b) * 2 + (h)) * HTB)
#define PG8_SB(b, h) ((4 + (b) * 2 + (h)) * HTB)
#define PG8_STAGE(bufoff, gbase, voff) do { _Pragma("unroll") for (int _i = 0; _i < 2; ++_i) \
        __builtin_amdgcn_global_load_lds((const unsigned*)((const char*)(gbase) + (voff)[_i]), (LAS unsigned*)(lds + (bufoff) + ldsw + _i * 8192), 16, 0, 0); } while (0)
#define PG8_LDA(dst, b, h) do { _Pragma("unroll") for (int m = 0; m < 4; ++m) _Pragma("unroll") for (int k = 0; k < 2; ++k) dst[m][k] = *(const LAS bf16x8*)(lds + PG8_SA(b, h) + aoff + m * 2048 + k * 1024); } while (0)
#define PG8_LDB(dst, b, h) do { _Pragma("unroll") for (int n = 0; n < 2; ++n) _Pragma("unroll") for (int k = 0; k < 2; ++k) dst[n][k] = *(const LAS bf16x8*)(lds + PG8_SB(b, h) + boff + n * 2048 + k * 1024); } while (0)
#define PG8_MMA(ai, bj, At, Bt) do { __builtin_amdgcn_s_setprio(1); _Pragma("unroll") for (int m = 0; m < 4; ++m) _Pragma("unroll") for (int n = 0; n < 2; ++n) _Pragma("unroll") for (int k = 0; k < 2; ++k) \
        acc[ai][bj][m][n] = __builtin_amdgcn_mfma_f32_16x16x32_bf16(Bt[n][k], At[m][k], acc[ai][bj][m][n], 0, 0, 0); __builtin_amdgcn_s_setprio(0); } while (0)
#define PG8_WAIT_V(n) asm volatile("s_waitcnt vmcnt(" #n ")" ::: "memory")
#define PG8_WAIT_L(n) asm volatile("s_waitcnt lgkmcnt(" #n ")" ::: "memory")
#define PG8_BAR __builtin_amdgcn_s_barrier()
#define PG8_SCHED __builtin_amdgcn_sched_barrier(0)
    Unit cur, nxt; int ui = 0;
    if (!S.next(0, cur)) return;
    f32x4 acc[2][2][4][2];
#pragma unroll
    for (int a = 0; a < 2; ++a)
#pragma unroll
        for (int b = 0; b < 2; ++b)
#pragma unroll
            for (int m = 0; m < 4; ++m)
#pragma unroll
                for (int n = 0; n < 2; ++n) acc[a][b][m][n] = (f32x4){0.f, 0.f, 0.f, 0.f};
    bf16x8 At[4][2], B0[2][2], B1[2][2];
    unsigned vA0[2], vA1[2], vN0[2], vN1[2];
#pragma unroll
    for (int i = 0; i < 2; ++i) { vA0[i] = S.arow_off(cur, Rr[i]) + cof[i]; vA1[i] = S.arow_off(cur, Rr[i] + HALF) + cof[i]; }
    const char* cA = S.abase(cur); const char* cB = S.bbase(cur);
    PG8_STAGE(PG8_SB(0, 0), cB, voffB); PG8_STAGE(PG8_SB(0, 1), cB + hstepB, voffB); PG8_STAGE(PG8_SA(0, 0), cA, vA0); PG8_STAGE(PG8_SA(0, 1), cA, vA1);
    if (wr == 1) PG8_BAR;
    PG8_WAIT_V(2); PG8_BAR;
    PG8_STAGE(PG8_SB(1, 0), cB + kstep, voffB); PG8_STAGE(PG8_SA(1, 0), cA + kstep, vA0); PG8_STAGE(PG8_SB(1, 1), cB + hstepB + kstep, voffB);
    PG8_WAIT_V(6); PG8_BAR;
    for (;;) {
        const bool has_next = S.next(ui + 1, nxt);
        const char* nA = has_next ? S.abase(nxt) : cA; const char* nB = has_next ? S.bbase(nxt) : cB;
#pragma unroll
        for (int i = 0; i < 2; ++i) { vN0[i] = has_next ? S.arow_off(nxt, Rr[i]) + cof[i] : vA0[i]; vN1[i] = has_next ? S.arow_off(nxt, Rr[i] + HALF) + cof[i] : vA1[i]; }
#pragma unroll 1
        for (int t = 0; t < nt; t += 2) {
            const bool last = (t == nt - 2);
            const char* a1 = cA + (size_t)(t + 1) * kstep;
            const char* a2 = last ? nA : cA + (size_t)(t + 2) * kstep; const char* b2 = last ? nB : cB + (size_t)(t + 2) * kstep;
            const char* a3 = a2 + kstep; const char* b3 = b2 + kstep;
            unsigned w0[2], w1[2];
#pragma unroll
            for (int i = 0; i < 2; ++i) { w0[i] = last ? vN0[i] : vA0[i]; w1[i] = last ? vN1[i] : vA1[i]; }
            PG8_LDB(B0, 0, 0); PG8_LDB(B1, 0, 1); PG8_SCHED; PG8_LDA(At, 0, 0); PG8_STAGE(PG8_SA(1, 1), a1, vA1);
            PG8_WAIT_V(8); PG8_WAIT_L(0); PG8_BAR; PG8_MMA(0, 0, At, B0); PG8_MMA(0, 1, At, B1); PG8_BAR; PG8_SCHED;
            PG8_LDA(At, 0, 1); PG8_STAGE(PG8_SB(0, 0), b2, voffB); PG8_STAGE(PG8_SB(0, 1), b2 + hstepB, voffB); PG8_STAGE(PG8_SA(0, 0), a2, w0);
            PG8_WAIT_V(8); PG8_WAIT_L(0); PG8_BAR; PG8_MMA(1, 0, At, B0); PG8_MMA(1, 1, At, B1); PG8_BAR; PG8_SCHED;
            PG8_LDB(B0, 1, 0); PG8_LDB(B1, 1, 1); PG8_SCHED; PG8_LDA(At, 1, 0); PG8_STAGE(PG8_SA(0, 1), a2, w1);
            PG8_WAIT_V(8); PG8_WAIT_L(0); PG8_BAR; PG8_MMA(0, 0, At, B0); PG8_MMA(0, 1, At, B1); PG8_BAR; PG8_SCHED;
            PG8_LDA(At, 1, 1); PG8_STAGE(PG8_SB(1, 0), b3, voffB); PG8_STAGE(PG8_SB(1, 1), b3 + hstepB, voffB); PG8_STAGE(PG8_SA(1, 0), a3, w0);
            PG8_WAIT_V(8); PG8_WAIT_L(0); PG8_BAR; PG8_MMA(1, 0, At, B0); PG8_MMA(1, 1, At, B1); PG8_BAR; PG8_SCHED;
            if constexpr (Epi::MIDK) { if (t + 2 == nt / 2) E.midk(acc, cur, wr, wc, fr, fq); }
        }
        if constexpr (ALIGN_EPI) { if (wr == 0) PG8_BAR; }
        E(acc, cur, wr, wc, fr, fq);
        if (!has_next) break;
#pragma unroll
        for (int a = 0; a < 2; ++a)
#pragma unroll
            for (int b = 0; b < 2; ++b)
#pragma unroll
                for (int m = 0; m < 4; ++m)
#pragma unroll
                    for (int n = 0; n < 2; ++n) acc[a][b][m][n] = (f32x4){0.f, 0.f, 0.f, 0.f};
        cur = nxt; cA = nA; cB = nB; ++ui;
#pragma unroll
        for (int i = 0; i < 2; ++i) { vA0[i] = vN0[i]; vA1[i] = vN1[i]; }
        if constexpr (ALIGN_EPI) { if (wr == 1) PG8_BAR; }
    }
    PG8_WAIT_V(0);
    if constexpr (!ALIGN_EPI) { if (wr == 0) PG8_BAR; }
    PG8_BAR;
#undef PG8_SA
#undef PG8_SB
#undef PG8_STAGE
#undef PG8_LDA
#undef PG8_LDB
#undef PG8_MMA
#undef PG8_WAIT_V
#undef PG8_WAIT_L
#undef PG8_BAR
#undef PG8_SCHED
}

struct StaticOrder {
    const char* A; const char* Bt; int K;
    int nM, nN, nwg, G, c;
    __device__ void init(const void* A_, const void* Bt_, int M, int N, int K_, int G_, int c_) { A = (const char*)A_; Bt = (const char*)Bt_; K = K_; nM = M / BM; nN = N / BM; nwg = nM * nN; G = G_; c = c_; }
    __device__ bool next(int i, Unit& u) const {
        const long L = (long)i * G + c; if (L >= nwg) return false;
        int wgid = (int)L; { const int q = nwg / NXCD, r = nwg % NXCD, xcd = wgid % NXCD, off = wgid / NXCD; wgid = (xcd < r ? xcd * (q + 1) : r * (q + 1) + (xcd - r) * q) + off; }
        const int nig = WGM * nN, gid = wgid / nig, fm = gid * WGM, gsz = (nM - fm) < WGM ? (nM - fm) : WGM;
        u.pm = fm + ((wgid % nig) % gsz); u.pn = (wgid % nig) / gsz; return true;
    }
    __device__ __forceinline__ const char* abase(const Unit& u) const { return A + (size_t)u.pm * BM * K * 2; }
    __device__ __forceinline__ const char* bbase(const Unit& u) const { return Bt + (size_t)u.pn * BM * K * 2; }
    __device__ __forceinline__ unsigned arow_off(const Unit&, int R) const { return (unsigned)(R * K) * 2u; }
};
}

#define XB_TMO      128
#define XB_XCNT(j)  (256  + 64 * (j))
#define XB_XSUB(j)  (1280 + 64 * (j))
#define XB_XGEN(j)  (2304 + 64 * (j))
#define XB_TOP      3328
#define XB_TOPGEN   3392
#define XCD_BAR_WORDS 3456
#define XB_SPIN_CAP (1u << 18)
__device__ __forceinline__ unsigned xb_ld(unsigned* p)              { return __hip_atomic_load(p, __ATOMIC_RELAXED, __HIP_MEMORY_SCOPE_AGENT); }
__device__ __forceinline__ unsigned xb_add(unsigned* p, unsigned v) { return __hip_atomic_fetch_add(p, v, __ATOMIC_RELAXED, __HIP_MEMORY_SCOPE_AGENT); }
__device__ __forceinline__ unsigned xb_xcc_id() { return (unsigned)__builtin_amdgcn_s_getreg((3 << 11) | 20) & 0xFu; }
#define XB_SPIN(cond, bar) do { unsigned _sp = 0; while (cond) { __builtin_amdgcn_s_sleep(1); \
    if ((++_sp & 255u) == 0u) { if (xb_ld(&(bar)[XB_TMO])) break; if (_sp > XB_SPIN_CAP) { atomicAdd(&(bar)[XB_TMO], 1u); break; } } } } while (0)
struct XcdBarrier { unsigned* bar; unsigned x; volatile LAS unsigned* st; };
__device__ __forceinline__ XcdBarrier xcd_barrier_post(unsigned* bar, volatile LAS unsigned* st) {
    XcdBarrier b; b.bar = bar; b.x = xb_xcc_id(); b.st = st;
    if (threadIdx.x == 0) (void)xb_add(&bar[XB_XCNT(b.x)], 1u);
    return b;
}
__device__ __forceinline__ void xcd_barrier_complete(unsigned* bar, unsigned x, unsigned& nloc, unsigned& nx) {
    const unsigned G = gridDim.x * gridDim.y * gridDim.z;
    unsigned sum, cnt, mine, sp = 0u;
    for (;;) {
        sum = 0u; cnt = 0u; mine = 0u;
#pragma unroll
        for (unsigned j = 0; j < 16; ++j) { const unsigned c = xb_ld(&bar[XB_XCNT(j)]); sum += c; cnt += (c > 0u) ? 1u : 0u; mine = (j == x) ? c : mine; }
        if (sum == G) break;
        __builtin_amdgcn_s_sleep(1);
        if ((++sp & 255u) == 0u) { if (xb_ld(&bar[XB_TMO])) break; if (sp > XB_SPIN_CAP) { atomicAdd(&bar[XB_TMO], 1u); break; } }
    }
    nloc = mine > 0u ? mine : 1u; nx = cnt > 0u ? cnt : 1u;
}
__device__ __forceinline__ void xcd_barrier(const XcdBarrier& b) {
    asm volatile("s_waitcnt vmcnt(0)" ::: "memory");
    __syncthreads();
    if (threadIdx.x == 0) {
        unsigned* bar = b.bar;
        __builtin_amdgcn_s_waitcnt(0);
        unsigned nloc = b.st[0], nx = b.st[1];
        if (nloc == 0u) { xcd_barrier_complete(bar, b.x, nloc, nx); b.st[0] = nloc; b.st[1] = nx; }
        const unsigned old = xb_add(&bar[XB_XSUB(b.x)], 1u);
        const unsigned gen = old / nloc;
        if (old + 1u == (gen + 1u) * nloc) {
            __builtin_amdgcn_fence(__ATOMIC_RELEASE, "agent");
            asm volatile("s_waitcnt vmcnt(0)" ::: "memory");
            const unsigned og = xb_add(&bar[XB_TOP], 1u);
            const unsigned tg = og / nx;
            if (og + 1u == (tg + 1u) * nx) xb_add(&bar[XB_TOPGEN], 1u);
            else XB_SPIN(xb_ld(&bar[XB_TOPGEN]) == tg, bar);
            __builtin_amdgcn_fence(__ATOMIC_ACQUIRE, "agent");
            xb_add(&bar[XB_XGEN(b.x)], 1u);
            asm volatile("s_waitcnt vmcnt(0)" ::: "memory");
        } else {
            XB_SPIN(xb_ld(&bar[XB_XGEN(b.x)]) == gen, bar);
            __builtin_amdgcn_fence(__ATOMIC_ACQUIRE, "agent");
            asm volatile("s_waitcnt vmcnt(0)" ::: "memory");
        }
    }
    __syncthreads();
}

constexpr int NWAVES = 8;
constexpr int RING_BYTES = 135168, LDSCTL_OFF = RING_BYTES, MISC_OFF = LDSCTL_OFF + 320, LDS_BYTES = 147456;
constexpr int CW_BAR = 4096;
#define LDS_WAIT() asm volatile("s_waitcnt lgkmcnt(0)" ::: "memory")
#define VM_WAIT() asm volatile("s_waitcnt vmcnt(0)" ::: "memory")

struct Args {
    const float* in[24]; float* out; unsigned char* ws; int ph_lo, ph_hi;
};
struct Frame {
    LAS unsigned char* lds; unsigned char* ws; unsigned* ctl;
    int tid, lane, wave, G, bx;
};

__device__ __forceinline__ void p0_tr_item(const float* __restrict__ W, int ldn, int c0, int k0, bf16_t* dst, int K, const float* __restrict__ sc0, const float* __restrict__ sc1, LAS float* scr, int lane) {
    if (c0 >= 0) {
        f32x4 v[8];
#pragma unroll
        for (int i = 0; i < 8; ++i) v[i] = *(const f32x4*)(W + (size_t)(k0 + 8 * i + (lane >> 3)) * ldn + c0 + (lane & 7) * 4);
#pragma unroll
        for (int i = 0; i < 8; ++i) { const int kk = 8 * i + (lane >> 3), k = k0 + kk; f32x4 x = v[i];
            if (sc0) x *= (k < 512 || !sc1) ? sc0[k] : sc1[k - 512];
            LAS float* s = scr + kk * 33 + (lane & 7) * 4; s[0] = x.x; s[1] = x.y; s[2] = x.z; s[3] = x.w; }
    } else {
#pragma unroll 8
        for (int i = 0; i < 32; ++i) { const int kk = 2 * i + (lane >> 5); scr[kk * 33 + (lane & 31)] = 0.f; }
    }
    LDS_WAIT(); asm volatile("" ::: "memory");
    const int c = lane & 7;
#pragma unroll
    for (int j = 0; j < 4; ++j) { const int n = (lane >> 3) + 8 * j; const LAS float* s = scr + (8 * c) * 33 + n;
        u32x4 o; o.x = pk2(s[0 * 33], s[1 * 33]); o.y = pk2(s[2 * 33], s[3 * 33]); o.z = pk2(s[4 * 33], s[5 * 33]); o.w = pk2(s[6 * 33], s[7 * 33]);
        ST16((dst + (size_t)n * K + k0 + 8 * c), o); }
    LDS_WAIT(); asm volatile("" ::: "memory");
}
__device__ __forceinline__ int win_src_col(int tile, int q) {
    if (tile <= 1) return 256 * tile + 64 * (q & 3) + ((q >> 2) ? 32 : 0);
    if (tile == 2) { const int tb[8] = {512, 576, 640, 672, 544, 608, 704, 736}; int r = tb[0];
#pragma unroll
        for (int i = 1; i < 8; ++i) r = (q == i) ? tb[i] : r; return r; }
    if (tile == 3) return 768 + 32 * q;
    if (tile == 4) return 1024 + 32 * q;
    return q == 0 ? 1280 : (q == 4 ? 1312 : -1);
}
__device__ __forceinline__ int wuq_src_col(int tile, int q) {
    if (tile <= 1) return (2 * tile + (q >> 2)) * 192 + 32 * (q & 3);
    return (q & 3) * 192 + 128 + ((q >> 2) ? 32 : 0);
}

__device__ __forceinline__ void ln_row_bf16(const float* __restrict__ src, const float* __restrict__ g, const float* __restrict__ b, bf16_t* dst, int lane) {
    f32x4 v[4]; float s = 0.f;
#pragma unroll
    for (int j = 0; j < 4; ++j) { v[j] = *(const f32x4*)(src + j * 256 + lane * 4); s += (v[j].x + v[j].y) + (v[j].z + v[j].w); }
    const float mean = wave_sum(s) * (1.f / DM); float s2 = 0.f;
#pragma unroll
    for (int j = 0; j < 4; ++j) { v[j] = v[j] - mean; s2 += (v[j].x * v[j].x + v[j].y * v[j].y) + (v[j].z * v[j].z + v[j].w * v[j].w); }
    const float rstd = 1.f / sqrtf(wave_sum(s2) * (1.f / DM) + LN_EPS);
#pragma unroll
    for (int j = 0; j < 4; ++j) { const int c = j * 256 + lane * 4; const f32x4 gg = *(const f32x4*)(g + c), bb = *(const f32x4*)(b + c);
        const f32x4 o = v[j] * rstd * gg + bb; u32x2 w; w.x = pk2(o.x, o.y); w.y = pk2(o.z, o.w); *(u32x2*)(dst + c) = w; }
}

__device__ __forceinline__ bf16x8 ld_bcol8(const float* __restrict__ W, int ldn, int k0, int col) {
    float x[8];
#pragma unroll
    for (int j = 0; j < 8; ++j) x[j] = W[(size_t)(k0 + j) * ldn + col];
    u32x4 w; w.x = pk2(x[0], x[1]); w.y = pk2(x[2], x[3]); w.z = pk2(x[4], x[5]); w.w = pk2(x[6], x[7]);
    return __builtin_bit_cast(bf16x8, w);
}
__device__ __forceinline__ void p0_meta_block(const Frame& F, const Args& a, const int blk) {
    constexpr int RSH = 1032;
    LAS bf16_t* hm = (LAS bf16_t*)(F.lds);
    LAS float* pc = (LAS float*)(F.lds + 33280);
    const int lane = F.lane, w = F.wave, fr = lane & 15, fq = lane >> 4;
    const float* meta = a.in[1]; const float* g = a.in[2]; const float* b = a.in[3]; const float* w_in = a.in[4];
    float* UM = (float*)(F.ws + WS_UM);
#pragma unroll 1
    for (int rr = 0; rr < 2; ++rr) { const int row = 2 * w + rr; const float* src = meta + (size_t)row * DM;
        f32x4 v[4]; float s = 0.f;
#pragma unroll
        for (int j = 0; j < 4; ++j) { v[j] = *(const f32x4*)(src + j * 256 + lane * 4); s += (v[j].x + v[j].y) + (v[j].z + v[j].w); }
        const float mean = wave_sum(s) * (1.f / DM); float s2 = 0.f;
#pragma unroll
        for (int j = 0; j < 4; ++j) { v[j] = v[j] - mean; s2 += (v[j].x * v[j].x + v[j].y * v[j].y) + (v[j].z * v[j].z + v[j].w * v[j].w); }
        const float rstd = 1.f / sqrtf(wave_sum(s2) * (1.f / DM) + LN_EPS);
#pragma unroll
        for (int j = 0; j < 4; ++j) { const int c = j * 256 + lane * 4; const f32x4 gg = *(const f32x4*)(g + c), bb = *(const f32x4*)(b + c); const f32x4 o = v[j] * rstd * gg + bb;
            u32x2 pw; pw.x = pk2(o.x, o.y); pw.y = pk2(o.z, o.w); *(LAS u32x2*)(hm + row * RSH + c) = pw; } }
    __syncthreads();
    const int col = (blk < 16 ? 512 + 16 * blk : (blk < 32 ? 1024 + 16 * (blk - 16) : 1280 + 16 * (blk - 32))) + fr;
    bf16x8 bv[4];
#pragma unroll
    for (int s = 0; s < 4; ++s) bv[s] = ld_bcol8(w_in, INC, 32 * (4 * w + s) + 8 * fq, col);
    f32x4 c = {0.f, 0.f, 0.f, 0.f};
#pragma unroll
    for (int s = 0; s < 4; ++s) { const bf16x8 av = *(const LAS bf16x8*)(hm + fr * RSH + 32 * (4 * w + s) + 8 * fq); c = __builtin_amdgcn_mfma_f32_16x16x32_bf16(av, bv[s], c, 0, 0, 0); }
#pragma unroll
    for (int j = 0; j < 4; ++j) pc[w * 256 + (fq * 4 + j) * 16 + fr] = c[j];
    __syncthreads();
    if (F.tid < 256) { float sum = 0.f;
#pragma unroll
        for (int q = 0; q < 8; ++q) sum += pc[q * 256 + F.tid];
        const int oc = (blk < 16 ? 16 * blk : (blk < 32 ? 256 + 16 * (blk - 16) : 512 + 16 * (blk - 32))) + (F.tid & 15);
        UM[(F.tid >> 4) * 576 + oc] = sum; }
    __syncthreads();
}
__device__ __forceinline__ void p2_meta(const Frame& F, const Args& a, const int q) {
    const int lane = F.lane, w = F.wave, fr = lane & 15, fq = lane >> 4;
    const float* UM = (const float*)(F.ws + WS_UM); const float* gkv = a.in[8]; const float* w_ukv = a.in[9];
    bf16_t* KA = (bf16_t*)(F.ws + WS_KA); bf16_t* VA = (bf16_t*)(F.ws + WS_VA); bf16_t* KM = (bf16_t*)(F.ws + WS_KM); bf16_t* VM = (bf16_t*)(F.ws + WS_VM);
    if (q < 64) {
        LAS float* rs = (LAS float*)(F.lds); LAS float* pc = (LAS float*)(F.lds + 256);
#pragma unroll 1
        for (int rr = 0; rr < 2; ++rr) { const int row = 2 * w + rr; float ss = 0.f;
#pragma unroll
            for (int j = 0; j < 4; ++j) { const float v = UM[row * 576 + 256 + 64 * j + lane]; ss += v * v; }
            ss = wave_sum(ss); if (lane == 0) rs[row] = 1.f / sqrtf(ss * (1.f / 256.f) + RMS_EPS); }
        const bf16x8 bv = ld_bcol8(w_ukv, 1024, 32 * w + 8 * fq, 16 * q + fr);
        __syncthreads();
        float x[8]; const float r_ = rs[fr];
#pragma unroll
        for (int j = 0; j < 8; ++j) { const int k = 32 * w + 8 * fq + j; x[j] = UM[fr * 576 + 256 + k] * r_ * gkv[k]; }
        u32x4 aw; aw.x = pk2(x[0], x[1]); aw.y = pk2(x[2], x[3]); aw.z = pk2(x[4], x[5]); aw.w = pk2(x[6], x[7]);
        f32x4 c = {0.f, 0.f, 0.f, 0.f};
        c = __builtin_amdgcn_mfma_f32_16x16x32_bf16(__builtin_bit_cast(bf16x8, aw), bv, c, 0, 0, 0);
#pragma unroll
        for (int j = 0; j < 4; ++j) pc[w * 256 + (fq * 4 + j) * 16 + fr] = c[j];
        __syncthreads();
        if (F.tid < 256) { float sum = 0.f;
#pragma unroll
            for (int p = 0; p < 8; ++p) sum += pc[p * 256 + F.tid];
            const int r = F.tid >> 4, col = 16 * q + (F.tid & 15), h = col >> 8, cc = col & 255; const bf16_t hv = (bf16_t)f2bf(sum);
            for (int b2 = 0; b2 < NB; ++b2) { const size_t prow = (size_t)b2 * LP + NPAD + r;
                if (cc < 128) KM[prow * 768 + h * 192 + cc] = hv; else VM[prow * 512 + h * 128 + (cc - 128)] = hv; } }
        __syncthreads();
    } else {
        const int idx = (q - 64) * 256 + F.tid;
        if (F.tid < 256 && idx < 16 * 320) { const int r = idx / 320, c = idx % 320;
            const int oc = c < 256 ? c : c + 256; float v = UM[r * 576 + oc];
            if (c < 128 || c >= 256) { const float p = UM[r * 576 + (oc ^ 32)]; float cs, sn; rope_cs(r, c & 31, cs, sn); v = (c & 32) ? v * cs + p * sn : v * cs - p * sn; }
            const bf16_t hv = (bf16_t)f2bf(v);
            for (int b2 = 0; b2 < NB; ++b2) { const size_t prow = (size_t)b2 * LP + NPAD + r;
                if (c < 128) KA[prow * 128 + c] = hv; else if (c < 256) VA[prow * 128 + (c - 128)] = hv;
                else { const int cc = c - 256; KM[prow * 768 + 128 + cc] = hv; KM[prow * 768 + 192 + 128 + cc] = hv; KM[prow * 768 + 384 + 128 + cc] = hv; KM[prow * 768 + 576 + 128 + cc] = hv; } } }
    }
}

__device__ __forceinline__ void moe_wconv(LAS unsigned char* lds, unsigned char* ws, const float* wgate, const float* wup, const float* wdown, int wave, int lane, int widx, int nw) {
    LAS float* scr = (LAS float*)(lds + wave * 16384);
    constexpr int I_GU = 32 * 16 * 16, I_DN = 32 * 4 * 32;
    for (int it = widx; it < I_GU + I_DN; it += nw) {
        if (it < I_GU) { const int e = it / 256, r2 = it % 256, kb = r2 / 16, nb = r2 % 16; const int tile = nb >> 3, q = nb & 7;
            const float* src = (q < 4 ? wgate : wup) + (size_t)e * DM * 256;
            p0_tr_item(src, 256, 128 * tile + 32 * (q & 3), 64 * kb, (bf16_t*)(ws + WS_WGU) + ((size_t)e * 512 + 32 * nb) * DM, DM, nullptr, nullptr, scr, lane); }
        else { const int r = it - I_GU; const int e = r / 128, r2 = r % 128, kb = r2 / 32, nb = r2 % 32;
            p0_tr_item(wdown + (size_t)e * 256 * DM, DM, 32 * nb, 64 * kb, (bf16_t*)(ws + WS_WDN) + ((size_t)e * 1024 + 32 * nb) * 256, 256, nullptr, nullptr, scr, lane); }
    }
}
__device__ __forceinline__ void p0_prologue(const Frame& F, const Args& a) {
    for (int blk = F.bx; blk < 36; blk += F.G) p0_meta_block(F, a, blk);
    LAS float* scr = (LAS float*)(F.lds + F.wave * 16384);
    const int gw = F.bx * NWAVES + F.wave, NGW = F.G * NWAVES, lane = F.lane;
    unsigned char* ws = F.ws;
    constexpr int I_IN = 16 * 48, I_UQ = 4 * 24, I_UKV = 4 * 32, I_O = 16 * 32;
    constexpr int NITEMS = I_IN + I_UQ + I_UKV + I_O;
    for (int it = gw; it < NITEMS; it += NGW) {
        int r = it;
        if (r < I_IN) { const int kb = r / 48, nb = r % 48; p0_tr_item(a.in[4], INC, win_src_col(nb >> 3, nb & 7), 64 * kb, (bf16_t*)(ws + WS_WIN) + (size_t)(32 * nb) * DM, DM, nullptr, nullptr, scr, lane); continue; } r -= I_IN;
        if (r < I_UQ) { const int kb = r / 24, nb = r % 24; p0_tr_item(a.in[7], 768, wuq_src_col(nb >> 3, nb & 7), 64 * kb, (bf16_t*)(ws + WS_WUQ) + (size_t)(32 * nb) * 256, 256, a.in[6], nullptr, scr, lane); continue; } r -= I_UQ;
        if (r < I_UKV) { const int kb = r / 32, nb = r % 32; p0_tr_item(a.in[9], 1024, 32 * nb, 64 * kb, (bf16_t*)(ws + WS_WUKV) + (size_t)(32 * nb) * 256, 256, a.in[8], nullptr, scr, lane); continue; } r -= I_UKV;
        { const int kb = r / 32, nb = r % 32; p0_tr_item(a.in[12], DM, 32 * nb, 64 * kb, (bf16_t*)(ws + WS_WO) + (size_t)(32 * nb) * DM, DM, a.in[10], a.in[11], scr, lane); }
    }
    { float* COS = (float*)(ws + WS_COS); float* SIN = (float*)(ws + WS_SIN);
      for (int it = gw; it < NPOS * 32 / 64; it += NGW) { const int idx = it * 64 + lane; float c, s; rope_cs(idx >> 5, idx & 31, c, s); COS[idx] = c; SIN[idx] = s; } }
    for (int it = gw; it < NB * NPAD; it += NGW) { const size_t prow = (size_t)(it / NPAD) * LP + (it % NPAD);
        const u32x4 z = {0u, 0u, 0u, 0u};
        for (int o = lane * 16; o < 3072; o += 1024) {
            unsigned char* p;
            if (o < 256) p = ws + WS_KA + prow * 256 + o; else if (o < 512) p = ws + WS_VA + prow * 256 + (o - 512 + 256);
            else if (o < 2048) p = ws + WS_KM + prow * 1536 + (o - 512); else p = ws + WS_VM + prow * 1024 + (o - 2048);
            ST16(p, z); } }
    { const float* x = a.in[0]; const float* g = a.in[2]; const float* b = a.in[3]; bf16_t* H0 = (bf16_t*)(ws + WS_H0);
      for (int m = gw; m < T; m += 2 * NGW) {
        const int m2 = m + NGW; const bool two = m2 < T;
        f32x4 v[2][4]; float s[2] = {0.f, 0.f};
#pragma unroll
        for (int j = 0; j < 4; ++j) { v[0][j] = *(const f32x4*)(x + (size_t)m * DM + j * 256 + lane * 4); v[1][j] = two ? *(const f32x4*)(x + (size_t)m2 * DM + j * 256 + lane * 4) : (f32x4){0.f, 0.f, 0.f, 0.f}; }
#pragma unroll
        for (int q = 0; q < 2; ++q)
#pragma unroll
            for (int j = 0; j < 4; ++j) s[q] += (v[q][j].x + v[q][j].y) + (v[q][j].z + v[q][j].w);
#pragma unroll
        for (int q = 0; q < 2; ++q) { if (q == 1 && !two) break;
            const float mean = wave_sum(s[q]) * (1.f / DM); float s2 = 0.f;
#pragma unroll
            for (int j = 0; j < 4; ++j) { v[q][j] = v[q][j] - mean; s2 += (v[q][j].x * v[q][j].x + v[q][j].y * v[q][j].y) + (v[q][j].z * v[q][j].z + v[q][j].w * v[q][j].w); }
            const float rstd = 1.f / sqrtf(wave_sum(s2) * (1.f / DM) + LN_EPS);
            bf16_t* dstp = H0 + (size_t)(q ? m2 : m) * DM;
#pragma unroll
            for (int j = 0; j < 4; ++j) { const int c = j * 256 + lane * 4; const f32x4 gg = *(const f32x4*)(g + c), bb = *(const f32x4*)(b + c);
                const f32x4 o = v[q][j] * rstd * gg + bb; u32x2 w2; w2.x = pk2(o.x, o.y); w2.y = pk2(o.z, o.w); *(u32x2*)(dstp + c) = w2; } }
      } }
}

__device__ __forceinline__ void rope8(const f32x4 lo0, const f32x4 lo1, const f32x4 hi0, const f32x4 hi1, const float* __restrict__ cosr, const float* __restrict__ sinr, u32x4& olo, u32x4& ohi, float scale) {
    const f32x4 c0 = *(const f32x4*)cosr, c1 = *(const f32x4*)(cosr + 4), s0 = *(const f32x4*)sinr, s1 = *(const f32x4*)(sinr + 4);
    olo = pg8::pack8((lo0 * c0 - hi0 * s0) * scale, (lo1 * c1 - hi1 * s1) * scale);
    ohi = pg8::pack8((hi0 * c0 + lo0 * s0) * scale, (hi1 * c1 + lo1 * s1) * scale);
}
struct EpiInProj {
    static constexpr bool PERM = true, MIDK = false;
    unsigned char* ws;
    __device__ __forceinline__ void operator()(const f32x4 (&acc)[2][2][4][2], const pg8::Unit& u, int wr, int wc, int fr, int fq) const {
        const int pn = u.pn, bb = u.pm >> 5, t0 = (u.pm & 31) * 256 + wr * 64 + fr;
        const float* COS = (const float*)(ws + WS_COS); const float* SIN = (const float*)(ws + WS_SIN);
        const int j0 = 8 * fq;
#pragma unroll
        for (int ai = 0; ai < 2; ++ai)
#pragma unroll
            for (int m = 0; m < 4; ++m) {
                const int t = t0 + ai * 128 + m * 16; const size_t mrow = (size_t)bb * SEQ + t; const size_t prow = (size_t)bb * LP + 128 + t; const int pos = t + NMETA;
                const f32x4 a00 = acc[ai][0][m][0], a01 = acc[ai][0][m][1], a10 = acc[ai][1][m][0], a11 = acc[ai][1][m][1];
                if (pn <= 1) { u32x4 lo, hi; rope8(a00, a01, a10, a11, COS + pos * 32 + j0, SIN + pos * 32 + j0, lo, hi, 1.f);
                    bf16_t* q = (bf16_t*)(ws + WS_QA) + mrow * 512 + (4 * pn + wc) * 64 + j0; ST16(q, lo); ST16((q + 32), hi); }
                else if (pn == 2) {
                    if (wc < 2) { u32x4 lo, hi; rope8(a00, a01, a10, a11, COS + pos * 32 + j0, SIN + pos * 32 + j0, lo, hi, 1.f);
                        bf16_t* k = (bf16_t*)(ws + WS_KA) + prow * 128 + wc * 64 + j0; ST16(k, lo); ST16((k + 32), hi); }
                    else { bf16_t* v = (bf16_t*)(ws + WS_VA) + prow * 128 + 32 * (wc - 2) + j0; ST16(v, pg8::pack8(a00, a01)); ST16((v + 64), pg8::pack8(a10, a11)); } }
                else if (pn <= 4) {
                    bf16_t* c = (bf16_t*)(ws + (pn == 3 ? WS_CQ : WS_CKV)) + mrow * 256 + 32 * wc + j0; ST16(c, pg8::pack8(a00, a01)); ST16((c + 128), pg8::pack8(a10, a11));
                    const f32x4 q = a00 * a00 + a01 * a01 + a10 * a10 + a11 * a11; float s = (q[0] + q[1]) + (q[2] + q[3]);
                    s += __shfl_xor(s, 16); s += __shfl_xor(s, 32);
                    if (fq == 0) ((float*)(ws + (pn == 3 ? WS_CQS : WS_CKVS)))[mrow * 4 + wc] = s; }
                else { if (wc == 0) { u32x4 lo, hi; rope8(a00, a01, a10, a11, COS + pos * 32 + j0, SIN + pos * 32 + j0, lo, hi, 1.f);
                        bf16_t* k = (bf16_t*)(ws + WS_KM) + prow * 768 + 128 + j0;
#pragma unroll
                        for (int h = 0; h < 4; ++h) { ST16((k + h * 192), lo); ST16((k + h * 192 + 32), hi); } } }
            }
    }
};

struct UpOrder {
    const char* CQ; const char* CKV; const char* Wq; const char* Wkv; int G, c;
    __device__ bool next(int i, pg8::Unit& u) const {
        if (G % 8 == 0) { const int x = c & 7, slot = c >> 3, ns = G >> 3; const int j = i * ns + slot;
            if (j >= 112) return false;
            if (j < 48) { u.pm = x + 8 * (j / 3); u.pn = j % 3; } else { const int j2 = j - 48; u.pm = x + 8 * (j2 >> 2); u.pn = 3 + (j2 & 3); }
            return true; }
        int L = i * G + c; if (L >= 896) return false;
        if (L < 384) { u.pm = L / 3; u.pn = L % 3; } else { L -= 384; u.pm = L >> 2; u.pn = 3 + (L & 3); }
        return true;
    }
    __device__ __forceinline__ const char* abase(const pg8::Unit& u) const { return (u.pn < 3 ? CQ : CKV) + (size_t)u.pm * 256 * 256 * 2; }
    __device__ __forceinline__ const char* bbase(const pg8::Unit& u) const { return u.pn < 3 ? Wq + (size_t)u.pn * 256 * 256 * 2 : Wkv + (size_t)(u.pn - 3) * 256 * 256 * 2; }
    __device__ __forceinline__ unsigned arow_off(const pg8::Unit&, int R) const { return (unsigned)(R * 256) * 2u; }
};
struct EpiUp {
    static constexpr bool PERM = true, MIDK = false;
    unsigned char* ws;
    __device__ __forceinline__ void operator()(const f32x4 (&acc)[2][2][4][2], const pg8::Unit& u, int wr, int wc, int fr, int fq) const {
        const int pn = u.pn, bb = u.pm >> 5, tb = (u.pm & 31) * 256;
        const size_t m0 = (size_t)bb * SEQ + tb, p0 = (size_t)bb * LP + 128 + tb;
        const char* COSb = (const char*)(ws + WS_COS) + (size_t)(tb + NMETA) * 128; const char* SINb = (const char*)(ws + WS_SIN) + (size_t)(tb + NMETA) * 128;
        const char* SSb = (const char*)(ws + (pn < 3 ? WS_CQS : WS_CKVS)) + m0 * 16;
        char* QMb = (char*)(ws + WS_QM) + m0 * 1536; char* KMb = (char*)(ws + WS_KM) + p0 * 1536; char* VMb = (char*)(ws + WS_VM) + p0 * 1024;
        int rl = wr * 64 + fr; asm volatile("" : "+v"(rl));
        const int j0 = 8 * fq;
        f32x4 sv[8];
#pragma unroll
        for (int q = 0; q < 8; ++q) sv[q] = *(const f32x4*)(SSb + (size_t)((unsigned)(rl + (q >> 2) * 128 + (q & 3) * 16) * 16u));
#pragma unroll
        for (int ai = 0; ai < 2; ++ai)
#pragma unroll
            for (int m = 0; m < 4; ++m) {
                const unsigned r = (unsigned)(rl + ai * 128 + m * 16); const f32x4 s4 = sv[ai * 4 + m];
                const float rstd = 1.f / sqrtf(((s4[0] + s4[1]) + (s4[2] + s4[3])) * (1.f / 256.f) + RMS_EPS);
                const f32x4 a00 = acc[ai][0][m][0] * rstd, a01 = acc[ai][0][m][1] * rstd, a10 = acc[ai][1][m][0] * rstd, a11 = acc[ai][1][m][1] * rstd;
                if (pn < 2) { char* q = QMb + (size_t)(r * 1536u + (unsigned)(((2 * pn) * 192 + 32 * wc + j0) * 2)); ST16(q, pg8::pack8(a00, a01)); ST16((q + 384), pg8::pack8(a10, a11)); }
                else if (pn == 2) { u32x4 lo, hi; const unsigned co = r * 128u + (unsigned)(j0 * 4); rope8(a00, a01, a10, a11, (const float*)(COSb + (size_t)co), (const float*)(SINb + (size_t)co), lo, hi, 1.f);
                    char* q = QMb + (size_t)(r * 1536u + (unsigned)((wc * 192 + 128 + j0) * 2)); ST16(q, lo); ST16((q + 64), hi); }
                else { const int h = pn - 3;
                    ST16(KMb + (size_t)(r * 1536u + (unsigned)((h * 192 + 32 * wc + j0) * 2)), pg8::pack8(a00, a01));
                    ST16(VMb + (size_t)(r * 1024u + (unsigned)((h * 128 + 32 * wc + j0) * 2)), pg8::pack8(a10, a11)); }
            }
    }
};

#ifndef ATT_PIPE
#define ATT_PIPE 0
#endif
#ifndef ATT_QKT_PF
#define ATT_QKT_PF 3
#endif
#ifndef ATT_QKT_GROUP
#define ATT_QKT_GROUP 0
#endif
#ifndef ATT_PF0
#define ATT_PF0 4
#endif
#ifndef ATT_HALF
#define ATT_HALF 0
#endif
#ifndef ATT_SKEW_SWA
#define ATT_SKEW_SWA 0
#endif
#ifndef ATT_SKEW
#define ATT_SKEW 1
#endif
namespace att {
typedef short s16x4 __attribute__((ext_vector_type(4)));
typedef float f32x16 __attribute__((ext_vector_type(16)));
constexpr int NW = 8, QBLK = 32, KVBLK = 64, QB = NW * QBLK;
#define SBAR() __builtin_amdgcn_sched_barrier(0)
__device__ __forceinline__ int crow(int r, int hi) { return (r & 3) + 8 * (r >> 2) + 4 * hi; }
typedef float f32x2_t __attribute__((ext_vector_type(2))); typedef __bf16 bf16x2_t __attribute__((ext_vector_type(2)));
__device__ __forceinline__ unsigned cvtpk(float lo, float hi) { const f32x2_t v = {lo, hi}; const bf16x2_t b = __builtin_convertvector(v, bf16x2_t); return __builtin_bit_cast(unsigned, b); }
__device__ __forceinline__ int v_rd_base(int lane) { return ((lane & 3) << 3) | (((lane >> 2) & 3) << 6) | (((lane >> 4) & 1) << 5) | (((lane >> 5) & 1) << 8); }

template <int DQK_, int DV_, int LDQ_, int LDK_, int LDV_, int W_, bool SK_, int NPARK_>
struct Cfg {
    static constexpr int DQK = DQK_, DV = DV_, LDQ = LDQ_, LDK = LDK_, LDV = LDV_, W = W_; static constexpr bool SK = SK_;
    static constexpr int ROWB = DQK * 2, SHM_K = KVBLK * ROWB, SHM_V = KVBLK * DV * 2;
    static constexpr int KCPR = DQK / 8, VCPR = DV / 8, NKC = KVBLK * KCPR / 512, NVC = KVBLK * VCPR / 512, KG = (DV / 32) * 512, NQF = DQK / 16, NOF = DV / 32;
    static constexpr int NPARK = NPARK_, NQR = DQK_ / 16 - NPARK_;
    static constexpr int WS_OFF = 2 * SHM_V + 2 * SHM_K, PARK_OFF = WS_OFF + NW * 64 * 4, LDS_BYTES = PARK_OFF + NW * NPARK_ * 1024;
};
template <class C> struct BlockRef { const bf16_t* Q; const bf16_t* K; const bf16_t* V; bf16_t* O; float* SSQ; int P0; float m0, l0, c2; };
template <class C> struct Seam { bf16x8 qr[C::NQR]; bf16x8 st_k[C::NKC]; bf16x8 st_v[C::NVC]; };

__device__ __forceinline__ void mask_tile(f32x16& p0, f32x16& p1, int dq, unsigned W, int klim) {
    const float NEG = -__builtin_inff();
#pragma unroll
    for (int r = 0; r < 16; ++r) {
        const int c = (r & 3) + 8 * (r >> 2);
        if ((unsigned)(dq - c) >= W || c < klim) p0[r] = NEG;
        if ((unsigned)(dq - c - 32) >= W || c + 32 < klim) p1[r] = NEG;
    }
}
__device__ __forceinline__ void partialSM(f32x16& p0, f32x16& p1, float& m_reg, float& mn, float& alpha, float c2, float thr) {
    float pmax = p0[0];
#pragma unroll
    for (int r = 1; r < 16; ++r) pmax = fmaxf(pmax, p0[r]);
#pragma unroll
    for (int r = 0; r < 16; ++r) pmax = fmaxf(pmax, p1[r]);
    { auto rr = __builtin_amdgcn_permlane32_swap(__float_as_uint(pmax), __float_as_uint(pmax), false, false);
      pmax = fmaxf(__uint_as_float(rr[0]), __uint_as_float(rr[1])); }
    if (__builtin_expect(__all((pmax - m_reg) <= thr), 1)) { mn = m_reg; alpha = 1.f; }
    else { mn = fmaxf(m_reg, pmax); alpha = __builtin_amdgcn_exp2f((m_reg - mn) * c2); m_reg = mn; }
    const float mnL = -mn * c2;
#pragma unroll
    for (int r = 0; r < 16; ++r) p0[r] = fmaf(p0[r], c2, mnL);
#pragma unroll
    for (int r = 0; r < 16; ++r) p1[r] = fmaf(p1[r], c2, mnL);
#pragma unroll
    for (int r = 0; r < 16; ++r) p0[r] = __builtin_amdgcn_exp2f(p0[r]);
}
__device__ __forceinline__ void finishSM(f32x16& p0, f32x16& p1, float alpha, float& l_reg, bf16x8& pa0, bf16x8& pa1, bf16x8& pa2, bf16x8& pa3) {
#pragma unroll
    for (int r = 0; r < 16; ++r) p1[r] = __builtin_amdgcn_exp2f(p1[r]);
    float ps = 0;
#pragma unroll
    for (int r = 0; r < 16; ++r) ps += p0[r];
#pragma unroll
    for (int r = 0; r < 16; ++r) ps += p1[r];
    { auto rr = __builtin_amdgcn_permlane32_swap(__float_as_uint(ps), __float_as_uint(ps), false, false);
      ps = __uint_as_float(rr[0]) + __uint_as_float(rr[1]); }
    l_reg = l_reg * alpha + ps;
#define PK4(P, B_, OUT) do { unsigned a0 = cvtpk(P[B_+0], P[B_+1]), a1 = cvtpk(P[B_+2], P[B_+3]);                          \
        unsigned b0 = cvtpk(P[B_+4], P[B_+5]), b1 = cvtpk(P[B_+6], P[B_+7]);                                             \
        auto r0 = __builtin_amdgcn_permlane32_swap(a0, b0, false, false); auto r1 = __builtin_amdgcn_permlane32_swap(a1, b1, false, false); \
        u32x4 w = {r0[0], r1[0], r0[1], r1[1]}; OUT = *reinterpret_cast<bf16x8*>(&w); } while (0)
    PK4(p0, 0, pa0); PK4(p0, 8, pa1); PK4(p1, 0, pa2); PK4(p1, 8, pa3);
#undef PK4
}
template <class C, int D0, int PF> struct QktSched { static __device__ __forceinline__ void run() {
    __builtin_amdgcn_sched_group_barrier(0x008, 2, 0);
    if constexpr (D0 + PF < C::NQF) __builtin_amdgcn_sched_group_barrier(0x100, 2 + ((D0 + PF >= C::NQR) ? 1 : 0), 0);
    if constexpr (D0 + 1 < C::NQF) QktSched<C, D0 + 1, PF>::run(); } };
template <class C, int KB>
__device__ __forceinline__ void qkt(f32x16& p0, f32x16& p1, const char* K_lds, int r32, int hi, const bf16x8* qr, const char* qpark, bool act) {
    if (C::SK && !act) { const float NEG = -__builtin_inff();
#pragma unroll
        for (int r = 0; r < 16; ++r) { p0[r] = NEG; p1[r] = NEG; } return; }
    p0 = f32x16{}; p1 = f32x16{};
    const char* kb[4];
#pragma unroll
    for (int dd = 0; dd < 4; ++dd) kb[dd] = K_lds + KB * C::SHM_K + r32 * C::ROWB + (((dd * 16 + hi * 8) * 2) ^ (((r32 >> 1) & 7) << 4));
#pragma unroll
    for (int d0 = 0; d0 < C::NQF; ++d0) { const char* a = kb[d0 & 3] + (d0 >> 2) * 128;
        bf16x8 b0 = *reinterpret_cast<const bf16x8*>(a);
        bf16x8 b1 = *reinterpret_cast<const bf16x8*>(a + 32 * C::ROWB);
        bf16x8 qf; if (d0 < C::NQR) qf = qr[d0 < C::NQR ? d0 : 0]; else qf = *reinterpret_cast<const bf16x8*>(qpark + (d0 - C::NQR) * 1024);
        p0 = __builtin_amdgcn_mfma_f32_32x32x16_bf16(b0, qf, p0, 0, 0, 0);
        p1 = __builtin_amdgcn_mfma_f32_32x32x16_bf16(b1, qf, p1, 0, 0, 0);
        if (ATT_QKT_GROUP && C::NQF > 8 && (d0 & 3) == 3) SBAR(); }
#if ATT_QKT_PF > 0
    { constexpr int PF = ATT_QKT_PF < C::NQF ? ATT_QKT_PF : C::NQF;
      __builtin_amdgcn_sched_group_barrier(0x100, 2 * PF + ((PF > C::NQR) ? (PF - C::NQR) : 0), 0);
      QktSched<C, 0, PF>::run(); }
#endif
}
template <class C, int D0, int PF> struct QktSchedD { static __device__ __forceinline__ void run() {
    __builtin_amdgcn_sched_group_barrier(0x008, 1, 0); __builtin_amdgcn_sched_group_barrier(0x400, 2, 0); __builtin_amdgcn_sched_group_barrier(0x002, 3, 0);
    __builtin_amdgcn_sched_group_barrier(0x008, 1, 0); __builtin_amdgcn_sched_group_barrier(0x400, 1, 0); __builtin_amdgcn_sched_group_barrier(0x002, 3, 0);
    if constexpr (D0 + PF < C::NQF) __builtin_amdgcn_sched_group_barrier(0x100, 2 + ((D0 + PF >= C::NQR) ? 1 : 0), 0);
    if constexpr (D0 + 1 < C::NQF) QktSchedD<C, D0 + 1, PF>::run(); } };
template <class C, int KB>
__device__ __forceinline__ void qkt_dummy(f32x16& p0, f32x16& p1, const char* K_lds, int r32, int hi, const bf16x8* qr, const char* qpark, f32x4& dmy) {
    p0 = f32x16{}; p1 = f32x16{};
    const char* kb[4];
#pragma unroll
    for (int dd = 0; dd < 4; ++dd) kb[dd] = K_lds + KB * C::SHM_K + r32 * C::ROWB + (((dd * 16 + hi * 8) * 2) ^ (((r32 >> 1) & 7) << 4));
    f32x4 d2 = dmy;
#pragma unroll
    for (int d0 = 0; d0 < C::NQF; ++d0) { const char* a = kb[d0 & 3] + (d0 >> 2) * 128;
        bf16x8 b0 = *reinterpret_cast<const bf16x8*>(a);
        bf16x8 b1 = *reinterpret_cast<const bf16x8*>(a + 32 * C::ROWB);
        bf16x8 qf; if (d0 < C::NQR) qf = qr[d0 < C::NQR ? d0 : 0]; else qf = *reinterpret_cast<const bf16x8*>(qpark + (d0 - C::NQR) * 1024);
        p0 = __builtin_amdgcn_mfma_f32_32x32x16_bf16(b0, qf, p0, 0, 0, 0);
        p1 = __builtin_amdgcn_mfma_f32_32x32x16_bf16(b1, qf, p1, 0, 0, 0);
#pragma unroll
        for (int e = 0; e < 3; ++e) { const int i = (d0 * 3 + e) & 3; d2[i] = __builtin_amdgcn_exp2f(d2[i]); d2[(i + 1) & 3] = fmaf(d2[(i + 1) & 3], 1.0001f, d2[i]); d2[(i + 2) & 3] = fmaf(d2[(i + 2) & 3], 0.9999f, d2[i]); }
    }
    dmy = d2;
    { __builtin_amdgcn_sched_group_barrier(0x100, 6 + ((3 > C::NQR) ? (3 - C::NQR) : 0), 0);
      QktSchedD<C, 0, 3>::run(); }
}
template <class C, int VB>
__device__ __forceinline__ void pv_tile(f32x16* o, int vb0, bf16x8 pa0, bf16x8 pa1, bf16x8 pa2, bf16x8 pa3, bool act) {
    if (C::SK && !act) return;
#define TRRD(dst, off) asm volatile("ds_read_b64_tr_b16 %0, %1 offset:%2" : "=&v"(dst) : "v"(vb0), "i"(off) : "memory")
#define PV_RD(S_, d0) do { constexpr int b_ = VB * C::SHM_V + (d0) * 512; constexpr int KG_ = C::KG;   \
        TRRD(l0##S_, b_); TRRD(h0##S_, b_ + KG_); TRRD(l1##S_, b_ + 2 * KG_); TRRD(h1##S_, b_ + 3 * KG_); TRRD(l2##S_, b_ + 4 * KG_); TRRD(h2##S_, b_ + 5 * KG_); TRRD(l3##S_, b_ + 6 * KG_); TRRD(h3##S_, b_ + 7 * KG_); } while (0)
#define PV_MM(S_, d0) do {   \
        o[d0] = __builtin_amdgcn_mfma_f32_32x32x16_bf16(pa0, (bf16x8){l0##S_[0], l0##S_[1], l0##S_[2], l0##S_[3], h0##S_[0], h0##S_[1], h0##S_[2], h0##S_[3]}, o[d0], 0, 0, 0);   \
        o[d0] = __builtin_amdgcn_mfma_f32_32x32x16_bf16(pa1, (bf16x8){l1##S_[0], l1##S_[1], l1##S_[2], l1##S_[3], h1##S_[0], h1##S_[1], h1##S_[2], h1##S_[3]}, o[d0], 0, 0, 0);   \
        o[d0] = __builtin_amdgcn_mfma_f32_32x32x16_bf16(pa2, (bf16x8){l2##S_[0], l2##S_[1], l2##S_[2], l2##S_[3], h2##S_[0], h2##S_[1], h2##S_[2], h2##S_[3]}, o[d0], 0, 0, 0);   \
        o[d0] = __builtin_amdgcn_mfma_f32_32x32x16_bf16(pa3, (bf16x8){l3##S_[0], l3##S_[1], l3##S_[2], l3##S_[3], h3##S_[0], h3##S_[1], h3##S_[2], h3##S_[3]}, o[d0], 0, 0, 0); } while (0)
#define PV_W8() do { asm volatile("s_waitcnt lgkmcnt(8)" ::: "memory"); SBAR(); } while (0)
#define PV_W0() do { asm volatile("s_waitcnt lgkmcnt(0)" ::: "memory"); SBAR(); } while (0)
    s16x4 l0A, l1A, l2A, l3A, h0A, h1A, h2A, h3A, l0B, l1B, l2B, l3B, h0B, h1B, h2B, h3B;
    SBAR(); asm volatile("s_waitcnt lgkmcnt(0)" ::: "memory");
    PV_RD(A, 0); PV_RD(B, 1); PV_W8(); PV_MM(A, 0); SBAR();
    if constexpr (C::NOF == 4) { PV_RD(A, 2); PV_W8(); PV_MM(B, 1); SBAR(); PV_RD(B, 3); PV_W8(); PV_MM(A, 2); SBAR(); PV_W0(); PV_MM(B, 3); }
    else { PV_W0(); PV_MM(B, 1); }
    SBAR();
#undef PV_RD
#undef PV_MM
#undef PV_W8
#undef PV_W0
#undef TRRD
}
template <class C> __device__ __forceinline__ int jlo(int P0) { const int lowk = P0 - C::W + 1; int j = lowk > 0 ? lowk / KVBLK : 0; const int jm = NPAD / KVBLK; return j < jm ? jm : j; }

#define AT_RSRC(p) __builtin_amdgcn_make_buffer_rsrc((void*)(p), 0, 0x7fffffff, 0x00020000)
#define AT_BLD(rs, vo, so) __builtin_bit_cast(bf16x8, __builtin_amdgcn_raw_buffer_load_b128((rs), (int)(vo), (int)(so), 0))
#define AT_SLOAD(Kp, Vp, k0) do { const __amdgpu_buffer_rsrc_t kr__ = AT_RSRC(Kp), vr__ = AT_RSRC(Vp); const int ks__ = (k0) * (C::LDK * 2), vs__ = (k0) * (C::LDV * 2); \
    _Pragma("unroll") for (int i_ = 0; i_ < C::NVC; ++i_) S.st_v[i_] = AT_BLD(vr__, vgo + (unsigned)(i_ * 128), vs__); \
    _Pragma("unroll") for (int i_ = 0; i_ < C::NKC; ++i_) S.st_k[i_] = AT_BLD(kr__, kgo + (unsigned)(i_ * 128), ks__); } while (0)
#define AT_LOAD_K(Kp, k0) do { const __amdgpu_buffer_rsrc_t kr__ = AT_RSRC(Kp); const int ks__ = (k0) * (C::LDK * 2); \
    _Pragma("unroll") for (int i_ = 0; i_ < C::NKC; ++i_) S.st_k[i_] = AT_BLD(kr__, kgo + (unsigned)(i_ * 128), ks__); } while (0)
#define AT_LOAD_V(Vp, k0) do { const __amdgpu_buffer_rsrc_t vr__ = AT_RSRC(Vp); const int vs__ = (k0) * (C::LDV * 2); \
    _Pragma("unroll") for (int i_ = 0; i_ < C::NVC; ++i_) S.st_v[i_] = AT_BLD(vr__, vgo + (unsigned)(i_ * 128), vs__); } while (0)
#define AT_SWRITE_K(bf) do { _Pragma("unroll") for (int i_ = 0; i_ < C::NKC; ++i_) *(bf16x8*)(K_lds + (bf) * C::SHM_K + klo + i_ * 128) = S.st_k[i_]; } while (0)
#define AT_SWRITE_V(bf) do { _Pragma("unroll") for (int i_ = 0; i_ < C::NVC; ++i_) *(bf16x8*)(V_lds + (bf) * C::SHM_V + vlo + i_ * 1024) = S.st_v[i_]; } while (0)
#define AT_STAGE_OFFS() \
    const int srow_ = tid >> 3, scc_ = tid & 7; \
    const unsigned kgo = (unsigned)(srow_ * C::LDK + scc_ * 8) * 2u, vgo = (unsigned)(srow_ * C::LDV + scc_ * 8) * 2u; \
    const int klo = srow_ * C::ROWB + ((scc_ * 16) ^ (((srow_ >> 1) & 7) << 4)); \
    const int skk_ = (srow_ & ~0xC) | ((srow_ & 4) << 1) | ((srow_ & 8) >> 1); \
    const int vlo = ((skk_ >> 3) * C::NOF + (scc_ >> 2)) * 512 + ((skk_ & 7) * 32 + (scc_ & 3) * 8) * 2;
#define AT_VMW() asm volatile("s_waitcnt vmcnt(0)" ::: "memory")
#define AT_VMWN(n) asm volatile("s_waitcnt vmcnt(%0)" :: "i"(n) : "memory")

#define AT_QLOAD(Qp) do { bf16x8 qp_[C::NPARK > 0 ? C::NPARK : 1]; \
    const __amdgpu_buffer_rsrc_t qr__ = AT_RSRC(Qp); const int qs__ = wid * (QBLK * C::LDQ * 2); const unsigned qo__ = (unsigned)(r32 * C::LDQ + hi * 8) * 2u; \
    _Pragma("unroll") for (int d0 = 0; d0 < C::NPARK; ++d0) qp_[d0] = AT_BLD(qr__, qo__ + (unsigned)((C::NQR + d0) * 32), qs__); \
    _Pragma("unroll") for (int d0 = 0; d0 < C::NQR; ++d0) S.qr[d0] = AT_BLD(qr__, qo__ + (unsigned)(d0 * 32), qs__); \
    SBAR(); AT_VMWN(C::NQR); \
    _Pragma("unroll") for (int d0 = 0; d0 < C::NPARK; ++d0) *(bf16x8*)(qpark + d0 * 1024) = qp_[d0]; } while (0)
template <class C>
__device__ __forceinline__ void prime(const BlockRef<C>& cur, char* lds, Seam<C>& S, const int tid) {
    const int wid = __builtin_amdgcn_readfirstlane(tid >> 6), lane = tid & 63, r32 = lane & 31, hi = lane >> 5;
    char* K_lds = lds + 2 * C::SHM_V;
    AT_STAGE_OFFS()
    const int kb0 = jlo<C>(cur.P0) * KVBLK;
    char* qpark = lds + C::PARK_OFF + wid * (C::NPARK * 1024) + lane * 16;
    AT_SLOAD(cur.K, cur.V, kb0); SBAR(); AT_QLOAD(cur.Q); AT_VMW(); AT_SWRITE_K(0);
    __syncthreads();
}
template <class C>
__device__ __forceinline__ void block(const BlockRef<C>& cur, const BlockRef<C>& nxt, char* lds, Seam<C>& S, int ssq_slot, const int tid) {
    constexpr bool SK = C::SK; constexpr int W = C::W;
    const int wid = __builtin_amdgcn_readfirstlane(tid >> 6), lane = tid & 63, r32 = lane & 31, hi = lane >> 5;
    const int j_lo = jlo<C>(cur.P0);
    const int j_hi = (cur.P0 + QB - 1) / KVBLK + 1;
    const int NT = j_hi - j_lo;
    const int kbn = jlo<C>(nxt.P0) * KVBLK;
    const int qlo = cur.P0 + wid * QBLK, qm = qlo + r32 - 4 * hi;
    char* V_lds = lds; char* K_lds = lds + 2 * C::SHM_V;
    AT_STAGE_OFFS()
    float* ws = (float*)(lds + C::WS_OFF) + wid * 64; float* li_l = ws, * al_l = ws + 32;
    char* qpark = lds + C::PARK_OFF + wid * (C::NPARK * 1024) + lane * 16;
    float m_reg = cur.m0, l_reg = cur.l0; const float c2 = cur.c2, thr = 8.f * 1.4426950408889634f / c2;
    f32x16 o[C::NOF];
#pragma unroll
    for (int d_ = 0; d_ < C::NOF; ++d_) o[d_] = f32x16{};
    const int vb0 = (int)(uintptr_t)V_lds + v_rd_base(lane);
    const bf16_t* Kh = cur.K; const bf16_t* Vh = cur.V;
#define RESC(a) do { if (__any((a) < 1.f)) { if (hi == 0) al_l[r32] = (a); asm volatile("s_waitcnt lgkmcnt(0)" ::: "memory");              \
                     _Pragma("unroll") for (int d_ = 0; d_ < C::NOF; ++d_) _Pragma("unroll") for (int r = 0; r < 16; ++r) o[d_][r] *= al_l[crow(r, hi)]; } } while (0)
#define KBASE(t) ((j_lo + (t)) * KVBLK)
#define ACT(t) (KBASE(t) <= qlo + QBLK - 1 && KBASE(t) + KVBLK - 1 >= qlo - W + 1)
#define MASKT(P0_, P1_, t) do { const int kb_ = KBASE(t); if ((!SK || ACT(t)) && (kb_ + KVBLK - 1 > qlo || kb_ <= qlo + QBLK - 1 - W || kb_ < NPAD)) mask_tile(P0_, P1_, qm - kb_, (unsigned)W, NPAD - kb_ - 4 * hi); } while (0)
#if ATT_PIPE
    f32x16 pA0, pA1, pB0, pB1; float mnA, mnB, alA, alB; bf16x8 pa0, pa1, pa2, pa3;
    AT_SWRITE_V(0); SBAR();
    if (NT > 1) { AT_SLOAD(Kh, Vh, KBASE(1)); }
    SBAR(); qkt<C, 0>(pA0, pA1, K_lds, r32, hi, S.qr, qpark, ACT(0));
    MASKT(pA0, pA1, 0); partialSM(pA0, pA1, m_reg, mnA, alA, c2, thr);
    if (NT > 1) { AT_VMW(); AT_SWRITE_V(1); AT_SWRITE_K(1); }
    __syncthreads();
#define HALF_STEP(PX0, PX1, mnX, alX, PY0, PY1, alY, t, KB, VB, SB) do {                                                      \
        SBAR(); qkt<C, KB>(PX0, PX1, K_lds, r32, hi, S.qr, qpark, ACT(t));                                                  \
        finishSM(PY0, PY1, alY, l_reg, pa0, pa1, pa2, pa3); SBAR();                                                           \
        if ((t) + 1 < NT) { AT_SLOAD(Kh, Vh, KBASE((t) + 1)); SBAR(); }                                               \
        pv_tile<C, VB>(o, vb0, pa0, pa1, pa2, pa3, ACT((t) - 1)); MASKT(PX0, PX1, (t)); partialSM(PX0, PX1, m_reg, mnX, alX, c2, thr);       \
        __syncthreads();                                                                                                      \
        if ((t) + 1 < NT) { AT_VMW(); if (SB) { AT_SWRITE_V(1); AT_SWRITE_K(1); } else { AT_SWRITE_V(0); AT_SWRITE_K(0); } }                                                                          \
        RESC(alX); __syncthreads(); } while (0)
    for (int t = 1; t + 1 < NT; t += 2) {
        HALF_STEP(pB0, pB1, mnB, alB, pA0, pA1, alA, t, 1, 0, 0);
        HALF_STEP(pA0, pA1, mnA, alA, pB0, pB1, alB, t + 1, 0, 1, 1);
    }
#undef HALF_STEP
    const bool even = (NT & 1) == 0;
    if (even) { SBAR(); qkt<C, 1>(pB0, pB1, K_lds, r32, hi, S.qr, qpark, ACT(NT - 1)); SBAR(); }
    AT_SLOAD(nxt.K, nxt.V, kbn); SBAR();
    finishSM(pA0, pA1, alA, l_reg, pa0, pa1, pa2, pa3); SBAR();
    pv_tile<C, 0>(o, vb0, pa0, pa1, pa2, pa3, ACT(even ? NT - 2 : NT - 1));
    if (even) { MASKT(pB0, pB1, NT - 1); partialSM(pB0, pB1, m_reg, mnB, alB, c2, thr); __syncthreads(); RESC(alB);
        finishSM(pB0, pB1, alB, l_reg, pa0, pa1, pa2, pa3); SBAR(); pv_tile<C, 1>(o, vb0, pa0, pa1, pa2, pa3, ACT(NT - 1)); }
    SBAR();
    AT_QLOAD(nxt.Q);
    AT_SWRITE_K(0); SBAR();
#else
    f32x16 P0, P1; float mn, al; bf16x8 pa0, pa1, pa2, pa3;
    AT_SWRITE_V(0); __syncthreads();
#define STEP(t, B_, NB_) do { const bool more_ = (t) + 1 < NT;                                                              \
        SBAR(); if (more_) { AT_SLOAD(Kh, Vh, KBASE((t) + 1)); } else { AT_SLOAD(nxt.K, nxt.V, kbn); } SBAR();              \
        qkt<C, B_>(P0, P1, K_lds, r32, hi, S.qr, qpark, ACT(t)); SBAR();                                                   \
        MASKT(P0, P1, (t)); partialSM(P0, P1, m_reg, mn, al, c2, thr); RESC(al);                                            \
        finishSM(P0, P1, al, l_reg, pa0, pa1, pa2, pa3); SBAR();                                                             \
        pv_tile<C, B_>(o, vb0, pa0, pa1, pa2, pa3, ACT(t)); SBAR();                                                        \
        if (more_) { AT_VMW(); AT_SWRITE_V(NB_); AT_SWRITE_K(NB_); }                                                        \
        __syncthreads(); } while (0)
    int t = 0;
    for (; t + 1 < NT; t += 2) { STEP(t, 0, 1); STEP(t + 1, 1, 0); }
    if (t < NT) { STEP(t, 0, 1); }
#undef STEP
    AT_QLOAD(nxt.Q);
    AT_SWRITE_K(0); SBAR();
#endif
    if (hi == 0) li_l[r32] = l_reg; asm volatile("s_waitcnt lgkmcnt(0)" ::: "memory");
    float rli[16], sq[16];
#pragma unroll
    for (int r = 0; r < 16; ++r) { rli[r] = __builtin_amdgcn_rcpf(li_l[crow(r, hi)]); sq[r] = 0.f; }
    char* Ow = (char*)(cur.O + (size_t)(wid * QBLK) * 1024); const unsigned oo = (unsigned)(4 * hi * 1024 + r32) * 2u;
#pragma unroll
    for (int r = 0; r < 16; ++r) {
#pragma unroll
        for (int d0 = 0; d0 < C::NOF; ++d0) { const float v = o[d0][r] * rli[r]; sq[r] += v * v;
            const float vn = __shfl_xor(v, 1);
            if ((r32 & 1) == 0) *(unsigned*)(Ow + (size_t)(oo + (unsigned)((((r & 3) + 8 * (r >> 2)) * 1024 + d0 * 32) * 2))) = cvtpk(v, vn); } }
    float sel = 0.f; int r32e = r32, hie = hi; asm volatile("" : "+v"(r32e), "+v"(hie));
#pragma unroll
    for (int r = 0; r < 16; ++r) { float s = sq[r]; s += __shfl_xor(s, 1); s += __shfl_xor(s, 2); s += __shfl_xor(s, 4); s += __shfl_xor(s, 8); s += __shfl_xor(s, 16); sel = (r32e == r) ? s : sel; }
    if (r32e < 16) *(float*)((char*)(cur.SSQ + (size_t)(wid * QBLK) * 12 + ssq_slot) + (size_t)((unsigned)crow(r32e, hie) * 48u)) = sel;
    __syncthreads();
#undef RESC
#undef KBASE
#undef ACT
#undef MASKT
}

template <class C, int XP = 0>
__device__ __forceinline__ void block2(const BlockRef<C>& cur, char* lds, Seam<C>& S, int ssq_slot, const int tid) {
    constexpr bool SK = C::SK; constexpr int W = C::W;
    const int wid = __builtin_amdgcn_readfirstlane(tid >> 6), lane = tid & 63, r32 = lane & 31, hi = lane >> 5, g = wid >> 2;
    const int j_lo = jlo<C>(cur.P0);
    const int j_hi = (cur.P0 + QB - 1) / KVBLK + 1;
    const int NT = j_hi - j_lo;
    const int qlo = cur.P0 + wid * QBLK, qm = qlo + r32 - 4 * hi;
    char* V_lds = lds; char* K_lds = lds + 2 * C::SHM_V;
    AT_STAGE_OFFS()
    float* ws = (float*)(lds + C::WS_OFF) + wid * 64; float* li_l = ws, * al_l = ws + 32;
    char* qpark = lds + C::PARK_OFF + wid * (C::NPARK * 1024) + lane * 16;
    float m_reg = cur.m0, l_reg = cur.l0; const float c2 = cur.c2, thr = 8.f * 1.4426950408889634f / c2;
    f32x16 o[C::NOF];
#pragma unroll
    for (int d_ = 0; d_ < C::NOF; ++d_) o[d_] = f32x16{};
    const int vb0 = (int)(uintptr_t)V_lds + v_rd_base(lane);
    const bf16_t* Kh = cur.K; const bf16_t* Vh = cur.V;
#define RESC(a) do { if (__any((a) < 1.f)) { if (hi == 0) al_l[r32] = (a); asm volatile("s_waitcnt lgkmcnt(0)" ::: "memory");              \
                     _Pragma("unroll") for (int d_ = 0; d_ < C::NOF; ++d_) _Pragma("unroll") for (int r = 0; r < 16; ++r) o[d_][r] *= al_l[crow(r, hi)]; } } while (0)
#define KBASE(t) ((j_lo + (t)) * KVBLK)
#define ACT(t) (KBASE(t) <= qlo + QBLK - 1 && KBASE(t) + KVBLK - 1 >= qlo - W + 1)
#define MASKT(P0_, P1_, t) do { const int kb_ = KBASE(t); if ((!SK || ACT(t)) && (kb_ + KVBLK - 1 > qlo || kb_ <= qlo + QBLK - 1 - W || kb_ < NPAD)) mask_tile(P0_, P1_, qm - kb_, (unsigned)W, NPAD - kb_ - 4 * hi); } while (0)
#define BAR2() asm volatile("s_waitcnt lgkmcnt(0)\n\ts_barrier" ::: "memory")
#define LOADPAIR(tau) do { const int tau_ = (tau); if (tau_ < NT) { AT_LOAD_V(Vh, KBASE(tau_)); } if (tau_ + 1 < NT) { AT_LOAD_K(Kh, KBASE(tau_ + 1)); } } while (0)
#define WRITEPAIR(tau) do { const int tau_ = (tau); if (tau_ < NT) { AT_VMW(); AT_SWRITE_V(tau_ & 1); if (tau_ + 1 < NT) { AT_SWRITE_K((tau_ + 1) & 1); } } } while (0)
    AT_QLOAD(cur.Q);
    AT_LOAD_K(Kh, KBASE(0)); AT_VMW(); AT_SWRITE_K(0);
    if (g == 1) { AT_LOAD_V(Vh, KBASE(0)); AT_LOAD_K(Kh, KBASE(1)); AT_VMW(); AT_SWRITE_V(0); AT_SWRITE_K(1); }
    LOADPAIR(g);
    BAR2();
    if (g == 1) BAR2();
    f32x4 dmy = {0.f, 0.f, 0.f, 0.f}; asm volatile("" : "+v"(dmy));
    f32x16 P0 = f32x16{}, P1 = f32x16{}; float mn, al = 1.f; bf16x8 pa0 = bf16x8{}, pa1 = bf16x8{}, pa2 = bf16x8{}, pa3 = bf16x8{};
    qkt<C, 0>(P0, P1, K_lds, r32, hi, S.qr, qpark, ACT(0)); BAR2();
#define SSTAGE(t) do { if (XP != 1 && XP != 4) { MASKT(P0, P1, (t)); partialSM(P0, P1, m_reg, mn, al, c2, thr); RESC(al); finishSM(P0, P1, al, l_reg, pa0, pa1, pa2, pa3); } SBAR();   \
        if (XP != 2) { WRITEPAIR((t) + g); LOADPAIR((t) + g + 1); } BAR2(); } while (0)
#define MSTAGE(t, VB_, KB_) do { if (XP != 3) { pv_tile<C, VB_>(o, vb0, pa0, pa1, pa2, pa3, ACT(t)); SBAR();                                  \
        if ((t) + 1 < NT) { if (XP == 4) { qkt_dummy<C, KB_>(P0, P1, K_lds, r32, hi, S.qr, qpark, dmy); } else { qkt<C, KB_>(P0, P1, K_lds, r32, hi, S.qr, qpark, ACT((t) + 1)); } } } BAR2(); } while (0)
    int t = 0;
    for (; t + 1 < NT; t += 2) { SSTAGE(t); MSTAGE(t, 0, 1); SSTAGE(t + 1); MSTAGE(t + 1, 1, 0); }
    if (t < NT) { SSTAGE(t); MSTAGE(t, 0, 1); }
#undef SSTAGE
#undef MSTAGE
#undef LOADPAIR
#undef WRITEPAIR
    if (hi == 0) li_l[r32] = l_reg; asm volatile("s_waitcnt lgkmcnt(0)" ::: "memory");
    float rli[16], sq[16];
#pragma unroll
    for (int r = 0; r < 16; ++r) { rli[r] = __builtin_amdgcn_rcpf(li_l[crow(r, hi)]); sq[r] = 0.f; }
    char* Ow = (char*)(cur.O + (size_t)(wid * QBLK) * 1024); const unsigned oo = (unsigned)(4 * hi * 1024 + r32) * 2u;
#pragma unroll
    for (int r = 0; r < 16; ++r) {
#pragma unroll
        for (int d0 = 0; d0 < C::NOF; ++d0) { const float v = o[d0][r] * rli[r]; sq[r] += v * v;
            const float vn = __shfl_xor(v, 1);
            if (XP == 0 && (r32 & 1) == 0) *(unsigned*)(Ow + (size_t)(oo + (unsigned)((((r & 3) + 8 * (r >> 2)) * 1024 + d0 * 32) * 2))) = cvtpk(v, vn);
            if (XP != 0) asm volatile("" :: "v"(v)); } }
    float sel = 0.f; int r32e = r32, hie = hi; asm volatile("" : "+v"(r32e), "+v"(hie));
#pragma unroll
    for (int r = 0; r < 16; ++r) { float s = sq[r]; s += __shfl_xor(s, 1); s += __shfl_xor(s, 2); s += __shfl_xor(s, 4); s += __shfl_xor(s, 8); s += __shfl_xor(s, 16); sel = (r32e == r) ? s : sel; }
    if (XP == 0 && r32e < 16) *(float*)((char*)(cur.SSQ + (size_t)(wid * QBLK) * 12 + ssq_slot) + (size_t)((unsigned)crow(r32e, hie) * 48u)) = sel;
    if (XP != 0) asm volatile("" :: "v"(sel), "v"(dmy));
    if (g == 0) BAR2();
    BAR2();
#undef BAR2
#undef RESC
#undef KBASE
#undef ACT
#undef MASKT
}

typedef __attribute__((address_space(3))) const char* lds_cptr;
typedef short v4i16_t __attribute__((ext_vector_type(4)));
__device__ __forceinline__ s16x4 vtr(lds_cptr p) { return __builtin_bit_cast(s16x4, __builtin_amdgcn_ds_read_tr16_b64_v4i16((__attribute__((address_space(3))) v4i16_t*)p)); }
__device__ __forceinline__ void mask_half(f32x16& p, int dq, unsigned W, int klim) {
    const float NEG = -__builtin_inff();
#pragma unroll
    for (int r = 0; r < 16; ++r) { const int c = (r & 3) + 8 * (r >> 2); if ((unsigned)(dq - c) >= W || c < klim) p[r] = NEG; }
}
template <int NDS> struct StepSched { static __device__ __forceinline__ void run() {
    __builtin_amdgcn_sched_group_barrier(0x100, ATT_PF0, 0);
#define G_(n) __builtin_amdgcn_sched_group_barrier(0x008, 1, 0); if constexpr (ATT_PF0 + 2 * (n) < NDS) __builtin_amdgcn_sched_group_barrier(0x100, (NDS - ATT_PF0 - 2 * (n)) >= 2 ? 2 : 1, 0); \
              __builtin_amdgcn_sched_group_barrier(0x002, 4, 0); __builtin_amdgcn_sched_group_barrier(0x400, 1, 0);
    G_(0) G_(1) G_(2) G_(3) G_(4) G_(5) G_(6) G_(7) G_(8) G_(9) G_(10) G_(11) G_(12) G_(13) G_(14) G_(15) G_(16) G_(17) G_(18) G_(19)
#undef G_
} };
template <class C, int XP = 0>
__device__ __forceinline__ void block3(const BlockRef<C>& cur, char* lds, Seam<C>& S, int ssq_slot, const int tid) {
    static_assert(!C::SK && C::NOF == 4, "block3: causal, DV = 128");
    constexpr int W = C::W;
    const int wid = __builtin_amdgcn_readfirstlane(tid >> 6), lane = tid & 63, r32 = lane & 31, hi = lane >> 5;
    const int j_lo = jlo<C>(cur.P0);
    const int j_hi = (cur.P0 + QB - 1) / KVBLK + 1;
    const int NT = j_hi - j_lo;
    const int qlo = cur.P0 + wid * QBLK, qm = qlo + r32 - 4 * hi;
    char* V_lds = lds; char* K_lds = lds + 2 * C::SHM_V;
    AT_STAGE_OFFS()
    float* ws = (float*)(lds + C::WS_OFF) + wid * 64; float* li_l = ws, * al_l = ws + 32;
    char* qpark = lds + C::PARK_OFF + wid * (C::NPARK * 1024) + lane * 16;
    const lds_cptr qpl = (lds_cptr)qpark;
    const lds_cptr vp = (lds_cptr)V_lds + v_rd_base(lane);
    lds_cptr kp[4];
#pragma unroll
    for (int dd = 0; dd < 4; ++dd) kp[dd] = (lds_cptr)K_lds + r32 * C::ROWB + (((dd * 16 + hi * 8) * 2) ^ (((r32 >> 1) & 7) << 4));
    float m_reg = cur.m0, l_reg = cur.l0; const float c2 = cur.c2, thr = 8.f * 1.4426950408889634f / c2;
    f32x16 o[4];
#pragma unroll
    for (int d_ = 0; d_ < 4; ++d_) o[d_] = f32x16{};
    const bf16_t* Kh = cur.K; const bf16_t* Vh = cur.V;
#define KBASE(t) ((j_lo + (t)) * KVBLK)
#define BAR2() asm volatile("s_waitcnt lgkmcnt(0)\n\ts_barrier" ::: "memory")
#define RESC(a) do { if (__any((a) < 1.f)) { if (hi == 0) al_l[r32] = (a); asm volatile("s_waitcnt lgkmcnt(0)" ::: "memory");              \
                     _Pragma("unroll") for (int d_ = 0; d_ < 4; ++d_) _Pragma("unroll") for (int r = 0; r < 16; ++r) o[d_][r] *= al_l[crow(r, hi)]; } } while (0)
#define QPART(PN, KB_, HQ_) do { PN = f32x16{};                                                                                           \
        _Pragma("unroll") for (int d0 = 0; d0 < C::NQF; ++d0) { const bf16x8 kf = *(const __attribute__((address_space(3))) bf16x8*)(kp[d0 & 3] + ((KB_) * C::SHM_K + (HQ_) * 32 * C::ROWB + (d0 >> 2) * 128)); \
            bf16x8 qf; if (d0 < C::NQR) qf = S.qr[d0 < C::NQR ? d0 : 0]; else qf = *(const __attribute__((address_space(3))) bf16x8*)(qpl + (d0 - C::NQR) * 1024);                      \
            PN = __builtin_amdgcn_mfma_f32_32x32x16_bf16(kf, qf, PN, 0, 0, 0); } } while (0)
#define VPART(A_, B_, VB_, HV_) do {                                                                                                      \
        _Pragma("unroll") for (int d0 = 0; d0 < 4; ++d0) { const lds_cptr b_ = vp + ((VB_) * C::SHM_V + d0 * 512 + 4 * (HV_) * C::KG);     \
            const s16x4 la = vtr(b_), ha = vtr(b_ + C::KG), lb = vtr(b_ + 2 * C::KG), hb = vtr(b_ + 3 * C::KG);                            \
            o[d0] = __builtin_amdgcn_mfma_f32_32x32x16_bf16(A_, (bf16x8){la[0], la[1], la[2], la[3], ha[0], ha[1], ha[2], ha[3]}, o[d0], 0, 0, 0);   \
            o[d0] = __builtin_amdgcn_mfma_f32_32x32x16_bf16(B_, (bf16x8){lb[0], lb[1], lb[2], lb[3], hb[0], hb[1], hb[2], hb[3]}, o[d0], 0, 0, 0); } } while (0)
#define SMAX(PC, PM_) do {                                                                                                                \
        float pm_ = fmaxf(fmaxf(PC[0], PC[1]), fmaxf(PC[2], PC[3]));                                                                    \
        _Pragma("unroll") for (int r = 4; r < 16; r += 4) pm_ = fmaxf(pm_, fmaxf(fmaxf(PC[r], PC[r + 1]), fmaxf(PC[r + 2], PC[r + 3])));  \
        { auto rr = __builtin_amdgcn_permlane32_swap(__float_as_uint(pm_), __float_as_uint(pm_), false, false); pm_ = fmaxf(__uint_as_float(rr[0]), __uint_as_float(rr[1])); } \
        PM_ = pm_; } while (0)
#define SEXP(PC, PM_, NA_, NB_) do {                                                                                                      \
        const bool grow_ = ((PM_) - m_reg) > thr; const float mn_ = grow_ ? fmaxf(m_reg, (PM_)) : m_reg;                               \
        al = grow_ ? __builtin_amdgcn_exp2f((m_reg - mn_) * c2) : 1.f; m_reg = mn_; const float mnL_ = -mn_ * c2;                       \
        _Pragma("unroll") for (int r = 0; r < 16; ++r) PC[r] = __builtin_amdgcn_exp2f(fmaf(PC[r], c2, mnL_));                             \
        float ps_ = 0.f; _Pragma("unroll") for (int r = 0; r < 16; ++r) ps_ += PC[r];                                                     \
        { auto rr = __builtin_amdgcn_permlane32_swap(__float_as_uint(ps_), __float_as_uint(ps_), false, false); ps_ = __uint_as_float(rr[0]) + __uint_as_float(rr[1]); } \
        l_reg = l_reg * al + ps_;                                                                                                         \
        { unsigned a0 = cvtpk(PC[0], PC[1]), a1 = cvtpk(PC[2], PC[3]), b0 = cvtpk(PC[4], PC[5]), b1 = cvtpk(PC[6], PC[7]);               \
          auto r0 = __builtin_amdgcn_permlane32_swap(a0, b0, false, false); auto r1 = __builtin_amdgcn_permlane32_swap(a1, b1, false, false); \
          u32x4 w_ = {r0[0], r1[0], r0[1], r1[1]}; NA_ = __builtin_bit_cast(bf16x8, w_); }                                                \
        { unsigned a0 = cvtpk(PC[8], PC[9]), a1 = cvtpk(PC[10], PC[11]), b0 = cvtpk(PC[12], PC[13]), b1 = cvtpk(PC[14], PC[15]);         \
          auto r0 = __builtin_amdgcn_permlane32_swap(a0, b0, false, false); auto r1 = __builtin_amdgcn_permlane32_swap(a1, b1, false, false); \
          u32x4 w_ = {r0[0], r1[0], r0[1], r1[1]}; NB_ = __builtin_bit_cast(bf16x8, w_); } } while (0)
#define MASKH(PC, h) do { const int kbh_ = KBASE((h) >> 1) + 32 * ((h) & 1); if (kbh_ + 31 > qlo || kbh_ < NPAD) mask_half(PC, qm - kbh_, (unsigned)W, NPAD - kbh_ - 4 * hi); } while (0)
    AT_QLOAD(cur.Q);
    AT_LOAD_K(Kh, KBASE(0)); AT_LOAD_V(Vh, KBASE(0)); AT_VMW(); AT_SWRITE_K(0); AT_SWRITE_V(0);
    AT_LOAD_K(Kh, KBASE(1));
    BAR2();
    f32x16 PA, PB; float al = 1.f, pmA, pmB; bf16x8 fa = bf16x8{}, fb = bf16x8{}, ga, gb;
    QPART(PA, 0, 0); SBAR(); MASKH(PA, 0); SMAX(PA, pmA); SBAR();
    AT_LOAD_V(Vh, KBASE(1)); SBAR();
    QPART(PB, 0, 1); SEXP(PA, pmA, fa, fb); SBAR();
    MASKH(PB, 1); SMAX(PB, pmB); RESC(al); AT_VMWN(C::NVC); AT_SWRITE_K(1); BAR2();
#define FULL(h, PC, PMC, PN, PMN, A_, B_, NA_, NB_, VB_, HV_, KB_, HQ_, EVEN_) do { const int t_ = (h) >> 1;                              \
        if (EVEN_) { if (t_ + 1 < NT) { AT_LOAD_V(Vh, KBASE(t_ + 1)); } } else { if (t_ + 2 < NT) { AT_LOAD_K(Kh, KBASE(t_ + 2)); } } SBAR();  \
        VPART(A_, B_, VB_, HV_); QPART(PN, KB_, HQ_); SEXP(PC, PMC, NA_, NB_); StepSched<32 + C::NPARK>::run(); SBAR();                   \
        MASKH(PN, (h) + 1); SMAX(PN, PMN); RESC(al);                                                                                    \
        if (EVEN_) { if (t_ + 1 < NT) { AT_VMWN(C::NVC); AT_SWRITE_K((t_ + 1) & 1); } } else { if (t_ + 1 < NT) { if (t_ + 2 < NT) { AT_VMWN(C::NKC); } else { AT_VMW(); } AT_SWRITE_V((t_ + 1) & 1); } }  \
        BAR2(); } while (0)
    int h = 1;
    for (; h + 3 <= 2 * NT - 2; h += 4) {
        FULL(h,     PB, pmB, PA, pmA, fa, fb, ga, gb, 0, 0, 1, 0, false);
        FULL(h + 1, PA, pmA, PB, pmB, ga, gb, fa, fb, 0, 1, 1, 1, true);
        FULL(h + 2, PB, pmB, PA, pmA, fa, fb, ga, gb, 1, 0, 0, 0, false);
        FULL(h + 3, PA, pmA, PB, pmB, ga, gb, fa, fb, 1, 1, 0, 1, true);
    }
#undef FULL
    VPART(fa, fb, 0, 0); SEXP(PB, pmB, ga, gb); SBAR();
    RESC(al);
    VPART(ga, gb, 0, 1); SBAR();
#undef QPART
#undef VPART
#undef SMAX
#undef SEXP
#undef MASKH
    if (hi == 0) li_l[r32] = l_reg; asm volatile("s_waitcnt lgkmcnt(0)" ::: "memory");
    float rli[16], sq[16];
#pragma unroll
    for (int r = 0; r < 16; ++r) { rli[r] = __builtin_amdgcn_rcpf(li_l[crow(r, hi)]); sq[r] = 0.f; }
    char* Ow = (char*)(cur.O + (size_t)(wid * QBLK) * 1024); const unsigned oo = (unsigned)(4 * hi * 1024 + r32) * 2u;
#pragma unroll
    for (int r = 0; r < 16; ++r) {
#pragma unroll
        for (int d0 = 0; d0 < 4; ++d0) { const float v = o[d0][r] * rli[r]; sq[r] += v * v;
            const float vn = __shfl_xor(v, 1);
            if (XP == 0 && (r32 & 1) == 0) *(unsigned*)(Ow + (size_t)(oo + (unsigned)((((r & 3) + 8 * (r >> 2)) * 1024 + d0 * 32) * 2))) = cvtpk(v, vn);
            if (XP != 0) asm volatile("" :: "v"(v)); } }
    float sel = 0.f; int r32e = r32, hie = hi; asm volatile("" : "+v"(r32e), "+v"(hie));
#pragma unroll
    for (int r = 0; r < 16; ++r) { float s = sq[r]; s += __shfl_xor(s, 1); s += __shfl_xor(s, 2); s += __shfl_xor(s, 4); s += __shfl_xor(s, 8); s += __shfl_xor(s, 16); sel = (r32e == r) ? s : sel; }
    if (XP == 0 && r32e < 16) *(float*)((char*)(cur.SSQ + (size_t)(wid * QBLK) * 12 + ssq_slot) + (size_t)((unsigned)crow(r32e, hie) * 48u)) = sel;
    if (XP != 0) asm volatile("" :: "v"(sel));
    BAR2();
#undef BAR2
#undef RESC
#undef KBASE
}
#undef AT_STAGE_OFFS
#undef AT_LOAD_K
#undef AT_LOAD_V
#undef AT_SLOAD
#undef AT_SWRITE_K
#undef AT_SWRITE_V
#undef AT_VMW
#undef AT_VMWN
#undef AT_QLOAD
#undef AT_RSRC
#undef AT_BLD
#undef SBAR

typedef Cfg<192, 128, 768, 768, 512, LP, false, 6> CfgMLA;
typedef Cfg<64, 64, 512, 128, 128, 128, true, 0> CfgSWA;
constexpr float C2_MLA = 1.4426950408889634f * 0.07216878364870322f, C2_SWA = 1.4426950408889634f * 0.125f;
static_assert(CfgMLA::LDS_BYTES <= RING_BYTES && CfgSWA::LDS_BYTES <= RING_BYTES, "attention LDS");

__device__ __forceinline__ BlockRef<CfgMLA> mla_ref(unsigned char* ws, int bh, int qb) {
    const int b = bh >> 2, h = bh & 3; BlockRef<CfgMLA> r; const size_t m0 = (size_t)b * SEQ + (size_t)qb * QB;
    r.Q = (const bf16_t*)(ws + WS_QM) + m0 * 768 + h * 192; r.K = (const bf16_t*)(ws + WS_KM) + (size_t)b * LP * 768 + h * 192;
    r.V = (const bf16_t*)(ws + WS_VM) + (size_t)b * LP * 512 + h * 128; r.O = (bf16_t*)(ws + WS_AO) + m0 * 1024 + 512 + h * 128;
    r.SSQ = (float*)(ws + WS_SSQ) + m0 * 12; r.P0 = 128 + qb * QB; r.m0 = -1e30f; r.l0 = 0.f; r.c2 = C2_MLA; return r;
}
__device__ __forceinline__ BlockRef<CfgSWA> swa_ref(unsigned char* ws, const float* sinks, int bh, int qb) {
    const int b = bh >> 3, h = bh & 7, kvh = h >> 2; BlockRef<CfgSWA> r; const size_t m0 = (size_t)b * SEQ + (size_t)qb * QB;
    r.Q = (const bf16_t*)(ws + WS_QA) + m0 * 512 + h * 64; r.K = (const bf16_t*)(ws + WS_KA) + (size_t)b * LP * 128 + kvh * 64;
    r.V = (const bf16_t*)(ws + WS_VA) + (size_t)b * LP * 128 + kvh * 64; r.O = (bf16_t*)(ws + WS_AO) + m0 * 1024 + h * 64;
    r.SSQ = (float*)(ws + WS_SSQ) + m0 * 12; r.P0 = 128 + qb * QB; r.m0 = sinks[h] * 8.f; r.l0 = 1.f; r.c2 = C2_SWA; return r;
}
template <int XP = 0>
__device__ __forceinline__ void attn_phase(char* lds, unsigned char* ws, const float* sinks, int vcu, int G, const float* wgate, const float* wup, const float* wdown) {
    {
        const int nit = (256 - vcu + G - 1) / G;
        const int nblk = 2 * (nit > 0 ? nit : 0);
        if (nblk > 0) {
            Seam<CfgMLA> S; int tid = threadIdx.x; asm volatile("" : "+v"(tid));
#define MLA_REF(k) mla_ref(ws, (vcu + ((k) >> 1) * G) >> 4, ((k) & 1) ? ((vcu + ((k) >> 1) * G) & 15) : 31 - ((vcu + ((k) >> 1) * G) & 15))
            BlockRef<CfgMLA> cur = MLA_REF(0);
#if ATT_SKEW
#if ATT_HALF
            for (int k = 0; k < nblk; ++k) { cur = MLA_REF(k); block3<CfgMLA, XP>(cur, lds, S, 8 + (((vcu + (k >> 1) * G) >> 4) & 3), tid); }
#else
            block2<CfgMLA, XP>(cur, lds, S, 8 + ((vcu >> 4) & 3), tid);
            if (XP == 0) {
                int t2 = threadIdx.x; asm volatile("" : "+v"(t2));
                moe_wconv((LAS unsigned char*)lds, ws, wgate, wup, wdown, __builtin_amdgcn_readfirstlane(t2 >> 6), t2 & 63, vcu * NWAVES + __builtin_amdgcn_readfirstlane(t2 >> 6), G * NWAVES); __syncthreads(); }
            for (int k = 1; k < nblk; ++k) { cur = MLA_REF(k); block2<CfgMLA, XP>(cur, lds, S, 8 + (((vcu + (k >> 1) * G) >> 4) & 3), tid); }
#endif
#else
            prime<CfgMLA>(cur, lds, S, tid);
            for (int k = 0; k < nblk; ++k) { const BlockRef<CfgMLA> nxt = (k + 1 < nblk) ? MLA_REF(k + 1) : cur; block<CfgMLA>(cur, nxt, lds, S, 8 + (((vcu + (k >> 1) * G) >> 4) & 3), tid); cur = nxt; }
#endif
#undef MLA_REF
        }
    }
    {
        const int nit = (256 - vcu + G - 1) / G;
        const int nblk = 4 * (nit > 0 ? nit : 0);
        if (nblk > 0) {
            Seam<CfgSWA> S; int tid = threadIdx.x; asm volatile("" : "+v"(tid));
#define SWA_REF(k) swa_ref(ws, sinks, (4 * (vcu + ((k) >> 2) * G) + ((k) & 3)) >> 5, (4 * (vcu + ((k) >> 2) * G) + ((k) & 3)) & 31)
            BlockRef<CfgSWA> cur = SWA_REF(0);
#if ATT_SKEW_SWA
            for (int k = 0; k < nblk; ++k) { cur = SWA_REF(k); block2<CfgSWA, XP>(cur, lds, S, ((4 * (vcu + (k >> 2) * G) + (k & 3)) >> 5) & 7, tid); }
#else
            prime<CfgSWA>(cur, lds, S, tid);
            for (int k = 0; k < nblk; ++k) { const BlockRef<CfgSWA> nxt = (k + 1 < nblk) ? SWA_REF(k + 1) : cur; block<CfgSWA>(cur, nxt, lds, S, ((4 * (vcu + (k >> 2) * G) + (k & 3)) >> 5) & 7, tid); cur = nxt; }
#endif
#undef SWA_REF
        }
    }
}
}

struct EpiOut {
    static constexpr bool PERM = true, MIDK = true;
    unsigned char* ws;
    __device__ __forceinline__ void midk(f32x4 (&acc)[2][2][4][2], const pg8::Unit& u, int wr, int wc, int fr, int fq) const {
        const char* SSQb = (const char*)(ws + WS_SSQ) + (size_t)u.pm * (256 * 48);
        unsigned lo = (unsigned)(wr * 64 + fr) * 48u; asm volatile("" : "+v"(lo));
#pragma unroll
        for (int ai = 0; ai < 2; ++ai) {
            f32x4 s0[4], s1[4], s2[4];
#pragma unroll
            for (int m = 0; m < 4; ++m) { const char* p = SSQb + (size_t)(lo + (unsigned)((ai * 128 + m * 16) * 48)); s0[m] = *(const f32x4*)p; s1[m] = *(const f32x4*)(p + 16); s2[m] = *(const f32x4*)(p + 32); }
#pragma unroll
            for (int m = 0; m < 4; ++m) {
                const float sa = ((s0[m][0] + s0[m][1]) + (s0[m][2] + s0[m][3])) + ((s1[m][0] + s1[m][1]) + (s1[m][2] + s1[m][3])), sb = (s2[m][0] + s2[m][1]) + (s2[m][2] + s2[m][3]);
                const float rho = sqrtf((sb * (1.f / 512.f) + RMS_EPS) / (sa * (1.f / 512.f) + RMS_EPS));
#pragma unroll
                for (int bj = 0; bj < 2; ++bj)
#pragma unroll
                    for (int n = 0; n < 2; ++n) acc[ai][bj][m][n] *= rho; }
            asm volatile("" ::: "memory"); }
    }
    __device__ __forceinline__ void operator()(const f32x4 (&acc)[2][2][4][2], const pg8::Unit& u, int wr, int wc, int fr, int fq) const {
        const char* SSQb = (const char*)(ws + WS_SSQ) + (size_t)u.pm * (256 * 48) + 32;
        const size_t tile = ((size_t)u.pm * 256) * DM + (size_t)u.pn * 256;
        const char* H0b = (const char*)(ws + WS_H0) + tile * 2; char* Pb = (char*)(ws + WS_PRE1) + tile * 2;
        unsigned lo = (unsigned)(wr * 64 + fr) * 48u, eo = (unsigned)((wr * 64 + fr) * DM + wc * 32 + 8 * fq) * 2u; asm volatile("" : "+v"(lo), "+v"(eo));
        f32x4 s2[8];
#pragma unroll
        for (int q = 0; q < 8; ++q) s2[q] = *(const f32x4*)(SSQb + (size_t)(lo + (unsigned)(((q >> 2) * 128 + (q & 3) * 16) * 48)));
#pragma unroll
        for (int ai = 0; ai < 2; ++ai) {
            u32x4 h[4][2];
#pragma unroll
            for (int m = 0; m < 4; ++m)
#pragma unroll
                for (int bj = 0; bj < 2; ++bj) h[m][bj] = *(const u32x4*)(H0b + (size_t)(eo + (unsigned)(((ai * 128 + m * 16) * DM + bj * 128) * 2)));
#pragma unroll
            for (int m = 0; m < 4; ++m) { const f32x4 sq = s2[ai * 4 + m];
                const float rb = 1.f / sqrtf(((sq[0] + sq[1]) + (sq[2] + sq[3])) * (1.f / 512.f) + RMS_EPS);
#pragma unroll
                for (int bj = 0; bj < 2; ++bj) { const u32x4 hv = h[m][bj]; f32x4 o0 = acc[ai][bj][m][0] * rb, o1 = acc[ai][bj][m][1] * rb;
                    o0[0] += ALPHA * __uint_as_float(hv.x << 16); o0[1] += ALPHA * __uint_as_float(hv.x & 0xffff0000u); o0[2] += ALPHA * __uint_as_float(hv.y << 16); o0[3] += ALPHA * __uint_as_float(hv.y & 0xffff0000u);
                    o1[0] += ALPHA * __uint_as_float(hv.z << 16); o1[1] += ALPHA * __uint_as_float(hv.z & 0xffff0000u); o1[2] += ALPHA * __uint_as_float(hv.w << 16); o1[3] += ALPHA * __uint_as_float(hv.w & 0xffff0000u);
                    ST16(Pb + (size_t)(eo + (unsigned)(((ai * 128 + m * 16) * DM + bj * 128) * 2)), pg8::pack8(o0, o1)); } }
            asm volatile("" ::: "memory"); }
    }
};

__device__ __forceinline__ void split_bf16x8(const f32x4 x0, const f32x4 x1, bf16x8& hi, bf16x8& lo) {
    unsigned h[8]; float r[8];
#pragma unroll
    for (int e = 0; e < 4; ++e) { h[e] = f2bf(x0[e]); r[e] = x0[e] - __uint_as_float(h[e] << 16); h[4 + e] = f2bf(x1[e]); r[4 + e] = x1[e] - __uint_as_float(h[4 + e] << 16); }
    u32x4 hw, lw;
    hw.x = h[0] | (h[1] << 16); hw.y = h[2] | (h[3] << 16); hw.z = h[4] | (h[5] << 16); hw.w = h[6] | (h[7] << 16);
    lw.x = pk2(r[0], r[1]); lw.y = pk2(r[2], r[3]); lw.z = pk2(r[4], r[5]); lw.w = pk2(r[6], r[7]);
    hi = __builtin_bit_cast(bf16x8, hw); lo = __builtin_bit_cast(bf16x8, lw);
}
__device__ __forceinline__ void p5_ln1_router(const Frame& F, const Args& a) {
    constexpr int RS = 1032;
    LAS float* hrow = (LAS float*)F.lds;
    LAS float* part = (LAS float*)(F.lds + 16 * RS * 4);
    LAS float* lg = part + 8 * 16 * 48;
    const int tid5 = threadIdx.x, lane = tid5 & 63, w = F.wave, fr = lane & 15, fq = lane >> 4;
    const bf16_t* PRE1 = (const bf16_t*)(F.ws + WS_PRE1); bf16_t* H1 = (bf16_t*)(F.ws + WS_H1);
    const float* g1 = a.in[13]; const float* b1 = a.in[14]; const float* wg = a.in[15]; const float* bg = a.in[16]; const float* wr = a.in[17]; const float* br = a.in[18];
    int* list = (int*)(F.ws + WS_LIST); float* ew = (float*)(F.ws + WS_EW);
    bf16x8 Bh[4][3], Bl[4][3];
#pragma unroll
    for (int s = 0; s < 4; ++s)
#pragma unroll
        for (int cb = 0; cb < 3; ++cb) { const int n = cb * 16 + fr; float x[8];
#pragma unroll
            for (int j = 0; j < 8; ++j) { const int k = 128 * w + 32 * s + 8 * fq + j; x[j] = n < 4 ? wg[k * 4 + n] : (n < 36 ? wr[k * 32 + (n - 4)] : 0.f); }
            split_bf16x8((f32x4){x[0], x[1], x[2], x[3]}, (f32x4){x[4], x[5], x[6], x[7]}, Bh[s][cb], Bl[s][cb]); }
    u32x2 pv[2][4];
    int it = F.bx;
    if (it < T / 16) {
#pragma unroll
        for (int rr = 0; rr < 2; ++rr)
#pragma unroll
            for (int j = 0; j < 4; ++j) pv[rr][j] = *(const u32x2*)(PRE1 + (size_t)(it * 16 + 2 * w + rr) * DM + j * 256 + lane * 4);
    }
    for (; it < T / 16; it += F.G) {
        const int R0 = it * 16;
#pragma unroll
        for (int rr = 0; rr < 2; ++rr) { const int r = 2 * w + rr;
            f32x4 v[4]; float s = 0.f;
#pragma unroll
            for (int j = 0; j < 4; ++j) { const u32x2 q2 = pv[rr][j]; v[j].x = __uint_as_float(q2.x << 16); v[j].y = __uint_as_float(q2.x & 0xffff0000u); v[j].z = __uint_as_float(q2.y << 16); v[j].w = __uint_as_float(q2.y & 0xffff0000u); s += (v[j].x + v[j].y) + (v[j].z + v[j].w); }
            const float mean = wave_sum(s) * (1.f / DM); float s2 = 0.f;
#pragma unroll
            for (int j = 0; j < 4; ++j) { v[j] = v[j] - mean; s2 += (v[j].x * v[j].x + v[j].y * v[j].y) + (v[j].z * v[j].z + v[j].w * v[j].w); }
            const float rstd = 1.f / sqrtf(wave_sum(s2) * (1.f / DM) + LN_EPS);
#pragma unroll
            for (int j = 0; j < 4; ++j) { const int c = j * 256 + lane * 4; const f32x4 gg = *(const f32x4*)(g1 + c), bb = *(const f32x4*)(b1 + c);
                const f32x4 o = v[j] * rstd * gg + bb; *(LAS f32x4*)(hrow + r * RS + c) = o;
                u32x2 pw; pw.x = pk2(o.x, o.y); pw.y = pk2(o.z, o.w); *(u32x2*)(H1 + (size_t)(R0 + r) * DM + c) = pw; } }
        __syncthreads();
        if (it + F.G < T / 16) {
#pragma unroll
            for (int rr = 0; rr < 2; ++rr)
#pragma unroll
                for (int j = 0; j < 4; ++j) pv[rr][j] = *(const u32x2*)(PRE1 + (size_t)((it + F.G) * 16 + 2 * w + rr) * DM + j * 256 + lane * 4);
        }
        f32x4 c0 = {0.f, 0.f, 0.f, 0.f}, c1 = c0, c2 = c0;
#pragma unroll
        for (int s = 0; s < 4; ++s) { const LAS float* ap = hrow + fr * RS + 128 * w + 32 * s + 8 * fq;
            bf16x8 ah, al; split_bf16x8(*(const LAS f32x4*)ap, *(const LAS f32x4*)(ap + 4), ah, al);
            c0 = __builtin_amdgcn_mfma_f32_16x16x32_bf16(ah, Bh[s][0], c0, 0, 0, 0); c0 = __builtin_amdgcn_mfma_f32_16x16x32_bf16(al, Bh[s][0], c0, 0, 0, 0); c0 = __builtin_amdgcn_mfma_f32_16x16x32_bf16(ah, Bl[s][0], c0, 0, 0, 0);
            c1 = __builtin_amdgcn_mfma_f32_16x16x32_bf16(ah, Bh[s][1], c1, 0, 0, 0); c1 = __builtin_amdgcn_mfma_f32_16x16x32_bf16(al, Bh[s][1], c1, 0, 0, 0); c1 = __builtin_amdgcn_mfma_f32_16x16x32_bf16(ah, Bl[s][1], c1, 0, 0, 0);
            c2 = __builtin_amdgcn_mfma_f32_16x16x32_bf16(ah, Bh[s][2], c2, 0, 0, 0); c2 = __builtin_amdgcn_mfma_f32_16x16x32_bf16(al, Bh[s][2], c2, 0, 0, 0); c2 = __builtin_amdgcn_mfma_f32_16x16x32_bf16(ah, Bl[s][2], c2, 0, 0, 0); }
#pragma unroll
        for (int j = 0; j < 4; ++j) { LAS float* pp = part + (w * 16 + fq * 4 + j) * 48 + fr; pp[0] = c0[j]; pp[16] = c1[j]; pp[32] = c2[j]; }
        __syncthreads();
        for (int idx = tid5; idx < 16 * 48; idx += NWAVES * 64) { float sum = 0.f;
#pragma unroll
            for (int q = 0; q < 8; ++q) sum += part[q * 768 + idx];
            lg[idx] = sum; }
        __syncthreads();
        if (tid5 < 16) { const int m = R0 + tid5; const LAS float* L = lg + tid5 * 48;
            const float l0 = L[0] + bg[0], l1 = L[1] + bg[1], l2 = L[2] + bg[2], l3 = L[3] + bg[3];
            const float mx = fmaxf(fmaxf(l0, l1), fmaxf(l2, l3));
            const float ex0 = expf(l0 - mx), ex1 = expf(l1 - mx), ex2 = expf(l2 - mx), ex3 = expf(l3 - mx);
            const float se = ((ex0 + ex1) + ex2) + ex3;
            int gi = 0; float gt = ex0 / se;
            { const float p = ex1 / se; if (p > gt) { gt = p; gi = 1; } }
            { const float p = ex2 / se; if (p > gt) { gt = p; gi = 2; } }
            { const float p = ex3 / se; if (p > gt) { gt = p; gi = 3; } }
            int e1 = 0, e2 = -1; float t1 = -INFINITY, t2 = -INFINITY;
#pragma unroll 1
            for (int i = 0; i < 8; ++i) { const float v = L[4 + gi * 8 + i] + br[gi * 8 + i];
                if (v > t1) { t2 = t1; e2 = e1; t1 = v; e1 = i; } else if (v > t2) { t2 = v; e2 = i; } }
            const float z = expf(t2 - t1), w1 = gt / (1.f + z), w2 = gt * z / (1.f + z);
            const int ea = gi * 8 + e1, eb = gi * 8 + e2;
            const unsigned pa = atomicAdd(&F.ctl[CW_CNT + 64 * ea], 1u); const unsigned pb = atomicAdd(&F.ctl[CW_CNT + 64 * eb], 1u);
            list[(size_t)ea * T + pa] = m * 2; list[(size_t)eb * T + pb] = m * 2 + 1; ew[m * 2] = w1; ew[m * 2 + 1] = w2; }
    }
}

struct MoeOrder {
    const unsigned* ctl; const int* list; const char* A; const char* Bt; int nN, G, c; bool gather;
    __device__ bool next(int i, pg8::Unit& u) const {
        if (G % 8 == 0) {
            const int x = c & 7, slot = c >> 3, ns = G >> 3; const int j = i * ns + slot; const int tlx = j / nN; int accx = 0, accg = 0; bool found = false;
            for (int e = 0; e < 32; ++e) { const int cn = (int)ctl[CW_CNT + 64 * e]; const int nt = (cn + 255) >> 8;
                if ((e & 7) == x) { if (!found && tlx < accx + nt) { u.e = e; u.r0 = (tlx - accx) * 256; u.n = cn; u.pm = accg + (tlx - accx); u.pn = j % nN; found = true; } accx += nt; }
                accg += nt; }
            return found; }
        const int L = i * G + c; const int tl = L / nN; int acc = 0;
        for (int e = 0; e < 32; ++e) { const int cn = (int)ctl[CW_CNT + 64 * e]; const int nt = (cn + 255) >> 8;
            if (tl < acc + nt) { u.e = e; u.r0 = (tl - acc) * 256; u.n = cn; u.pm = tl; u.pn = L % nN; return true; } acc += nt; }
        return false;
    }
    __device__ __forceinline__ const char* abase(const pg8::Unit& u) const { return gather ? A : A + (size_t)u.pm * 256 * 256 * 2; }
    __device__ __forceinline__ const char* bbase(const pg8::Unit& u) const { return gather ? Bt + ((size_t)u.e * 512 + u.pn * 256) * DM * 2 : Bt + ((size_t)u.e * 1024 + u.pn * 256) * 256 * 2; }
    __device__ __forceinline__ unsigned arow_off(const pg8::Unit& u, int R) const {
        if (!gather) return (unsigned)(R * 256) * 2u;
        const int idx = (u.r0 + R < u.n) ? list[(size_t)u.e * T + u.r0 + R] : 0;
        return (unsigned)(idx >> 1) * (unsigned)(DM * 2);
    }
};
struct EpiGU {
    static constexpr bool PERM = true, MIDK = false;
    unsigned char* ws;
    __device__ __forceinline__ void operator()(const f32x4 (&acc)[2][2][4][2], const pg8::Unit& u, int wr, int wc, int fr, int fq) const {
        const char* listb = (const char*)(ws + WS_LIST) + ((size_t)u.e * T + u.r0) * 4; const char* ewb = (const char*)(ws + WS_EW);
        char* Hb = (char*)(ws + WS_HID) + (((size_t)u.pm * 256) * 256 + u.pn * 128) * 2;
        int Rl = wr * 64 + fr; const int nrem = u.n - u.r0; asm volatile("" : "+v"(Rl));
        const unsigned ho = (unsigned)(Rl * 256 + wc * 32 + 8 * fq) * 2u;
        unsigned idx[8]; float wgt[8];
#pragma unroll
        for (int q = 0; q < 8; ++q) { const int R = Rl + (q >> 2) * 128 + (q & 3) * 16; idx[q] = (R < nrem) ? *(const unsigned*)(listb + (size_t)((unsigned)R * 4u)) : 0xffffffffu; }
#pragma unroll
        for (int q = 0; q < 8; ++q) wgt[q] = (idx[q] != 0xffffffffu) ? *(const float*)(ewb + (size_t)(idx[q] * 4u)) : 0.f;
#pragma unroll
        for (int ai = 0; ai < 2; ++ai)
#pragma unroll
            for (int m = 0; m < 4; ++m) { const float wg_ = wgt[ai * 4 + m];
                f32x4 o[2];
#pragma unroll
                for (int n = 0; n < 2; ++n) { const f32x4 gv = acc[ai][0][m][n], uv = acc[ai][1][m][n];
#pragma unroll
                    for (int e = 0; e < 4; ++e) o[n][e] = gv[e] * __builtin_amdgcn_rcpf(1.f + __builtin_amdgcn_exp2f(-1.4426950408889634f * gv[e])) * uv[e] * wg_; }
                ST16(Hb + (size_t)(ho + (unsigned)((ai * 128 + m * 16) * 512)), pg8::pack8(o[0], o[1])); }
    }
};
struct EpiDown {
    static constexpr bool PERM = true, MIDK = false;
    unsigned char* ws;
    __device__ __forceinline__ void operator()(const f32x4 (&acc)[2][2][4][2], const pg8::Unit& u, int wr, int wc, int fr, int fq) const {
        const char* listb = (const char*)(ws + WS_LIST) + ((size_t)u.e * T + u.r0) * 4; char* Yb = (char*)(ws + WS_Y) + (size_t)(u.pn * 256) * 2;
        int Rl = wr * 64 + fr; const int nrem = u.n - u.r0; asm volatile("" : "+v"(Rl));
        const unsigned yo = (unsigned)(wc * 32 + 8 * fq) * 2u;
        unsigned idx[8];
#pragma unroll
        for (int q = 0; q < 8; ++q) { const int R = Rl + (q >> 2) * 128 + (q & 3) * 16; idx[q] = (R < nrem) ? *(const unsigned*)(listb + (size_t)((unsigned)R * 4u)) : 0xffffffffu; }
#pragma unroll
        for (int ai = 0; ai < 2; ++ai)
#pragma unroll
            for (int m = 0; m < 4; ++m) { const unsigned ix = idx[ai * 4 + m];
                if (ix != 0xffffffffu) { char* y = Yb + (size_t)ix * (DM * 2) + yo;
                    ST16(y, pg8::pack8(acc[ai][0][m][0], acc[ai][0][m][1])); ST16((y + 256), pg8::pack8(acc[ai][1][m][0], acc[ai][1][m][1])); } }
    }
};

__device__ __forceinline__ void p8_ln2(const Frame& F, const Args& a) {
    const bf16_t* H1 = (const bf16_t*)(F.ws + WS_H1); const bf16_t* Y = (const bf16_t*)(F.ws + WS_Y); const float* g = a.in[22]; const float* b = a.in[23]; float* out = a.out;
    const int lane = threadIdx.x & 63; const int NGW = F.G * NWAVES;
    for (int m0 = F.bx * NWAVES + F.wave; m0 < T; m0 += 2 * NGW) {
        const int m1 = m0 + NGW; const bool two = m1 < T; const int mm[2] = {m0, two ? m1 : m0};
        u32x2 hq[2][4], y0[2][4], y1[2][4];
#pragma unroll
        for (int q = 0; q < 2; ++q)
#pragma unroll
            for (int j = 0; j < 4; ++j) { const int c = j * 256 + lane * 4; const size_t m = (size_t)mm[q];
                hq[q][j] = *(const u32x2*)(H1 + m * DM + c); y0[q][j] = *(const u32x2*)(Y + (2 * m) * DM + c); y1[q][j] = *(const u32x2*)(Y + (2 * m + 1) * DM + c); }
#pragma unroll
        for (int q = 0; q < 2; ++q) { if (q == 1 && !two) break;
            f32x4 v[4]; float s = 0.f;
#pragma unroll
            for (int j = 0; j < 4; ++j) { const u32x2 h = hq[q][j], a0 = y0[q][j], a1 = y1[q][j];
                v[j].x = ALPHA * __uint_as_float(h.x << 16) + __uint_as_float(a0.x << 16) + __uint_as_float(a1.x << 16);
                v[j].y = ALPHA * __uint_as_float(h.x & 0xffff0000u) + __uint_as_float(a0.x & 0xffff0000u) + __uint_as_float(a1.x & 0xffff0000u);
                v[j].z = ALPHA * __uint_as_float(h.y << 16) + __uint_as_float(a0.y << 16) + __uint_as_float(a1.y << 16);
                v[j].w = ALPHA * __uint_as_float(h.y & 0xffff0000u) + __uint_as_float(a0.y & 0xffff0000u) + __uint_as_float(a1.y & 0xffff0000u);
                s += (v[j].x + v[j].y) + (v[j].z + v[j].w); }
            const float mean = wave_sum(s) * (1.f / DM); float s2 = 0.f;
#pragma unroll
            for (int j = 0; j < 4; ++j) { v[j] = v[j] - mean; s2 += (v[j].x * v[j].x + v[j].y * v[j].y) + (v[j].z * v[j].z + v[j].w * v[j].w); }
            const float rstd = 1.f / sqrtf(wave_sum(s2) * (1.f / DM) + LN_EPS);
            float* orow = out + (size_t)mm[q] * DM;
#pragma unroll
            for (int j = 0; j < 4; ++j) { const int c = j * 256 + lane * 4; const f32x4 gg = *(const f32x4*)(g + c), bb = *(const f32x4*)(b + c);
                *(f32x4*)(orow + c) = v[j] * rstd * gg + bb; } }
    }
}

__global__ void __launch_bounds__(NWAVES * 64, 2) mega(Args args) {
    extern __shared__ __attribute__((aligned(16))) unsigned char lds_raw[];
    Frame F;
    F.lds = (LAS unsigned char*)lds_raw; F.ws = args.ws; F.ctl = (unsigned*)(args.ws + WS_CTL);
    F.tid = threadIdx.x; F.lane = F.tid & 63; F.wave = __builtin_amdgcn_readfirstlane(F.tid >> 6); F.G = gridDim.x; F.bx = blockIdx.x;
    volatile LAS unsigned* MISC = (volatile LAS unsigned*)(F.lds + MISC_OFF);
    for (int u = F.tid; u < (LDS_BYTES - LDSCTL_OFF) / 4; u += NWAVES * 64) ((LAS unsigned*)(F.lds + LDSCTL_OFF))[u] = 0u;
    __syncthreads();
    XcdBarrier bar = xcd_barrier_post(F.ctl + CW_BAR, MISC + 8);
    const int lo = args.ph_lo, hi = args.ph_hi;
#define IN(k) (lo <= (k) && (k) < hi)
#define BOTH(k) (IN(k) && IN((k) + 1))
    if (IN(0)) { p0_prologue(F, args); if (BOTH(0)) xcd_barrier(bar); }
    if (IN(1)) {
        pg8::StaticOrder S; S.init(args.ws + WS_H0, args.ws + WS_WIN, T, 1536, DM, F.G, F.bx);
        EpiInProj E{args.ws};
        pg8::gemm_phase<EpiInProj, pg8::StaticOrder, true>(F.lds, DM, S, E);
        if (BOTH(1)) xcd_barrier(bar);
    }
    if (IN(2)) {
        { int q = F.bx;
          if (F.G % 8 == 0 && F.G >= 224) { const int slot = F.bx >> 3; q = slot >= 16 ? (slot - 16) * 8 + (F.bx & 7) : 1 << 20; }
          for (; q < 84; q += F.G) p2_meta(F, args, q); }
        UpOrder S{(const char*)(args.ws + WS_CQ), (const char*)(args.ws + WS_CKV), (const char*)(args.ws + WS_WUQ), (const char*)(args.ws + WS_WUKV), F.G, F.bx};
        EpiUp E{args.ws};
        pg8::gemm_phase<EpiUp, UpOrder, true>(F.lds, 256, S, E);
        if (BOTH(2)) xcd_barrier(bar);
    }
    if (IN(3)) {
        const int vcu = (F.G % 8 == 0) ? (F.bx % 8) * (F.G / 8) + F.bx / 8 : F.bx;
        att::attn_phase<0>((char*)lds_raw, args.ws, args.in[5], vcu, F.G, args.in[19], args.in[20], args.in[21]);
        if (BOTH(3)) xcd_barrier(bar);
    }
    if (IN(4)) {
        pg8::StaticOrder S; S.init(args.ws + WS_AO, args.ws + WS_WO, T, DM, DM, F.G, F.bx);
        EpiOut E{args.ws};
        pg8::gemm_phase<EpiOut, pg8::StaticOrder, true>(F.lds, DM, S, E);
        if (BOTH(4)) xcd_barrier(bar);
    }
    if (IN(5)) { p5_ln1_router(F, args); if (BOTH(5)) xcd_barrier(bar); }
    if (IN(6)) {
        MoeOrder S{F.ctl, (const int*)(args.ws + WS_LIST), (const char*)(args.ws + WS_H1), (const char*)(args.ws + WS_WGU), 2, F.G, F.bx, true};
        EpiGU E{args.ws};
        pg8::gemm_phase<EpiGU, MoeOrder, true>(F.lds, DM, S, E);
        if (BOTH(6)) xcd_barrier(bar);
    }
    if (IN(7)) {
        MoeOrder S{F.ctl, (const int*)(args.ws + WS_LIST), (const char*)(args.ws + WS_HID), (const char*)(args.ws + WS_WDN), 4, F.G, F.bx, false};
        EpiDown E{args.ws};
        pg8::gemm_phase<EpiDown, MoeOrder, true>(F.lds, 256, S, E);
        if (BOTH(7)) xcd_barrier(bar);
    }
    if (IN(8)) { p8_ln2(F, args); }
#undef IN
#undef BOTH
}

extern "C" void kernel_launch(void* const* d_in, const int* in_sizes, int n_in, void* d_out, int out_size, void* d_ws, size_t ws_size, hipStream_t stream) {
    static int grid = 0;
    if (grid == 0) {
        if (n_in != 24 || ws_size < WS_END || out_size != T * DM) { fprintf(stderr, "kernel_launch: unexpected shapes n_in=%d ws=%zu out=%d\n", n_in, ws_size, out_size); grid = -1; return; }
        int dev = 0, cus = 0, per_cu = 0;
        if (hipGetDevice(&dev) != hipSuccess || hipDeviceGetAttribute(&cus, hipDeviceAttributeMultiprocessorCount, dev) != hipSuccess) { grid = -1; return; }
        if (hipFuncSetAttribute((const void*)mega, hipFuncAttributeMaxDynamicSharedMemorySize, LDS_BYTES) != hipSuccess) { fprintf(stderr, "hipFuncSetAttribute failed\n"); grid = -1; return; }
        if (hipOccupancyMaxActiveBlocksPerMultiprocessor(&per_cu, (const void*)mega, NWAVES * 64, LDS_BYTES) != hipSuccess || per_cu < 1) { fprintf(stderr, "occupancy query: %d blocks per CU\n", per_cu); (void)hipGetLastError(); grid = -1; return; }
        (void)hipGetLastError();
        grid = cus;
    }
    if (grid < 0) return;
    static_assert((CW_BAR + XCD_BAR_WORDS) * 4 <= 32768 && (CW_CNT + 64 * 32) * 4 <= 32768, "control words inside the per-call memset");
    (void)hipMemsetAsync((unsigned char*)d_ws + WS_CTL, 0, 32768, stream);
    Args a{};
    for (int i = 0; i < 24; ++i) a.in[i] = (const float*)d_in[i];
    a.out = (float*)d_out; a.ws = (unsigned char*)d_ws; a.ph_lo = 0; a.ph_hi = 9;
    hipLaunchKernelGGL(mega, dim3(grid), dim3(NWAVES * 64), LDS_BYTES, stream, a);
}
```

```cpp
#include <hip/hip_runtime.h>
#include <cstdio>
#include <cstdint>

typedef unsigned short bf16_t;
typedef float f32x4 __attribute__((ext_vector_type(4)));
typedef unsigned u32x4 __attribute__((ext_vector_type(4)));
typedef unsigned u32x2 __attribute__((ext_vector_type(2)));

constexpr int NB = 4, SEQ = 8192, DM = 1024, T = NB * SEQ, LP = SEQ + 128, NPAD = 112, NMETA = 16;
constexpr int INC = 1344;
constexpr float LN_EPS = 1e-5f, RMS_EPS = 1e-6f;
constexpr float ALPHA = 1.189207115002721f;
constexpr size_t MiB = 1u << 20;

constexpr size_t WS_CTL = 0;
constexpr size_t WS_HM = 1 * MiB;
constexpr size_t WS_CKVM = 1 * MiB + 128 * 1024;
constexpr size_t WS_UM = 1 * MiB + 256 * 1024;
constexpr size_t WS_KVTM = 1 * MiB + 640 * 1024;
constexpr size_t WS_SSQ = 2 * MiB;
constexpr size_t WS_EW = 4 * MiB;
constexpr size_t WS_LIST = 5 * MiB;
constexpr size_t WS_W = 16 * MiB;
constexpr size_t WS_H0 = 72 * MiB;
constexpr size_t WS_QA = 136 * MiB;
constexpr size_t WS_KA = 168 * MiB;
constexpr size_t WS_VA = 177 * MiB;
constexpr size_t WS_CQ = 186 * MiB;
constexpr size_t WS_CKV = 202 * MiB;
constexpr size_t WS_KM = 218 * MiB;
constexpr size_t WS_VM = 267 * MiB;
constexpr size_t WS_QM = 300 * MiB;
constexpr size_t WS_AO = 348 * MiB;
constexpr size_t WS_HID = 412 * MiB;
constexpr size_t WS_PRE1 = 136 * MiB;
constexpr size_t WS_H1 = 264 * MiB;
constexpr size_t WS_Y = 72 * MiB;
constexpr size_t WS_TMP = 348 * MiB;
constexpr size_t WS_AN = 412 * MiB;
constexpr size_t WS_END = 512 * MiB;
constexpr int CW_CNT = 1024;

__constant__ float c_inv_freq[32] = {1.000000000e+00f, 7.498942614e-01f, 5.623413324e-01f, 4.216965139e-01f, 3.162277639e-01f, 2.371373773e-01f, 1.778279394e-01f, 1.333521307e-01f, 1.000000015e-01f, 7.498941571e-02f, 5.623413250e-02f, 4.216965288e-02f, 3.162277490e-02f, 2.371373773e-02f, 1.778279431e-02f, 1.333521493e-02f, 9.999999776e-03f, 7.498941850e-03f, 5.623413250e-03f, 4.216964822e-03f, 3.162277630e-03f, 2.371373586e-03f, 1.778279431e-03f, 1.333521446e-03f, 1.000000047e-03f, 7.498942432e-04f, 5.623413017e-04f, 4.216965172e-04f, 3.162277571e-04f, 2.371373703e-04f, 1.778279402e-04f, 1.333521504e-04f};

#ifndef ST_NT
#define ST_NT 0
#endif
#if ST_NT
#define ST16(p, v) __builtin_nontemporal_store((v), (u32x4*)(p))
#define ST16F(p, v) __builtin_nontemporal_store((v), (f32x4*)(p))
#else
#define ST16(p, v) (*(u32x4*)(p) = (v))
#define ST16F(p, v) (*(f32x4*)(p) = (v))
#endif
__device__ __forceinline__ float bf2f(bf16_t v) { return __uint_as_float((unsigned)v << 16); }
__device__ __forceinline__ unsigned f2bf(float f) { unsigned u = __float_as_uint(f); return (u + 0x7fffu + ((u >> 16) & 1u)) >> 16; }
__device__ __forceinline__ unsigned pk2(float lo, float hi) { return f2bf(lo) | (f2bf(hi) << 16); }
__device__ __forceinline__ int lane_id() { return (int)__builtin_amdgcn_mbcnt_hi(~0u, __builtin_amdgcn_mbcnt_lo(~0u, 0u)); }
__device__ __forceinline__ float wave_sum(float v) {
#pragma unroll
    for (int o = 1; o < 64; o <<= 1) v += __shfl_xor(v, o);
    return v;
}
__device__ __forceinline__ float wave_max(float v) {
#pragma unroll
    for (int o = 1; o < 64; o <<= 1) v = fmaxf(v, __shfl_xor(v, o));
    return v;
}
__device__ __forceinline__ void rope_cs(int pos, int i, float& c, float& s) {
    const double ang = (double)pos * (double)c_inv_freq[i];
    const double rev = ang * 0.15915494309189535;
    const float fr = (float)(rev - __builtin_rint(rev));
    s = __builtin_amdgcn_sinf(fr); c = __builtin_amdgcn_cosf(fr);
}


#define LAS __attribute__((address_space(3)))
#define GAS __attribute__((address_space(1)))
typedef short bf16x8 __attribute__((ext_vector_type(8)));
typedef float f32x2 __attribute__((ext_vector_type(2)));

constexpr size_t WS_CQS = 9 * MiB;
constexpr size_t WS_CKVS = 10 * MiB;
constexpr size_t WS_COS = 11 * MiB;
constexpr size_t WS_SIN = 13 * MiB;
constexpr size_t WS_WIN = 16 * MiB;
constexpr size_t WS_WUQ = 19 * MiB;
constexpr size_t WS_WUKV = 19 * MiB + 512 * 1024;
constexpr size_t WS_WO = 20 * MiB;
constexpr size_t WS_WGU = 22 * MiB;
constexpr size_t WS_WDN = 54 * MiB;
constexpr int NPOS = SEQ + NMETA;

namespace pg8 {
constexpr int BM = 256, BK = 64, HALF = 128, HTB = HALF * BK * 2, STAGE_BYTES = 8 * HTB, NXCD = 8, WGM = 8;
__host__ __device__ __forceinline__ int lds_byte(int r, int c) { const int st = (r >> 4) * 2 + (c >> 5), rr = r & 15, cc = c & 31, ob = rr * 64 + cc * 2; return st * 1024 + (ob ^ (((ob >> 9) & 1) << 5)); }
__host__ __device__ __forceinline__ void stage_rc(int b, int& R, int& C) { const int st = b / 1024, sb = b % 1024, swz = sb ^ (((sb >> 9) & 1) << 5); R = (st >> 1) * 16 + swz / 64; C = (st & 1) * 32 + (swz % 64) / 2; }
__host__ __device__ __forceinline__ int perm32(int rho) { const int n = rho >> 4, i = rho & 15; return 8 * (i >> 2) + 4 * n + (i & 3); }
struct Unit { int pm, pn, e, r0, n; };
typedef float f32x2_t __attribute__((ext_vector_type(2))); typedef __bf16 bf16x2_t __attribute__((ext_vector_type(2)));
__device__ __forceinline__ unsigned cvt_pk_bf16(float lo, float hi) { const f32x2_t v = {lo, hi}; const bf16x2_t b = __builtin_convertvector(v, bf16x2_t); return __builtin_bit_cast(unsigned, b); }
__device__ __forceinline__ u32x4 pack8(const f32x4 a, const f32x4 b) { u32x4 w; w.x = cvt_pk_bf16(a[0], a[1]); w.y = cvt_pk_bf16(a[2], a[3]); w.z = cvt_pk_bf16(b[0], b[1]); w.w = cvt_pk_bf16(b[2], b[3]); return w; }

template <class Epi, class Sched, bool ALIGN_EPI>
__device__ __forceinline__ void gemm_phase(LAS unsigned char* lds, const int K, const Sched& S, const Epi& E) {
    const int tid = threadIdx.x, wid = __builtin_amdgcn_readfirstlane(tid >> 6), lane = tid & 63, wr = wid >> 2, wc = wid & 3, fr = lane & 15, fq = lane >> 4;
    const int nt = K / BK;
    int Rr[2]; unsigned cof[2], voffB[2];
#pragma unroll
    for (int i = 0; i < 2; ++i) { int R, C; stage_rc(tid * 16 + i * 8192, R, C); Rr[i] = R; cof[i] = (unsigned)C * 2u; const int Rb = Epi::PERM ? ((R & ~31) + perm32(R & 31)) : R; voffB[i] = (unsigned)(Rb * K + C) * 2u; }
    const size_t kstep = (size_t)(BK * 2);
    const size_t hstepB = (size_t)HALF * K * 2;
    const unsigned ldsw = (unsigned)wid * 1024u;
    const int aoff = lds_byte(wr * 64 + fr, fq * 8), boff = lds_byte(wc * 32 + fr, fq * 8);
#define PG8_SA(b, h) (((b) * 2 + (h)) * HTB)
#define PG8_SB(b, h) ((4 + (b) * 2 + (h)) * HTB)
#define PG8_STAGE(bufoff, gbase, voff) do { _Pragma("unroll") for (int _i = 0; _i < 2; ++_i) \
        __builtin_amdgcn_global_load_lds((const unsigned*)((const char*)(gbase) + (voff)[_i]), (LAS unsigned*)(lds + (bufoff) + ldsw + _i * 8192), 16, 0, 0); } while (0)
#define PG8_LDA(dst, b, h) do { _Pragma("unroll") for (int m = 0; m < 4; ++m) _Pragma("unroll") for (int k = 0; k < 2; ++k) dst[m][k] = *(const LAS bf16x8*)(lds + PG8_SA(b, h) + aoff + m * 2048 + k * 1024); } while (0)
#define PG8_LDB(dst, b, h) do { _Pragma("unroll") for (int n = 0; n < 2; ++n) _Pragma("unroll") for (int k = 0; k < 2; ++k) dst[n][k] = *(const LAS bf16x8*)(lds + PG8_SB(b, h) + boff + n * 2048 + k * 1024); } while (0)
#define PG8_MMA(ai, bj, At, Bt) do { __builtin_amdgcn_s_setprio(1); _Pragma("unroll") for (int m = 0; m < 4; ++m) _Pragma("unroll") for (int n = 0; n < 2; ++n) _Pragma("unroll") for (int k = 0; k < 2; ++k) \
        acc[ai][bj][m][n] = __builtin_amdgcn_mfma_f32_16x16x32_bf16(Bt[n][k], At[m][k], acc[ai][bj][m][n], 0, 0, 0); __builtin_amdgcn_s_setprio(0); } while (0)
#define PG8_WAIT_V(n) asm volatile("s_waitcnt vmcnt(" #n ")" ::: "memory")
#define PG8_WAIT_L(n) asm volatile("s_waitcnt lgkmcnt(" #n ")" ::: "memory")
#define PG8_BAR __builtin_amdgcn_s_barrier()
#define PG8_SCHED __builtin_amdgcn_sched_barrier(0)
    Unit cur, nxt; int ui = 0;
    if (!S.next(0, cur)) return;
    f32x4 acc[2][2][4][2];
#pragma unroll
    for (int a = 0; a < 2; ++a)
#pragma unroll
        for (int b = 0; b < 2; ++b)
#pragma unroll
            for (int m = 0; m < 4; ++m)
#pragma unroll
                for (int n = 0; n < 2; ++n) acc[a][b][m][n] = (f32x4){0.f, 0.f, 0.f, 0.f};
    bf16x8 At[4][2], B0[2][2], B1[2][2];
    unsigned vA0[2], vA1[2], vN0[2], vN1[2];
#pragma unroll
    for (int i = 0; i < 2; ++i) { vA0[i] = S.arow_off(cur, Rr[i]) + cof[i]; vA1[i] = S.arow_off(cur, Rr[i] + HALF) + cof[i]; }
    const char* cA = S.abase(cur); const char* cB = S.bbase(cur);
    PG8_STAGE(PG8_SB(0, 0), cB, voffB); PG8_STAGE(PG8_SB(0, 1), cB + hstepB, voffB); PG8_STAGE(PG8_SA(0, 0), cA, vA0); PG8_STAGE(PG8_SA(0, 1), cA, vA1);
    if (wr == 1) PG8_BAR;
    PG8_WAIT_V(2); PG8_BAR;
    PG8_STAGE(PG8_SB(1, 0), cB + kstep, voffB); PG8_STAGE(PG8_SA(1, 0), cA + kstep, vA0); PG8_STAGE(PG8_SB(1, 1), cB + hstepB + kstep, voffB);
    PG8_WAIT_V(6); PG8_BAR;
    for (;;) {
        const bool has_next = S.next(ui + 1, nxt);
        const char* nA = has_next ? S.abase(nxt) : cA; const char* nB = has_next ? S.bbase(nxt) : cB;
#pragma unroll
        for (int i = 0; i < 2; ++i) { vN0[i] = has_next ? S.arow_off(nxt, Rr[i]) + cof[i] : vA0[i]; vN1[i] = has_next ? S.arow_off(nxt, Rr[i] + HALF) + cof[i] : vA1[i]; }
#pragma unroll 1
        for (int t = 0; t < nt; t += 2) {
            const bool last = (t == nt - 2);
            const char* a1 = cA + (size_t)(t + 1) * kstep;
            const char* a2 = last ? nA : cA + (size_t)(t + 2) * kstep; const char* b2 = last ? nB : cB + (size_t)(t + 2) * kstep;
            const char* a3 = a2 + kstep; const char* b3 = b2 + kstep;
            unsigned w0[2], w1[2];
#pragma unroll
            for (int i = 0; i < 2; ++i) { w0[i] = last ? vN0[i] : vA0[i]; w1[i] = last ? vN1[i] : vA1[i]; }
            PG8_LDB(B0, 0, 0); PG8_LDB(B1, 0, 1); PG8_SCHED; PG8_LDA(At, 0, 0); PG8_STAGE(PG8_SA(1, 1), a1, vA1);
            PG8_WAIT_V(8); PG8_WAIT_L(0); PG8_BAR; PG8_MMA(0, 0, At, B0); PG8_MMA(0, 1, At, B1); PG8_BAR; PG8_SCHED;
            PG8_LDA(At, 0, 1); PG8_STAGE(PG8_SB(0, 0), b2, voffB); PG8_STAGE(PG8_SB(0, 1), b2 + hstepB, voffB); PG8_STAGE(PG8_SA(0, 0), a2, w0);
            PG8_WAIT_V(8); PG8_WAIT_L(0); PG8_BAR; PG8_MMA(1, 0, At, B0); PG8_MMA(1, 1, At, B1); PG8_BAR; PG8_SCHED;
            PG8_LDB(B0, 1, 0); PG8_LDB(B1, 1, 1); PG8_SCHED; PG8_LDA(At, 1, 0); PG8_STAGE(PG8_SA(0, 1), a2, w1);
            PG8_WAIT_V(8); PG8_WAIT_L(0); PG8_BAR; PG8_MMA(0, 0, At, B0); PG8_MMA(0, 1, At, B1); PG8_BAR; PG8_SCHED;
            PG8_LDA(At, 1, 1); PG8_STAGE(PG8_SB(1, 0), b3, voffB); PG8_STAGE(PG8_SB(1, 1), b3 + hstepB, voffB); PG8_STAGE(PG8_SA(1, 0), a3, w0);
            PG8_WAIT_V(8); PG8_WAIT_L(0); PG8_BAR; PG8_MMA(1, 0, At, B0); PG8_MMA(1, 1, At, B1); PG8_BAR; PG8_SCHED;
            if constexpr (Epi::MIDK) { if (t + 2 == nt / 2) E.midk(acc, cur, wr, wc, fr, fq); }
        }
        if constexpr (ALIGN_EPI) { if (wr == 0) PG8_BAR; }
        E(acc, cur, wr, wc, fr, fq);
        if (!has_next) break;
#pragma unroll
        for (int a = 0; a < 2; ++a)
#pragma unroll
            for (int b = 0; b < 2; ++b)
#pragma unroll
                for (int m = 0; m < 4; ++m)
#pragma unroll
                    for (int n = 0; n < 2; ++n) acc[a][b][m][n] = (f32x4){0.f, 0.f, 0.f, 0.f};
        cur = nxt; cA = nA; cB = nB; ++ui;
#pragma unroll
        for (int i = 0; i < 2; ++i) { vA0[i] = vN0[i]; vA1[i] = vN1[i]; }
        if constexpr (ALIGN_EPI) { if (wr == 1) PG8_BAR; }
    }
    PG8_WAIT_V(0);
    if constexpr (!ALIGN_EPI) { if (wr == 0) PG8_BAR; }
    PG8_BAR;
#undef PG8_SA
#undef PG8_SB
#undef PG8_STAGE
#undef PG8_LDA
#undef PG8_LDB
#undef PG8_MMA
#undef PG8_WAIT_V
#undef PG8_WAIT_L
#undef PG8_BAR
#undef PG8_SCHED
}

struct StaticOrder {
    const char* A; const char* Bt; int K;
    int nM, nN, nwg, G, c;
    __device__ void init(const void* A_, const void* Bt_, int M, int N, int K_, int G_, int c_) { A = (const char*)A_; Bt = (const char*)Bt_; K = K_; nM = M / BM; nN = N / BM; nwg = nM * nN; G = G_; c = c_; }
    __device__ bool next(int i, Unit& u) const {
        const long L = (long)i * G + c; if (L >= nwg) return false;
        int wgid = (int)L; { const int q = nwg / NXCD, r = nwg % NXCD, xcd = wgid % NXCD, off = wgid / NXCD; wgid = (xcd < r ? xcd * (q + 1) : r * (q + 1) + (xcd - r) * q) + off; }
        const int nig = WGM * nN, gid = wgid / nig, fm = gid * WGM, gsz = (nM - fm) < WGM ? (nM - fm) : WGM;
        u.pm = fm + ((wgid % nig) % gsz); u.pn = (wgid % nig) / gsz; return true;
    }
    __device__ __forceinline__ const char* abase(const Unit& u) const { return A + (size_t)u.pm * BM * K * 2; }
    __device__ __forceinline__ const char* bbase(const Unit& u) const { return Bt + (size_t)u.pn * BM * K * 2; }
    __device__ __forceinline__ unsigned arow_off(const Unit&, int R) const { return (unsigned)(R * K) * 2u; }
};
}

#define XB_TMO      128
#define XB_XCNT(j)  (256  + 64 * (j))
#define XB_XSUB(j)  (1280 + 64 * (j))
#define XB_XGEN(j)  (2304 + 64 * (j))
#define XB_TOP      3328
#define XB_TOPGEN   3392
#define XCD_BAR_WORDS 3456
#define XB_SPIN_CAP (1u << 18)
__device__ __forceinline__ unsigned xb_ld(unsigned* p)              { return __hip_atomic_load(p, __ATOMIC_RELAXED, __HIP_MEMORY_SCOPE_AGENT); }
__device__ __forceinline__ unsigned xb_add(unsigned* p, unsigned v) { return __hip_atomic_fetch_add(p, v, __ATOMIC_RELAXED, __HIP_MEMORY_SCOPE_AGENT); }
__device__ __forceinline__ unsigned xb_xcc_id() { return (unsigned)__builtin_amdgcn_s_getreg((3 << 11) | 20) & 0xFu; }
#define XB_SPIN(cond, bar) do { unsigned _sp = 0; while (cond) { __builtin_amdgcn_s_sleep(1); \
    if ((++_sp & 255u) == 0u) { if (xb_ld(&(bar)[XB_TMO])) break; if (_sp > XB_SPIN_CAP) { atomicAdd(&(bar)[XB_TMO], 1u); break; } } } } while (0)
struct XcdBarrier { unsigned* bar; unsigned x; volatile LAS unsigned* st; };
__device__ __forceinline__ XcdBarrier xcd_barrier_post(unsigned* bar, volatile LAS unsigned* st) {
    XcdBarrier b; b.bar = bar; b.x = xb_xcc_id(); b.st = st;
    if (threadIdx.x == 0) (void)xb_add(&bar[XB_XCNT(b.x)], 1u);
    return b;
}
__device__ __forceinline__ void xcd_barrier_complete(unsigned* bar, unsigned x, unsigned& nloc, unsigned& nx) {
    const unsigned G = gridDim.x * gridDim.y * gridDim.z;
    unsigned sum, cnt, mine, sp = 0u;
    for (;;) {
        sum = 0u; cnt = 0u; mine = 0u;
#pragma unroll
        for (unsigned j = 0; j < 16; ++j) { const unsigned c = xb_ld(&bar[XB_XCNT(j)]); sum += c; cnt += (c > 0u) ? 1u : 0u; mine = (j == x) ? c : mine; }
        if (sum == G) break;
        __builtin_amdgcn_s_sleep(1);
        if ((++sp & 255u) == 0u) { if (xb_ld(&bar[XB_TMO])) break; if (sp > XB_SPIN_CAP) { atomicAdd(&bar[XB_TMO], 1u); break; } }
    }
    nloc = mine > 0u ? mine : 1u; nx = cnt > 0u ? cnt : 1u;
}
__device__ __forceinline__ void xcd_barrier(const XcdBarrier& b) {
    asm volatile("s_waitcnt vmcnt(0)" ::: "memory");
    __syncthreads();
    if (threadIdx.x == 0) {
        unsigned* bar = b.bar;
        __builtin_amdgcn_s_waitcnt(0);
        unsigned nloc = b.st[0], nx = b.st[1];
        if (nloc == 0u) { xcd_barrier_complete(bar, b.x, nloc, nx); b.st[0] = nloc; b.st[1] = nx; }
        const unsigned old = xb_add(&bar[XB_XSUB(b.x)], 1u);
        const unsigned gen = old / nloc;
        if (old + 1u == (gen + 1u) * nloc) {
            __builtin_amdgcn_fence(__ATOMIC_RELEASE, "agent");
            asm volatile("s_waitcnt vmcnt(0)" ::: "memory");
            const unsigned og = xb_add(&bar[XB_TOP], 1u);
            const unsigned tg = og / nx;
            if (og + 1u == (tg + 1u) * nx) xb_add(&bar[XB_TOPGEN], 1u);
            else XB_SPIN(xb_ld(&bar[XB_TOPGEN]) == tg, bar);
            __builtin_amdgcn_fence(__ATOMIC_ACQUIRE, "agent");
            xb_add(&bar[XB_XGEN(b.x)], 1u);
            asm volatile("s_waitcnt vmcnt(0)" ::: "memory");
        } else {
            XB_SPIN(xb_ld(&bar[XB_XGEN(b.x)]) == gen, bar);
            __builtin_amdgcn_fence(__ATOMIC_ACQUIRE, "agent");
            asm volatile("s_waitcnt vmcnt(0)" ::: "memory");
        }
    }
    __syncthreads();
}

constexpr int NWAVES = 8;
constexpr int RING_BYTES = 135168, LDSCTL_OFF = RING_BYTES, MISC_OFF = LDSCTL_OFF + 320, LDS_BYTES = 147456;
constexpr int CW_BAR = 4096;
#define LDS_WAIT() asm volatile("s_waitcnt lgkmcnt(0)" ::: "memory")
#define VM_WAIT() asm volatile("s_waitcnt vmcnt(0)" ::: "memory")

struct Args {
    const float* in[24]; float* out; unsigned char* ws; int ph_lo, ph_hi;
};
struct Frame {
    LAS unsigned char* lds; unsigned char* ws; unsigned* ctl;
    int tid, lane, wave, G, bx;
};

__device__ __forceinline__ void p0_tr_item(const float* __restrict__ W, int ldn, int c0, int k0, bf16_t* dst, int K, const float* __restrict__ sc0, const float* __restrict__ sc1, LAS float* scr, int lane) {
    if (c0 >= 0) {
        f32x4 v[8];
#pragma unroll
        for (int i = 0; i < 8; ++i) v[i] = *(const f32x4*)(W + (size_t)(k0 + 8 * i + (lane >> 3)) * ldn + c0 + (lane & 7) * 4);
#pragma unroll
        for (int i = 0; i < 8; ++i) { const int kk = 8 * i + (lane >> 3), k = k0 + kk; f32x4 x = v[i];
            if (sc0) x *= (k < 512 || !sc1) ? sc0[k] : sc1[k - 512];
            LAS float* s = scr + kk * 33 + (lane & 7) * 4; s[0] = x.x; s[1] = x.y; s[2] = x.z; s[3] = x.w; }
    } else {
#pragma unroll 8
        for (int i = 0; i < 32; ++i) { const int kk = 2 * i + (lane >> 5); scr[kk * 33 + (lane & 31)] = 0.f; }
    }
    LDS_WAIT(); asm volatile("" ::: "memory");
    const int c = lane & 7;
#pragma unroll
    for (int j = 0; j < 4; ++j) { const int n = (lane >> 3) + 8 * j; const LAS float* s = scr + (8 * c) * 33 + n;
        u32x4 o; o.x = pk2(s[0 * 33], s[1 * 33]); o.y = pk2(s[2 * 33], s[3 * 33]); o.z = pk2(s[4 * 33], s[5 * 33]); o.w = pk2(s[6 * 33], s[7 * 33]);
        ST16((dst + (size_t)n * K + k0 + 8 * c), o); }
    LDS_WAIT(); asm volatile("" ::: "memory");
}
__device__ __forceinline__ int win_src_col(int tile, int q) {
    if (tile <= 1) return 256 * tile + 64 * (q & 3) + ((q >> 2) ? 32 : 0);
    if (tile == 2) { const int tb[8] = {512, 576, 640, 672, 544, 608, 704, 736}; int r = tb[0];
#pragma unroll
        for (int i = 1; i < 8; ++i) r = (q == i) ? tb[i] : r; return r; }
    if (tile == 3) return 768 + 32 * q;
    if (tile == 4) return 1024 + 32 * q;
    return q == 0 ? 1280 : (q == 4 ? 1312 : -1);
}
__device__ __forceinline__ int wuq_src_col(int tile, int q) {
    if (tile <= 1) return (2 * tile + (q >> 2)) * 192 + 32 * (q & 3);
    return (q & 3) * 192 + 128 + ((q >> 2) ? 32 : 0);
}

__device__ __forceinline__ void ln_row_bf16(const float* __restrict__ src, const float* __restrict__ g, const float* __restrict__ b, bf16_t* dst, int lane) {
    f32x4 v[4]; float s = 0.f;
#pragma unroll
    for (int j = 0; j < 4; ++j) { v[j] = *(const f32x4*)(src + j * 256 + lane * 4); s += (v[j].x + v[j].y) + (v[j].z + v[j].w); }
    const float mean = wave_sum(s) * (1.f / DM); float s2 = 0.f;
#pragma unroll
    for (int j = 0; j < 4; ++j) { v[j] = v[j] - mean; s2 += (v[j].x * v[j].x + v[j].y * v[j].y) + (v[j].z * v[j].z + v[j].w * v[j].w); }
    const float rstd = 1.f / sqrtf(wave_sum(s2) * (1.f / DM) + LN_EPS);
#pragma unroll
    for (int j = 0; j < 4; ++j) { const int c = j * 256 + lane * 4; const f32x4 gg = *(const f32x4*)(g + c), bb = *(const f32x4*)(b + c);
        const f32x4 o = v[j] * rstd * gg + bb; u32x2 w; w.x = pk2(o.x, o.y); w.y = pk2(o.z, o.w); *(u32x2*)(dst + c) = w; }
}

__device__ __forceinline__ bf16x8 ld_bcol8(const float* __restrict__ W, int ldn, int k0, int col) {
    float x[8];
#pragma unroll
    for (int j = 0; j < 8; ++j) x[j] = W[(size_t)(k0 + j) * ldn + col];
    u32x4 w; w.x = pk2(x[0], x[1]); w.y = pk2(x[2], x[3]); w.z = pk2(x[4], x[5]); w.w = pk2(x[6], x[7]);
    return __builtin_bit_cast(bf16x8, w);
}
__device__ __forceinline__ void p0_meta_block(const Frame& F, const Args& a, const int blk) {
    constexpr int RSH = 1032;
    LAS bf16_t* hm = (LAS bf16_t*)(F.lds);
    LAS float* pc = (LAS float*)(F.lds + 33280);
    const int lane = F.lane, w = F.wave, fr = lane & 15, fq = lane >> 4;
    const float* meta = a.in[1]; const float* g = a.in[2]; const float* b = a.in[3]; const float* w_in = a.in[4];
    float* UM = (float*)(F.ws + WS_UM);
#pragma unroll 1
    for (int rr = 0; rr < 2; ++rr) { const int row = 2 * w + rr; const float* src = meta + (size_t)row * DM;
        f32x4 v[4]; float s = 0.f;
#pragma unroll
        for (int j = 0; j < 4; ++j) { v[j] = *(const f32x4*)(src + j * 256 + lane * 4); s += (v[j].x + v[j].y) + (v[j].z + v[j].w); }
        const float mean = wave_sum(s) * (1.f / DM); float s2 = 0.f;
#pragma unroll
        for (int j = 0; j < 4; ++j) { v[j] = v[j] - mean; s2 += (v[j].x * v[j].x + v[j].y * v[j].y) + (v[j].z * v[j].z + v[j].w * v[j].w); }
        const float rstd = 1.f / sqrtf(wave_sum(s2) * (1.f / DM) + LN_EPS);
#pragma unroll
        for (int j = 0; j < 4; ++j) { const int c = j * 256 + lane * 4; const f32x4 gg = *(const f32x4*)(g + c), bb = *(const f32x4*)(b + c); const f32x4 o = v[j] * rstd * gg + bb;
            u32x2 pw; pw.x = pk2(o.x, o.y); pw.y = pk2(o.z, o.w); *(LAS u32x2*)(hm + row * RSH + c) = pw; } }
    __syncthreads();
    const int col = (blk < 16 ? 512 + 16 * blk : (blk < 32 ? 1024 + 16 * (blk - 16) : 1280 + 16 * (blk - 32))) + fr;
    bf16x8 bv[4];
#pragma unroll
    for (int s = 0; s < 4; ++s) bv[s] = ld_bcol8(w_in, INC, 32 * (4 * w + s) + 8 * fq, col);
    f32x4 c = {0.f, 0.f, 0.f, 0.f};
#pragma unroll
    for (int s = 0; s < 4; ++s) { const bf16x8 av = *(const LAS bf16x8*)(hm + fr * RSH + 32 * (4 * w + s) + 8 * fq); c = __builtin_amdgcn_mfma_f32_16x16x32_bf16(av, bv[s], c, 0, 0, 0); }
#pragma unroll
    for (int j = 0; j < 4; ++j) pc[w * 256 + (fq * 4 + j) * 16 + fr] = c[j];
    __syncthreads();
    if (F.tid < 256) { float sum = 0.f;
#pragma unroll
        for (int q = 0; q < 8; ++q) sum += pc[q * 256 + F.tid];
        const int oc = (blk < 16 ? 16 * blk : (blk < 32 ? 256 + 16 * (blk - 16) : 512 + 16 * (blk - 32))) + (F.tid & 15);
        UM[(F.tid >> 4) * 576 + oc] = sum; }
    __syncthreads();
}
__device__ __forceinline__ void p2_meta(const Frame& F, const Args& a, const int q) {
    const int lane = F.lane, w = F.wave, fr = lane & 15, fq = lane >> 4;
    const float* UM = (const float*)(F.ws + WS_UM); const float* gkv = a.in[8]; const float* w_ukv = a.in[9];
    bf16_t* KA = (bf16_t*)(F.ws + WS_KA); bf16_t* VA = (bf16_t*)(F.ws + WS_VA); bf16_t* KM = (bf16_t*)(F.ws + WS_KM); bf16_t* VM = (bf16_t*)(F.ws + WS_VM);
    if (q < 64) {
        LAS float* rs = (LAS float*)(F.lds); LAS float* pc = (LAS float*)(F.lds + 256);
#pragma unroll 1
        for (int rr = 0; rr < 2; ++rr) { const int row = 2 * w + rr; float ss = 0.f;
#pragma unroll
            for (int j = 0; j < 4; ++j) { const float v = UM[row * 576 + 256 + 64 * j + lane]; ss += v * v; }
            ss = wave_sum(ss); if (lane == 0) rs[row] = 1.f / sqrtf(ss * (1.f / 256.f) + RMS_EPS); }
        const bf16x8 bv = ld_bcol8(w_ukv, 1024, 32 * w + 8 * fq, 16 * q + fr);
        __syncthreads();
        float x[8]; const float r_ = rs[fr];
#pragma unroll
        for (int j = 0; j < 8; ++j) { const int k = 32 * w + 8 * fq + j; x[j] = UM[fr * 576 + 256 + k] * r_ * gkv[k]; }
        u32x4 aw; aw.x = pk2(x[0], x[1]); aw.y = pk2(x[2], x[3]); aw.z = pk2(x[4], x[5]); aw.w = pk2(x[6], x[7]);
        f32x4 c = {0.f, 0.f, 0.f, 0.f};
        c = __builtin_amdgcn_mfma_f32_16x16x32_bf16(__builtin_bit_cast(bf16x8, aw), bv, c, 0, 0, 0);
#pragma unroll
        for (int j = 0; j < 4; ++j) pc[w * 256 + (fq * 4 + j) * 16 + fr] = c[j];
        __syncthreads();
        if (F.tid < 256) { float sum = 0.f;
#pragma unroll
            for (int p = 0; p < 8; ++p) sum += pc[p * 256 + F.tid];
            const int r = F.tid >> 4, col = 16 * q + (F.tid & 15), h = col >> 8, cc = col & 255; const bf16_t hv = (bf16_t)f2bf(sum);
            for (int b2 = 0; b2 < NB; ++b2) { const size_t prow = (size_t)b2 * LP + NPAD + r;
                if (cc < 128) KM[prow * 768 + h * 192 + cc] = hv; else VM[prow * 512 + h * 128 + (cc - 128)] = hv; } }
        __syncthreads();
    } else {
        const int idx = (q - 64) * 256 + F.tid;
        if (F.tid < 256 && idx < 16 * 320) { const int r = idx / 320, c = idx % 320;
            const int oc = c < 256 ? c : c + 256; float v = UM[r * 576 + oc];
            if (c < 128 || c >= 256) { const float p = UM[r * 576 + (oc ^ 32)]; float cs, sn; rope_cs(r, c & 31, cs, sn); v = (c & 32) ? v * cs + p * sn : v * cs - p * sn; }
            const bf16_t hv = (bf16_t)f2bf(v);
            for (int b2 = 0; b2 < NB; ++b2) { const size_t prow = (size_t)b2 * LP + NPAD + r;
                if (c < 128) KA[prow * 128 + c] = hv; else if (c < 256) VA[prow * 128 + (c - 128)] = hv;
                else { const int cc = c - 256; KM[prow * 768 + 128 + cc] = hv; KM[prow * 768 + 192 + 128 + cc] = hv; KM[prow * 768 + 384 + 128 + cc] = hv; KM[prow * 768 + 576 + 128 + cc] = hv; } } }
    }
}

__device__ __forceinline__ void moe_wconv(LAS unsigned char* lds, unsigned char* ws, const float* wgate, const float* wup, const float* wdown, int wave, int lane, int widx, int nw) {
    LAS float* scr = (LAS float*)(lds + wave * 16384);
    constexpr int I_GU = 32 * 16 * 16, I_DN = 32 * 4 * 32;
    for (int it = widx; it < I_GU + I_DN; it += nw) {
        if (it < I_GU) { const int e = it / 256, r2 = it % 256, kb = r2 / 16, nb = r2 % 16; const int tile = nb >> 3, q = nb & 7;
            const float* src = (q < 4 ? wgate : wup) + (size_t)e * DM * 256;
            p0_tr_item(src, 256, 128 * tile + 32 * (q & 3), 64 * kb, (bf16_t*)(ws + WS_WGU) + ((size_t)e * 512 + 32 * nb) * DM, DM, nullptr, nullptr, scr, lane); }
        else { const int r = it - I_GU; const int e = r / 128, r2 = r % 128, kb = r2 / 32, nb = r2 % 32;
            p0_tr_item(wdown + (size_t)e * 256 * DM, DM, 32 * nb, 64 * kb, (bf16_t*)(ws + WS_WDN) + ((size_t)e * 1024 + 32 * nb) * 256, 256, nullptr, nullptr, scr, lane); }
    }
}
__device__ __forceinline__ void p0_prologue(const Frame& F, const Args& a) {
    for (int blk = F.bx; blk < 36; blk += F.G) p0_meta_block(F, a, blk);
    LAS float* scr = (LAS float*)(F.lds + F.wave * 16384);
    const int gw = F.bx * NWAVES + F.wave, NGW = F.G * NWAVES, lane = F.lane;
    unsigned char* ws = F.ws;
    constexpr int I_IN = 16 * 48, I_UQ = 4 * 24, I_UKV = 4 * 32, I_O = 16 * 32;
    constexpr int NITEMS = I_IN + I_UQ + I_UKV + I_O;
    for (int it = gw; it < NITEMS; it += NGW) {
        int r = it;
        if (r < I_IN) { const int kb = r / 48, nb = r % 48; p0_tr_item(a.in[4], INC, win_src_col(nb >> 3, nb & 7), 64 * kb, (bf16_t*)(ws + WS_WIN) + (size_t)(32 * nb) * DM, DM, nullptr, nullptr, scr, lane); continue; } r -= I_IN;
        if (r < I_UQ) { const int kb = r / 24, nb = r % 24; p0_tr_item(a.in[7], 768, wuq_src_col(nb >> 3, nb & 7), 64 * kb, (bf16_t*)(ws + WS_WUQ) + (size_t)(32 * nb) * 256, 256, a.in[6], nullptr, scr, lane); continue; } r -= I_UQ;
        if (r < I_UKV) { const int kb = r / 32, nb = r % 32; p0_tr_item(a.in[9], 1024, 32 * nb, 64 * kb, (bf16_t*)(ws + WS_WUKV) + (size_t)(32 * nb) * 256, 256, a.in[8], nullptr, scr, lane); continue; } r -= I_UKV;
        { const int kb = r / 32, nb = r % 32; p0_tr_item(a.in[12], DM, 32 * nb, 64 * kb, (bf16_t*)(ws + WS_WO) + (size_t)(32 * nb) * DM, DM, a.in[10], a.in[11], scr, lane); }
    }
    { float* COS = (float*)(ws + WS_COS); float* SIN = (float*)(ws + WS_SIN);
      for (int it = gw; it < NPOS * 32 / 64; it += NGW) { const int idx = it * 64 + lane; float c, s; rope_cs(idx >> 5, idx & 31, c, s); COS[idx] = c; SIN[idx] = s; } }
    for (int it = gw; it < NB * NPAD; it += NGW) { const size_t prow = (size_t)(it / NPAD) * LP + (it % NPAD);
        const u32x4 z = {0u, 0u, 0u, 0u};
        for (int o = lane * 16; o < 3072; o += 1024) {
            unsigned char* p;
            if (o < 256) p = ws + WS_KA + prow * 256 + o; else if (o < 512) p = ws + WS_VA + prow * 256 + (o - 512 + 256);
            else if (o < 2048) p = ws + WS_KM + prow * 1536 + (o - 512); else p = ws + WS_VM + prow * 1024 + (o - 2048);
            ST16(p, z); } }
    { const float* x = a.in[0]; const float* g = a.in[2]; const float* b = a.in[3]; bf16_t* H0 = (bf16_t*)(ws + WS_H0);
      for (int m = gw; m < T; m += 2 * NGW) {
        const int m2 = m + NGW; const bool two = m2 < T;
        f32x4 v[2][4]; float s[2] = {0.f, 0.f};
#pragma unroll
        for (int j = 0; j < 4; ++j) { v[0][j] = *(const f32x4*)(x + (size_t)m * DM + j * 256 + lane * 4); v[1][j] = two ? *(const f32x4*)(x + (size_t)m2 * DM + j * 256 + lane * 4) : (f32x4){0.f, 0.f, 0.f, 0.f}; }
#pragma unroll
        for (int q = 0; q < 2; ++q)
#pragma unroll
            for (int j = 0; j < 4; ++j) s[q] += (v[q][j].x + v[q][j].y) + (v[q][j].z + v[q][j].w);
#pragma unroll
        for (int q = 0; q < 2; ++q) { if (q == 1 && !two) break;
            const float mean = wave_sum(s[q]) * (1.f / DM); float s2 = 0.f;
#pragma unroll
            for (int j = 0; j < 4; ++j) { v[q][j] = v[q][j] - mean; s2 += (v[q][j].x * v[q][j].x + v[q][j].y * v[q][j].y) + (v[q][j].z * v[q][j].z + v[q][j].w * v[q][j].w); }
            const float rstd = 1.f / sqrtf(wave_sum(s2) * (1.f / DM) + LN_EPS);
            bf16_t* dstp = H0 + (size_t)(q ? m2 : m) * DM;
#pragma unroll
            for (int j = 0; j < 4; ++j) { const int c = j * 256 + lane * 4; const f32x4 gg = *(const f32x4*)(g + c), bb = *(const f32x4*)(b + c);
                const f32x4 o = v[q][j] * rstd * gg + bb; u32x2 w2; w2.x = pk2(o.x, o.y); w2.y = pk2(o.z, o.w); *(u32x2*)(dstp + c) = w2; } }
      } }
}

__device__ __forceinline__ void rope8(const f32x4 lo0, const f32x4 lo1, const f32x4 hi0, const f32x4 hi1, const float* __restrict__ cosr, const float* __restrict__ sinr, u32x4& olo, u32x4& ohi, float scale) {
    const f32x4 c0 = *(const f32x4*)cosr, c1 = *(const f32x4*)(cosr + 4), s0 = *(const f32x4*)sinr, s1 = *(const f32x4*)(sinr + 4);
    olo = pg8::pack8((lo0 * c0 - hi0 * s0) * scale, (lo1 * c1 - hi1 * s1) * scale);
    ohi = pg8::pack8((hi0 * c0 + lo0 * s0) * scale, (hi1 * c1 + lo1 * s1) * scale);
}
struct EpiInProj {
    static constexpr bool PERM = true, MIDK = false;
    unsigned char* ws;
    __device__ __forceinline__ void operator()(const f32x4 (&acc)[2][2][4][2], const pg8::Unit& u, int wr, int wc, int fr, int fq) const {
        const int pn = u.pn, bb = u.pm >> 5, t0 = (u.pm & 31) * 256 + wr * 64 + fr;
        const float* COS = (const float*)(ws + WS_COS); const float* SIN = (const float*)(ws + WS_SIN);
        const int j0 = 8 * fq;
#pragma unroll
        for (int ai = 0; ai < 2; ++ai)
#pragma unroll
            for (int m = 0; m < 4; ++m) {
                const int t = t0 + ai * 128 + m * 16; const size_t mrow = (size_t)bb * SEQ + t; const size_t prow = (size_t)bb * LP + 128 + t; const int pos = t + NMETA;
                const f32x4 a00 = acc[ai][0][m][0], a01 = acc[ai][0][m][1], a10 = acc[ai][1][m][0], a11 = acc[ai][1][m][1];
                if (pn <= 1) { u32x4 lo, hi; rope8(a00, a01, a10, a11, COS + pos * 32 + j0, SIN + pos * 32 + j0, lo, hi, 1.f);
                    bf16_t* q = (bf16_t*)(ws + WS_QA) + mrow * 512 + (4 * pn + wc) * 64 + j0; ST16(q, lo); ST16((q + 32), hi); }
                else if (pn == 2) {
                    if (wc < 2) { u32x4 lo, hi; rope8(a00, a01, a10, a11, COS + pos * 32 + j0, SIN + pos * 32 + j0, lo, hi, 1.f);
                        bf16_t* k = (bf16_t*)(ws + WS_KA) + prow * 128 + wc * 64 + j0; ST16(k, lo); ST16((k + 32), hi); }
                    else { bf16_t* v = (bf16_t*)(ws + WS_VA) + prow * 128 + 32 * (wc - 2) + j0; ST16(v, pg8::pack8(a00, a01)); ST16((v + 64), pg8::pack8(a10, a11)); } }
                else if (pn <= 4) {
                    bf16_t* c = (bf16_t*)(ws + (pn == 3 ? WS_CQ : WS_CKV)) + mrow * 256 + 32 * wc + j0; ST16(c, pg8::pack8(a00, a01)); ST16((c + 128), pg8::pack8(a10, a11));
                    const f32x4 q = a00 * a00 + a01 * a01 + a10 * a10 + a11 * a11; float s = (q[0] + q[1]) + (q[2] + q[3]);
                    s += __shfl_xor(s, 16); s += __shfl_xor(s, 32);
                    if (fq == 0) ((float*)(ws + (pn == 3 ? WS_CQS : WS_CKVS)))[mrow * 4 + wc] = s; }
                else { if (wc == 0) { u32x4 lo, hi; rope8(a00, a01, a10, a11, COS + pos * 32 + j0, SIN + pos * 32 + j0, lo, hi, 1.f);
                        bf16_t* k = (bf16_t*)(ws + WS_KM) + prow * 768 + 128 + j0;
#pragma unroll
                        for (int h = 0; h < 4; ++h) { ST16((k + h * 192), lo); ST16((k + h * 192 + 32), hi); } } }
            }
    }
};

struct UpOrder {
    const char* CQ; const char* CKV; const char* Wq; const char* Wkv; int G, c;
    __device__ bool next(int i, pg8::Unit& u) const {
        if (G % 8 == 0) { const int x = c & 7, slot = c >> 3, ns = G >> 3; const int j = i * ns + slot;
            if (j >= 112) return false;
            if (j < 48) { u.pm = x + 8 * (j / 3); u.pn = j % 3; } else { const int j2 = j - 48; u.pm = x + 8 * (j2 >> 2); u.pn = 3 + (j2 & 3); }
            return true; }
        int L = i * G + c; if (L >= 896) return false;
        if (L < 384) { u.pm = L / 3; u.pn = L % 3; } else { L -= 384; u.pm = L >> 2; u.pn = 3 + (L & 3); }
        return true;
    }
    __device__ __forceinline__ const char* abase(const pg8::Unit& u) const { return (u.pn < 3 ? CQ : CKV) + (size_t)u.pm * 256 * 256 * 2; }
    __device__ __forceinline__ const char* bbase(const pg8::Unit& u) const { return u.pn < 3 ? Wq + (size_t)u.pn * 256 * 256 * 2 : Wkv + (size_t)(u.pn - 3) * 256 * 256 * 2; }
    __device__ __forceinline__ unsigned arow_off(const pg8::Unit&, int R) const { return (unsigned)(R * 256) * 2u; }
};
struct EpiUp {
    static constexpr bool PERM = true, MIDK = false;
    unsigned char* ws;
    __device__ __forceinline__ void operator()(const f32x4 (&acc)[2][2][4][2], const pg8::Unit& u, int wr, int wc, int fr, int fq) const {
        const int pn = u.pn, bb = u.pm >> 5, tb = (u.pm & 31) * 256;
        const size_t m0 = (size_t)bb * SEQ + tb, p0 = (size_t)bb * LP + 128 + tb;
        const char* COSb = (const char*)(ws + WS_COS) + (size_t)(tb + NMETA) * 128; const char* SINb = (const char*)(ws + WS_SIN) + (size_t)(tb + NMETA) * 128;
        const char* SSb = (const char*)(ws + (pn < 3 ? WS_CQS : WS_CKVS)) + m0 * 16;
        char* QMb = (char*)(ws + WS_QM) + m0 * 1536; char* KMb = (char*)(ws + WS_KM) + p0 * 1536; char* VMb = (char*)(ws + WS_VM) + p0 * 1024;
        int rl = wr * 64 + fr; asm volatile("" : "+v"(rl));
        const int j0 = 8 * fq;
        f32x4 sv[8];
#pragma unroll
        for (int q = 0; q < 8; ++q) sv[q] = *(const f32x4*)(SSb + (size_t)((unsigned)(rl + (q >> 2) * 128 + (q & 3) * 16) * 16u));
#pragma unroll
        for (int ai = 0; ai < 2; ++ai)
#pragma unroll
            for (int m = 0; m < 4; ++m) {
                const unsigned r = (unsigned)(rl + ai * 128 + m * 16); const f32x4 s4 = sv[ai * 4 + m];
                const float rstd = 1.f / sqrtf(((s4[0] + s4[1]) + (s4[2] + s4[3])) * (1.f / 256.f) + RMS_EPS);
                const f32x4 a00 = acc[ai][0][m][0] * rstd, a01 = acc[ai][0][m][1] * rstd, a10 = acc[ai][1][m][0] * rstd, a11 = acc[ai][1][m][1] * rstd;
                if (pn < 2) { char* q = QMb + (size_t)(r * 1536u + (unsigned)(((2 * pn) * 192 + 32 * wc + j0) * 2)); ST16(q, pg8::pack8(a00, a01)); ST16((q + 384), pg8::pack8(a10, a11)); }
                else if (pn == 2) { u32x4 lo, hi; const unsigned co = r * 128u + (unsigned)(j0 * 4); rope8(a00, a01, a10, a11, (const float*)(COSb + (size_t)co), (const float*)(SINb + (size_t)co), lo, hi, 1.f);
                    char* q = QMb + (size_t)(r * 1536u + (unsigned)((wc * 192 + 128 + j0) * 2)); ST16(q, lo); ST16((q + 64), hi); }
                else { const int h = pn - 3;
                    ST16(KMb + (size_t)(r * 1536u + (unsigned)((h * 192 + 32 * wc + j0) * 2)), pg8::pack8(a00, a01));
                    ST16(VMb + (size_t)(r * 1024u + (unsigned)((h * 128 + 32 * wc + j0) * 2)), pg8::pack8(a10, a11)); }
            }
    }
};

#ifndef ATT_PIPE
#define ATT_PIPE 0
#endif
#ifndef ATT_QKT_PF
#define ATT_QKT_PF 3
#endif
#ifndef ATT_QKT_GROUP
#define ATT_QKT_GROUP 0
#endif
#ifndef ATT_PF0
#define ATT_PF0 4
#endif
#ifndef ATT_HALF
#define ATT_HALF 0
#endif
#ifndef ATT_DMA
#define ATT_DMA 1
#endif
#ifndef ATT_SKEW_SWA
#define ATT_SKEW_SWA 0
#endif
#ifndef ATT_SKEW
#define ATT_SKEW 1
#endif
namespace att {
typedef short s16x4 __attribute__((ext_vector_type(4)));
typedef float f32x16 __attribute__((ext_vector_type(16)));
constexpr int NW = 8, QBLK = 32, KVBLK = 64, QB = NW * QBLK;
#define SBAR() __builtin_amdgcn_sched_barrier(0)
__device__ __forceinline__ int crow(int r, int hi) { return (r & 3) + 8 * (r >> 2) + 4 * hi; }
typedef float f32x2_t __attribute__((ext_vector_type(2))); typedef __bf16 bf16x2_t __attribute__((ext_vector_type(2)));
__device__ __forceinline__ unsigned cvtpk(float lo, float hi) { const f32x2_t v = {lo, hi}; const bf16x2_t b = __builtin_convertvector(v, bf16x2_t); return __builtin_bit_cast(unsigned, b); }
__device__ __forceinline__ int v_rd_base(int lane) { return ((lane & 3) << 3) | (((lane >> 2) & 3) << 6) | (((lane >> 4) & 1) << 5) | (((lane >> 5) & 1) << 8); }

__device__ __forceinline__ void glds16s(const void* sbase, unsigned voff, unsigned lds_dst) {
    unsigned keep;
    asm volatile("s_mov_b32 %0, m0\n\ts_mov_b32 m0, %3\n\ts_nop 0\n\tglobal_load_lds_dwordx4 %1, %2\n\ts_mov_b32 m0, %0" : "=&s"(keep) : "v"(voff), "s"(sbase), "s"(lds_dst) : "memory");
}
template <int DQK_, int DV_, int LDQ_, int LDK_, int LDV_, int W_, bool SK_, int NPARK_>
struct Cfg {
    static constexpr int DQK = DQK_, DV = DV_, LDQ = LDQ_, LDK = LDK_, LDV = LDV_, W = W_; static constexpr bool SK = SK_;
    static constexpr int ROWB = DQK * 2, SHM_K = KVBLK * ROWB, SHM_V = KVBLK * DV * 2;
    static constexpr int KCPR = DQK / 8, VCPR = DV / 8, NKC = KVBLK * KCPR / 512, NVC = KVBLK * VCPR / 512, KG = (DV / 32) * 512, NQF = DQK / 16, NOF = DV / 32;
    static constexpr int NPARK = NPARK_, NQR = DQK_ / 16 - NPARK_;
    static constexpr int WS_OFF = 2 * SHM_V + 2 * SHM_K, PARK_OFF = WS_OFF + NW * 64 * 4, LDS_BYTES = PARK_OFF + NW * NPARK_ * 1024;
};
template <class C> struct BlockRef { const bf16_t* Q; const bf16_t* K; const bf16_t* V; bf16_t* O; float* SSQ; int P0; float m0, l0, c2; };
template <class C> struct Seam { bf16x8 qr[C::NQR]; bf16x8 st_k[C::NKC]; bf16x8 st_v[C::NVC]; };

__device__ __forceinline__ void mask_tile(f32x16& p0, f32x16& p1, int dq, unsigned W, int klim) {
    const float NEG = -__builtin_inff();
#pragma unroll
    for (int r = 0; r < 16; ++r) {
        const int c = (r & 3) + 8 * (r >> 2);
        if ((unsigned)(dq - c) >= W || c < klim) p0[r] = NEG;
        if ((unsigned)(dq - c - 32) >= W || c + 32 < klim) p1[r] = NEG;
    }
}
__device__ __forceinline__ void partialSM(f32x16& p0, f32x16& p1, float& m_reg, float& mn, float& alpha, float c2, float thr) {
    float t[8];
#pragma unroll
    for (int i = 0; i < 8; ++i) t[i] = fmaxf(fmaxf(p0[2 * i], p0[2 * i + 1]), fmaxf(p1[2 * i], p1[2 * i + 1]));
    float pmax = fmaxf(fmaxf(fmaxf(t[0], t[1]), fmaxf(t[2], t[3])), fmaxf(fmaxf(t[4], t[5]), fmaxf(t[6], t[7])));
    { auto rr = __builtin_amdgcn_permlane32_swap(__float_as_uint(pmax), __float_as_uint(pmax), false, false);
      pmax = fmaxf(__uint_as_float(rr[0]), __uint_as_float(rr[1])); }
    if (__builtin_expect(__all((pmax - m_reg) <= thr), 1)) { mn = m_reg; alpha = 1.f; }
    else { mn = fmaxf(m_reg, pmax); alpha = __builtin_amdgcn_exp2f((m_reg - mn) * c2); m_reg = mn; }
    const float mnL = -mn * c2;
#pragma unroll
    for (int r = 0; r < 16; ++r) p0[r] = fmaf(p0[r], c2, mnL);
#pragma unroll
    for (int r = 0; r < 16; ++r) p1[r] = fmaf(p1[r], c2, mnL);
#pragma unroll
    for (int r = 0; r < 16; ++r) p0[r] = __builtin_amdgcn_exp2f(p0[r]);
}
__device__ __forceinline__ void finishSM(f32x16& p0, f32x16& p1, float alpha, float& l_reg, bf16x8& pa0, bf16x8& pa1, bf16x8& pa2, bf16x8& pa3) {
#pragma unroll
    for (int r = 0; r < 16; ++r) p1[r] = __builtin_amdgcn_exp2f(p1[r]);
    float s[8];
#pragma unroll
    for (int i = 0; i < 8; ++i) s[i] = (p0[2 * i] + p0[2 * i + 1]) + (p1[2 * i] + p1[2 * i + 1]);
    float ps = ((s[0] + s[1]) + (s[2] + s[3])) + ((s[4] + s[5]) + (s[6] + s[7]));
    { auto rr = __builtin_amdgcn_permlane32_swap(__float_as_uint(ps), __float_as_uint(ps), false, false);
      ps = __uint_as_float(rr[0]) + __uint_as_float(rr[1]); }
    l_reg = l_reg * alpha + ps;
#define PK4(P, B_, OUT) do { unsigned a0 = cvtpk(P[B_+0], P[B_+1]), a1 = cvtpk(P[B_+2], P[B_+3]);                          \
        unsigned b0 = cvtpk(P[B_+4], P[B_+5]), b1 = cvtpk(P[B_+6], P[B_+7]);                                             \
        auto r0 = __builtin_amdgcn_permlane32_swap(a0, b0, false, false); auto r1 = __builtin_amdgcn_permlane32_swap(a1, b1, false, false); \
        u32x4 w = {r0[0], r1[0], r0[1], r1[1]}; OUT = *reinterpret_cast<bf16x8*>(&w); } while (0)
    PK4(p0, 0, pa0); PK4(p0, 8, pa1); PK4(p1, 0, pa2); PK4(p1, 8, pa3);
#undef PK4
}
template <class C, int D0, int PF> struct QktSched { static __device__ __forceinline__ void run() {
    __builtin_amdgcn_sched_group_barrier(0x008, 2, 0);
    if constexpr (D0 + PF < C::NQF) __builtin_amdgcn_sched_group_barrier(0x100, 2 + ((D0 + PF >= C::NQR) ? 1 : 0), 0);
    if constexpr (D0 + 1 < C::NQF) QktSched<C, D0 + 1, PF>::run(); } };
template <class C, int KB>
__device__ __forceinline__ void qkt(f32x16& p0, f32x16& p1, const char* K_lds, int r32, int hi, const bf16x8* qr, const char* qpark, bool act) {
    if (C::SK && !act) { const float NEG = -__builtin_inff();
#pragma unroll
        for (int r = 0; r < 16; ++r) { p0[r] = NEG; p1[r] = NEG; } return; }
    p0 = f32x16{}; p1 = f32x16{};
    const char* kb[4];
#pragma unroll
    for (int dd = 0; dd < 4; ++dd) kb[dd] = K_lds + KB * C::SHM_K + r32 * C::ROWB + (((dd * 16 + hi * 8) * 2) ^ (((r32 >> 1) & 7) << 4));
#pragma unroll
    for (int d0 = 0; d0 < C::NQF; ++d0) { const char* a = kb[d0 & 3] + (d0 >> 2) * 128;
        bf16x8 b0 = *reinterpret_cast<const bf16x8*>(a);
        bf16x8 b1 = *reinterpret_cast<const bf16x8*>(a + 32 * C::ROWB);
        bf16x8 qf; if (d0 < C::NQR) qf = qr[d0 < C::NQR ? d0 : 0]; else qf = *reinterpret_cast<const bf16x8*>(qpark + (d0 - C::NQR) * 1024);
        p0 = __builtin_amdgcn_mfma_f32_32x32x16_bf16(b0, qf, p0, 0, 0, 0);
        p1 = __builtin_amdgcn_mfma_f32_32x32x16_bf16(b1, qf, p1, 0, 0, 0);
        if (ATT_QKT_GROUP && C::NQF > 8 && (d0 & 3) == 3) SBAR(); }
#if ATT_QKT_PF > 0
    { constexpr int PF = ATT_QKT_PF < C::NQF ? ATT_QKT_PF : C::NQF;
      __builtin_amdgcn_sched_group_barrier(0x100, 2 * PF + ((PF > C::NQR) ? (PF - C::NQR) : 0), 0);
      QktSched<C, 0, PF>::run(); }
#endif
}
template <class C, int D0, int PF> struct QktSchedD { static __device__ __forceinline__ void run() {
    __builtin_amdgcn_sched_group_barrier(0x008, 1, 0); __builtin_amdgcn_sched_group_barrier(0x400, 2, 0); __builtin_amdgcn_sched_group_barrier(0x002, 3, 0);
    __builtin_amdgcn_sched_group_barrier(0x008, 1, 0); __builtin_amdgcn_sched_group_barrier(0x400, 1, 0); __builtin_amdgcn_sched_group_barrier(0x002, 3, 0);
    if constexpr (D0 + PF < C::NQF) __builtin_amdgcn_sched_group_barrier(0x100, 2 + ((D0 + PF >= C::NQR) ? 1 : 0), 0);
    if constexpr (D0 + 1 < C::NQF) QktSchedD<C, D0 + 1, PF>::run(); } };
template <class C, int KB>
__device__ __forceinline__ void qkt_dummy(f32x16& p0, f32x16& p1, const char* K_lds, int r32, int hi, const bf16x8* qr, const char* qpark, f32x4& dmy) {
    p0 = f32x16{}; p1 = f32x16{};
    const char* kb[4];
#pragma unroll
    for (int dd = 0; dd < 4; ++dd) kb[dd] = K_lds + KB * C::SHM_K + r32 * C::ROWB + (((dd * 16 + hi * 8) * 2) ^ (((r32 >> 1) & 7) << 4));
    f32x4 d2 = dmy;
#pragma unroll
    for (int d0 = 0; d0 < C::NQF; ++d0) { const char* a = kb[d0 & 3] + (d0 >> 2) * 128;
        bf16x8 b0 = *reinterpret_cast<const bf16x8*>(a);
        bf16x8 b1 = *reinterpret_cast<const bf16x8*>(a + 32 * C::ROWB);
        bf16x8 qf; if (d0 < C::NQR) qf = qr[d0 < C::NQR ? d0 : 0]; else qf = *reinterpret_cast<const bf16x8*>(qpark + (d0 - C::NQR) * 1024);
        p0 = __builtin_amdgcn_mfma_f32_32x32x16_bf16(b0, qf, p0, 0, 0, 0);
        p1 = __builtin_amdgcn_mfma_f32_32x32x16_bf16(b1, qf, p1, 0, 0, 0);
#pragma unroll
        for (int e = 0; e < 3; ++e) { const int i = (d0 * 3 + e) & 3; d2[i] = __builtin_amdgcn_exp2f(d2[i]); d2[(i + 1) & 3] = fmaf(d2[(i + 1) & 3], 1.0001f, d2[i]); d2[(i + 2) & 3] = fmaf(d2[(i + 2) & 3], 0.9999f, d2[i]); }
    }
    dmy = d2;
    { __builtin_amdgcn_sched_group_barrier(0x100, 6 + ((3 > C::NQR) ? (3 - C::NQR) : 0), 0);
      QktSchedD<C, 0, 3>::run(); }
}
template <class C, int VB>
__device__ __forceinline__ void pv_tile(f32x16* o, int vb0, bf16x8 pa0, bf16x8 pa1, bf16x8 pa2, bf16x8 pa3, bool act) {
    if (C::SK && !act) return;
#define TRRD(dst, off) asm volatile("ds_read_b64_tr_b16 %0, %1 offset:%2" : "=&v"(dst) : "v"(vb0), "i"(off) : "memory")
#define PV_RD(S_, d0) do { constexpr int b_ = VB * C::SHM_V + (d0) * 512; constexpr int KG_ = C::KG;   \
        TRRD(l0##S_, b_); TRRD(h0##S_, b_ + KG_); TRRD(l1##S_, b_ + 2 * KG_); TRRD(h1##S_, b_ + 3 * KG_); TRRD(l2##S_, b_ + 4 * KG_); TRRD(h2##S_, b_ + 5 * KG_); TRRD(l3##S_, b_ + 6 * KG_); TRRD(h3##S_, b_ + 7 * KG_); } while (0)
#define PV_MM(S_, d0) do {   \
        o[d0] = __builtin_amdgcn_mfma_f32_32x32x16_bf16(pa0, (bf16x8){l0##S_[0], l0##S_[1], l0##S_[2], l0##S_[3], h0##S_[0], h0##S_[1], h0##S_[2], h0##S_[3]}, o[d0], 0, 0, 0);   \
        o[d0] = __builtin_amdgcn_mfma_f32_32x32x16_bf16(pa1, (bf16x8){l1##S_[0], l1##S_[1], l1##S_[2], l1##S_[3], h1##S_[0], h1##S_[1], h1##S_[2], h1##S_[3]}, o[d0], 0, 0, 0);   \
        o[d0] = __builtin_amdgcn_mfma_f32_32x32x16_bf16(pa2, (bf16x8){l2##S_[0], l2##S_[1], l2##S_[2], l2##S_[3], h2##S_[0], h2##S_[1], h2##S_[2], h2##S_[3]}, o[d0], 0, 0, 0);   \
        o[d0] = __builtin_amdgcn_mfma_f32_32x32x16_bf16(pa3, (bf16x8){l3##S_[0], l3##S_[1], l3##S_[2], l3##S_[3], h3##S_[0], h3##S_[1], h3##S_[2], h3##S_[3]}, o[d0], 0, 0, 0); } while (0)
#define PV_W8() do { asm volatile("s_waitcnt lgkmcnt(8)" ::: "memory"); SBAR(); } while (0)
#define PV_W0() do { asm volatile("s_waitcnt lgkmcnt(0)" ::: "memory"); SBAR(); } while (0)
    s16x4 l0A, l1A, l2A, l3A, h0A, h1A, h2A, h3A, l0B, l1B, l2B, l3B, h0B, h1B, h2B, h3B;
    SBAR(); asm volatile("s_waitcnt lgkmcnt(0)" ::: "memory");
    PV_RD(A, 0); PV_RD(B, 1); PV_W8(); PV_MM(A, 0); SBAR();
    if constexpr (C::NOF == 4) { PV_RD(A, 2); PV_W8(); PV_MM(B, 1); SBAR(); PV_RD(B, 3); PV_W8(); PV_MM(A, 2); SBAR(); PV_W0(); PV_MM(B, 3); }
    else { PV_W0(); PV_MM(B, 1); }
    SBAR();
#undef PV_RD
#undef PV_MM
#undef PV_W8
#undef PV_W0
#undef TRRD
}
template <class C> __device__ __forceinline__ int jlo(int P0) { const int lowk = P0 - C::W + 1; int j = lowk > 0 ? lowk / KVBLK : 0; const int jm = NPAD / KVBLK; return j < jm ? jm : j; }

#define AT_RSRC(p) __builtin_amdgcn_make_buffer_rsrc((void*)(p), 0, 0x7fffffff, 0x00020000)
#define AT_BLD(rs, vo, so) __builtin_bit_cast(bf16x8, __builtin_amdgcn_raw_buffer_load_b128((rs), (int)(vo), (int)(so), 0))
#define AT_SLOAD(Kp, Vp, k0) do { const __amdgpu_buffer_rsrc_t kr__ = AT_RSRC(Kp), vr__ = AT_RSRC(Vp); const int ks__ = (k0) * (C::LDK * 2), vs__ = (k0) * (C::LDV * 2); \
    _Pragma("unroll") for (int i_ = 0; i_ < C::NVC; ++i_) S.st_v[i_] = AT_BLD(vr__, vgo + (unsigned)(i_ * 128), vs__); \
    _Pragma("unroll") for (int i_ = 0; i_ < C::NKC; ++i_) S.st_k[i_] = AT_BLD(kr__, kgo + (unsigned)(i_ * 128), ks__); } while (0)
#define AT_LOAD_K(Kp, k0) do { const __amdgpu_buffer_rsrc_t kr__ = AT_RSRC(Kp); const int ks__ = (k0) * (C::LDK * 2); \
    _Pragma("unroll") for (int i_ = 0; i_ < C::NKC; ++i_) S.st_k[i_] = AT_BLD(kr__, kgo + (unsigned)(i_ * 128), ks__); } while (0)
#define AT_LOAD_V(Vp, k0) do { const __amdgpu_buffer_rsrc_t vr__ = AT_RSRC(Vp); const int vs__ = (k0) * (C::LDV * 2); \
    _Pragma("unroll") for (int i_ = 0; i_ < C::NVC; ++i_) S.st_v[i_] = AT_BLD(vr__, vgo + (unsigned)(i_ * 128), vs__); } while (0)
#define AT_SWRITE_K(bf) do { _Pragma("unroll") for (int i_ = 0; i_ < C::NKC; ++i_) *(bf16x8*)(K_lds + (bf) * C::SHM_K + klo + i_ * 128) = S.st_k[i_]; } while (0)
#define AT_SWRITE_V(bf) do { _Pragma("unroll") for (int i_ = 0; i_ < C::NVC; ++i_) *(bf16x8*)(V_lds + (bf) * C::SHM_V + vlo + i_ * 1024) = S.st_v[i_]; } while (0)
#define AT_STAGE_OFFS() \
    const int srow_ = tid >> 3, scc_ = tid & 7; \
    const unsigned kgo = (unsigned)(srow_ * C::LDK + scc_ * 8) * 2u, vgo = (unsigned)(srow_ * C::LDV + scc_ * 8) * 2u; \
    const int klo = srow_ * C::ROWB + ((scc_ * 16) ^ (((srow_ >> 1) & 7) << 4)); \
    const int skk_ = (srow_ & ~0xC) | ((srow_ & 4) << 1) | ((srow_ & 8) >> 1); \
    const int vlo = ((skk_ >> 3) * C::NOF + (scc_ >> 2)) * 512 + ((skk_ & 7) * 32 + (scc_ & 3) * 8) * 2;
#define AT_VMW() asm volatile("s_waitcnt vmcnt(0)" ::: "memory")
#define AT_VMWN(n) asm volatile("s_waitcnt vmcnt(%0)" :: "i"(n) : "memory")

#define AT_QLOAD(Qp) do { bf16x8 qp_[C::NPARK > 0 ? C::NPARK : 1]; \
    const __amdgpu_buffer_rsrc_t qr__ = AT_RSRC(Qp); const int qs__ = wid * (QBLK * C::LDQ * 2); const unsigned qo__ = (unsigned)(r32 * C::LDQ + hi * 8) * 2u; \
    _Pragma("unroll") for (int d0 = 0; d0 < C::NPARK; ++d0) qp_[d0] = AT_BLD(qr__, qo__ + (unsigned)((C::NQR + d0) * 32), qs__); \
    _Pragma("unroll") for (int d0 = 0; d0 < C::NQR; ++d0) S.qr[d0] = AT_BLD(qr__, qo__ + (unsigned)(d0 * 32), qs__); \
    SBAR(); AT_VMWN(C::NQR); \
    _Pragma("unroll") for (int d0 = 0; d0 < C::NPARK; ++d0) *(bf16x8*)(qpark + d0 * 1024) = qp_[d0]; } while (0)
template <class C>
__device__ __forceinline__ void prime(const BlockRef<C>& cur, char* lds, Seam<C>& S, const int tid) {
    const int wid = __builtin_amdgcn_readfirstlane(tid >> 6), lane = tid & 63, r32 = lane & 31, hi = lane >> 5;
    char* K_lds = lds + 2 * C::SHM_V;
    AT_STAGE_OFFS()
    const int kb0 = jlo<C>(cur.P0) * KVBLK;
    char* qpark = lds + C::PARK_OFF + wid * (C::NPARK * 1024) + lane * 16;
    AT_SLOAD(cur.K, cur.V, kb0); SBAR(); AT_QLOAD(cur.Q); AT_VMW(); AT_SWRITE_K(0);
    __syncthreads();
}
template <class C>
__device__ __forceinline__ void block(const BlockRef<C>& cur, const BlockRef<C>& nxt, char* lds, Seam<C>& S, int ssq_slot, const int tid) {
    constexpr bool SK = C::SK; constexpr int W = C::W;
    const int wid = __builtin_amdgcn_readfirstlane(tid >> 6), lane = tid & 63, r32 = lane & 31, hi = lane >> 5;
    const int j_lo = jlo<C>(cur.P0);
    const int j_hi = (cur.P0 + QB - 1) / KVBLK + 1;
    const int NT = j_hi - j_lo;
    const int kbn = jlo<C>(nxt.P0) * KVBLK;
    const int qlo = cur.P0 + wid * QBLK, qm = qlo + r32 - 4 * hi;
    char* V_lds = lds; char* K_lds = lds + 2 * C::SHM_V;
    AT_STAGE_OFFS()
    float* ws = (float*)(lds + C::WS_OFF) + wid * 64; float* li_l = ws, * al_l = ws + 32;
    char* qpark = lds + C::PARK_OFF + wid * (C::NPARK * 1024) + lane * 16;
    float m_reg = cur.m0, l_reg = cur.l0; const float c2 = cur.c2, thr = 8.f * 1.4426950408889634f / c2;
    f32x16 o[C::NOF];
#pragma unroll
    for (int d_ = 0; d_ < C::NOF; ++d_) o[d_] = f32x16{};
    const int vb0 = (int)(uintptr_t)V_lds + v_rd_base(lane);
    const bf16_t* Kh = cur.K; const bf16_t* Vh = cur.V;
#define RESC(a) do { if (__any((a) < 1.f)) { if (hi == 0) al_l[r32] = (a); asm volatile("s_waitcnt lgkmcnt(0)" ::: "memory");              \
                     _Pragma("unroll") for (int d_ = 0; d_ < C::NOF; ++d_) _Pragma("unroll") for (int r = 0; r < 16; ++r) o[d_][r] *= al_l[crow(r, hi)]; } } while (0)
#define KBASE(t) ((j_lo + (t)) * KVBLK)
#define ACT(t) (KBASE(t) <= qlo + QBLK - 1 && KBASE(t) + KVBLK - 1 >= qlo - W + 1)
#define MASKT(P0_, P1_, t) do { const int kb_ = KBASE(t); if ((!SK || ACT(t)) && (kb_ + KVBLK - 1 > qlo || kb_ <= qlo + QBLK - 1 - W || kb_ < NPAD)) mask_tile(P0_, P1_, qm - kb_, (unsigned)W, NPAD - kb_ - 4 * hi); } while (0)
#if ATT_PIPE
    f32x16 pA0, pA1, pB0, pB1; float mnA, mnB, alA, alB; bf16x8 pa0, pa1, pa2, pa3;
    AT_SWRITE_V(0); SBAR();
    if (NT > 1) { AT_SLOAD(Kh, Vh, KBASE(1)); }
    SBAR(); qkt<C, 0>(pA0, pA1, K_lds, r32, hi, S.qr, qpark, ACT(0));
    MASKT(pA0, pA1, 0); partialSM(pA0, pA1, m_reg, mnA, alA, c2, thr);
    if (NT > 1) { AT_VMW(); AT_SWRITE_V(1); AT_SWRITE_K(1); }
    __syncthreads();
#define HALF_STEP(PX0, PX1, mnX, alX, PY0, PY1, alY, t, KB, VB, SB) do {                                                      \
        SBAR(); qkt<C, KB>(PX0, PX1, K_lds, r32, hi, S.qr, qpark, ACT(t));                                                  \
        finishSM(PY0, PY1, alY, l_reg, pa0, pa1, pa2, pa3); SBAR();                                                           \
        if ((t) + 1 < NT) { AT_SLOAD(Kh, Vh, KBASE((t) + 1)); SBAR(); }                                               \
        pv_tile<C, VB>(o, vb0, pa0, pa1, pa2, pa3, ACT((t) - 1)); MASKT(PX0, PX1, (t)); partialSM(PX0, PX1, m_reg, mnX, alX, c2, thr);       \
        __syncthreads();                                                                                                      \
        if ((t) + 1 < NT) { AT_VMW(); if (SB) { AT_SWRITE_V(1); AT_SWRITE_K(1); } else { AT_SWRITE_V(0); AT_SWRITE_K(0); } }                                                                          \
        RESC(alX); __syncthreads(); } while (0)
    for (int t = 1; t + 1 < NT; t += 2) {
        HALF_STEP(pB0, pB1, mnB, alB, pA0, pA1, alA, t, 1, 0, 0);
        HALF_STEP(pA0, pA1, mnA, alA, pB0, pB1, alB, t + 1, 0, 1, 1);
    }
#undef HALF_STEP
    const bool even = (NT & 1) == 0;
    if (even) { SBAR(); qkt<C, 1>(pB0, pB1, K_lds, r32, hi, S.qr, qpark, ACT(NT - 1)); SBAR(); }
    AT_SLOAD(nxt.K, nxt.V, kbn); SBAR();
    finishSM(pA0, pA1, alA, l_reg, pa0, pa1, pa2, pa3); SBAR();
    pv_tile<C, 0>(o, vb0, pa0, pa1, pa2, pa3, ACT(even ? NT - 2 : NT - 1));
    if (even) { MASKT(pB0, pB1, NT - 1); partialSM(pB0, pB1, m_reg, mnB, alB, c2, thr); __syncthreads(); RESC(alB);
        finishSM(pB0, pB1, alB, l_reg, pa0, pa1, pa2, pa3); SBAR(); pv_tile<C, 1>(o, vb0, pa0, pa1, pa2, pa3, ACT(NT - 1)); }
    SBAR();
    AT_QLOAD(nxt.Q);
    AT_SWRITE_K(0); SBAR();
#else
    f32x16 P0, P1; float mn, al; bf16x8 pa0, pa1, pa2, pa3;
    AT_SWRITE_V(0); __syncthreads();
#define STEP(t, B_, NB_) do { const bool more_ = (t) + 1 < NT;                                                              \
        SBAR(); if (more_) { AT_SLOAD(Kh, Vh, KBASE((t) + 1)); } else { AT_SLOAD(nxt.K, nxt.V, kbn); } SBAR();              \
        qkt<C, B_>(P0, P1, K_lds, r32, hi, S.qr, qpark, ACT(t)); SBAR();                                                   \
        MASKT(P0, P1, (t)); partialSM(P0, P1, m_reg, mn, al, c2, thr); RESC(al);                                            \
        finishSM(P0, P1, al, l_reg, pa0, pa1, pa2, pa3); SBAR();                                                             \
        pv_tile<C, B_>(o, vb0, pa0, pa1, pa2, pa3, ACT(t)); SBAR();                                                        \
        if (more_) { AT_VMW(); AT_SWRITE_V(NB_); AT_SWRITE_K(NB_); }                                                        \
        __syncthreads(); } while (0)
    int t = 0;
    for (; t + 1 < NT; t += 2) { STEP(t, 0, 1); STEP(t + 1, 1, 0); }
    if (t < NT) { STEP(t, 0, 1); }
#undef STEP
    AT_QLOAD(nxt.Q);
    AT_SWRITE_K(0); SBAR();
#endif
    if (hi == 0) li_l[r32] = l_reg; asm volatile("s_waitcnt lgkmcnt(0)" ::: "memory");
    float rli[16], sq[16];
#pragma unroll
    for (int r = 0; r < 16; ++r) { rli[r] = __builtin_amdgcn_rcpf(li_l[crow(r, hi)]); sq[r] = 0.f; }
    char* Ow = (char*)(cur.O + (size_t)(wid * QBLK) * 1024); const unsigned oo = (unsigned)(4 * hi * 1024 + r32) * 2u;
#pragma unroll
    for (int r = 0; r < 16; ++r) {
#pragma unroll
        for (int d0 = 0; d0 < C::NOF; ++d0) { const float v = o[d0][r] * rli[r]; sq[r] += v * v;
            const float vn = __shfl_xor(v, 1);
            if ((r32 & 1) == 0) *(unsigned*)(Ow + (size_t)(oo + (unsigned)((((r & 3) + 8 * (r >> 2)) * 1024 + d0 * 32) * 2))) = cvtpk(v, vn); } }
    float sel = 0.f; int r32e = r32, hie = hi; asm volatile("" : "+v"(r32e), "+v"(hie));
#pragma unroll
    for (int r = 0; r < 16; ++r) { float s = sq[r]; s += __shfl_xor(s, 1); s += __shfl_xor(s, 2); s += __shfl_xor(s, 4); s += __shfl_xor(s, 8); s += __shfl_xor(s, 16); sel = (r32e == r) ? s : sel; }
    if (r32e < 16) *(float*)((char*)(cur.SSQ + (size_t)(wid * QBLK) * 12 + ssq_slot) + (size_t)((unsigned)crow(r32e, hie) * 48u)) = sel;
    __syncthreads();
#undef RESC
#undef KBASE
#undef ACT
#undef MASKT
}

template <class C, int XP = 0>
__device__ __forceinline__ void block2(const BlockRef<C>& cur, char* lds, Seam<C>& S, int ssq_slot, const int tid) {
    constexpr bool SK = C::SK; constexpr int W = C::W;
    const int wid = __builtin_amdgcn_readfirstlane(tid >> 6), lane = tid & 63, r32 = lane & 31, hi = lane >> 5, g = wid >> 2;
    const int j_lo = jlo<C>(cur.P0);
    const int j_hi = (cur.P0 + QB - 1) / KVBLK + 1;
    const int NT = j_hi - j_lo;
    const int qlo = cur.P0 + wid * QBLK, qm = qlo + r32 - 4 * hi;
    char* V_lds = lds; char* K_lds = lds + 2 * C::SHM_V;
    AT_STAGE_OFFS()
    float* ws = (float*)(lds + C::WS_OFF) + wid * 64; float* li_l = ws, * al_l = ws + 32;
    char* qpark = lds + C::PARK_OFF + wid * (C::NPARK * 1024) + lane * 16;
    float m_reg = cur.m0, l_reg = cur.l0; const float c2 = cur.c2, thr = 8.f * 1.4426950408889634f / c2;
    f32x16 o[C::NOF];
#pragma unroll
    for (int d_ = 0; d_ < C::NOF; ++d_) o[d_] = f32x16{};
    const int vb0 = (int)(uintptr_t)V_lds + v_rd_base(lane);
    const bf16_t* Kh = cur.K; const bf16_t* Vh = cur.V;
#if ATT_DMA
    unsigned dk[C::NKC], dv[C::NVC]; const unsigned lds0 = (unsigned)(uintptr_t)lds;
#pragma unroll
    for (int i = 0; i < C::NKC; ++i) { const int L = (wid + 8 * i) * 1024 + lane * 16, row = L / C::ROWB, sw = L % C::ROWB; dk[i] = (unsigned)(row * (C::LDK * 2) + (sw ^ (((row >> 1) & 7) << 4))); }
#pragma unroll
    for (int i = 0; i < C::NVC; ++i) { const int L = (wid + 8 * i) * 1024 + lane * 16, sub = L >> 9, within = L & 511, kk = (sub / C::NOF) * 8 + (within >> 6);
        const int k = (kk & ~0xC) | ((kk & 4) << 1) | ((kk & 8) >> 1); dv[i] = (unsigned)(k * (C::LDV * 2) + ((sub % C::NOF) * 32 + ((within & 63) >> 1)) * 2); }
#define DMA_K(t, buf) do { const char* kb__ = (const char*)Kh + (size_t)KBASE(t) * (C::LDK * 2); _Pragma("unroll") for (int i_ = 0; i_ < C::NKC; ++i_) \
        glds16s(kb__, dk[i_], (unsigned)__builtin_amdgcn_readfirstlane((int)(lds0 + 2 * C::SHM_V + (buf) * C::SHM_K + (wid + 8 * i_) * 1024))); } while (0)
#define DMA_V(t, buf) do { const char* vb__ = (const char*)Vh + (size_t)KBASE(t) * (C::LDV * 2); _Pragma("unroll") for (int i_ = 0; i_ < C::NVC; ++i_) \
        glds16s(vb__, dv[i_], (unsigned)__builtin_amdgcn_readfirstlane((int)(lds0 + (buf) * C::SHM_V + (wid + 8 * i_) * 1024))); } while (0)
#define ISSUEPAIR(tau) do { const int tau_ = (tau); if (tau_ < NT) { DMA_V(tau_, tau_ & 1); } if (tau_ + 1 < NT) { DMA_K(tau_ + 1, (tau_ + 1) & 1); } } while (0)
#endif
#if ATT_DMA
#define ISSUEPAIR_(tau) ISSUEPAIR(tau)
#else
#define ISSUEPAIR_(tau) do { } while (0)
#endif
#define RESC(a) do { if (__any((a) < 1.f)) { if (hi == 0) al_l[r32] = (a); asm volatile("s_waitcnt lgkmcnt(0)" ::: "memory");              \
                     _Pragma("unroll") for (int d_ = 0; d_ < C::NOF; ++d_) _Pragma("unroll") for (int r = 0; r < 16; ++r) o[d_][r] *= al_l[crow(r, hi)]; } } while (0)
#define KBASE(t) ((j_lo + (t)) * KVBLK)
#define ACT(t) (KBASE(t) <= qlo + QBLK - 1 && KBASE(t) + KVBLK - 1 >= qlo - W + 1)
#define MASKT(P0_, P1_, t) do { const int kb_ = KBASE(t); if ((!SK || ACT(t)) && (kb_ + KVBLK - 1 > qlo || kb_ <= qlo + QBLK - 1 - W || kb_ < NPAD)) mask_tile(P0_, P1_, qm - kb_, (unsigned)W, NPAD - kb_ - 4 * hi); } while (0)
#define BAR2() asm volatile("s_waitcnt lgkmcnt(0)\n\ts_barrier" ::: "memory")
#define LOADPAIR(tau) do { const int tau_ = (tau); if (tau_ < NT) { AT_LOAD_V(Vh, KBASE(tau_)); } if (tau_ + 1 < NT) { AT_LOAD_K(Kh, KBASE(tau_ + 1)); } } while (0)
#define WRITEPAIR(tau) do { const int tau_ = (tau); if (tau_ < NT) { AT_VMW(); AT_SWRITE_V(tau_ & 1); if (tau_ + 1 < NT) { AT_SWRITE_K((tau_ + 1) & 1); } } } while (0)
    AT_QLOAD(cur.Q);
#if ATT_DMA
    DMA_K(0, 0); ISSUEPAIR(0); AT_VMW();
#else
    AT_LOAD_K(Kh, KBASE(0)); AT_VMW(); AT_SWRITE_K(0);
    if (g == 1) { AT_LOAD_V(Vh, KBASE(0)); AT_LOAD_K(Kh, KBASE(1)); AT_VMW(); AT_SWRITE_V(0); AT_SWRITE_K(1); }
    LOADPAIR(g);
#endif
    BAR2();
    if (g == 1) BAR2();
    f32x4 dmy = {0.f, 0.f, 0.f, 0.f}; asm volatile("" : "+v"(dmy));
    f32x16 P0 = f32x16{}, P1 = f32x16{}; float mn, al = 1.f; bf16x8 pa0 = bf16x8{}, pa1 = bf16x8{}, pa2 = bf16x8{}, pa3 = bf16x8{};
    qkt<C, 0>(P0, P1, K_lds, r32, hi, S.qr, qpark, ACT(0)); BAR2();
#if ATT_DMA
#define SSTAGE(t) do { if (g == 1 && XP != 2) { ISSUEPAIR((t) + 1); }                                                                    \
        if (XP != 1 && XP != 4) { MASKT(P0, P1, (t)); partialSM(P0, P1, m_reg, mn, al, c2, thr); RESC(al); finishSM(P0, P1, al, l_reg, pa0, pa1, pa2, pa3); } SBAR();   \
        if (g == 0) { AT_VMW(); } BAR2(); } while (0)
#else
#define SSTAGE(t) do { if (XP != 1 && XP != 4) { MASKT(P0, P1, (t)); partialSM(P0, P1, m_reg, mn, al, c2, thr); RESC(al); finishSM(P0, P1, al, l_reg, pa0, pa1, pa2, pa3); } SBAR();   \
        if (XP != 2) { WRITEPAIR((t) + g); LOADPAIR((t) + g + 1); } BAR2(); } while (0)
#endif
#define MSTAGE(t, VB_, KB_) do { if (ATT_DMA && g == 0 && XP != 2) { ISSUEPAIR_((t) + 1); } if (XP != 3) { pv_tile<C, VB_>(o, vb0, pa0, pa1, pa2, pa3, ACT(t)); SBAR();                                  \
        if ((t) + 1 < NT) { if (XP == 4) { qkt_dummy<C, KB_>(P0, P1, K_lds, r32, hi, S.qr, qpark, dmy); } else { qkt<C, KB_>(P0, P1, K_lds, r32, hi, S.qr, qpark, ACT((t) + 1)); } } } if (ATT_DMA && g == 1) { AT_VMW(); } BAR2(); } while (0)
    int t = 0;
    for (; t + 1 < NT; t += 2) { SSTAGE(t); MSTAGE(t, 0, 1); SSTAGE(t + 1); MSTAGE(t + 1, 1, 0); }
    if (t < NT) { SSTAGE(t); MSTAGE(t, 0, 1); }
#undef SSTAGE
#undef MSTAGE
#undef LOADPAIR
#undef WRITEPAIR
#undef ISSUEPAIR_
#if ATT_DMA
#undef ISSUEPAIR
#undef DMA_K
#undef DMA_V
#endif
    if (hi == 0) li_l[r32] = l_reg; asm volatile("s_waitcnt lgkmcnt(0)" ::: "memory");
    float rli[16], sq[16];
#pragma unroll
    for (int r = 0; r < 16; ++r) { rli[r] = __builtin_amdgcn_rcpf(li_l[crow(r, hi)]); sq[r] = 0.f; }
    char* Ow = (char*)(cur.O + (size_t)(wid * QBLK) * 1024); const unsigned oo = (unsigned)(4 * hi * 1024 + r32) * 2u;
#pragma unroll
    for (int r = 0; r < 16; ++r) {
#pragma unroll
        for (int d0 = 0; d0 < C::NOF; ++d0) { const float v = o[d0][r] * rli[r]; sq[r] += v * v;
            const float vn = __shfl_xor(v, 1);
            if (XP == 0 && (r32 & 1) == 0) *(unsigned*)(Ow + (size_t)(oo + (unsigned)((((r & 3) + 8 * (r >> 2)) * 1024 + d0 * 32) * 2))) = cvtpk(v, vn);
            if (XP != 0) asm volatile("" :: "v"(v)); } }
    float sel = 0.f; int r32e = r32, hie = hi; asm volatile("" : "+v"(r32e), "+v"(hie));
#pragma unroll
    for (int r = 0; r < 16; ++r) { float s = sq[r]; s += __shfl_xor(s, 1); s += __shfl_xor(s, 2); s += __shfl_xor(s, 4); s += __shfl_xor(s, 8); s += __shfl_xor(s, 16); sel = (r32e == r) ? s : sel; }
    if (XP == 0 && r32e < 16) *(float*)((char*)(cur.SSQ + (size_t)(wid * QBLK) * 12 + ssq_slot) + (size_t)((unsigned)crow(r32e, hie) * 48u)) = sel;
    if (XP != 0) asm volatile("" :: "v"(sel), "v"(dmy));
    if (g == 0) BAR2();
    BAR2();
#undef BAR2
#undef RESC
#undef KBASE
#undef ACT
#undef MASKT
}

typedef __attribute__((address_space(3))) const char* lds_cptr;
typedef short v4i16_t __attribute__((ext_vector_type(4)));
__device__ __forceinline__ s16x4 vtr(lds_cptr p) { return __builtin_bit_cast(s16x4, __builtin_amdgcn_ds_read_tr16_b64_v4i16((__attribute__((address_space(3))) v4i16_t*)p)); }
__device__ __forceinline__ void mask_half(f32x16& p, int dq, unsigned W, int klim) {
    const float NEG = -__builtin_inff();
#pragma unroll
    for (int r = 0; r < 16; ++r) { const int c = (r & 3) + 8 * (r >> 2); if ((unsigned)(dq - c) >= W || c < klim) p[r] = NEG; }
}
template <int NDS> struct StepSched { static __device__ __forceinline__ void run() {
    __builtin_amdgcn_sched_group_barrier(0x100, ATT_PF0, 0);
#define G_(n) __builtin_amdgcn_sched_group_barrier(0x008, 1, 0); if constexpr (ATT_PF0 + 2 * (n) < NDS) __builtin_amdgcn_sched_group_barrier(0x100, (NDS - ATT_PF0 - 2 * (n)) >= 2 ? 2 : 1, 0); \
              __builtin_amdgcn_sched_group_barrier(0x002, 4, 0); __builtin_amdgcn_sched_group_barrier(0x400, 1, 0);
    G_(0) G_(1) G_(2) G_(3) G_(4) G_(5) G_(6) G_(7) G_(8) G_(9) G_(10) G_(11) G_(12) G_(13) G_(14) G_(15) G_(16) G_(17) G_(18) G_(19)
#undef G_
} };
template <class C, int XP = 0>
__device__ __forceinline__ void block3(const BlockRef<C>& cur, char* lds, Seam<C>& S, int ssq_slot, const int tid) {
    static_assert(!C::SK && C::NOF == 4, "block3: causal, DV = 128");
    constexpr int W = C::W;
    const int wid = __builtin_amdgcn_readfirstlane(tid >> 6), lane = tid & 63, r32 = lane & 31, hi = lane >> 5;
    const int j_lo = jlo<C>(cur.P0);
    const int j_hi = (cur.P0 + QB - 1) / KVBLK + 1;
    const int NT = j_hi - j_lo;
    const int qlo = cur.P0 + wid * QBLK, qm = qlo + r32 - 4 * hi;
    char* V_lds = lds; char* K_lds = lds + 2 * C::SHM_V;
    AT_STAGE_OFFS()
    float* ws = (float*)(lds + C::WS_OFF) + wid * 64; float* li_l = ws, * al_l = ws + 32;
    char* qpark = lds + C::PARK_OFF + wid * (C::NPARK * 1024) + lane * 16;
    const lds_cptr qpl = (lds_cptr)qpark;
    const lds_cptr vp = (lds_cptr)V_lds + v_rd_base(lane);
    lds_cptr kp[4];
#pragma unroll
    for (int dd = 0; dd < 4; ++dd) kp[dd] = (lds_cptr)K_lds + r32 * C::ROWB + (((dd * 16 + hi * 8) * 2) ^ (((r32 >> 1) & 7) << 4));
    float m_reg = cur.m0, l_reg = cur.l0; const float c2 = cur.c2, thr = 8.f * 1.4426950408889634f / c2;
    f32x16 o[4];
#pragma unroll
    for (int d_ = 0; d_ < 4; ++d_) o[d_] = f32x16{};
    const bf16_t* Kh = cur.K; const bf16_t* Vh = cur.V;
#define KBASE(t) ((j_lo + (t)) * KVBLK)
#define BAR2() asm volatile("s_waitcnt lgkmcnt(0)\n\ts_barrier" ::: "memory")
#define RESC(a) do { if (__any((a) < 1.f)) { if (hi == 0) al_l[r32] = (a); asm volatile("s_waitcnt lgkmcnt(0)" ::: "memory");              \
                     _Pragma("unroll") for (int d_ = 0; d_ < 4; ++d_) _Pragma("unroll") for (int r = 0; r < 16; ++r) o[d_][r] *= al_l[crow(r, hi)]; } } while (0)
#define QPART(PN, KB_, HQ_) do { PN = f32x16{};                                                                                           \
        _Pragma("unroll") for (int d0 = 0; d0 < C::NQF; ++d0) { const bf16x8 kf = *(const __attribute__((address_space(3))) bf16x8*)(kp[d0 & 3] + ((KB_) * C::SHM_K + (HQ_) * 32 * C::ROWB + (d0 >> 2) * 128)); \
            bf16x8 qf; if (d0 < C::NQR) qf = S.qr[d0 < C::NQR ? d0 : 0]; else qf = *(const __attribute__((address_space(3))) bf16x8*)(qpl + (d0 - C::NQR) * 1024);                      \
            PN = __builtin_amdgcn_mfma_f32_32x32x16_bf16(kf, qf, PN, 0, 0, 0); } } while (0)
#define VPART(A_, B_, VB_, HV_) do {                                                                                                      \
        _Pragma("unroll") for (int d0 = 0; d0 < 4; ++d0) { const lds_cptr b_ = vp + ((VB_) * C::SHM_V + d0 * 512 + 4 * (HV_) * C::KG);     \
            const s16x4 la = vtr(b_), ha = vtr(b_ + C::KG), lb = vtr(b_ + 2 * C::KG), hb = vtr(b_ + 3 * C::KG);                            \
            o[d0] = __builtin_amdgcn_mfma_f32_32x32x16_bf16(A_, (bf16x8){la[0], la[1], la[2], la[3], ha[0], ha[1], ha[2], ha[3]}, o[d0], 0, 0, 0);   \
            o[d0] = __builtin_amdgcn_mfma_f32_32x32x16_bf16(B_, (bf16x8){lb[0], lb[1], lb[2], lb[3], hb[0], hb[1], hb[2], hb[3]}, o[d0], 0, 0, 0); } } while (0)
#define SMAX(PC, PM_) do {                                                                                                                \
        float pm_ = fmaxf(fmaxf(PC[0], PC[1]), fmaxf(PC[2], PC[3]));                                                                    \
        _Pragma("unroll") for (int r = 4; r < 16; r += 4) pm_ = fmaxf(pm_, fmaxf(fmaxf(PC[r], PC[r + 1]), fmaxf(PC[r + 2], PC[r + 3])));  \
        { auto rr = __builtin_amdgcn_permlane32_swap(__float_as_uint(pm_), __float_as_uint(pm_), false, false); pm_ = fmaxf(__uint_as_float(rr[0]), __uint_as_float(rr[1])); } \
        PM_ = pm_; } while (0)
#define SEXP(PC, PM_, NA_, NB_) do {                                                                                                      \
        const bool grow_ = ((PM_) - m_reg) > thr; const float mn_ = grow_ ? fmaxf(m_reg, (PM_)) : m_reg;                               \
        al = grow_ ? __builtin_amdgcn_exp2f((m_reg - mn_) * c2) : 1.f; m_reg = mn_; const float mnL_ = -mn_ * c2;                       \
        _Pragma("unroll") for (int r = 0; r < 16; ++r) PC[r] = __builtin_amdgcn_exp2f(fmaf(PC[r], c2, mnL_));                             \
        float ps_ = 0.f; _Pragma("unroll") for (int r = 0; r < 16; ++r) ps_ += PC[r];                                                     \
        { auto rr = __builtin_amdgcn_permlane32_swap(__float_as_uint(ps_), __float_as_uint(ps_), false, false); ps_ = __uint_as_float(rr[0]) + __uint_as_float(rr[1]); } \
        l_reg = l_reg * al + ps_;                                                                                                         \
        { unsigned a0 = cvtpk(PC[0], PC[1]), a1 = cvtpk(PC[2], PC[3]), b0 = cvtpk(PC[4], PC[5]), b1 = cvtpk(PC[6], PC[7]);               \
          auto r0 = __builtin_amdgcn_permlane32_swap(a0, b0, false, false); auto r1 = __builtin_amdgcn_permlane32_swap(a1, b1, false, false); \
          u32x4 w_ = {r0[0], r1[0], r0[1], r1[1]}; NA_ = __builtin_bit_cast(bf16x8, w_); }                                                \
        { unsigned a0 = cvtpk(PC[8], PC[9]), a1 = cvtpk(PC[10], PC[11]), b0 = cvtpk(PC[12], PC[13]), b1 = cvtpk(PC[14], PC[15]);         \
          auto r0 = __builtin_amdgcn_permlane32_swap(a0, b0, false, false); auto r1 = __builtin_amdgcn_permlane32_swap(a1, b1, false, false); \
          u32x4 w_ = {r0[0], r1[0], r0[1], r1[1]}; NB_ = __builtin_bit_cast(bf16x8, w_); } } while (0)
#define MASKH(PC, h) do { const int kbh_ = KBASE((h) >> 1) + 32 * ((h) & 1); if (kbh_ + 31 > qlo || kbh_ < NPAD) mask_half(PC, qm - kbh_, (unsigned)W, NPAD - kbh_ - 4 * hi); } while (0)
    AT_QLOAD(cur.Q);
    AT_LOAD_K(Kh, KBASE(0)); AT_LOAD_V(Vh, KBASE(0)); AT_VMW(); AT_SWRITE_K(0); AT_SWRITE_V(0);
    AT_LOAD_K(Kh, KBASE(1));
    BAR2();
    f32x16 PA, PB; float al = 1.f, pmA, pmB; bf16x8 fa = bf16x8{}, fb = bf16x8{}, ga, gb;
    QPART(PA, 0, 0); SBAR(); MASKH(PA, 0); SMAX(PA, pmA); SBAR();
    AT_LOAD_V(Vh, KBASE(1)); SBAR();
    QPART(PB, 0, 1); SEXP(PA, pmA, fa, fb); SBAR();
    MASKH(PB, 1); SMAX(PB, pmB); RESC(al); AT_VMWN(C::NVC); AT_SWRITE_K(1); BAR2();
#define FULL(h, PC, PMC, PN, PMN, A_, B_, NA_, NB_, VB_, HV_, KB_, HQ_, EVEN_) do { const int t_ = (h) >> 1;                              \
        if (EVEN_) { if (t_ + 1 < NT) { AT_LOAD_V(Vh, KBASE(t_ + 1)); } } else { if (t_ + 2 < NT) { AT_LOAD_K(Kh, KBASE(t_ + 2)); } } SBAR();  \
        VPART(A_, B_, VB_, HV_); QPART(PN, KB_, HQ_); SEXP(PC, PMC, NA_, NB_); StepSched<32 + C::NPARK>::run(); SBAR();                   \
        MASKH(PN, (h) + 1); SMAX(PN, PMN); RESC(al);                                                                                    \
        if (EVEN_) { if (t_ + 1 < NT) { AT_VMWN(C::NVC); AT_SWRITE_K((t_ + 1) & 1); } } else { if (t_ + 1 < NT) { if (t_ + 2 < NT) { AT_VMWN(C::NKC); } else { AT_VMW(); } AT_SWRITE_V((t_ + 1) & 1); } }  \
        BAR2(); } while (0)
    int h = 1;
    for (; h + 3 <= 2 * NT - 2; h += 4) {
        FULL(h,     PB, pmB, PA, pmA, fa, fb, ga, gb, 0, 0, 1, 0, false);
        FULL(h + 1, PA, pmA, PB, pmB, ga, gb, fa, fb, 0, 1, 1, 1, true);
        FULL(h + 2, PB, pmB, PA, pmA, fa, fb, ga, gb, 1, 0, 0, 0, false);
        FULL(h + 3, PA, pmA, PB, pmB, ga, gb, fa, fb, 1, 1, 0, 1, true);
    }
#undef FULL
    VPART(fa, fb, 0, 0); SEXP(PB, pmB, ga, gb); SBAR();
    RESC(al);
    VPART(ga, gb, 0, 1); SBAR();
#undef QPART
#undef VPART
#undef SMAX
#undef SEXP
#undef MASKH
    if (hi == 0) li_l[r32] = l_reg; asm volatile("s_waitcnt lgkmcnt(0)" ::: "memory");
    float rli[16], sq[16];
#pragma unroll
    for (int r = 0; r < 16; ++r) { rli[r] = __builtin_amdgcn_rcpf(li_l[crow(r, hi)]); sq[r] = 0.f; }
    char* Ow = (char*)(cur.O + (size_t)(wid * QBLK) * 1024); const unsigned oo = (unsigned)(4 * hi * 1024 + r32) * 2u;
#pragma unroll
    for (int r = 0; r < 16; ++r) {
#pragma unroll
        for (int d0 = 0; d0 < 4; ++d0) { const float v = o[d0][r] * rli[r]; sq[r] += v * v;
            const float vn = __shfl_xor(v, 1);
            if (XP == 0 && (r32 & 1) == 0) *(unsigned*)(Ow + (size_t)(oo + (unsigned)((((r & 3) + 8 * (r >> 2)) * 1024 + d0 * 32) * 2))) = cvtpk(v, vn);
            if (XP != 0) asm volatile("" :: "v"(v)); } }
    float sel = 0.f; int r32e = r32, hie = hi; asm volatile("" : "+v"(r32e), "+v"(hie));
#pragma unroll
    for (int r = 0; r < 16; ++r) { float s = sq[r]; s += __shfl_xor(s, 1); s += __shfl_xor(s, 2); s += __shfl_xor(s, 4); s += __shfl_xor(s, 8); s += __shfl_xor(s, 16); sel = (r32e == r) ? s : sel; }
    if (XP == 0 && r32e < 16) *(float*)((char*)(cur.SSQ + (size_t)(wid * QBLK) * 12 + ssq_slot) + (size_t)((unsigned)crow(r32e, hie) * 48u)) = sel;
    if (XP != 0) asm volatile("" :: "v"(sel));
    BAR2();
#undef BAR2
#undef RESC
#undef KBASE
}
#undef AT_STAGE_OFFS
#undef AT_LOAD_K
#undef AT_LOAD_V
#undef AT_SLOAD
#undef AT_SWRITE_K
#undef AT_SWRITE_V
#undef AT_VMW
#undef AT_VMWN
#undef AT_QLOAD
#undef AT_RSRC
#undef AT_BLD
#undef SBAR

typedef Cfg<192, 128, 768, 768, 512, LP, false, 6> CfgMLA;
typedef Cfg<64, 64, 512, 128, 128, 128, true, 0> CfgSWA;
constexpr float C2_MLA = 1.4426950408889634f * 0.07216878364870322f, C2_SWA = 1.4426950408889634f * 0.125f;
static_assert(CfgMLA::LDS_BYTES <= RING_BYTES && CfgSWA::LDS_BYTES <= RING_BYTES, "attention LDS");

__device__ __forceinline__ BlockRef<CfgMLA> mla_ref(unsigned char* ws, int bh, int qb) {
    const int b = bh >> 2, h = bh & 3; BlockRef<CfgMLA> r; const size_t m0 = (size_t)b * SEQ + (size_t)qb * QB;
    r.Q = (const bf16_t*)(ws + WS_QM) + m0 * 768 + h * 192; r.K = (const bf16_t*)(ws + WS_KM) + (size_t)b * LP * 768 + h * 192;
    r.V = (const bf16_t*)(ws + WS_VM) + (size_t)b * LP * 512 + h * 128; r.O = (bf16_t*)(ws + WS_AO) + m0 * 1024 + 512 + h * 128;
    r.SSQ = (float*)(ws + WS_SSQ) + m0 * 12; r.P0 = 128 + qb * QB; r.m0 = -1e30f; r.l0 = 0.f; r.c2 = C2_MLA; return r;
}
__device__ __forceinline__ BlockRef<CfgSWA> swa_ref(unsigned char* ws, const float* sinks, int bh, int qb) {
    const int b = bh >> 3, h = bh & 7, kvh = h >> 2; BlockRef<CfgSWA> r; const size_t m0 = (size_t)b * SEQ + (size_t)qb * QB;
    r.Q = (const bf16_t*)(ws + WS_QA) + m0 * 512 + h * 64; r.K = (const bf16_t*)(ws + WS_KA) + (size_t)b * LP * 128 + kvh * 64;
    r.V = (const bf16_t*)(ws + WS_VA) + (size_t)b * LP * 128 + kvh * 64; r.O = (bf16_t*)(ws + WS_AO) + m0 * 1024 + h * 64;
    r.SSQ = (float*)(ws + WS_SSQ) + m0 * 12; r.P0 = 128 + qb * QB; r.m0 = sinks[h] * 8.f; r.l0 = 1.f; r.c2 = C2_SWA; return r;
}
template <int XP = 0>
__device__ __forceinline__ void attn_phase(char* lds, unsigned char* ws, const float* sinks, int vcu, int G, const float* wgate, const float* wup, const float* wdown) {
    {
        const int nit = (256 - vcu + G - 1) / G;
        const int nblk = 2 * (nit > 0 ? nit : 0);
        if (nblk > 0) {
            Seam<CfgMLA> S; int tid = threadIdx.x; asm volatile("" : "+v"(tid));
#define MLA_REF(k) mla_ref(ws, (vcu + ((k) >> 1) * G) >> 4, ((k) & 1) ? ((vcu + ((k) >> 1) * G) & 15) : 31 - ((vcu + ((k) >> 1) * G) & 15))
            BlockRef<CfgMLA> cur = MLA_REF(0);
#if ATT_SKEW
#if ATT_HALF
            for (int k = 0; k < nblk; ++k) { cur = MLA_REF(k); block3<CfgMLA, XP>(cur, lds, S, 8 + (((vcu + (k >> 1) * G) >> 4) & 3), tid); }
#else
            block2<CfgMLA, XP>(cur, lds, S, 8 + ((vcu >> 4) & 3), tid);
            if (XP == 0) {
                int t2 = threadIdx.x; asm volatile("" : "+v"(t2));
                moe_wconv((LAS unsigned char*)lds, ws, wgate, wup, wdown, __builtin_amdgcn_readfirstlane(t2 >> 6), t2 & 63, vcu * NWAVES + __builtin_amdgcn_readfirstlane(t2 >> 6), G * NWAVES); __syncthreads(); }
            for (int k = 1; k < nblk; ++k) { cur = MLA_REF(k); block2<CfgMLA, XP>(cur, lds, S, 8 + (((vcu + (k >> 1) * G) >> 4) & 3), tid); }
#endif
#else
            prime<CfgMLA>(cur, lds, S, tid);
            for (int k = 0; k < nblk; ++k) { const BlockRef<CfgMLA> nxt = (k + 1 < nblk) ? MLA_REF(k + 1) : cur; block<CfgMLA>(cur, nxt, lds, S, 8 + (((vcu + (k >> 1) * G) >> 4) & 3), tid); cur = nxt; }
#endif
#undef MLA_REF
        }
    }
    {
        const int nit = (256 - vcu + G - 1) / G;
        const int nblk = 4 * (nit > 0 ? nit : 0);
        if (nblk > 0) {
            Seam<CfgSWA> S; int tid = threadIdx.x; asm volatile("" : "+v"(tid));
#define SWA_REF(k) swa_ref(ws, sinks, (4 * (vcu + ((k) >> 2) * G) + ((k) & 3)) >> 5, (4 * (vcu + ((k) >> 2) * G) + ((k) & 3)) & 31)
            BlockRef<CfgSWA> cur = SWA_REF(0);
#if ATT_SKEW_SWA
            for (int k = 0; k < nblk; ++k) { cur = SWA_REF(k); block2<CfgSWA, XP>(cur, lds, S, ((4 * (vcu + (k >> 2) * G) + (k & 3)) >> 5) & 7, tid); }
#else
            prime<CfgSWA>(cur, lds, S, tid);
            for (int k = 0; k < nblk; ++k) { const BlockRef<CfgSWA> nxt = (k + 1 < nblk) ? SWA_REF(k + 1) : cur; block<CfgSWA>(cur, nxt, lds, S, ((4 * (vcu + (k >> 2) * G) + (k & 3)) >> 5) & 7, tid); cur = nxt; }
#endif
#undef SWA_REF
        }
    }
}
}

struct EpiOut {
    static constexpr bool PERM = true, MIDK = true;
    unsigned char* ws;
    __device__ __forceinline__ void midk(f32x4 (&acc)[2][2][4][2], const pg8::Unit& u, int wr, int wc, int fr, int fq) const {
        const char* SSQb = (const char*)(ws + WS_SSQ) + (size_t)u.pm * (256 * 48);
        unsigned lo = (unsigned)(wr * 64 + fr) * 48u; asm volatile("" : "+v"(lo));
#pragma unroll
        for (int ai = 0; ai < 2; ++ai) {
            f32x4 s0[4], s1[4], s2[4];
#pragma unroll
            for (int m = 0; m < 4; ++m) { const char* p = SSQb + (size_t)(lo + (unsigned)((ai * 128 + m * 16) * 48)); s0[m] = *(const f32x4*)p; s1[m] = *(const f32x4*)(p + 16); s2[m] = *(const f32x4*)(p + 32); }
#pragma unroll
            for (int m = 0; m < 4; ++m) {
                const float sa = ((s0[m][0] + s0[m][1]) + (s0[m][2] + s0[m][3])) + ((s1[m][0] + s1[m][1]) + (s1[m][2] + s1[m][3])), sb = (s2[m][0] + s2[m][1]) + (s2[m][2] + s2[m][3]);
                const float rho = sqrtf((sb * (1.f / 512.f) + RMS_EPS) / (sa * (1.f / 512.f) + RMS_EPS));
#pragma unroll
                for (int bj = 0; bj < 2; ++bj)
#pragma unroll
                    for (int n = 0; n < 2; ++n) acc[ai][bj][m][n] *= rho; }
            asm volatile("" ::: "memory"); }
    }
    __device__ __forceinline__ void operator()(const f32x4 (&acc)[2][2][4][2], const pg8::Unit& u, int wr, int wc, int fr, int fq) const {
        const char* SSQb = (const char*)(ws + WS_SSQ) + (size_t)u.pm * (256 * 48) + 32;
        const size_t tile = ((size_t)u.pm * 256) * DM + (size_t)u.pn * 256;
        const char* H0b = (const char*)(ws + WS_H0) + tile * 2; char* Pb = (char*)(ws + WS_PRE1) + tile * 2;
        unsigned lo = (unsigned)(wr * 64 + fr) * 48u, eo = (unsigned)((wr * 64 + fr) * DM + wc * 32 + 8 * fq) * 2u; asm volatile("" : "+v"(lo), "+v"(eo));
        f32x4 s2[8];
#pragma unroll
        for (int q = 0; q < 8; ++q) s2[q] = *(const f32x4*)(SSQb + (size_t)(lo + (unsigned)(((q >> 2) * 128 + (q & 3) * 16) * 48)));
#pragma unroll
        for (int ai = 0; ai < 2; ++ai) {
            u32x4 h[4][2];
#pragma unroll
            for (int m = 0; m < 4; ++m)
#pragma unroll
                for (int bj = 0; bj < 2; ++bj) h[m][bj] = *(const u32x4*)(H0b + (size_t)(eo + (unsigned)(((ai * 128 + m * 16) * DM + bj * 128) * 2)));
#pragma unroll
            for (int m = 0; m < 4; ++m) { const f32x4 sq = s2[ai * 4 + m];
                const float rb = 1.f / sqrtf(((sq[0] + sq[1]) + (sq[2] + sq[3])) * (1.f / 512.f) + RMS_EPS);
#pragma unroll
                for (int bj = 0; bj < 2; ++bj) { const u32x4 hv = h[m][bj]; f32x4 o0 = acc[ai][bj][m][0] * rb, o1 = acc[ai][bj][m][1] * rb;
                    o0[0] += ALPHA * __uint_as_float(hv.x << 16); o0[1] += ALPHA * __uint_as_float(hv.x & 0xffff0000u); o0[2] += ALPHA * __uint_as_float(hv.y << 16); o0[3] += ALPHA * __uint_as_float(hv.y & 0xffff0000u);
                    o1[0] += ALPHA * __uint_as_float(hv.z << 16); o1[1] += ALPHA * __uint_as_float(hv.z & 0xffff0000u); o1[2] += ALPHA * __uint_as_float(hv.w << 16); o1[3] += ALPHA * __uint_as_float(hv.w & 0xffff0000u);
                    ST16(Pb + (size_t)(eo + (unsigned)(((ai * 128 + m * 16) * DM + bj * 128) * 2)), pg8::pack8(o0, o1)); } }
            asm volatile("" ::: "memory"); }
    }
};

__device__ __forceinline__ void split_bf16x8(const f32x4 x0, const f32x4 x1, bf16x8& hi, bf16x8& lo) {
    unsigned h[8]; float r[8];
#pragma unroll
    for (int e = 0; e < 4; ++e) { h[e] = f2bf(x0[e]); r[e] = x0[e] - __uint_as_float(h[e] << 16); h[4 + e] = f2bf(x1[e]); r[4 + e] = x1[e] - __uint_as_float(h[4 + e] << 16); }
    u32x4 hw, lw;
    hw.x = h[0] | (h[1] << 16); hw.y = h[2] | (h[3] << 16); hw.z = h[4] | (h[5] << 16); hw.w = h[6] | (h[7] << 16);
    lw.x = pk2(r[0], r[1]); lw.y = pk2(r[2], r[3]); lw.z = pk2(r[4], r[5]); lw.w = pk2(r[6], r[7]);
    hi = __builtin_bit_cast(bf16x8, hw); lo = __builtin_bit_cast(bf16x8, lw);
}
__device__ __forceinline__ void p5_ln1_router(const Frame& F, const Args& a) {
    constexpr int RS = 1032;
    LAS float* hrow = (LAS float*)F.lds;
    LAS float* part = (LAS float*)(F.lds + 16 * RS * 4);
    LAS float* lg = part + 8 * 16 * 48;
    const int tid5 = threadIdx.x, lane = tid5 & 63, w = F.wave, fr = lane & 15, fq = lane >> 4;
    const bf16_t* PRE1 = (const bf16_t*)(F.ws + WS_PRE1); bf16_t* H1 = (bf16_t*)(F.ws + WS_H1);
    const float* g1 = a.in[13]; const float* b1 = a.in[14]; const float* wg = a.in[15]; const float* bg = a.in[16]; const float* wr = a.in[17]; const float* br = a.in[18];
    int* list = (int*)(F.ws + WS_LIST); float* ew = (float*)(F.ws + WS_EW);
    bf16x8 Bh[4][3], Bl[4][3];
#pragma unroll
    for (int s = 0; s < 4; ++s)
#pragma unroll
        for (int cb = 0; cb < 3; ++cb) { const int n = cb * 16 + fr; float x[8];
#pragma unroll
            for (int j = 0; j < 8; ++j) { const int k = 128 * w + 32 * s + 8 * fq + j; x[j] = n < 4 ? wg[k * 4 + n] : (n < 36 ? wr[k * 32 + (n - 4)] : 0.f); }
            split_bf16x8((f32x4){x[0], x[1], x[2], x[3]}, (f32x4){x[4], x[5], x[6], x[7]}, Bh[s][cb], Bl[s][cb]); }
    u32x2 pv[2][4];
    int it = F.bx;
    if (it < T / 16) {
#pragma unroll
        for (int rr = 0; rr < 2; ++rr)
#pragma unroll
            for (int j = 0; j < 4; ++j) pv[rr][j] = *(const u32x2*)(PRE1 + (size_t)(it * 16 + 2 * w + rr) * DM + j * 256 + lane * 4);
    }
    for (; it < T / 16; it += F.G) {
        const int R0 = it * 16;
#pragma unroll
        for (int rr = 0; rr < 2; ++rr) { const int r = 2 * w + rr;
            f32x4 v[4]; float s = 0.f;
#pragma unroll
            for (int j = 0; j < 4; ++j) { const u32x2 q2 = pv[rr][j]; v[j].x = __uint_as_float(q2.x << 16); v[j].y = __uint_as_float(q2.x & 0xffff0000u); v[j].z = __uint_as_float(q2.y << 16); v[j].w = __uint_as_float(q2.y & 0xffff0000u); s += (v[j].x + v[j].y) + (v[j].z + v[j].w); }
            const float mean = wave_sum(s) * (1.f / DM); float s2 = 0.f;
#pragma unroll
            for (int j = 0; j < 4; ++j) { v[j] = v[j] - mean; s2 += (v[j].x * v[j].x + v[j].y * v[j].y) + (v[j].z * v[j].z + v[j].w * v[j].w); }
            const float rstd = 1.f / sqrtf(wave_sum(s2) * (1.f / DM) + LN_EPS);
#pragma unroll
            for (int j = 0; j < 4; ++j) { const int c = j * 256 + lane * 4; const f32x4 gg = *(const f32x4*)(g1 + c), bb = *(const f32x4*)(b1 + c);
                const f32x4 o = v[j] * rstd * gg + bb; *(LAS f32x4*)(hrow + r * RS + c) = o;
                u32x2 pw; pw.x = pk2(o.x, o.y); pw.y = pk2(o.z, o.w); *(u32x2*)(H1 + (size_t)(R0 + r) * DM + c) = pw; } }
        __syncthreads();
        if (it + F.G < T / 16) {
#pragma unroll
            for (int rr = 0; rr < 2; ++rr)
#pragma unroll
                for (int j = 0; j < 4; ++j) pv[rr][j] = *(const u32x2*)(PRE1 + (size_t)((it + F.G) * 16 + 2 * w + rr) * DM + j * 256 + lane * 4);
        }
        f32x4 c0 = {0.f, 0.f, 0.f, 0.f}, c1 = c0, c2 = c0;
#pragma unroll
        for (int s = 0; s < 4; ++s) { const LAS float* ap = hrow + fr * RS + 128 * w + 32 * s + 8 * fq;
            bf16x8 ah, al; split_bf16x8(*(const LAS f32x4*)ap, *(const LAS f32x4*)(ap + 4), ah, al);
            c0 = __builtin_amdgcn_mfma_f32_16x16x32_bf16(ah, Bh[s][0], c0, 0, 0, 0); c0 = __builtin_amdgcn_mfma_f32_16x16x32_bf16(al, Bh[s][0], c0, 0, 0, 0); c0 = __builtin_amdgcn_mfma_f32_16x16x32_bf16(ah, Bl[s][0], c0, 0, 0, 0);
            c1 = __builtin_amdgcn_mfma_f32_16x16x32_bf16(ah, Bh[s][1], c1, 0, 0, 0); c1 = __builtin_amdgcn_mfma_f32_16x16x32_bf16(al, Bh[s][1], c1, 0, 0, 0); c1 = __builtin_amdgcn_mfma_f32_16x16x32_bf16(ah, Bl[s][1], c1, 0, 0, 0);
            c2 = __builtin_amdgcn_mfma_f32_16x16x32_bf16(ah, Bh[s][2], c2, 0, 0, 0); c2 = __builtin_amdgcn_mfma_f32_16x16x32_bf16(al, Bh[s][2], c2, 0, 0, 0); c2 = __builtin_amdgcn_mfma_f32_16x16x32_bf16(ah, Bl[s][2], c2, 0, 0, 0); }
#pragma unroll
        for (int j = 0; j < 4; ++j) { LAS float* pp = part + (w * 16 + fq * 4 + j) * 48 + fr; pp[0] = c0[j]; pp[16] = c1[j]; pp[32] = c2[j]; }
        __syncthreads();
        for (int idx = tid5; idx < 16 * 48; idx += NWAVES * 64) { float sum = 0.f;
#pragma unroll
            for (int q = 0; q < 8; ++q) sum += part[q * 768 + idx];
            lg[idx] = sum; }
        __syncthreads();
        if (tid5 < 16) { const int m = R0 + tid5; const LAS float* L = lg + tid5 * 48;
            const float l0 = L[0] + bg[0], l1 = L[1] + bg[1], l2 = L[2] + bg[2], l3 = L[3] + bg[3];
            const float mx = fmaxf(fmaxf(l0, l1), fmaxf(l2, l3));
            const float ex0 = expf(l0 - mx), ex1 = expf(l1 - mx), ex2 = expf(l2 - mx), ex3 = expf(l3 - mx);
            const float se = ((ex0 + ex1) + ex2) + ex3;
            int gi = 0; float gt = ex0 / se;
            { const float p = ex1 / se; if (p > gt) { gt = p; gi = 1; } }
            { const float p = ex2 / se; if (p > gt) { gt = p; gi = 2; } }
            { const float p = ex3 / se; if (p > gt) { gt = p; gi = 3; } }
            int e1 = 0, e2 = -1; float t1 = -INFINITY, t2 = -INFINITY;
#pragma unroll 1
            for (int i = 0; i < 8; ++i) { const float v = L[4 + gi * 8 + i] + br[gi * 8 + i];
                if (v > t1) { t2 = t1; e2 = e1; t1 = v; e1 = i; } else if (v > t2) { t2 = v; e2 = i; } }
            const float z = expf(t2 - t1), w1 = gt / (1.f + z), w2 = gt * z / (1.f + z);
            const int ea = gi * 8 + e1, eb = gi * 8 + e2;
            const unsigned pa = atomicAdd(&F.ctl[CW_CNT + 64 * ea], 1u); const unsigned pb = atomicAdd(&F.ctl[CW_CNT + 64 * eb], 1u);
            list[(size_t)ea * T + pa] = m * 2; list[(size_t)eb * T + pb] = m * 2 + 1; ew[m * 2] = w1; ew[m * 2 + 1] = w2; }
    }
}

struct MoeOrder {
    const unsigned* ctl; const int* list; const char* A; const char* Bt; int nN, G, c; bool gather;
    __device__ bool next(int i, pg8::Unit& u) const {
        if (G % 8 == 0) {
            const int x = c & 7, slot = c >> 3, ns = G >> 3; const int j = i * ns + slot; const int tlx = j / nN; int accx = 0, accg = 0; bool found = false;
            for (int e = 0; e < 32; ++e) { const int cn = (int)ctl[CW_CNT + 64 * e]; const int nt = (cn + 255) >> 8;
                if ((e & 7) == x) { if (!found && tlx < accx + nt) { u.e = e; u.r0 = (tlx - accx) * 256; u.n = cn; u.pm = accg + (tlx - accx); u.pn = j % nN; found = true; } accx += nt; }
                accg += nt; }
            return found; }
        const int L = i * G + c; const int tl = L / nN; int acc = 0;
        for (int e = 0; e < 32; ++e) { const int cn = (int)ctl[CW_CNT + 64 * e]; const int nt = (cn + 255) >> 8;
            if (tl < acc + nt) { u.e = e; u.r0 = (tl - acc) * 256; u.n = cn; u.pm = tl; u.pn = L % nN; return true; } acc += nt; }
        return false;
    }
    __device__ __forceinline__ const char* abase(const pg8::Unit& u) const { return gather ? A : A + (size_t)u.pm * 256 * 256 * 2; }
    __device__ __forceinline__ const char* bbase(const pg8::Unit& u) const { return gather ? Bt + ((size_t)u.e * 512 + u.pn * 256) * DM * 2 : Bt + ((size_t)u.e * 1024 + u.pn * 256) * 256 * 2; }
    __device__ __forceinline__ unsigned arow_off(const pg8::Unit& u, int R) const {
        if (!gather) return (unsigned)(R * 256) * 2u;
        const int idx = (u.r0 + R < u.n) ? list[(size_t)u.e * T + u.r0 + R] : 0;
        return (unsigned)(idx >> 1) * (unsigned)(DM * 2);
    }
};
struct EpiGU {
    static constexpr bool PERM = true, MIDK = false;
    unsigned char* ws;
    __device__ __forceinline__ void operator()(const f32x4 (&acc)[2][2][4][2], const pg8::Unit& u, int wr, int wc, int fr, int fq) const {
        const char* listb = (const char*)(ws + WS_LIST) + ((size_t)u.e * T + u.r0) * 4; const char* ewb = (const char*)(ws + WS_EW);
        char* Hb = (char*)(ws + WS_HID) + (((size_t)u.pm * 256) * 256 + u.pn * 128) * 2;
        int Rl = wr * 64 + fr; const int nrem = u.n - u.r0; asm volatile("" : "+v"(Rl));
        const unsigned ho = (unsigned)(Rl * 256 + wc * 32 + 8 * fq) * 2u;
        unsigned idx[8]; float wgt[8];
#pragma unroll
        for (int q = 0; q < 8; ++q) { const int R = Rl + (q >> 2) * 128 + (q & 3) * 16; idx[q] = (R < nrem) ? *(const unsigned*)(listb + (size_t)((unsigned)R * 4u)) : 0xffffffffu; }
#pragma unroll
        for (int q = 0; q < 8; ++q) wgt[q] = (idx[q] != 0xffffffffu) ? *(const float*)(ewb + (size_t)(idx[q] * 4u)) : 0.f;
#pragma unroll
        for (int ai = 0; ai < 2; ++ai)
#pragma unroll
            for (int m = 0; m < 4; ++m) { const float wg_ = wgt[ai * 4 + m];
                f32x4 o[2];
#pragma unroll
                for (int n = 0; n < 2; ++n) { const f32x4 gv = acc[ai][0][m][n], uv = acc[ai][1][m][n];
#pragma unroll
                    for (int e = 0; e < 4; ++e) o[n][e] = gv[e] * __builtin_amdgcn_rcpf(1.f + __builtin_amdgcn_exp2f(-1.4426950408889634f * gv[e])) * uv[e] * wg_; }
                ST16(Hb + (size_t)(ho + (unsigned)((ai * 128 + m * 16) * 512)), pg8::pack8(o[0], o[1])); }
    }
};
struct EpiDown {
    static constexpr bool PERM = true, MIDK = false;
    unsigned char* ws;
    __device__ __forceinline__ void operator()(const f32x4 (&acc)[2][2][4][2], const pg8::Unit& u, int wr, int wc, int fr, int fq) const {
        const char* listb = (const char*)(ws + WS_LIST) + ((size_t)u.e * T + u.r0) * 4; char* Yb = (char*)(ws + WS_Y) + (size_t)(u.pn * 256) * 2;
        int Rl = wr * 64 + fr; const int nrem = u.n - u.r0; asm volatile("" : "+v"(Rl));
        const unsigned yo = (unsigned)(wc * 32 + 8 * fq) * 2u;
        unsigned idx[8];
#pragma unroll
        for (int q = 0; q < 8; ++q) { const int R = Rl + (q >> 2) * 128 + (q & 3) * 16; idx[q] = (R < nrem) ? *(const unsigned*)(listb + (size_t)((unsigned)R * 4u)) : 0xffffffffu; }
#pragma unroll
        for (int ai = 0; ai < 2; ++ai)
#pragma unroll
            for (int m = 0; m < 4; ++m) { const unsigned ix = idx[ai * 4 + m];
                if (ix != 0xffffffffu) { char* y = Yb + (size_t)ix * (DM * 2) + yo;
                    ST16(y, pg8::pack8(acc[ai][0][m][0], acc[ai][0][m][1])); ST16((y + 256), pg8::pack8(acc[ai][1][m][0], acc[ai][1][m][1])); } }
    }
};

__device__ __forceinline__ void p8_ln2(const Frame& F, const Args& a) {
    const bf16_t* H1 = (const bf16_t*)(F.ws + WS_H1); const bf16_t* Y = (const bf16_t*)(F.ws + WS_Y); const float* g = a.in[22]; const float* b = a.in[23]; float* out = a.out;
    const int lane = threadIdx.x & 63; const int NGW = F.G * NWAVES;
    for (int m0 = F.bx * NWAVES + F.wave; m0 < T; m0 += 2 * NGW) {
        const int m1 = m0 + NGW; const bool two = m1 < T; const int mm[2] = {m0, two ? m1 : m0};
        u32x2 hq[2][4], y0[2][4], y1[2][4];
#pragma unroll
        for (int q = 0; q < 2; ++q)
#pragma unroll
            for (int j = 0; j < 4; ++j) { const int c = j * 256 + lane * 4; const size_t m = (size_t)mm[q];
                hq[q][j] = *(const u32x2*)(H1 + m * DM + c); y0[q][j] = *(const u32x2*)(Y + (2 * m) * DM + c); y1[q][j] = *(const u32x2*)(Y + (2 * m + 1) * DM + c); }
#pragma unroll
        for (int q = 0; q < 2; ++q) { if (q == 1 && !two) break;
            f32x4 v[4]; float s = 0.f;
#pragma unroll
            for (int j = 0; j < 4; ++j) { const u32x2 h = hq[q][j], a0 = y0[q][j], a1 = y1[q][j];
                v[j].x = ALPHA * __uint_as_float(h.x << 16) + __uint_as_float(a0.x << 16) + __uint_as_float(a1.x << 16);
                v[j].y = ALPHA * __uint_as_float(h.x & 0xffff0000u) + __uint_as_float(a0.x & 0xffff0000u) + __uint_as_float(a1.x & 0xffff0000u);
                v[j].z = ALPHA * __uint_as_float(h.y << 16) + __uint_as_float(a0.y << 16) + __uint_as_float(a1.y << 16);
                v[j].w = ALPHA * __uint_as_float(h.y & 0xffff0000u) + __uint_as_float(a0.y & 0xffff0000u) + __uint_as_float(a1.y & 0xffff0000u);
                s += (v[j].x + v[j].y) + (v[j].z + v[j].w); }
            const float mean = wave_sum(s) * (1.f / DM); float s2 = 0.f;
#pragma unroll
            for (int j = 0; j < 4; ++j) { v[j] = v[j] - mean; s2 += (v[j].x * v[j].x + v[j].y * v[j].y) + (v[j].z * v[j].z + v[j].w * v[j].w); }
            const float rstd = 1.f / sqrtf(wave_sum(s2) * (1.f / DM) + LN_EPS);
            float* orow = out + (size_t)mm[q] * DM;
#pragma unroll
            for (int j = 0; j < 4; ++j) { const int c = j * 256 + lane * 4; const f32x4 gg = *(const f32x4*)(g + c), bb = *(const f32x4*)(b + c);
                *(f32x4*)(orow + c) = v[j] * rstd * gg + bb; } }
    }
}

__global__ void __launch_bounds__(NWAVES * 64, 2) mega(Args args) {
    extern __shared__ __attribute__((aligned(16))) unsigned char lds_raw[];
    Frame F;
    F.lds = (LAS unsigned char*)lds_raw; F.ws = args.ws; F.ctl = (unsigned*)(args.ws + WS_CTL);
    F.tid = threadIdx.x; F.lane = F.tid & 63; F.wave = __builtin_amdgcn_readfirstlane(F.tid >> 6); F.G = gridDim.x; F.bx = blockIdx.x;
    volatile LAS unsigned* MISC = (volatile LAS unsigned*)(F.lds + MISC_OFF);
    for (int u = F.tid; u < (LDS_BYTES - LDSCTL_OFF) / 4; u += NWAVES * 64) ((LAS unsigned*)(F.lds + LDSCTL_OFF))[u] = 0u;
    __syncthreads();
    XcdBarrier bar = xcd_barrier_post(F.ctl + CW_BAR, MISC + 8);
    const int lo = args.ph_lo, hi = args.ph_hi;
#define IN(k) (lo <= (k) && (k) < hi)
#define BOTH(k) (IN(k) && IN((k) + 1))
    if (IN(0)) { p0_prologue(F, args); if (BOTH(0)) xcd_barrier(bar); }
    if (IN(1)) {
        pg8::StaticOrder S; S.init(args.ws + WS_H0, args.ws + WS_WIN, T, 1536, DM, F.G, F.bx);
        EpiInProj E{args.ws};
        pg8::gemm_phase<EpiInProj, pg8::StaticOrder, true>(F.lds, DM, S, E);
        if (BOTH(1)) xcd_barrier(bar);
    }
    if (IN(2)) {
        { int q = F.bx;
          if (F.G % 8 == 0 && F.G >= 224) { const int slot = F.bx >> 3; q = slot >= 16 ? (slot - 16) * 8 + (F.bx & 7) : 1 << 20; }
          for (; q < 84; q += F.G) p2_meta(F, args, q); }
        UpOrder S{(const char*)(args.ws + WS_CQ), (const char*)(args.ws + WS_CKV), (const char*)(args.ws + WS_WUQ), (const char*)(args.ws + WS_WUKV), F.G, F.bx};
        EpiUp E{args.ws};
        pg8::gemm_phase<EpiUp, UpOrder, true>(F.lds, 256, S, E);
        if (BOTH(2)) xcd_barrier(bar);
    }
    if (IN(3)) {
        const int vcu = (F.G % 8 == 0) ? (F.bx % 8) * (F.G / 8) + F.bx / 8 : F.bx;
        att::attn_phase<0>((char*)lds_raw, args.ws, args.in[5], vcu, F.G, args.in[19], args.in[20], args.in[21]);
        if (BOTH(3)) xcd_barrier(bar);
    }
    if (IN(4)) {
        pg8::StaticOrder S; S.init(args.ws + WS_AO, args.ws + WS_WO, T, DM, DM, F.G, F.bx);
        EpiOut E{args.ws};
        pg8::gemm_phase<EpiOut, pg8::StaticOrder, true>(F.lds, DM, S, E);
        if (BOTH(4)) xcd_barrier(bar);
    }
    if (IN(5)) { p5_ln1_router(F, args); if (BOTH(5)) xcd_barrier(bar); }
    if (IN(6)) {
        MoeOrder S{F.ctl, (const int*)(args.ws + WS_LIST), (const char*)(args.ws + WS_H1), (const char*)(args.ws + WS_WGU), 2, F.G, F.bx, true};
        EpiGU E{args.ws};
        pg8::gemm_phase<EpiGU, MoeOrder, true>(F.lds, DM, S, E);
        if (BOTH(6)) xcd_barrier(bar);
    }
    if (IN(7)) {
        MoeOrder S{F.ctl, (const int*)(args.ws + WS_LIST), (const char*)(args.ws + WS_HID), (const char*)(args.ws + WS_WDN), 4, F.G, F.bx, false};
        EpiDown E{args.ws};
        pg8::gemm_phase<EpiDown, MoeOrder, true>(F.lds, 256, S, E);
        if (BOTH(7)) xcd_barrier(bar);
    }
    if (IN(8)) { p8_ln2(F, args); }
#undef IN
#undef BOTH
}

extern "C" void kernel_launch(void* const* d_in, const int* in_sizes, int n_in, void* d_out, int out_size, void* d_ws, size_t ws_size, hipStream_t stream) {
    static int grid = 0;
    if (grid == 0) {
        if (n_in != 24 || ws_size < WS_END || out_size != T * DM) { fprintf(stderr, "kernel_launch: unexpected shapes n_in=%d ws=%zu out=%d\n", n_in, ws_size, out_size); grid = -1; return; }
        int dev = 0, cus = 0, per_cu = 0;
        if (hipGetDevice(&dev) != hipSuccess || hipDeviceGetAttribute(&cus, hipDeviceAttributeMultiprocessorCount, dev) != hipSuccess) { grid = -1; return; }
        if (hipFuncSetAttribute((const void*)mega, hipFuncAttributeMaxDynamicSharedMemorySize, LDS_BYTES) != hipSuccess) { fprintf(stderr, "hipFuncSetAttribute failed\n"); grid = -1; return; }
        if (hipOccupancyMaxActiveBlocksPerMultiprocessor(&per_cu, (const void*)mega, NWAVES * 64, LDS_BYTES) != hipSuccess || per_cu < 1) { fprintf(stderr, "occupancy query: %d blocks per CU\n", per_cu); (void)hipGetLastError(); grid = -1; return; }
        (void)hipGetLastError();
        grid = cus;
    }
    if (grid < 0) return;
    static_assert((CW_BAR + XCD_BAR_WORDS) * 4 <= 32768 && (CW_CNT + 64 * 32) * 4 <= 32768, "control words inside the per-call memset");
    (void)hipMemsetAsync((unsigned char*)d_ws + WS_CTL, 0, 32768, stream);
    Args a{};
    for (int i = 0; i < 24; ++i) a.in[i] = (const float*)d_in[i];
    a.out = (float*)d_out; a.ws = (unsigned char*)d_ws; a.ph_lo = 0; a.ph_hi = 9;
    hipLaunchKernelGGL(mega, dim3(grid), dim3(NWAVES * 64), LDS_BYTES, stream, a);
}
```
